# Optimizing an MI355X kernel written in HIP

```python
import math
import jax
import jax.numpy as jnp
from jax import lax
import numpy as np

D_MODEL = 2048
BATCH = 1
SEQ = 16384
DEPTH = 2

HEAD_DIM = 128
N_HEADS_TOTAL = D_MODEL // HEAD_DIM
N_HEADS_A = N_HEADS_TOTAL // 2
N_HEADS_B = N_HEADS_TOTAL - N_HEADS_A
N_HEADS_C = N_HEADS_TOTAL // 2
N_HEADS_D = N_HEADS_TOTAL - N_HEADS_C
DIFF_QK_DIM = HEAD_DIM // 2
Q_BLOCK = 128
MOBA_BLOCK = 256
MOBA_TOPK = 3
MOBA_Q_CHUNK = 32
N_BUCKETS = 32
MAX_EXACT = N_BUCKETS // 2
MAX_DISTANCE = 1024
N_EXPERTS = 16
N_GROUPS = 4
EXPERTS_PER_GROUP = N_EXPERTS // N_GROUPS
TOP_K = 2
D_EXPERT = D_MODEL // 2
ALPHA = (2.0 * DEPTH) ** 0.25
BETA = (8.0 * DEPTH) ** -0.25
LN_EPS = 1e-5
NEG_INF = -1e30
N_EVEN = (DEPTH + 1) // 2
N_ODD = DEPTH // 2
EVEN_SIZES = (N_HEADS_A * HEAD_DIM,) * 3 + (N_HEADS_A,) + (N_HEADS_B * HEAD_DIM,) * 3
ODD_SIZES = (N_HEADS_C * HEAD_DIM,) * 3 + (N_HEADS_D * HEAD_DIM,) * 3

kernel_name = "hybrid_fox_moba_diff_stickbreak_grouped_moe"


def _split_points(sizes):
    return [int(v) for v in np.cumsum(np.asarray(sizes))[:-1]]


def _value_col_scale(sizes, value_slots):
    parts = [np.full((n,), BETA if i in value_slots else 1.0, np.float32) for i, n in enumerate(sizes)]
    return jnp.asarray(np.concatenate(parts))


def layer_norm(x, g, b):
    xf = x.astype(jnp.float32)
    mu = jnp.mean(xf, axis=-1, keepdims=True)
    var = jnp.mean(jnp.square(xf - mu), axis=-1, keepdims=True)
    return ((xf - mu) * lax.rsqrt(var + LN_EPS) * g + b).astype(x.dtype)


def to_heads(t, n_heads):
    b, s, _ = t.shape
    return t.reshape(b, s, n_heads, -1).transpose(0, 2, 1, 3)


def merge_heads(o):
    b, h, s, d = o.shape
    return o.transpose(0, 2, 1, 3).reshape(b, s, h * d)


def t5_bucket(dist):
    n = jnp.maximum(dist, 0)
    nf = jnp.maximum(n, 1).astype(jnp.float32)
    large = MAX_EXACT + (jnp.log(nf / MAX_EXACT) / math.log(MAX_DISTANCE / MAX_EXACT)
                         * (N_BUCKETS - MAX_EXACT)).astype(jnp.int32)
    large = jnp.minimum(large, N_BUCKETS - 1)
    return jnp.where(n < MAX_EXACT, n, large)


def map_query_blocks(fn, q_like, block):
    s = q_like[0].shape[2]
    nblk = s // block

    def split(t):
        t = t.reshape(t.shape[0], t.shape[1], nblk, block, *t.shape[3:])
        return jnp.moveaxis(t, 2, 0)

    xs = (jnp.arange(nblk, dtype=jnp.int32) * block,) + tuple(split(t) for t in q_like)
    out = lax.map(lambda a: fn(*a), xs)
    out = jnp.moveaxis(out, 0, 2)
    return out.reshape(out.shape[0], out.shape[1], s, out.shape[-1])


def forgetting_attention(q, k, v, log_f):
    s = k.shape[2]
    c = lax.cumsum(log_f, axis=2)
    kpos = jnp.arange(s)
    scale = HEAD_DIM ** -0.5

    def block(start, qb, cb):
        qpos = start + jnp.arange(Q_BLOCK)
        logits = jnp.einsum('bhqd,bhkd->bhqk', qb, k, preferred_element_type=jnp.float32) * scale
        logits = logits + cb[..., :, None] - c[..., None, :]
        logits = jnp.where(kpos[None, :] <= qpos[:, None], logits, NEG_INF)
        p = jax.nn.softmax(logits, axis=-1)
        return jnp.einsum('bhqk,bhkd->bhqd', p.astype(v.dtype), v)

    return map_query_blocks(block, (q, c), Q_BLOCK)


def moba_attention(q, k, v, rel_table):
    b, h, s, d = q.shape
    nblk = max(-(-s // MOBA_BLOCK), MOBA_TOPK)
    s_pad = nblk * MOBA_BLOCK
    pad = ((0, 0), (0, 0), (0, s_pad - s), (0, 0))
    kp = jnp.pad(k, pad)
    vp = jnp.pad(v, pad)
    kb = kp.reshape(b, h, nblk, MOBA_BLOCK, d)
    vb = vp.reshape(b, h, nblk, MOBA_BLOCK, d)
    kmean = jnp.mean(kb.astype(jnp.float32), axis=3)
    table_t = rel_table.T
    scale = HEAD_DIM ** -0.5
    bidx = jnp.arange(b)[:, None, None, None]
    hidx = jnp.arange(h)[None, :, None, None]
    inner = jnp.arange(MOBA_BLOCK)
    blk_ids = jnp.arange(nblk)

    def chunk(start, qc):
        qpos = start + jnp.arange(MOBA_Q_CHUNK)
        own = start // MOBA_BLOCK
        gate = jnp.einsum('bhqd,bhnd->bhqn', qc.astype(jnp.float32), kmean)
        gate = jnp.where(blk_ids < own, gate, NEG_INF)
        _, sel = lax.top_k(gate, MOBA_TOPK)
        valid = jnp.arange(MOBA_TOPK) < own
        ks = kb[bidx, hidx, sel]
        vs = vb[bidx, hidx, sel]
        k_own = lax.dynamic_slice_in_dim(kp, own * MOBA_BLOCK, MOBA_BLOCK, axis=2)
        v_own = lax.dynamic_slice_in_dim(vp, own * MOBA_BLOCK, MOBA_BLOCK, axis=2)
        pos_sel = sel[..., None] * MOBA_BLOCK + inner
        pos_own = own * MOBA_BLOCK + inner
        bias_sel = table_t[hidx[..., None], t5_bucket(qpos[None, None, :, None, None] - pos_sel)]
        bias_own = jnp.take(table_t, t5_bucket(qpos[:, None] - pos_own[None, :]), axis=1)
        l_sel = jnp.einsum('bhqd,bhqnkd->bhqnk', qc, ks, preferred_element_type=jnp.float32) * scale
        l_sel = jnp.where(valid[:, None], l_sel + bias_sel, NEG_INF)
        l_own = jnp.einsum('bhqd,bhkd->bhqk', qc, k_own, preferred_element_type=jnp.float32) * scale
        l_own = jnp.where(pos_own[None, :] <= qpos[:, None], l_own + bias_own[None], NEG_INF)
        logits = jnp.concatenate([l_sel.reshape(b, h, MOBA_Q_CHUNK, MOBA_TOPK * MOBA_BLOCK), l_own], axis=-1)
        p = jax.nn.softmax(logits, axis=-1).astype(v.dtype)
        p_sel = p[..., :MOBA_TOPK * MOBA_BLOCK].reshape(b, h, MOBA_Q_CHUNK, MOBA_TOPK, MOBA_BLOCK)
        p_own = p[..., MOBA_TOPK * MOBA_BLOCK:]
        return (jnp.einsum('bhqnk,bhqnkd->bhqd', p_sel, vs)
                + jnp.einsum('bhqk,bhkd->bhqd', p_own, v_own))

    return map_query_blocks(chunk, (q,), MOBA_Q_CHUNK)


def differential_attention(q, k, v, lam, rel_table, subln_g, lambda_init):
    s = k.shape[2]
    kpos = jnp.arange(s)
    table_t = rel_table.T
    scale = DIFF_QK_DIM ** -0.5

    def block(start, qb):
        qpos = start + jnp.arange(Q_BLOCK)
        dist = qpos[:, None] - kpos[None, :]
        bias = jnp.take(table_t, t5_bucket(dist), axis=1)
        logits = jnp.einsum('bhqid,bhkid->bhiqk', qb, k, preferred_element_type=jnp.float32) * scale
        logits = jnp.where(dist >= 0, logits + bias[None, :, None], NEG_INF)
        p = jax.nn.softmax(logits, axis=-1)
        attn = p[:, :, 0] - lam * p[:, :, 1]
        return jnp.einsum('bhqk,bhkd->bhqd', attn.astype(v.dtype), v)

    o = map_query_blocks(block, (q,), Q_BLOCK).astype(jnp.float32)
    o = o * lax.rsqrt(jnp.mean(o * o, axis=-1, keepdims=True) + LN_EPS) * subln_g
    return (o * (1.0 - lambda_init)).astype(v.dtype)


def stick_breaking_attention(q, k, v):
    s = k.shape[2]
    kpos = jnp.arange(s)
    scale = HEAD_DIM ** -0.5

    def block(start, qb):
        qpos = start + jnp.arange(Q_BLOCK)
        mask = kpos[None, :] < qpos[:, None]
        z = jnp.einsum('bhqd,bhkd->bhqk', qb, k, preferred_element_type=jnp.float32) * scale
        log_rem = jnp.where(mask, jax.nn.log_sigmoid(-z), 0.0)
        after = lax.cumsum(log_rem, axis=3, reverse=True) - log_rem
        a = jnp.where(mask, jnp.exp(jax.nn.log_sigmoid(z) + after), 0.0)
        return jnp.einsum('bhqk,bhkd->bhqd', a.astype(v.dtype), v)

    return map_query_blocks(block, (q,), Q_BLOCK)


def grouped_moe(x, w_router, b_router, w_gate, w_up, w_down):
    b, s, _ = x.shape
    logits = jnp.einsum('bsd,de->bse', x, w_router, preferred_element_type=jnp.float32) + b_router
    aff = jax.nn.softmax(logits.astype(jnp.float32), axis=-1)
    grp = aff.reshape(b, s, N_GROUPS, EXPERTS_PER_GROUP)
    g_sel = jnp.argmax(jnp.max(grp, axis=-1), axis=-1)
    g_onehot = jax.nn.one_hot(g_sel, N_GROUPS, dtype=grp.dtype)
    in_group = jnp.sum(grp * g_onehot[..., None], axis=2)
    top_val, top_loc = lax.top_k(in_group, TOP_K)
    top_w = top_val / jnp.sum(top_val, axis=-1, keepdims=True)
    expert_id = g_sel[..., None] * EXPERTS_PER_GROUP + top_loc
    gates = jnp.sum(jax.nn.one_hot(expert_id, N_EXPERTS, dtype=jnp.float32) * top_w[..., None], axis=-2)
    gates = gates.astype(x.dtype)
    out = jnp.zeros_like(x)
    for e in range(N_EXPERTS):
        hid = jax.nn.silu(x @ w_gate[e]) * (x @ w_up[e])
        out = out + gates[..., e:e + 1] * (hid @ w_down[e])
    return out


def setup_inputs(seed: int = 0) -> dict:
    key = jax.random.key(seed)
    ks = jax.random.split(key, 17)
    f32 = jnp.float32

    def nrm(k, shape, sc):
        return jax.random.normal(k, shape, f32) * sc

    mix_width = N_HEADS_TOTAL * HEAD_DIM
    x = nrm(ks[0], (BATCH, SEQ, D_MODEL), 1.0)
    w_in_even = nrm(ks[1], (N_EVEN, D_MODEL, sum(EVEN_SIZES)), D_MODEL ** -0.5) * _value_col_scale(EVEN_SIZES, (2, 6))
    w_out_even = nrm(ks[2], (N_EVEN, mix_width, D_MODEL), mix_width ** -0.5 * BETA)
    forget_bias = jax.random.uniform(ks[3], (N_EVEN, N_HEADS_A), f32, 1.0, 5.0)
    w_in_odd = nrm(ks[4], (N_ODD, D_MODEL, sum(ODD_SIZES)), D_MODEL ** -0.5) * _value_col_scale(ODD_SIZES, (2, 5))
    w_out_odd = nrm(ks[5], (N_ODD, mix_width, D_MODEL), mix_width ** -0.5 * BETA)
    lambda_q = nrm(ks[6], (N_ODD, 2, DIFF_QK_DIM), 0.1)
    lambda_k = nrm(ks[7], (N_ODD, 2, DIFF_QK_DIM), 0.1)
    subln_gain = 1.0 + nrm(ks[8], (N_ODD, HEAD_DIM), 0.02)
    rel_bias = nrm(ks[9], (N_BUCKETS, N_HEADS_B), 0.5)
    w_router = nrm(ks[10], (D_MODEL, N_EXPERTS), D_MODEL ** -0.5)
    b_router = nrm(ks[11], (N_EXPERTS,), 0.01)
    w_gate = nrm(ks[12], (DEPTH, N_EXPERTS, D_MODEL, D_EXPERT), D_MODEL ** -0.5)
    w_up = nrm(ks[13], (DEPTH, N_EXPERTS, D_MODEL, D_EXPERT), D_MODEL ** -0.5)
    w_down = nrm(ks[14], (DEPTH, N_EXPERTS, D_EXPERT, D_MODEL), D_EXPERT ** -0.5 * BETA)
    ln_gain = 1.0 + nrm(ks[15], (DEPTH, 2, D_MODEL), 0.02)
    ln_bias = nrm(ks[16], (DEPTH, 2, D_MODEL), 0.02)
    return {"x": x, "w_in_even": w_in_even, "w_out_even": w_out_even, "forget_bias": forget_bias,
            "w_in_odd": w_in_odd, "w_out_odd": w_out_odd, "lambda_q": lambda_q, "lambda_k": lambda_k,
            "subln_gain": subln_gain, "rel_bias": rel_bias, "w_router": w_router, "b_router": b_router,
            "w_gate": w_gate, "w_up": w_up, "w_down": w_down, "ln_gain": ln_gain, "ln_bias": ln_bias}


def reference(x, w_in_even, w_out_even, forget_bias, w_in_odd, w_out_odd, lambda_q, lambda_k,
              subln_gain, rel_bias, w_router, b_router, w_gate, w_up, w_down, ln_gain, ln_bias):
    b, s, _ = x.shape
    for layer in range(DEPTH):
        i = layer // 2
        if layer % 2 == 0:
            h = jnp.einsum('bsd,dc->bsc', x, w_in_even[i])
            qa, ka, va, fa, qb, kb, vb = jnp.split(h, _split_points(EVEN_SIZES), axis=-1)
            log_f = jax.nn.log_sigmoid((fa + forget_bias[i]).astype(jnp.float32)).transpose(0, 2, 1)
            oa = forgetting_attention(to_heads(qa, N_HEADS_A), to_heads(ka, N_HEADS_A),
                                      to_heads(va, N_HEADS_A), log_f)
            ob = moba_attention(to_heads(qb, N_HEADS_B), to_heads(kb, N_HEADS_B),
                                to_heads(vb, N_HEADS_B), rel_bias)
            o = jnp.concatenate([oa, ob], axis=1)
            y = jnp.einsum('bsc,cd->bsd', merge_heads(o), w_out_even[i])
        else:
            h = jnp.einsum('bsd,dc->bsc', x, w_in_odd[i])
            qc, kc, vc, qd, kd, vd = jnp.split(h, _split_points(ODD_SIZES), axis=-1)
            qc = to_heads(qc, N_HEADS_C).reshape(b, N_HEADS_C, s, 2, DIFF_QK_DIM)
            kc = to_heads(kc, N_HEADS_C).reshape(b, N_HEADS_C, s, 2, DIFF_QK_DIM)
            lambda_init = 0.8 - 0.6 * math.exp(-0.3 * layer)
            lq = lambda_q[i].astype(jnp.float32)
            lk = lambda_k[i].astype(jnp.float32)
            lam = jnp.exp(jnp.sum(lq[0] * lk[0])) - jnp.exp(jnp.sum(lq[1] * lk[1])) + lambda_init
            oc = differential_attention(qc, kc, to_heads(vc, N_HEADS_C), lam, rel_bias,
                                        subln_gain[i], lambda_init)
            od = stick_breaking_attention(to_heads(qd, N_HEADS_D), to_heads(kd, N_HEADS_D),
                                          to_heads(vd, N_HEADS_D))
            o = jnp.concatenate([oc, od], axis=1)
            y = jnp.einsum('bsc,cd->bsd', merge_heads(o), w_out_odd[i])
        x = layer_norm(ALPHA * x + y, ln_gain[layer, 0], ln_bias[layer, 0])
        ff = grouped_moe(x, w_router, b_router, w_gate[layer], w_up[layer], w_down[layer])
        x = layer_norm(ALPHA * x + ff, ln_gain[layer, 1], ln_bias[layer, 1])
    return x
```

```cpp
#include <hip/hip_runtime.h>
#include <cstdio>
#include <cstdint>

namespace pg8 {
#define PG8_LAS __attribute__((address_space(3)))
typedef unsigned short bf16_t;
typedef short bf16x8 __attribute__((ext_vector_type(8)));
typedef float f32x4 __attribute__((ext_vector_type(4)));
typedef unsigned u32x4 __attribute__((ext_vector_type(4)));
constexpr int BM = 256, BK = 64, HALF = 128, HTB = HALF * BK * 2  , STAGE_BYTES = 8 * HTB, NXCD = 8, WGM = 8;

__host__ __device__ __forceinline__ int lds_byte(int r, int c) { const int st = (r >> 4) * 2 + (c >> 5), rr = r & 15, cc = c & 31, ob = rr * 64 + cc * 2; return st * 1024 + (ob ^ (((ob >> 9) & 1) << 5)); }
__host__ __device__ __forceinline__ void stage_rc(int b, int& R, int& C) { const int st = b / 1024, sb = b % 1024, swz = sb ^ (((sb >> 9) & 1) << 5); R = (st >> 1) * 16 + swz / 64; C = (st & 1) * 32 + (swz % 64) / 2; }
__host__ __device__ __forceinline__ int perm32(int rho) { const int n = rho >> 4, i = rho & 15; return 8 * (i >> 2) + 4 * n + (i & 3); }

struct Unit { int pm, pn, e, mi; };
struct Gemm { const bf16_t* A; const bf16_t* Bt; int M, N, K, rb; };

struct DenseOrder {
    static constexpr bool GATHER = false;
    int nM, nN, nwg, G, c;
    __device__ void init(int M, int N, int G_, int c_) { nM = M / BM; nN = N / BM; nwg = nM * nN; G = G_; c = c_; }
    __device__ bool next(int i, Unit& u) const {
        const long L = (long)i * G + c; if (L >= nwg) return false;
        int wgid = (int)L; { const int q = nwg / NXCD, r = nwg % NXCD, xcd = wgid % NXCD, off = wgid / NXCD; wgid = (xcd < r ? xcd * (q + 1) : r * (q + 1) + (xcd - r) * q) + off; }
        const int nig = WGM * nN, gid = wgid / nig, fm = gid * WGM, gsz = (nM - fm) < WGM ? (nM - fm) : WGM;
        u.pm = fm + ((wgid % nig) % gsz); u.pn = (wgid % nig) / gsz; u.e = 0; u.mi = 0; return true;
    }
    __device__ __forceinline__ unsigned a_off(const Gemm& g, const Unit& u) const { return (unsigned)u.pm * (unsigned)(2 * HALF) * (unsigned)g.rb; }
    __device__ __forceinline__ unsigned b_off(const Gemm& g, const Unit& u) const { return (unsigned)u.pn * (unsigned)(2 * HALF) * (unsigned)g.rb; }
    __device__ __forceinline__ void a_voff(const Gemm& g, const Unit&, const int (&R)[2], const int (&C)[2], unsigned (&vo)[2][2]) const {
#pragma unroll
        for (int h = 0; h < 2; ++h)
#pragma unroll
            for (int i = 0; i < 2; ++i) vo[h][i] = (unsigned)((h * HALF + R[i]) * g.rb + C[i] * 2);
    }
};

__device__ __forceinline__ unsigned cvt_pk_bf16(float lo, float hi) { unsigned r; asm volatile("v_cvt_pk_bf16_f32 %0, %1, %2" : "=v"(r) : "v"(lo), "v"(hi)); return r; }

struct EpiBf16 {
    static constexpr bool PERM = true;
    bf16_t* O; int ldc;
    __device__ __forceinline__ void operator()(const f32x4 (&acc)[2][2][4][2], const Unit& u, int wr, int wc, int fr, int fq) const {
        const int row0 = u.pm * BM + wr * 64 + fr; const int col0 = u.pn * BM + wc * 32 + 8 * fq;
#pragma unroll
        for (int ai = 0; ai < 2; ++ai)
#pragma unroll
            for (int m = 0; m < 4; ++m) { bf16_t* rowp = O + (size_t)(row0 + ai * HALF + m * 16) * ldc + col0;
#pragma unroll
                for (int bj = 0; bj < 2; ++bj) { const f32x4 v0 = acc[ai][bj][m][0], v1 = acc[ai][bj][m][1];
                    u32x4 w; w.x = cvt_pk_bf16(v0[0], v0[1]); w.y = cvt_pk_bf16(v0[2], v0[3]); w.z = cvt_pk_bf16(v1[0], v1[1]); w.w = cvt_pk_bf16(v1[2], v1[3]);
                    *(u32x4*)(rowp + bj * HALF) = w; } }
    }
};

typedef int v8i_t __attribute__((ext_vector_type(8)));
typedef int v4i_t __attribute__((ext_vector_type(4)));
template <class Epi, class Sched, bool F8 = false, int SCW = 127, int SCX = 127>
__device__ __forceinline__ void gemm_phase(PG8_LAS unsigned char* lds, const Gemm g, const Sched& S, const Epi& E) {
    const int tid = threadIdx.x, wid = __builtin_amdgcn_readfirstlane(tid >> 6), lane = tid & 63, wr = wid >> 2, wc = wid & 3, fr = lane & 15, fq = lane >> 4;
    const int RB = g.rb, nt = RB / 128;
    unsigned voffB[2]; int sR[2], sC[2];
#pragma unroll
    for (int i = 0; i < 2; ++i) { int R, C; stage_rc(tid * 16 + i * 8192, R, C); const int Rb = Epi::PERM ? ((R & ~31) + perm32(R & 31)) : R;
        sR[i] = R; sC[i] = C; voffB[i] = (unsigned)(Rb * RB + C * 2); }
    const unsigned kstep = (unsigned)(BK * 2);
    const unsigned hstep = (unsigned)HALF * (unsigned)RB;
    const __amdgpu_buffer_rsrc_t rsA = __builtin_amdgcn_make_buffer_rsrc((void*)g.A, 0, 0x7ffffff0, 0x00020000), rsB = __builtin_amdgcn_make_buffer_rsrc((void*)g.Bt, 0, 0x7ffffff0, 0x00020000);
    const unsigned ldsw = (unsigned)wid * 1024u;
    const int aoff = lds_byte(wr * 64 + fr, fq * (F8 ? 16 : 8)), boff = lds_byte(wc * 32 + fr, fq * (F8 ? 16 : 8));
    constexpr int KOFF = F8 ? 16 : 1024;
#define PG8_SA(b, h) (((b) * 2 + (h)) * HTB)
#define PG8_SB(b, h) ((4 + (b) * 2 + (h)) * HTB)
#define PG8_STAGE(bufoff, rs, soff, voff) do { _Pragma("unroll") for (int _i = 0; _i < 2; ++_i) \
        __builtin_amdgcn_raw_ptr_buffer_load_lds(rs, (PG8_LAS void*)(lds + (bufoff) + ldsw + _i * 8192), 16, (int)(voff)[_i], (int)(soff), 0, 0); } while (0)
#define PG8_LD8(addr) __builtin_shufflevector(*(const PG8_LAS v4i_t*)(addr), *(const PG8_LAS v4i_t*)((addr) + 16), 0, 1, 2, 3, 4, 5, 6, 7)
#define PG8_LDA8(dst, b, h) do { _Pragma("unroll") for (int m = 0; m < 4; ++m) dst[m] = PG8_LD8(lds + PG8_SA(b, h) + aoff + m * 2048); } while (0)
#define PG8_LDB8(dst, b, h) do { _Pragma("unroll") for (int n = 0; n < 2; ++n) dst[n] = PG8_LD8(lds + PG8_SB(b, h) + boff + n * 2048); } while (0)
#define PG8_MMA8(ai, bj, At, Bt) do { __builtin_amdgcn_s_setprio(1); _Pragma("unroll") for (int m = 0; m < 4; ++m) _Pragma("unroll") for (int n = 0; n < 2; ++n) \
        acc[ai][bj][m][n] = __builtin_amdgcn_mfma_scale_f32_16x16x128_f8f6f4(Bt[n], At[m], acc[ai][bj][m][n], 0, 0, 0, SCW, 0, SCX); __builtin_amdgcn_s_setprio(0); } while (0)
#define PG8_LDA(dst, b, h) do { _Pragma("unroll") for (int m = 0; m < 4; ++m) _Pragma("unroll") for (int k = 0; k < 2; ++k) dst[m][k] = *(const PG8_LAS bf16x8*)(lds + PG8_SA(b, h) + aoff + m * 2048 + k * KOFF); } while (0)
#define PG8_LDB(dst, b, h) do { _Pragma("unroll") for (int n = 0; n < 2; ++n) _Pragma("unroll") for (int k = 0; k < 2; ++k) dst[n][k] = *(const PG8_LAS bf16x8*)(lds + PG8_SB(b, h) + boff + n * 2048 + k * KOFF); } while (0)
#define PG8_MMA(ai, bj, At, Bt) do { __builtin_amdgcn_s_setprio(1); _Pragma("unroll") for (int m = 0; m < 4; ++m) _Pragma("unroll") for (int n = 0; n < 2; ++n) _Pragma("unroll") for (int k = 0; k < 2; ++k) \
        acc[ai][bj][m][n] = __builtin_amdgcn_mfma_f32_16x16x32_bf16(Bt[n][k], At[m][k], acc[ai][bj][m][n], 0, 0, 0); __builtin_amdgcn_s_setprio(0); } while (0)
#define PG8_WAIT_V(n) asm volatile("s_waitcnt vmcnt(" #n ")" ::: "memory")
#define PG8_WAIT_L(n) asm volatile("s_waitcnt lgkmcnt(" #n ")" ::: "memory")
#define PG8_BAR __builtin_amdgcn_s_barrier()
#define PG8_SCHED __builtin_amdgcn_sched_barrier(0)
    Unit cur, nxt; int ui = 0;
    if (!S.next(0, cur)) return;
    f32x4 acc[2][2][4][2];
#pragma unroll
    for (int a = 0; a < 2; ++a)
#pragma unroll
        for (int b = 0; b < 2; ++b)
#pragma unroll
            for (int m = 0; m < 4; ++m)
#pragma unroll
                for (int n = 0; n < 2; ++n) acc[a][b][m][n] = (f32x4){0.f, 0.f, 0.f, 0.f};
    bf16x8 At[4][2], B0[2][2], B1[2][2];
    v8i_t At8[4], B08[2], B18[2];
    unsigned vAc[2][2], vAn[2][2];
    S.a_voff(g, cur, sR, sC, vAc);
    if constexpr (Sched::GATHER) { asm volatile("s_waitcnt vmcnt(0)" ::: "memory"); asm volatile("" : "+v"(vAc[0][0]), "+v"(vAc[0][1]), "+v"(vAc[1][0]), "+v"(vAc[1][1])); }
    unsigned cA = S.a_off(g, cur), cB = S.b_off(g, cur);
    PG8_STAGE(PG8_SB(0, 0), rsB, cB, voffB); PG8_STAGE(PG8_SB(0, 1), rsB, cB + hstep, voffB); PG8_STAGE(PG8_SA(0, 0), rsA, cA, vAc[0]); PG8_STAGE(PG8_SA(0, 1), rsA, cA, vAc[1]);
    if (wr == 1) PG8_BAR;
    PG8_WAIT_V(2); PG8_BAR;
    PG8_STAGE(PG8_SB(1, 0), rsB, cB + kstep, voffB); PG8_STAGE(PG8_SA(1, 0), rsA, cA + kstep, vAc[0]); PG8_STAGE(PG8_SB(1, 1), rsB, cB + hstep + kstep, voffB);
    PG8_WAIT_V(6); PG8_BAR;
    for (;;) {
        const bool has_next = S.next(ui + 1, nxt);
        if constexpr (Sched::GATHER) {
            if (has_next) { S.a_voff(g, nxt, sR, sC, vAn); asm volatile("s_waitcnt vmcnt(0)" ::: "memory"); }
            else {
#pragma unroll
                for (int h = 0; h < 2; ++h)
#pragma unroll
                    for (int i = 0; i < 2; ++i) vAn[h][i] = vAc[h][i]; }
            asm volatile("" : "+v"(vAn[0][0]), "+v"(vAn[0][1]), "+v"(vAn[1][0]), "+v"(vAn[1][1]));
        } else {
#pragma unroll
            for (int h = 0; h < 2; ++h)
#pragma unroll
                for (int i = 0; i < 2; ++i) vAn[h][i] = vAc[h][i];
        }
        const unsigned nA = has_next ? S.a_off(g, nxt) : cA, nB = has_next ? S.b_off(g, nxt) : cB;
#pragma unroll 1
        for (int t = 0; t < nt; t += 2) {
            const bool last = (t == nt - 2);
            const unsigned a1 = cA + (unsigned)(t + 1) * kstep;
            const unsigned a2 = last ? nA : cA + (unsigned)(t + 2) * kstep, b2 = last ? nB : cB + (unsigned)(t + 2) * kstep;
            const unsigned a3 = a2 + kstep, b3 = b2 + kstep;
            unsigned v2[2][2];
#pragma unroll
            for (int h = 0; h < 2; ++h)
#pragma unroll
                for (int i = 0; i < 2; ++i) v2[h][i] = last ? vAn[h][i] : vAc[h][i];
            if constexpr (F8) {
            PG8_LDB8(B08, 0, 0); PG8_LDB8(B18, 0, 1); PG8_SCHED; PG8_LDA8(At8, 0, 0); PG8_STAGE(PG8_SA(1, 1), rsA, a1, vAc[1]);
            PG8_WAIT_V(8); PG8_WAIT_L(0); PG8_BAR; PG8_MMA8(0, 0, At8, B08); PG8_MMA8(0, 1, At8, B18); PG8_BAR; PG8_SCHED;
            PG8_LDA8(At8, 0, 1); PG8_STAGE(PG8_SB(0, 0), rsB, b2, voffB); PG8_STAGE(PG8_SB(0, 1), rsB, b2 + hstep, voffB); PG8_STAGE(PG8_SA(0, 0), rsA, a2, v2[0]);
            PG8_WAIT_V(8); PG8_WAIT_L(0); PG8_BAR; PG8_MMA8(1, 0, At8, B08); PG8_MMA8(1, 1, At8, B18); PG8_BAR; PG8_SCHED;
            PG8_LDB8(B08, 1, 0); PG8_LDB8(B18, 1, 1); PG8_SCHED; PG8_LDA8(At8, 1, 0); PG8_STAGE(PG8_SA(0, 1), rsA, a2, v2[1]);
            PG8_WAIT_V(8); PG8_WAIT_L(0); PG8_BAR; PG8_MMA8(0, 0, At8, B08); PG8_MMA8(0, 1, At8, B18); PG8_BAR; PG8_SCHED;
            PG8_LDA8(At8, 1, 1); PG8_STAGE(PG8_SB(1, 0), rsB, b3, voffB); PG8_STAGE(PG8_SB(1, 1), rsB, b3 + hstep, voffB); PG8_STAGE(PG8_SA(1, 0), rsA, a3, v2[0]);
            PG8_WAIT_V(8); PG8_WAIT_L(0); PG8_BAR; PG8_MMA8(1, 0, At8, B08); PG8_MMA8(1, 1, At8, B18); PG8_BAR; PG8_SCHED;
            } else {
            PG8_LDB(B0, 0, 0); PG8_LDB(B1, 0, 1); PG8_SCHED; PG8_LDA(At, 0, 0); PG8_STAGE(PG8_SA(1, 1), rsA, a1, vAc[1]);
            PG8_WAIT_V(8); PG8_WAIT_L(0); PG8_BAR; PG8_MMA(0, 0, At, B0); PG8_MMA(0, 1, At, B1); PG8_BAR; PG8_SCHED;
            PG8_LDA(At, 0, 1); PG8_STAGE(PG8_SB(0, 0), rsB, b2, voffB); PG8_STAGE(PG8_SB(0, 1), rsB, b2 + hstep, voffB); PG8_STAGE(PG8_SA(0, 0), rsA, a2, v2[0]);
            PG8_WAIT_V(8); PG8_WAIT_L(0); PG8_BAR; PG8_MMA(1, 0, At, B0); PG8_MMA(1, 1, At, B1); PG8_BAR; PG8_SCHED;
            PG8_LDB(B0, 1, 0); PG8_LDB(B1, 1, 1); PG8_SCHED; PG8_LDA(At, 1, 0); PG8_STAGE(PG8_SA(0, 1), rsA, a2, v2[1]);
            PG8_WAIT_V(8); PG8_WAIT_L(0); PG8_BAR; PG8_MMA(0, 0, At, B0); PG8_MMA(0, 1, At, B1); PG8_BAR; PG8_SCHED;
            PG8_LDA(At, 1, 1); PG8_STAGE(PG8_SB(1, 0), rsB, b3, voffB); PG8_STAGE(PG8_SB(1, 1), rsB, b3 + hstep, voffB); PG8_STAGE(PG8_SA(1, 0), rsA, a3, v2[0]);
            PG8_WAIT_V(8); PG8_WAIT_L(0); PG8_BAR; PG8_MMA(1, 0, At, B0); PG8_MMA(1, 1, At, B1); PG8_BAR; PG8_SCHED;
            }
        }
        if (wr == 0) PG8_BAR;
        { int t_ = threadIdx.x; asm volatile("" : "+v"(t_)); const int l_ = t_ & 63; E(acc, cur, wr, wc, l_ & 15, l_ >> 4); }
        if (!has_next) break;
#pragma unroll
        for (int a = 0; a < 2; ++a)
#pragma unroll
            for (int b = 0; b < 2; ++b)
#pragma unroll
                for (int m = 0; m < 4; ++m)
#pragma unroll
                    for (int n = 0; n < 2; ++n) acc[a][b][m][n] = (f32x4){0.f, 0.f, 0.f, 0.f};
        cur = nxt; cA = nA; cB = nB; ++ui;
#pragma unroll
        for (int h = 0; h < 2; ++h)
#pragma unroll
            for (int i = 0; i < 2; ++i) vAc[h][i] = vAn[h][i];
        if (wr == 1) PG8_BAR;
    }
    PG8_WAIT_V(0);
    PG8_BAR;
#undef PG8_SA
#undef PG8_SB
#undef PG8_STAGE
#undef PG8_LDA
#undef PG8_LDB
#undef PG8_MMA
#undef PG8_MMA8
#undef PG8_LD8
#undef PG8_LDA8
#undef PG8_LDB8
#undef PG8_WAIT_V
#undef PG8_WAIT_L
#undef PG8_BAR
#undef PG8_SCHED
}
}

#ifndef DBL_PHASE
#define DBL_PHASE -1
#endif
#ifndef TEST_ATT
#define TEST_ATT 0
#endif
#ifndef TEST_C0
#define TEST_C0 0
#define TEST_NC 2048
#endif
#ifndef TEST_RLO
#define TEST_RLO 0
#define TEST_RHI 256
#endif
#ifndef SB_TRIVIAL
#define SB_TRIVIAL 0
#endif
#ifndef SB_R2PROBE
#define SB_R2PROBE 0
#endif
#ifndef TEST_BADVAL
#define TEST_BADVAL 1e6f
#endif
#ifndef TEST_NANCOUNT
#define TEST_NANCOUNT 0
#endif
#ifndef TEST_GAIN
#define TEST_GAIN 4.0f
#endif
constexpr int SEQ = 16384, DM = 2048, NHEADS = 16, HD = 128, NEXP = 16, DEXP = 1024, NQKV = 6144, NIN0 = 6152;
constexpr float ALPHA = 1.4142135623730951f;
constexpr float LN_EPS = 1e-5f;
constexpr float SCALE128 = 0.08838834764831845f;
constexpr float SCALE64 = 0.125f;
constexpr float LAMBDA_INIT = 0.8f - 0.6f * 0.7408182206817179f;
constexpr int NWAVES = 8, NTHREADS = 512;

constexpr size_t MiB = (size_t)1 << 20;
constexpr size_t WS_CTL = 0, CTL_ZERO_BYTES = 1 * MiB;
constexpr size_t WS_KMEAN = 1 * MiB;
constexpr size_t WS_LOGF = WS_KMEAN + 262144;
constexpr size_t WS_CLOC = WS_LOGF + 524288;
constexpr size_t WS_C = WS_CLOC + 524288;
constexpr size_t WS_CTOT = WS_C + 524288;
constexpr size_t WS_LUT = WS_CTOT + 4096;
constexpr size_t WS_LAM = WS_LUT + 32768;
constexpr size_t WS_MLIST = 4 * MiB;
constexpr size_t WS_MGW = 6 * MiB;
constexpr size_t WS_WIN0 = 8 * MiB, WS_WOUT0 = 32 * MiB, WS_WIN1 = 40 * MiB, WS_WOUT1 = 64 * MiB;
constexpr size_t WS_WGU = 72 * MiB;
constexpr size_t WS_WDN = 328 * MiB;
constexpr size_t WS_XB = 456 * MiB;
constexpr size_t WS_H = 520 * MiB;
constexpr size_t WS_O = 712 * MiB;
constexpr size_t WS_Y = 776 * MiB;
constexpr size_t WS_X1 = 840 * MiB;
constexpr size_t WS_X1F8 = 904 * MiB;
constexpr size_t WS_END = 936 * MiB;
constexpr size_t WS_YSLOT = WS_H;
constexpr size_t WS_HID = WS_O;
constexpr int HID_ROWS = 36864;
constexpr size_t DO_SEL = 0;

constexpr int CW_TMO = 0;
constexpr int CW_BAR = 4096;
constexpr int CW_MOECNT = 8192;
constexpr int CW_MOBACNT = 9216;

constexpr int RING_BYTES = 147456;
constexpr int LCTL_OFF = RING_BYTES;
constexpr int LDS_BYTES = 155648;

#define GAS __attribute__((address_space(1)))
#define LAS __attribute__((address_space(3)))
typedef unsigned short bf16;
typedef unsigned v4u __attribute__((ext_vector_type(4)));
typedef unsigned v2u __attribute__((ext_vector_type(2)));
typedef float f32x4 __attribute__((ext_vector_type(4)));
typedef short bf16x8 __attribute__((ext_vector_type(8)));
typedef GAS unsigned gu32;
#define RLX_AGENT __ATOMIC_RELAXED, __HIP_MEMORY_SCOPE_AGENT
#define LDS_WAIT() asm volatile("s_waitcnt lgkmcnt(0)" ::: "memory")
__device__ __forceinline__ unsigned f2bf(float f) { unsigned u = __builtin_bit_cast(unsigned, f); return (u + 0x7fffu + ((u >> 16) & 1u)) >> 16; }
__device__ __forceinline__ unsigned pk2(float lo, float hi) { return f2bf(lo) | (f2bf(hi) << 16); }
__device__ __forceinline__ unsigned pk4_fp8(float a, float b, float c, float d) { int w = 0; w = __builtin_amdgcn_cvt_pk_fp8_f32(a, b, w, false); w = __builtin_amdgcn_cvt_pk_fp8_f32(c, d, w, true); return (unsigned)w; }
__device__ __forceinline__ float bf2f(unsigned short b) { return __builtin_bit_cast(float, (unsigned)b << 16); }
__device__ __forceinline__ float bflo(unsigned w) { return __builtin_bit_cast(float, w << 16); }
__device__ __forceinline__ float bfhi(unsigned w) { return __builtin_bit_cast(float, w & 0xffff0000u); }
__device__ __forceinline__ int fresh_tid() { int t = threadIdx.x; asm volatile("" : "+v"(t)); return t; }
__device__ __forceinline__ float wave_sum(float v) {
#pragma unroll
    for (int o = 1; o < 64; o <<= 1) v += __shfl_xor(v, o);
    return v;
}
__device__ __forceinline__ float log_sigmoid(float v) { return fminf(v, 0.f) - log1pf(__expf(-fabsf(v))); }

#define XB_TMO      128
#define XB_XCNT(j)  (256  + 64 * (j))
#define XB_XSUB(j)  (1280 + 64 * (j))
#define XB_XGEN(j)  (2304 + 64 * (j))
#define XB_TOP      3328
#define XB_TOPGEN   3392
#define XCD_BAR_WORDS 3456
#define XB_SPIN_CAP (1u << 22)
__device__ __forceinline__ unsigned xb_ld(unsigned* p)              { return __hip_atomic_load(p, __ATOMIC_RELAXED, __HIP_MEMORY_SCOPE_AGENT); }
__device__ __forceinline__ unsigned xb_add(unsigned* p, unsigned v) { return __hip_atomic_fetch_add(p, v, __ATOMIC_RELAXED, __HIP_MEMORY_SCOPE_AGENT); }
__device__ __forceinline__ unsigned xb_xcc_id() { return (unsigned)__builtin_amdgcn_s_getreg((3 << 11) | 20) & 0xFu; }
#define XB_SPIN(cond, bar) do { unsigned _sp = 0; while (cond) { __builtin_amdgcn_s_sleep(1); \
    if ((++_sp & 255u) == 0u) { if (xb_ld(&(bar)[XB_TMO])) break; if (_sp > XB_SPIN_CAP) { atomicAdd(&(bar)[XB_TMO], 1u); break; } } } } while (0)
struct XcdBarrier { unsigned* bar; unsigned x; volatile LAS unsigned* st; };
__device__ __forceinline__ XcdBarrier xcd_barrier_post(unsigned* bar, volatile LAS unsigned* st) {
    XcdBarrier b; b.bar = bar; b.x = xb_xcc_id(); b.st = st;
    if (threadIdx.x == 0) (void)xb_add(&bar[XB_XCNT(b.x)], 1u);
    return b;
}
__device__ __forceinline__ void xcd_barrier_complete(unsigned* bar, unsigned x, unsigned& nloc, unsigned& nx) {
    const unsigned G = gridDim.x * gridDim.y * gridDim.z;
    unsigned sum, cnt, mine, sp = 0u;
    for (;;) {
        sum = 0u; cnt = 0u; mine = 0u;
#pragma unroll
        for (unsigned j = 0; j < 16; ++j) { const unsigned c = xb_ld(&bar[XB_XCNT(j)]); sum += c; cnt += (c > 0u) ? 1u : 0u; mine = (j == x) ? c : mine; }
        if (sum == G) break;
        __builtin_amdgcn_s_sleep(1);
        if ((++sp & 255u) == 0u) { if (xb_ld(&bar[XB_TMO])) break; if (sp > XB_SPIN_CAP) { atomicAdd(&bar[XB_TMO], 1u); break; } }
    }
    nloc = mine > 0u ? mine : 1u; nx = cnt > 0u ? cnt : 1u;
}
__device__ __forceinline__ void xcd_barrier(const XcdBarrier& b) {
    asm volatile("s_waitcnt vmcnt(0)" ::: "memory");
    __syncthreads();
    if (threadIdx.x == 0) {
        unsigned* bar = b.bar;
        __builtin_amdgcn_s_waitcnt(0);
        unsigned nloc = b.st[0], nx = b.st[1];
        if (nloc == 0u) { xcd_barrier_complete(bar, b.x, nloc, nx); b.st[0] = nloc; b.st[1] = nx; }
        const unsigned old = xb_add(&bar[XB_XSUB(b.x)], 1u);
        const unsigned gen = old / nloc;
        if (old + 1u == (gen + 1u) * nloc) {
            __builtin_amdgcn_fence(__ATOMIC_RELEASE, "agent");
            asm volatile("s_waitcnt vmcnt(0)" ::: "memory");
            const unsigned og = xb_add(&bar[XB_TOP], 1u);
            const unsigned tg = og / nx;
            if (og + 1u == (tg + 1u) * nx) xb_add(&bar[XB_TOPGEN], 1u);
            else XB_SPIN(xb_ld(&bar[XB_TOPGEN]) == tg, bar);
            __builtin_amdgcn_fence(__ATOMIC_ACQUIRE, "agent");
            xb_add(&bar[XB_XGEN(b.x)], 1u);
            asm volatile("s_waitcnt vmcnt(0)" ::: "memory");
        } else {
            XB_SPIN(xb_ld(&bar[XB_XGEN(b.x)]) == gen, bar);
            __builtin_amdgcn_fence(__ATOMIC_ACQUIRE, "agent");
            asm volatile("s_waitcnt vmcnt(0)" ::: "memory");
        }
    }
    __syncthreads();
}

struct Args {
    const float* x; const float* w_in_even; const float* w_out_even; const float* forget_bias; const float* w_in_odd; const float* w_out_odd;
    const float* lambda_q; const float* lambda_k; const float* subln_gain; const float* rel_bias; const float* w_router; const float* b_router;
    const float* w_gate; const float* w_up; const float* w_down; const float* ln_gain; const float* ln_bias;
    float* out; unsigned char* ws; int ph_lo, ph_hi;
};

struct P0Item { const float* src; void* dst; int ldw, ldk, dr0, f8; };
__device__ __forceinline__ P0Item p0_decode(const Args& A, unsigned char* ws, int it) {
    constexpr int I_IN = 32 * 192, I_OUT = 32 * 64, I_EXP = 32 * 1024;
    int r = it; const float* W; unsigned char* WT; int ldw, sc0, k0, ldk, dr0, f8 = 0;
    if (r < I_IN) { const int kb = r / 192, nb = r % 192, n0 = nb * 32; W = A.w_in_even; ldw = NIN0; sc0 = n0 + (n0 >= 3072 ? 8 : 0); k0 = kb * 64; WT = ws + WS_WIN0; ldk = DM; dr0 = n0; f8 = 1; }
    else if (r < I_IN + I_OUT) { r -= I_IN; const int kb = r / 64, nb = r % 64; W = A.w_out_even; ldw = DM; sc0 = nb * 32; k0 = kb * 64; WT = ws + WS_WOUT0; ldk = DM; dr0 = nb * 32; }
    else if (r < 2 * I_IN + I_OUT) { r -= I_IN + I_OUT; const int kb = r / 192, nb = r % 192; W = A.w_in_odd; ldw = NQKV; sc0 = nb * 32; k0 = kb * 64; WT = ws + WS_WIN1; ldk = DM; dr0 = nb * 32; }
    else if (r < 2 * I_IN + 2 * I_OUT) { r -= 2 * I_IN + I_OUT; const int kb = r / 64, nb = r % 64; W = A.w_out_odd; ldw = DM; sc0 = nb * 32; k0 = kb * 64; WT = ws + WS_WOUT1; ldk = DM; dr0 = nb * 32; }
    else if (r < 2 * I_IN + 2 * I_OUT + 2 * I_EXP) {
        r -= 2 * I_IN + 2 * I_OUT; const int isup = r >= I_EXP; if (isup) r -= I_EXP;
        const int le = r >> 10, q = r & 1023, kb = q >> 5, nb = q & 31, n0 = nb * 32;
        W = (isup ? A.w_up : A.w_gate) + (size_t)le * DM * DEXP; ldw = DEXP; sc0 = n0; k0 = kb * 64; WT = ws + WS_WGU + (size_t)le * 2048 * 2048; ldk = DM; dr0 = (n0 >> 7) * 256 + (n0 & 127) + (isup ? 128 : 0); f8 = 1; }
    else { r -= 2 * I_IN + 2 * I_OUT + 2 * I_EXP; const int le = r >> 10, q = r & 1023, kb = q >> 6, nb = q & 63;
        W = A.w_down + (size_t)le * DEXP * DM; ldw = DM; sc0 = nb * 32; k0 = kb * 64; WT = ws + WS_WDN + (size_t)le * 2048 * 1024; ldk = DEXP; dr0 = nb * 32; f8 = 1; }
    P0Item p; p.src = W + (size_t)k0 * ldw + sc0; p.ldw = ldw; p.ldk = ldk; p.dr0 = dr0; p.f8 = f8;
    p.dst = f8 ? (void*)(WT + k0) : (void*)(WT + (size_t)k0 * 2);
    return p;
}
__device__ __forceinline__ void p0_prologue(const Args& A, LAS unsigned char* lds, int G) {
    const int tid = fresh_tid(), lane = tid & 63, wave = __builtin_amdgcn_readfirstlane(tid >> 6);
    LAS float* scr = (LAS float*)(lds + wave * 16384);
    const int gw = blockIdx.x * NWAVES + wave, NGW = G * NWAVES;
    unsigned char* ws = A.ws;
    constexpr int NITEMS = 2 * 32 * 192 + 2 * 32 * 64 + 3 * 32 * 1024;
    f32x4 v[8];
    const int kk0 = lane >> 3, n4 = (lane & 7) * 4, c = lane & 7;
    int it = gw;
    P0Item cur = p0_decode(A, ws, it < NITEMS ? it : 0);
    if (it < NITEMS) {
#pragma unroll
        for (int i = 0; i < 8; ++i) v[i] = *(const f32x4*)(cur.src + (size_t)(8 * i + kk0) * cur.ldw + n4); }
    for (; it < NITEMS; it += NGW) {
#pragma unroll
        for (int i = 0; i < 8; ++i) *(LAS f32x4*)(scr + (8 * i + kk0) * 36 + n4) = v[i];
        const int nit = it + NGW; const P0Item nxt = p0_decode(A, ws, nit < NITEMS ? nit : 0);
        if (nit < NITEMS) {
#pragma unroll
            for (int i = 0; i < 8; ++i) v[i] = *(const f32x4*)(nxt.src + (size_t)(8 * i + kk0) * nxt.ldw + n4); }
        LDS_WAIT(); asm volatile("" ::: "memory");
#pragma unroll
        for (int j = 0; j < 4; ++j) { const int n = (lane >> 3) + 8 * j; const LAS float* s = scr + (8 * c) * 36 + n;
            if (cur.f8) { v2u o; o.x = pk4_fp8(s[0 * 36] * 32.f, s[1 * 36] * 32.f, s[2 * 36] * 32.f, s[3 * 36] * 32.f); o.y = pk4_fp8(s[4 * 36] * 32.f, s[5 * 36] * 32.f, s[6 * 36] * 32.f, s[7 * 36] * 32.f);
                *(GAS v2u*)((unsigned char*)cur.dst + (size_t)(cur.dr0 + n) * cur.ldk + 8 * c) = o; }
            else { v4u o; o.x = pk2(s[0 * 36], s[1 * 36]); o.y = pk2(s[2 * 36], s[3 * 36]); o.z = pk2(s[4 * 36], s[5 * 36]); o.w = pk2(s[6 * 36], s[7 * 36]);
                *(GAS v4u*)((bf16*)cur.dst + (size_t)(cur.dr0 + n) * cur.ldk + 8 * c) = o; } }
        LDS_WAIT(); asm volatile("" ::: "memory");
        cur = nxt;
    }
    __syncthreads();
    LAS float* wfa = (LAS float*)lds;
    for (int idx = tid; idx < 8 * DM; idx += NTHREADS) { const int d = idx >> 3, j = idx & 7; wfa[j * DM + d] = A.w_in_even[(size_t)d * NIN0 + 3072 + j]; }
    __syncthreads();
    float* logf = (float*)(ws + WS_LOGF); bf16* xb = (bf16*)(ws + WS_XB);
    for (int m = gw; m < SEQ; m += NGW) {
        const GAS f32x4* xr = (const GAS f32x4*)(A.x + (size_t)m * DM) + lane;
        f32x4 v[8];
#pragma unroll
        for (int j = 0; j < 8; ++j) v[j] = xr[64 * j];
        GAS unsigned* o8 = (GAS unsigned*)((unsigned char*)xb + (size_t)m * DM) + lane;
#pragma unroll
        for (int j = 0; j < 8; ++j) o8[64 * j] = pk4_fp8(v[j].x, v[j].y, v[j].z, v[j].w);
        float mine = 0.f;
#pragma unroll 1
        for (int e = 0; e < 8; ++e) { float s = 0.f;
#pragma unroll
            for (int j = 0; j < 8; ++j) { const f32x4 w = *(const LAS f32x4*)(wfa + e * DM + 256 * j + 4 * lane); s += v[j].x * w.x + v[j].y * w.y + v[j].z * w.z + v[j].w * w.w; }
            s = wave_sum(s); mine = (lane == e) ? s : mine; }
        if (lane < 8) logf[lane * SEQ + m] = log_sigmoid(mine + A.forget_bias[lane]);
    }
    {
        float* lut = (float*)(ws + WS_LUT);
        for (int idx = blockIdx.x * NTHREADS + tid; idx < 8 * 1024; idx += G * NTHREADS) { const int hh = idx >> 10, d = idx & 1023;
            int b; if (d < 16) b = d; else { b = 16 + (int)(log((double)d / 16.0) / log(64.0) * 16.0 + 1e-9); b = b > 31 ? 31 : b; }
            lut[idx] = A.rel_bias[b * 8 + hh]; }
        if (tid == 0 && blockIdx.x == 0) { float s0 = 0.f, s1 = 0.f; for (int d = 0; d < 64; ++d) { s0 += A.lambda_q[d] * A.lambda_k[d]; s1 += A.lambda_q[64 + d] * A.lambda_k[64 + d]; }
            ((float*)(ws + WS_LAM))[0] = expf(s0) - expf(s1) + LAMBDA_INIT; }
    }
}

__device__ __forceinline__ void p2_kmean_cumsum(const Args& A, char* lds, int G) {
    const int tid = fresh_tid(), lane = tid & 63, wave = tid >> 6;
    const bf16* h = (const bf16*)(A.ws + WS_H);
    float* red = (float*)lds;
    for (int u = blockIdx.x; u < 1536; u += G) {
        if (u >= 1024) {
            const int v = u - 1024, hd = v >> 6, n = v & 63, c = tid & 15, g = tid >> 4; float mx = 0.f;
            for (int i = 0; i < 8; ++i) { const v4u w = *(const v4u*)(h + (size_t)(n * 256 + g + 32 * i) * NQKV + 1024 + hd * 128 + c * 8);
                float s = bflo(w.x) * bflo(w.x) + bfhi(w.x) * bfhi(w.x) + bflo(w.y) * bflo(w.y) + bfhi(w.y) * bfhi(w.y) + bflo(w.z) * bflo(w.z) + bfhi(w.z) * bfhi(w.z) + bflo(w.w) * bflo(w.w) + bfhi(w.w) * bfhi(w.w);
                s += __shfl_xor(s, 1); s += __shfl_xor(s, 2); s += __shfl_xor(s, 4); s += __shfl_xor(s, 8); mx = fmaxf(mx, s); }
            for (int o = 16; o < 64; o <<= 1) mx = fmaxf(mx, __shfl_xor(mx, o));
            if (lane == 0) atomicMax((unsigned*)(A.ws + WS_CTL) + 10496 + hd, __float_as_uint(mx));
        } else if (u < 512) {
            const int hd = u >> 6, n = u & 63, c = tid & 15, g = tid >> 4;
            float s[8] = {0, 0, 0, 0, 0, 0, 0, 0};
            for (int i = 0; i < 8; ++i) { const v4u w = *(const v4u*)(h + (size_t)(n * 256 + g + 32 * i) * NQKV + 4096 + hd * 128 + c * 8);
                s[0] += bflo(w.x); s[1] += bfhi(w.x); s[2] += bflo(w.y); s[3] += bfhi(w.y); s[4] += bflo(w.z); s[5] += bfhi(w.z); s[6] += bflo(w.w); s[7] += bfhi(w.w); }
            for (int j = 0; j < 8; ++j) red[g * 128 + c * 8 + j] = s[j];
            __syncthreads();
            if (tid < 128) { float t = 0.f; for (int gg = 0; gg < 32; ++gg) t += red[gg * 128 + tid]; ((float*)(A.ws + WS_KMEAN))[(size_t)u * 128 + tid] = t * (1.f / 256.f); }
            __syncthreads();
        } else {
            const int v = u - 512, hd = v >> 6, ch = v & 63;
            const float* lf = (const float*)(A.ws + WS_LOGF) + hd * SEQ + ch * 256;
            float x = (tid < 256) ? lf[tid] : 0.f;
            for (int o = 1; o < 64; o <<= 1) { const float y = __shfl_up(x, o); if (lane >= o) x += y; }
            if (lane == 63 && wave < 4) red[wave] = x;
            __syncthreads();
            if (tid < 256) { float pre = 0.f; for (int w = 0; w < wave; ++w) pre += red[w]; x += pre;
                ((float*)(A.ws + WS_CLOC))[hd * SEQ + ch * 256 + tid] = x;
                if (tid == 255) ((float*)(A.ws + WS_CTOT))[hd * 64 + ch] = x; }
            __syncthreads();
        }
    }
}

__device__ __forceinline__ void p3_gate_cfinal(const Args& A, char* lds, int G, int* sel) {
    const int tid = fresh_tid(), lane = tid & 63, wave = tid >> 6;
    const bf16* h = (const bf16*)(A.ws + WS_H);
    float* km = (float*)lds;
    float* scal = (float*)(lds + 65536); int* lcnt = (int*)(lds + 66560); int* gbs = lcnt + 64;
    for (int u = blockIdx.x; u < 1024; u += G) {
        if (u < 512) {
            const int hd = u >> 6, qb = u & 63;
            const float* kmg = (const float*)(A.ws + WS_KMEAN) + (size_t)hd * 64 * 128;
            for (int i = tid; i < qb * 128; i += NTHREADS) km[i] = kmg[i];
            if (tid < 64) lcnt[tid] = 0;
            __syncthreads();
            const int t = qb * 256 + (tid >> 1), dh = tid & 1;
            float q[64];
            { const bf16* qp = h + (size_t)t * NQKV + 3072 + hd * 128 + dh * 64;
#pragma unroll
              for (int i = 0; i < 8; ++i) { const v4u w = *(const v4u*)(qp + i * 8);
                q[i * 8 + 0] = bflo(w.x); q[i * 8 + 1] = bfhi(w.x); q[i * 8 + 2] = bflo(w.y); q[i * 8 + 3] = bfhi(w.y); q[i * 8 + 4] = bflo(w.z); q[i * 8 + 5] = bfhi(w.z); q[i * 8 + 6] = bflo(w.w); q[i * 8 + 7] = bfhi(w.w); } }
            float v0 = -3e38f, v1 = -3e38f, v2 = -3e38f; int i0 = 0, i1 = 1, i2 = 2;
            for (int n = 0; n < qb; ++n) {
                const float* kr = km + n * 128 + dh * 64; float s = 0.f;
#pragma unroll
                for (int d = 0; d < 64; d += 4) { const f32x4 kv = *(const f32x4*)(kr + d); s += q[d] * kv.x + q[d + 1] * kv.y + q[d + 2] * kv.z + q[d + 3] * kv.w; }
                s += __shfl_xor(s, 1);
                if (s > v0) { v2 = v1; i2 = i1; v1 = v0; i1 = i0; v0 = s; i0 = n; }
                else if (s > v1) { v2 = v1; i2 = i1; v1 = s; i1 = n; }
                else if (s > v2) { v2 = s; i2 = n; }
            }
            const int nsel = qb < 3 ? qb : 3;
            if (dh == 0) *(int4*)(sel + ((size_t)hd * SEQ + t) * 4) = make_int4(i0, i1, i2, nsel);
            int lp0 = 0, lp1 = 0, lp2 = 0;
            if (dh == 0) { if (nsel > 0) lp0 = atomicAdd(&lcnt[i0], 1); if (nsel > 1) lp1 = atomicAdd(&lcnt[i1], 1); if (nsel > 2) lp2 = atomicAdd(&lcnt[i2], 1); }
            __syncthreads();
            if (tid < 64) { const int c = lcnt[tid]; gbs[tid] = c > 0 ? (int)__hip_atomic_fetch_add((unsigned*)(A.ws + WS_CTL) + CW_MOBACNT + hd * 64 + tid, (unsigned)c, RLX_AGENT) : 0; }
            __syncthreads();
            if (dh == 0) { int* ml = (int*)((unsigned char*)A.out + (4u << 20)) + (size_t)hd * 64 * SEQ;
                if (nsel > 0) ml[(size_t)i0 * SEQ + gbs[i0] + lp0] = t * 4 + 0;
                if (nsel > 1) ml[(size_t)i1 * SEQ + gbs[i1] + lp1] = t * 4 + 1;
                if (nsel > 2) ml[(size_t)i2 * SEQ + gbs[i2] + lp2] = t * 4 + 2; }
            __syncthreads();
        } else {
            const int v = u - 512, hd = v >> 6, ch = v & 63;
            if (wave == 0) { float x = (lane < ch) ? ((const float*)(A.ws + WS_CTOT))[hd * 64 + lane] : 0.f; x = wave_sum(x); if (lane == 0) scal[0] = x; }
            __syncthreads();
            if (tid < 256) ((float*)(A.ws + WS_C))[hd * SEQ + ch * 256 + tid] = ((const float*)(A.ws + WS_CLOC))[hd * SEQ + ch * 256 + tid] + scal[0];
            __syncthreads();
        }
    }
}

template <int VAR>
__device__ __forceinline__ void naive_attn_unit(const Args& A, char* lds, int hd, int qblk, const int* sel) {
    const int tid = fresh_tid(), ql = tid >> 2, part = tid & 3;
    const int t0 = qblk * 128, t = t0 + ql;
    float* Ks = (float*)lds; float* Vs = Ks + 64 * 128; float* Cs = Vs + 64 * 128;
    const bf16* h = (const bf16*)(A.ws + WS_H); bf16* ob = (bf16*)(A.ws + WS_O);
    const int second = (VAR == 1 || VAR == 3) ? 1 : 0;
    const int qcol = second * 3072 + hd * 128, kcol = qcol + 1024, vcol = qcol + 2048, ocol = (second * 8 + hd) * 128;
    const float* cg = (const float*)(A.ws + WS_C) + hd * SEQ;
    const float* lut = (const float*)(A.ws + WS_LUT) + hd * 1024;
    float q[32];
    if (VAR != 2) { const bf16* qp = h + (size_t)t * NQKV + qcol + part * 32;
#pragma unroll
        for (int d = 0; d < 32; ++d) q[d] = bf2f(qp[d]); }
    else { const bf16* qp = h + (size_t)t * NQKV + qcol + part * 16;
#pragma unroll
        for (int d = 0; d < 16; ++d) { q[d] = bf2f(qp[d]); q[16 + d] = bf2f(qp[64 + d]); } }
    float o[32], o2[32];
#pragma unroll
    for (int d = 0; d < 32; ++d) { o[d] = 0.f; o2[d] = 0.f; }
    float m1 = -1e30f, l1 = 0.f, m2 = -1e30f, l2 = 0.f, R = 0.f;
    const float ct = (VAR == 0) ? cg[t] : 0.f;
    int s0 = -1, s1 = -1, s2 = -1;
    if (VAR == 1) { const int4 sv = *(const int4*)(sel + ((size_t)hd * SEQ + t) * 4); if (sv.w > 0) s0 = sv.x; if (sv.w > 1) s1 = sv.y; if (sv.w > 2) s2 = sv.z; }
    const int own = t >> 8;
    const int jmax = (t0 + 127) >> 6;
    for (int jj = 0; jj <= jmax; ++jj) {
        const int j = (VAR == 3) ? (jmax - jj) : jj;
        __syncthreads();
        for (int idx = tid; idx < 1024; idx += NTHREADS) { const int row = idx >> 4, c8 = (idx & 15) * 8;
            const v4u kw = *(const v4u*)(h + (size_t)(j * 64 + row) * NQKV + kcol + c8); const v4u vw = *(const v4u*)(h + (size_t)(j * 64 + row) * NQKV + vcol + c8);
            float* kd = Ks + row * 128 + c8; float* vd = Vs + row * 128 + c8;
            kd[0] = bflo(kw.x); kd[1] = bfhi(kw.x); kd[2] = bflo(kw.y); kd[3] = bfhi(kw.y); kd[4] = bflo(kw.z); kd[5] = bfhi(kw.z); kd[6] = bflo(kw.w); kd[7] = bfhi(kw.w);
            vd[0] = bflo(vw.x); vd[1] = bfhi(vw.x); vd[2] = bflo(vw.y); vd[3] = bfhi(vw.y); vd[4] = bflo(vw.z); vd[5] = bfhi(vw.z); vd[6] = bflo(vw.w); vd[7] = bfhi(vw.w); }
        if (VAR == 0 && tid < 64) Cs[tid] = cg[j * 64 + tid];
        __syncthreads();
        for (int ss = 0; ss < 64; ++ss) {
            const int s = (VAR == 3) ? (63 - ss) : ss; const int ks = j * 64 + s;
            float d1 = 0.f, d2 = 0.f;
            if (VAR != 2) { const float* kr = Ks + s * 128 + part * 32;
#pragma unroll
                for (int d = 0; d < 32; d += 4) { const f32x4 kv = *(const f32x4*)(kr + d); d1 += q[d] * kv.x + q[d + 1] * kv.y + q[d + 2] * kv.z + q[d + 3] * kv.w; } }
            else { const float* kr = Ks + s * 128 + part * 16;
#pragma unroll
                for (int d = 0; d < 16; d += 4) { const f32x4 ka = *(const f32x4*)(kr + d); const f32x4 kb = *(const f32x4*)(kr + 64 + d);
                    d1 += q[d] * ka.x + q[d + 1] * ka.y + q[d + 2] * ka.z + q[d + 3] * ka.w; d2 += q[16 + d] * kb.x + q[17 + d] * kb.y + q[18 + d] * kb.z + q[19 + d] * kb.w; } }
            d1 += __shfl_xor(d1, 1); d1 += __shfl_xor(d1, 2);
            if (VAR == 2) { d2 += __shfl_xor(d2, 1); d2 += __shfl_xor(d2, 2); }
            const float* vr = Vs + s * 128 + part * 32;
            if (VAR == 0 || VAR == 1) {
                bool valid; float sc;
                if (VAR == 0) { valid = ks <= t; sc = d1 * SCALE128 + (ct - Cs[s]); }
                else { const int nb = ks >> 8; valid = (nb == own && ks <= t) || nb == s0 || nb == s1 || nb == s2; const int dist = t - ks; sc = d1 * SCALE128 + lut[dist < 0 ? 0 : (dist > 1023 ? 1023 : dist)]; }
                if (valid) { const float mn = fmaxf(m1, sc), al = __expf(m1 - mn), p = __expf(sc - mn); l1 = l1 * al + p; m1 = mn;
#pragma unroll
                    for (int d = 0; d < 32; ++d) o[d] = o[d] * al + p * vr[d]; }
            } else if (VAR == 2) {
                if (ks <= t) { const float bias = lut[(t - ks) > 1023 ? 1023 : (t - ks)];
                    const float sa = d1 * SCALE64 + bias, sb = d2 * SCALE64 + bias;
                    const float mna = fmaxf(m1, sa), ala = __expf(m1 - mna), pa = __expf(sa - mna); l1 = l1 * ala + pa; m1 = mna;
                    const float mnb = fmaxf(m2, sb), alb = __expf(m2 - mnb), pb = __expf(sb - mnb); l2 = l2 * alb + pb; m2 = mnb;
#pragma unroll
                    for (int d = 0; d < 32; ++d) { const float vv = vr[d]; o[d] = o[d] * ala + pa * vv; o2[d] = o2[d] * alb + pb * vv; } }
            } else {
                if (ks < t) { const float z = d1 * SCALE128; float a = __expf(log_sigmoid(z) + R); R += log_sigmoid(-z);
#if SB_TRIVIAL
                    a = 0.015625f;
#endif

#pragma unroll
                    for (int d = 0; d < 32; ++d) o[d] += a * vr[d]; }
            }
        }
    }
    if (VAR == 0 || VAR == 1) { const float il = 1.f / l1;
#pragma unroll
        for (int d = 0; d < 32; ++d) o[d] *= il; }
    if (VAR == 2) { const float lam = ((const float*)(A.ws + WS_LAM))[0]; const float i1 = 1.f / l1, i2 = lam / l2; float ss = 0.f;
#pragma unroll
        for (int d = 0; d < 32; ++d) { o[d] = o[d] * i1 - o2[d] * i2; ss += o[d] * o[d]; }
        ss += __shfl_xor(ss, 1); ss += __shfl_xor(ss, 2);
        const float r = rsqrtf(ss * (1.f / 128.f) + LN_EPS) * (1.f - LAMBDA_INIT);
#pragma unroll
        for (int d = 0; d < 32; ++d) o[d] = o[d] * r * A.subln_gain[part * 32 + d]; }
    bf16* op = ob + (size_t)t * DM + ocol + part * 32;
#pragma unroll
    for (int d = 0; d < 32; d += 2) *(unsigned*)(op + d) = pk2(o[d], o[d + 1]);
}

#ifndef SB_R2PROBE
#define SB_R2PROBE 0
#endif
#ifndef FOX_CH
#define FOX_CH 16
#endif
#ifndef SB_NOCHUNK
#define SB_NOCHUNK 0
#endif
#ifndef SB_TRIVIAL
#define SB_TRIVIAL 0
#endif
namespace att {
typedef float f32x16 __attribute__((ext_vector_type(16)));
typedef short s16x4 __attribute__((ext_vector_type(4)));
constexpr int PITCH = NQKV;
constexpr int SHM_V = 16384, SHM_K = 16384;
constexpr int L_V = 0, L_K = 2 * SHM_V, L_WS = L_K + 2 * SHM_K, L_KB = L_WS + NWAVES * 64 * 4, L_FLAG = L_KB + 512, L_LUT = L_FLAG + 512, LUT_PAD = 320, LUT_N = LUT_PAD + 1024,
              L_STASH = L_LUT + LUT_N * 4 + 256, L_END = L_STASH + 65536;
static_assert(L_STASH % 16 == 0 && L_END <= RING_BYTES, "attention LDS map");
constexpr float THR = 8.f;
#define KSWZ(row, colB) ((row) * 256 + ((colB) ^ (((row) & 7) << 4)))
#define SBAR() __builtin_amdgcn_sched_barrier(0)
__device__ __forceinline__ int v_st(int k, int c) { const int kk = (k & ~0xC) | ((k & 4) << 1) | ((k & 8) >> 1); return ((kk >> 3) * 4 + (c >> 5)) * 512 + ((kk & 7) * 32 + (c & 31)) * 2; }
__device__ __forceinline__ int v_rd_base(int lane) { return ((lane & 3) << 3) | (((lane >> 2) & 3) << 6) | (((lane >> 4) & 1) << 5) | (((lane >> 5) & 1) << 8); }
constexpr int v_rd_off(int d0, int ks, int half) { return d0 * 512 + ks * 4096 + half * 2048; }
__device__ __forceinline__ int crow(int r, int hi) { return (r & 3) + 8 * (r >> 2) + 4 * hi; }
typedef __bf16 bf16x2_t __attribute__((ext_vector_type(2)));
typedef float f32x2_t __attribute__((ext_vector_type(2)));
__device__ __forceinline__ unsigned cvtpk(float lo, float hi) { f32x2_t v = {lo, hi}; bf16x2_t b = __builtin_convertvector(v, bf16x2_t); return __builtin_bit_cast(unsigned, b); }

template <int DQ> __device__ __forceinline__ void partialSM(f32x16& p0, f32x16& p1, float& m_reg, float& mn, float& alpha) {
    constexpr float SC = (DQ == 128) ? SCALE128 : SCALE64; constexpr float C2 = 1.4426950408889634f * SC;
    float pmax = p0[0]; for (int r = 1; r < 16; ++r) pmax = fmaxf(pmax, p0[r]); for (int r = 0; r < 16; ++r) pmax = fmaxf(pmax, p1[r]);
    { auto rr = __builtin_amdgcn_permlane32_swap(__float_as_uint(pmax), __float_as_uint(pmax), false, false);
      pmax = fmaxf(__uint_as_float(rr[0]), __uint_as_float(rr[1])); }
    if (__builtin_expect(__all((pmax - m_reg) * SC <= THR), 1)) { mn = m_reg; alpha = 1.f; }
    else { mn = fmaxf(m_reg, pmax); alpha = __builtin_amdgcn_exp2f((m_reg - mn) * C2); m_reg = mn; }
    const float mnL = -mn * C2;
    for (int r = 0; r < 16; ++r) p0[r] = fmaf(p0[r], C2, mnL); for (int r = 0; r < 16; ++r) p1[r] = fmaf(p1[r], C2, mnL);
    for (int r = 0; r < 16; ++r) p0[r] = __builtin_amdgcn_exp2f(p0[r]);
}
#define PK4(P, B_, OUT) do { unsigned a0 = cvtpk(P[B_+0], P[B_+1]), a1 = cvtpk(P[B_+2], P[B_+3]);                          \
        unsigned b0 = cvtpk(P[B_+4], P[B_+5]), b1 = cvtpk(P[B_+6], P[B_+7]);                                             \
        auto r0 = __builtin_amdgcn_permlane32_swap(a0, b0, false, false); auto r1 = __builtin_amdgcn_permlane32_swap(a1, b1, false, false); \
        pg8::u32x4 w = {r0[0], r1[0], r0[1], r1[1]}; OUT = *reinterpret_cast<bf16x8*>(&w); } while (0)
__device__ __forceinline__ void finishSM(f32x16& p0, f32x16& p1, float alpha, float& l_reg, bf16x8& pa0, bf16x8& pa1, bf16x8& pa2, bf16x8& pa3) {
    for (int r = 0; r < 16; ++r) p1[r] = __builtin_amdgcn_exp2f(p1[r]);
    float ps = 0; for (int r = 0; r < 16; ++r) ps += p0[r]; for (int r = 0; r < 16; ++r) ps += p1[r];
    { auto rr = __builtin_amdgcn_permlane32_swap(__float_as_uint(ps), __float_as_uint(ps), false, false);
      ps = __uint_as_float(rr[0]) + __uint_as_float(rr[1]); }
    l_reg = l_reg * alpha + ps;
    PK4(p0, 0, pa0); PK4(p0, 8, pa1); PK4(p1, 0, pa2); PK4(p1, 8, pa3);
}
__device__ __forceinline__ void sb_half(f32x16& p, float& R2, int hi) {
#if SB_TRIVIAL
#pragma unroll
    for (int r = 0; r < 16; ++r) p[r] = (p[r] < -1e37f) ? 0.f : 0.015625f;
    return;
#endif
    constexpr float C2 = 1.4426950408889634f * SCALE128;
    float T = R2;
#pragma unroll
    for (int g = 3; g >= 0; --g) { float z[4], lr[4];
#pragma unroll
        for (int e = 0; e < 4; ++e) { z[e] = p[4 * g + e] * C2; lr[e] = -(fmaxf(z[e], 0.f) + __builtin_amdgcn_logf(1.f + __builtin_amdgcn_exp2f(-fabsf(z[e])))); }
        const float G = (lr[0] + lr[1]) + (lr[2] + lr[3]);
        auto rr = __builtin_amdgcn_permlane32_swap(__float_as_uint(G), __float_as_uint(G), false, false);
        const float Go = hi ? __uint_as_float(rr[0]) : __uint_as_float(rr[1]);
        float a = T + (hi ? 0.f : Go);
        p[4 * g + 3] = __builtin_amdgcn_exp2f(z[3] + lr[3] + a); a += lr[3];
        p[4 * g + 2] = __builtin_amdgcn_exp2f(z[2] + lr[2] + a); a += lr[2];
        p[4 * g + 1] = __builtin_amdgcn_exp2f(z[1] + lr[1] + a); a += lr[1];
        p[4 * g + 0] = __builtin_amdgcn_exp2f(z[0] + lr[0] + a);
        T += G + Go; }
    R2 = T;
}
__device__ __forceinline__ void sb_pack(f32x16& p0, f32x16& p1, bf16x8& pa0, bf16x8& pa1, bf16x8& pa2, bf16x8& pa3) { PK4(p0, 0, pa0); PK4(p0, 8, pa1); PK4(p1, 0, pa2); PK4(p1, 8, pa3); }
#undef PK4

template <int KB, int DQ>
__device__ __forceinline__ void qkt(f32x16& p0, f32x16& p1, const LAS char* K_lds, int r32, int hi, const bf16x8* qr) {
    p0 = f32x16{}; p1 = f32x16{};
    const LAS char* kb[4];
    { int t_ = threadIdx.x; asm volatile("" : "+v"(t_)); r32 = t_ & 31; hi = (t_ >> 5) & 1; }
#pragma unroll
    for (int dd = 0; dd < 4; ++dd) kb[dd] = K_lds + KB * SHM_K + KSWZ(r32, (dd * 16 + hi * 8) * 2);
#pragma unroll
    for (int d0 = 0; d0 < DQ / 16; ++d0) { const LAS char* a = kb[d0 & 3] + (d0 >> 2) * 128;
        bf16x8 b0 = *reinterpret_cast<const LAS bf16x8*>(a);
        bf16x8 b1 = *reinterpret_cast<const LAS bf16x8*>(a + 32 * 256);
        p0 = __builtin_amdgcn_mfma_f32_32x32x16_bf16(b0, qr[d0], p0, 0, 0, 0);
        p1 = __builtin_amdgcn_mfma_f32_32x32x16_bf16(b1, qr[d0], p1, 0, 0, 0); }
}
template <int VB>
__device__ __forceinline__ void pv_tile2(f32x16* o, int vb0, bf16x8 pa0, bf16x8 pa1, bf16x8 pa2, bf16x8 pa3) {
#define TRRD(dst, off) asm volatile("ds_read_b64_tr_b16 %0, %1 offset:%2" : "=&v"(dst) : "v"(vb0), "i"(off) : "memory")
#define PV_RD(d0, P) constexpr int b##P = VB * SHM_V + v_rd_off(d0, 0, 0); s16x4 l0##P, l1##P, l2##P, l3##P, h0##P, h1##P, h2##P, h3##P; \
        TRRD(l0##P, b##P); TRRD(h0##P, b##P + 2048); TRRD(l1##P, b##P + 4096); TRRD(h1##P, b##P + 6144); TRRD(l2##P, b##P + 8192); TRRD(h2##P, b##P + 10240); TRRD(l3##P, b##P + 12288); TRRD(h3##P, b##P + 14336)
#define PV_MM(d0, P) do { \
        o[d0] = __builtin_amdgcn_mfma_f32_32x32x16_bf16(pa0, (bf16x8){l0##P[0], l0##P[1], l0##P[2], l0##P[3], h0##P[0], h0##P[1], h0##P[2], h0##P[3]}, o[d0], 0, 0, 0);   \
        o[d0] = __builtin_amdgcn_mfma_f32_32x32x16_bf16(pa1, (bf16x8){l1##P[0], l1##P[1], l1##P[2], l1##P[3], h1##P[0], h1##P[1], h1##P[2], h1##P[3]}, o[d0], 0, 0, 0);   \
        o[d0] = __builtin_amdgcn_mfma_f32_32x32x16_bf16(pa2, (bf16x8){l2##P[0], l2##P[1], l2##P[2], l2##P[3], h2##P[0], h2##P[1], h2##P[2], h2##P[3]}, o[d0], 0, 0, 0);   \
        o[d0] = __builtin_amdgcn_mfma_f32_32x32x16_bf16(pa3, (bf16x8){l3##P[0], l3##P[1], l3##P[2], l3##P[3], h3##P[0], h3##P[1], h3##P[2], h3##P[3]}, o[d0], 0, 0, 0); } while (0)
#define PV_WAIT() asm volatile("s_waitcnt lgkmcnt(0)" : "+v"(l0A), "+v"(l1A), "+v"(l2A), "+v"(l3A), "+v"(h0A), "+v"(h1A), "+v"(h2A), "+v"(h3A), \
        "+v"(l0B), "+v"(l1B), "+v"(l2B), "+v"(l3B), "+v"(h0B), "+v"(h1B), "+v"(h2B), "+v"(h3B) :: "memory")
    { PV_RD(0, A); PV_RD(1, B); PV_WAIT(); SBAR(); PV_MM(0, A); PV_MM(1, B); SBAR(); }
    { PV_RD(2, A); PV_RD(3, B); PV_WAIT(); SBAR(); PV_MM(2, A); PV_MM(3, B); }
#undef PV_WAIT
#undef PV_RD
#undef PV_MM
#undef TRRD
}
template <int VB>
__device__ __forceinline__ void pv_tile(f32x16* o, int vb0, bf16x8 pa0, bf16x8 pa1, bf16x8 pa2, bf16x8 pa3) {
#define TRRD(dst, off) asm volatile("ds_read_b64_tr_b16 %0, %1 offset:%2" : "=&v"(dst) : "v"(vb0), "i"(off) : "memory")
#define PV_D0(d0) do { s16x4 l0, l1, l2, l3, h0, h1, h2, h3; constexpr int b_ = VB * SHM_V + v_rd_off(d0, 0, 0); \
        TRRD(l0, b_); TRRD(h0, b_ + 2048); TRRD(l1, b_ + 4096); TRRD(h1, b_ + 6144); TRRD(l2, b_ + 8192); TRRD(h2, b_ + 10240); TRRD(l3, b_ + 12288); TRRD(h3, b_ + 14336); \
        asm volatile("s_waitcnt lgkmcnt(0)" : "+v"(l0), "+v"(l1), "+v"(l2), "+v"(l3), "+v"(h0), "+v"(h1), "+v"(h2), "+v"(h3) :: "memory"); SBAR();     \
        o[d0] = __builtin_amdgcn_mfma_f32_32x32x16_bf16(pa0, (bf16x8){l0[0], l0[1], l0[2], l0[3], h0[0], h0[1], h0[2], h0[3]}, o[d0], 0, 0, 0);   \
        o[d0] = __builtin_amdgcn_mfma_f32_32x32x16_bf16(pa1, (bf16x8){l1[0], l1[1], l1[2], l1[3], h1[0], h1[1], h1[2], h1[3]}, o[d0], 0, 0, 0);   \
        o[d0] = __builtin_amdgcn_mfma_f32_32x32x16_bf16(pa2, (bf16x8){l2[0], l2[1], l2[2], l2[3], h2[0], h2[1], h2[2], h2[3]}, o[d0], 0, 0, 0);   \
        o[d0] = __builtin_amdgcn_mfma_f32_32x32x16_bf16(pa3, (bf16x8){l3[0], l3[1], l3[2], l3[3], h3[0], h3[1], h3[2], h3[3]}, o[d0], 0, 0, 0); } while (0)
    PV_D0(0); PV_D0(1); PV_D0(2); PV_D0(3);
#undef PV_D0
#undef TRRD
}

struct ChunkArgs {
    const bf16* hbase; unsigned kcolB, vcolB;
    int ja, jb;
    int qpos;
    int qlo;
    const float* cb; float cref;
};
template <int DQ, int MODE, bool REV>
__device__ __forceinline__ void attn_chunk(const ChunkArgs& a, const bf16x8* qr, float& m_reg, float& l_reg, f32x16* o, LAS char* lds) {
    int tid_ = threadIdx.x; asm volatile("" : "+v"(tid_)); const int tid = tid_, wid = __builtin_amdgcn_readfirstlane(tid >> 6), lane = tid & 63, r32 = lane & 31, hi = lane >> 5;
    const int NT = a.jb - a.ja;
    LAS char* V_lds = lds + L_V; LAS char* K_lds = lds + L_K;
    LAS float* ws = (LAS float*)(lds + L_WS) + wid * 64; LAS float* al_l = ws + 32;
    LAS float* kbl = (LAS float*)(lds + L_KB); const LAS float* lutl = (const LAS float*)(lds + L_LUT);
    const int vb0 = (int)(uintptr_t)V_lds + v_rd_base(lane);
    const __amdgpu_buffer_rsrc_t hrs = __builtin_amdgcn_make_buffer_rsrc((void*)a.hbase, 0, (int)((size_t)SEQ * PITCH * 2), 0x00020000);
#define FRESH_TID(t_) int t_ = threadIdx.x; asm volatile("" : "+v"(t_))
    const int qlo = a.qlo;
    bf16x8 st_v0, st_v1, st_k0, st_k1; float st_c = 0.f;
#define KBASE(t) ((REV ? (a.jb - 1 - (t)) : (a.ja + (t))) * 64)
#define VMW() asm volatile("s_waitcnt vmcnt(0)" ::: "memory")
#define SLOAD(k0) do { FRESH_TID(t_); const int sr = t_ >> 4, sc = (t_ & 15) * 8; const unsigned so_ = (unsigned)(k0) * (unsigned)(PITCH * 2); \
        const unsigned vo0 = (unsigned)(sr * PITCH + sc) * 2u, vo1 = vo0 + (unsigned)(32 * PITCH * 2); \
        st_v0 = __builtin_bit_cast(bf16x8, __builtin_amdgcn_raw_buffer_load_b128(hrs, vo0, so_ + a.vcolB, 0)); st_v1 = __builtin_bit_cast(bf16x8, __builtin_amdgcn_raw_buffer_load_b128(hrs, vo1, so_ + a.vcolB, 0)); \
        if constexpr (DQ == 128) { st_k0 = __builtin_bit_cast(bf16x8, __builtin_amdgcn_raw_buffer_load_b128(hrs, vo0, so_ + a.kcolB, 0)); st_k1 = __builtin_bit_cast(bf16x8, __builtin_amdgcn_raw_buffer_load_b128(hrs, vo1, so_ + a.kcolB, 0)); } \
        else { const unsigned vk0 = (unsigned)((t_ >> 3) * PITCH + (t_ & 7) * 8) * 2u; st_k0 = __builtin_bit_cast(bf16x8, __builtin_amdgcn_raw_buffer_load_b128(hrs, vk0, so_ + a.kcolB, 0)); } \
        if constexpr (MODE == 0) { if (t_ < 64) st_c = (a.cref - a.cb[(k0) + t_]) * (1.f / SCALE128); } } while (0)
#define SWRITE_K(bf) do { FRESH_TID(t_); if constexpr (DQ == 128) { const int sr = t_ >> 4, sc = (t_ & 15) * 8, kws = KSWZ(sr, sc * 2); *(LAS bf16x8*)(K_lds + (bf) * SHM_K + kws) = st_k0; *(LAS bf16x8*)(K_lds + (bf) * SHM_K + kws + 32 * 256) = st_k1; } \
        else { const int sr2 = t_ >> 3, sc2 = (t_ & 7) * 8, kws2 = KSWZ(sr2, sc2 * 2); *(LAS bf16x8*)(K_lds + (bf) * SHM_K + kws2) = st_k0; } \
        if constexpr (MODE == 0) { if (t_ < 64) kbl[(bf) * 64 + t_] = st_c; } } while (0)
#define SWRITE_V(bf) do { FRESH_TID(t_); const int sr = t_ >> 4, sc = (t_ & 15) * 8, vst0 = v_st(sr, sc), vst1 = v_st(32 + sr, sc); *(LAS bf16x8*)(V_lds + (bf) * SHM_V + vst0) = st_v0; *(LAS bf16x8*)(V_lds + (bf) * SHM_V + vst1) = st_v1; } while (0)
#define SWRITE(bf) do { SWRITE_V(bf); SWRITE_K(bf); } while (0)
#define SCORES(P0_, P1_, t, BF) do { const int kb_ = KBASE(t); int dq; { FRESH_TID(t_); const int r32_ = t_ & 31, hi_ = (t_ >> 5) & 1; dq = ((MODE == 2) ? a.qpos : (qlo + r32_)) - 4 * hi_ - kb_; } \
        if constexpr (MODE == 0) { \
            _Pragma("unroll") for (int g = 0; g < 4; ++g) { const f32x4 b0 = *(const LAS f32x4*)(kbl + (BF) * 64 + 8 * g + 4 * hi), b1 = *(const LAS f32x4*)(kbl + (BF) * 64 + 32 + 8 * g + 4 * hi); \
                _Pragma("unroll") for (int e = 0; e < 4; ++e) { P0_[4 * g + e] += b0[e]; P1_[4 * g + e] += b1[e]; } asm volatile("" ::: "memory"); } } \
        if constexpr (MODE == 1) { if (qlo - (kb_ + 63) < 790) { const LAS float* lp = lutl + (dq + LUT_PAD - 59); \
            _Pragma("unroll") for (int r = 0; r < 16; ++r) { const int c = (r & 3) + 8 * (r >> 2); P0_[r] += lp[59 - c]; P1_[r] += lp[27 - c]; } } } \
        if constexpr (MODE == 2) { \
            _Pragma("unroll") for (int r = 0; r < 16; ++r) { const int c = (r & 3) + 8 * (r >> 2); int d0_ = dq - c, d1_ = dq - c - 32; d0_ = d0_ > 1023 ? 1023 : d0_; d1_ = d1_ > 1023 ? 1023 : d1_; \
                P0_[r] += lutl[d0_ + LUT_PAD]; P1_[r] += lutl[d1_ + LUT_PAD]; } } \
        if (MODE == 2 || kb_ + 63 >= qlo) { const float NEG = (MODE == 3) ? -3.0e4f : -__builtin_inff(); constexpr int ST = (MODE == 3) ? 1 : 0; \
            _Pragma("unroll") for (int r = 0; r < 16; ++r) { const int c = (r & 3) + 8 * (r >> 2); if (dq - c < ST) P0_[r] = NEG; if (dq - c - 32 < ST) P1_[r] = NEG; } } } while (0)
#define RESC(al) do { if (__any((al) < 1.f)) { if (hi == 0) al_l[r32] = (al); asm volatile("s_waitcnt lgkmcnt(0)" ::: "memory"); \
                     for (int d_ = 0; d_ < 4; ++d_) for (int r = 0; r < 16; ++r) o[d_][r] *= al_l[crow(r, hi)]; } } while (0)
#define PARTIAL(P0_, P1_, mnX, alX) do { if constexpr (MODE == 3) { sb_half(P1_, m_reg, hi); } else { partialSM<DQ>(P0_, P1_, m_reg, mnX, alX); } } while (0)
#define FINISH(P0_, P1_, alY) do { if constexpr (MODE == 3) { sb_half(P0_, m_reg, hi); sb_pack(P0_, P1_, pa0, pa1, pa2, pa3); } else { finishSM(P0_, P1_, alY, l_reg, pa0, pa1, pa2, pa3); } } while (0)
#define RESCALE(al) do { if constexpr (MODE != 3) { RESC(al); } } while (0)
    f32x16 pA0, pA1, pB0, pB1; float mnA = 0.f, mnB = 0.f, alA = 1.f, alB = 1.f; bf16x8 pa0, pa1, pa2, pa3;
    SLOAD(KBASE(0)); VMW(); SWRITE_K(0);
    __syncthreads();
    SWRITE_V(0); SBAR();
    if (NT > 1) SLOAD(KBASE(1));
    SBAR(); qkt<0, DQ>(pA0, pA1, K_lds, r32, hi, qr);
    SCORES(pA0, pA1, 0, 0); PARTIAL(pA0, pA1, mnA, alA);
    if (NT > 1) { VMW(); SWRITE(1); }
    __syncthreads();
#define HALF_STEP(PX0, PX1, mnX, alX, PY0, PY1, alY, t, KB, VB, SB) do {                                 \
        SBAR(); qkt<KB, DQ>(PX0, PX1, K_lds, r32, hi, qr);                                                \
        FINISH(PY0, PY1, alY); SBAR();                                                                    \
        if ((t) + 1 < NT) { SLOAD(KBASE((t) + 1)); SBAR(); }                                              \
        pv_tile<VB>(o, vb0, pa0, pa1, pa2, pa3); SCORES(PX0, PX1, (t), KB); PARTIAL(PX0, PX1, mnX, alX);   \
        __syncthreads();                                                                                  \
        if ((t) + 1 < NT) { VMW(); SWRITE(SB); }                                                          \
        RESCALE(alX); __syncthreads(); } while (0)
    for (int t = 1; t + 1 < NT; t += 2) {
        HALF_STEP(pB0, pB1, mnB, alB, pA0, pA1, alA, t, 1, 0, 0);
        HALF_STEP(pA0, pA1, mnA, alA, pB0, pB1, alB, t + 1, 0, 1, 1);
    }
    const bool even = (NT & 1) == 0;
    if (even) { SBAR(); qkt<1, DQ>(pB0, pB1, K_lds, r32, hi, qr); SBAR(); }
    FINISH(pA0, pA1, alA); SBAR();
    pv_tile<0>(o, vb0, pa0, pa1, pa2, pa3);
    if (even) { SCORES(pB0, pB1, NT - 1, 1); PARTIAL(pB0, pB1, mnB, alB); __syncthreads(); RESCALE(alB);
        FINISH(pB0, pB1, alB); SBAR(); pv_tile<1>(o, vb0, pa0, pa1, pa2, pa3); }
    __syncthreads();
#undef KBASE
#undef VMW
#undef SLOAD
#undef FRESH_TID
#undef SWRITE_K
#undef SWRITE_V
#undef SWRITE
#undef SCORES
#undef RESC
#undef PARTIAL
#undef FINISH
#undef RESCALE
#undef HALF_STEP
}

template <int DQ> __device__ __forceinline__ void load_q(bf16x8* qr, const bf16* qrow, int hi) {
#pragma unroll
    for (int d0 = 0; d0 < DQ / 16; ++d0) qr[d0] = *(const bf16x8*)(qrow + d0 * 16 + hi * 8);
}
__device__ __forceinline__ void load_lut(LAS char* lds, const float* lutg, float inv_scale) {
    LAS float* l = (LAS float*)(lds + L_LUT); const float far = lutg[1023];
    for (int i = threadIdx.x; i < LUT_N; i += NTHREADS) l[i] = (i < LUT_PAD) ? 0.f : (lutg[i - LUT_PAD] - far) * inv_scale;
}
__device__ __forceinline__ void store_o(const f32x16* o, const float* rl  , bf16* obase, int ldo, int r32, int hi) {
#pragma unroll
    for (int r = 0; r < 16; ++r) { const int orow = crow(r, hi);
#pragma unroll
        for (int d0 = 0; d0 < 4; ++d0) { const float v = o[d0][r] * rl[r]; const float vn = __shfl_xor(v, 1);
            if ((r32 & 1) == 0) *(unsigned*)(obase + (size_t)orow * ldo + d0 * 32 + r32) = cvtpk(v, vn); } }
}
}

__device__ __forceinline__ void fox_epilogue(const att::f32x16* o, float l_reg, LAS char* lds, bf16* oblk, int ldo) {
    int t_ = threadIdx.x; asm volatile("" : "+v"(t_)); const int wid = __builtin_amdgcn_readfirstlane(t_ >> 6), r32 = t_ & 31, hi = (t_ >> 5) & 1;
    LAS float* li_l = (LAS float*)(lds + att::L_WS) + wid * 64;
    if (hi == 0) li_l[r32] = l_reg; asm volatile("s_waitcnt lgkmcnt(0)" ::: "memory");
    float rli[16];
#pragma unroll
    for (int r = 0; r < 16; ++r) rli[r] = __builtin_amdgcn_rcpf(li_l[att::crow(r, hi)]);
    att::store_o(o, rli, oblk + (size_t)(wid * 32) * ldo, ldo, r32, hi);
    __syncthreads();
}
constexpr int CW_KMAX = 10496;
__device__ __forceinline__ void fox_block(const Args& A, LAS char* lds, int hd, int qb, bf16* obuf, int ldo, int ocol) {
    int tid_ = threadIdx.x; asm volatile("" : "+v"(tid_)); const int tid = tid_, wid = __builtin_amdgcn_readfirstlane(tid >> 6), lane = tid & 63, r32 = lane & 31, hi = lane >> 5;
    const bf16* h = (const bf16*)(A.ws + WS_H); const int P0 = qb * 256;
    const float* cg = (const float*)(A.ws + WS_C) + hd * SEQ;
    bf16x8 qr[8]; att::load_q<128>(qr, h + (size_t)(P0 + wid * 32 + r32) * NQKV + hd * 128, hi);
    att::ChunkArgs ca; ca.hbase = h; ca.kcolB = (unsigned)(1024 + hd * 128) * 2u; ca.vcolB = (unsigned)(2048 + hd * 128) * 2u;
    ca.qpos = P0 + wid * 32 + r32; ca.qlo = P0 + wid * 32; ca.cb = cg; ca.cref = cg[P0];
    float m_reg = -1e30f, l_reg = 0.f; att::f32x16 o[4] = {};
    LAS int* flg = (LAS int*)(lds + att::L_FLAG);
    int jb = P0 / 64 + 4;
    for (;;) {
        const int ja = jb > FOX_CH ? jb - FOX_CH : 0;
        ca.ja = ja; ca.jb = jb;
        att::attn_chunk<128, 0, true>(ca, qr, m_reg, l_reg, o, lds);
        if (ja == 0) break;
        float qn2 = 0.f;
#pragma unroll
        for (int d0 = 0; d0 < 8; ++d0)
#pragma unroll
            for (int j = 0; j < 8; ++j) { const float v = bf2f((unsigned short)qr[d0][j]); qn2 += v * v; }
        { auto rr = __builtin_amdgcn_permlane32_swap(__float_as_uint(qn2), __float_as_uint(qn2), false, false); qn2 = __uint_as_float(rr[0]) + __uint_as_float(rr[1]); }
        const float kmax2 = __uint_as_float(__hip_atomic_load((unsigned*)(A.ws + WS_CTL) + CW_KMAX + hd, RLX_AGENT));
        const float qk_bound = sqrtf(qn2 * kmax2) * 1.001f;
        const float kb_low = (ca.cref - cg[ja * 64]) * (1.f / SCALE128);
        const int done = __all((qk_bound + kb_low - m_reg) * (1.4426950408889634f * SCALE128) < -152.f) ? 1 : 0;
        { int t_ = threadIdx.x; asm volatile("" : "+v"(t_)); if ((t_ & 63) == 0) flg[t_ >> 6] = done; }
        __syncthreads();
        int all = 1;
#pragma unroll
        for (int w = 0; w < NWAVES; ++w) all &= flg[w];
        __syncthreads();
        if (all) break;
        jb = ja;
    }
    fox_epilogue(o, l_reg, lds, obuf + (size_t)P0 * ldo + ocol, ldo);
}

template <int MP>
__device__ __forceinline__ void diff_map(const Args& A, LAS char* lds, int hd, int qb, bf16* obuf) {
    int tid_ = threadIdx.x; asm volatile("" : "+v"(tid_)); const int tid = tid_, wid = __builtin_amdgcn_readfirstlane(tid >> 6), lane = tid & 63, r32 = lane & 31, hi = lane >> 5;
    const bf16* h = (const bf16*)(A.ws + WS_H); const int P0 = qb * 256;
    LAS unsigned short* stash = (LAS unsigned short*)(lds + att::L_STASH) + wid * 4096 + lane;
    LAS float* li_l = (LAS float*)(lds + att::L_WS) + wid * 64;
    bf16x8 qr[4]; att::load_q<64>(qr, h + (size_t)(P0 + wid * 32 + r32) * NQKV + hd * 128 + MP * 64, hi);
    att::ChunkArgs ca; ca.hbase = h; ca.kcolB = (unsigned)(1024 + hd * 128 + MP * 64) * 2u; ca.vcolB = (unsigned)(2048 + hd * 128) * 2u;
    ca.ja = 0; ca.jb = P0 / 64 + 4; ca.qpos = P0 + wid * 32 + r32; ca.qlo = P0 + wid * 32; ca.cb = nullptr; ca.cref = 0.f;
    float m_reg = -1e30f, l_reg = 0.f;
    att::f32x16 o[4] = {};
    att::attn_chunk<64, 1, false>(ca, qr, m_reg, l_reg, o, lds);
    if (hi == 0) li_l[r32] = l_reg; asm volatile("s_waitcnt lgkmcnt(0)" ::: "memory");
    if constexpr (MP == 0) {
#pragma unroll
        for (int r = 0; r < 16; ++r) { const float rl = __builtin_amdgcn_rcpf(li_l[att::crow(r, hi)]);
#pragma unroll
            for (int d0 = 0; d0 < 4; ++d0) stash[(r * 4 + d0) * 64] = (unsigned short)f2bf(o[d0][r] * rl); }
    } else {
        const float lam = ((const float*)(A.ws + WS_LAM))[0];
        bf16* ob = obuf + (size_t)(P0 + wid * 32) * DM + hd * 128;
#pragma unroll
        for (int r = 0; r < 16; ++r) { const float rl = lam * __builtin_amdgcn_rcpf(li_l[att::crow(r, hi)]); float v[4]; float ss = 0.f;
#pragma unroll
            for (int d0 = 0; d0 < 4; ++d0) { v[d0] = bf2f(stash[(r * 4 + d0) * 64]) - o[d0][r] * rl; ss += v[d0] * v[d0]; }
            ss += __shfl_xor(ss, 1); ss += __shfl_xor(ss, 2); ss += __shfl_xor(ss, 4); ss += __shfl_xor(ss, 8); ss += __shfl_xor(ss, 16);
            const float sc = rsqrtf(ss * (1.f / 128.f) + LN_EPS) * (1.f - LAMBDA_INIT); const int orow = att::crow(r, hi);
#pragma unroll
            for (int d0 = 0; d0 < 4; ++d0) { const float w = v[d0] * sc * A.subln_gain[d0 * 32 + r32]; const float wn = __shfl_xor(w, 1);
                if ((r32 & 1) == 0) *(unsigned*)(ob + (size_t)orow * DM + d0 * 32 + r32) = att::cvtpk(w, wn); } }
    }
    __syncthreads();
}
__device__ __forceinline__ void diff_block(const Args& A, LAS char* lds, int hd, int qb, bf16* obuf) {
    att::load_lut(lds, (const float*)(A.ws + WS_LUT) + hd * 1024, 1.f / SCALE64);
    diff_map<0>(A, lds, hd, qb, obuf);
    diff_map<1>(A, lds, hd, qb, obuf);
}

__device__ __forceinline__ void sb_block(const Args& A, LAS char* lds, int hd, int qb, bf16* obuf) {
    int tid_ = threadIdx.x; asm volatile("" : "+v"(tid_)); const int tid = tid_, wid = __builtin_amdgcn_readfirstlane(tid >> 6), lane = tid & 63, r32 = lane & 31, hi = lane >> 5;
    const bf16* h = (const bf16*)(A.ws + WS_H); const int P0 = qb * 256;
    bf16x8 qr[8]; att::load_q<128>(qr, h + (size_t)(P0 + wid * 32 + r32) * NQKV + 3072 + hd * 128, hi);
    att::ChunkArgs ca; ca.hbase = h; ca.kcolB = (unsigned)(4096 + hd * 128) * 2u; ca.vcolB = (unsigned)(5120 + hd * 128) * 2u;
    ca.qpos = P0 + wid * 32 + r32; ca.qlo = P0 + wid * 32; ca.cb = nullptr; ca.cref = 0.f;
    float R2 = 0.f, l_dummy = 0.f; att::f32x16 o[4] = {};
    LAS int* flg = (LAS int*)(lds + att::L_FLAG);
    int jb = P0 / 64 + 4;
    for (;;) {
#if SB_NOCHUNK
        const int ja = 0;
#else
        const int ja = jb > 8 ? jb - 8 : 0;
#endif
        ca.ja = ja; ca.jb = jb;
        att::attn_chunk<128, 3, true>(ca, qr, R2, l_dummy, o, lds);
        const int done = __all(R2 < -150.1f) ? 1 : 0;
        if (lane == 0) flg[wid] = done;
        __syncthreads();
        int all = 1;
#pragma unroll
        for (int w = 0; w < NWAVES; ++w) all &= flg[w];
        __syncthreads();
        if (all || ja == 0) break;
        jb = ja;
    }
#if SB_R2PROBE
    { float rm = fmaxf(R2, 0.f); for (int o_ = 1; o_ < 64; o_ <<= 1) rm = fmaxf(rm, __shfl_xor(rm, o_));
      if (lane == 0) { atomicMax((unsigned*)(A.ws + WS_CTL) + 10240, __float_as_uint(rm)); __hip_atomic_store((float*)(A.ws + WS_CTL) + 10241, 1.f, RLX_AGENT); } }
#endif
    float one[16];
#pragma unroll
    for (int r = 0; r < 16; ++r) one[r] = 1.f;
    att::store_o(o, one, obuf + (size_t)(P0 + wid * 32) * DM + (8 + hd) * 128, DM, r32, hi);
    __syncthreads();
}

__device__ __forceinline__ void sb_unit_test(const Args& A, float sentinel) {
    const int lane = threadIdx.x & 63, r32 = lane & 31, hi = lane >> 5;
    float maxerr = 0.f;
    for (int pat = 0; pat < 4; ++pat) {
        att::f32x16 p0, p1; float R2 = (pat == 3) ? -20.f : 0.f; const float R2in = R2;
        const int lim = (pat == 0) ? 64 : (pat == 1) ? (r32 * 2 + 1) : (pat == 2) ? (r32 < 16 ? 0 : 40) : 33;
#define ZRAW(k) (((k) >= lim) ? sentinel : (25.f * __sinf(0.37f * (float)(k) + 0.11f * (float)r32 + (float)pat)))
#pragma unroll
        for (int r = 0; r < 16; ++r) { p0[r] = ZRAW(att::crow(r, hi)); p1[r] = ZRAW(32 + att::crow(r, hi)); }
        att::sb_half(p1, R2, hi); att::sb_half(p0, R2, hi);
        constexpr float C2 = 1.4426950408889634f * SCALE128;
        float Rr = R2in;
        for (int k = 63; k >= 0; --k) { const float z2 = ZRAW(k) * C2; const float sp = fmaxf(z2, 0.f) + log2f(1.f + exp2f(-fabsf(z2))); const float aref = exp2f(z2 - sp + Rr); Rr -= sp;
#pragma unroll
            for (int r = 0; r < 16; ++r) { if (att::crow(r, hi) == k) maxerr = fmaxf(maxerr, fabsf(p0[r] - aref)); if (32 + att::crow(r, hi) == k) maxerr = fmaxf(maxerr, fabsf(p1[r] - aref)); }
            if (!(aref == aref)) maxerr = 1e9f; }
        maxerr = fmaxf(maxerr, fabsf(R2 - Rr) * 1e-3f);
        if (!(R2 == R2)) maxerr = 1e9f;
#pragma unroll
        for (int r = 0; r < 16; ++r) if (!(p0[r] == p0[r]) || !(p1[r] == p1[r])) maxerr = 1e9f;
#undef ZRAW
    }
    for (int o_ = 1; o_ < 64; o_ <<= 1) maxerr = fmaxf(maxerr, __shfl_xor(maxerr, o_));
    if (lane == 0) { atomicMax((unsigned*)(A.ws + WS_CTL) + 10240, __float_as_uint(maxerr)); __hip_atomic_store((float*)(A.ws + WS_CTL) + 10241, 1.f, RLX_AGENT); }
}

constexpr size_t DO_LSE = 2 * MiB, DO_MLIST = 4 * MiB;
__device__ __forceinline__ void moba_block(const Args& A, LAS char* lds, int hd, int n, int chunk  , int cnt) {
    int tid_ = threadIdx.x; asm volatile("" : "+v"(tid_)); const int tid = tid_, wid = __builtin_amdgcn_readfirstlane(tid >> 6), lane = tid & 63, r32 = lane & 31, hi = lane >> 5;
    const bf16* h = (const bf16*)(A.ws + WS_H);
    int t, slot, valid;
    if (chunk < 0) { t = n * 256 + wid * 32 + r32; slot = 3; valid = 1; }
    else { const int idx = chunk * 256 + wid * 32 + r32; valid = idx < cnt; const int ent = valid ? ((const int*)((const unsigned char*)A.out + DO_MLIST))[(size_t)(hd * 64 + n) * SEQ + idx] : (SEQ - 1) * 4; t = ent >> 2; slot = ent & 3; }
    bf16x8 qr[8]; att::load_q<128>(qr, h + (size_t)t * NQKV + 3072 + hd * 128, hi);
    att::ChunkArgs ca; ca.hbase = h; ca.kcolB = (unsigned)(4096 + hd * 128) * 2u; ca.vcolB = (unsigned)(5120 + hd * 128) * 2u;
    ca.ja = n * 4; ca.jb = n * 4 + 4; ca.qpos = t; ca.qlo = 0; ca.cb = nullptr; ca.cref = 0.f;
    float m_reg = -1e30f, l_reg = 0.f; att::f32x16 o[4] = {};
    att::attn_chunk<128, 2, false>(ca, qr, m_reg, l_reg, o, lds);
    LAS float* li_l = (LAS float*)(lds + att::L_WS) + wid * 64; LAS int* dst_l = (LAS int*)(li_l + 32);
    const int dst = valid ? ((hd * SEQ + t) * 4 + slot) : -1;
    if (hi == 0) { li_l[r32] = l_reg; dst_l[r32] = dst;
        if (valid) ((float*)((unsigned char*)A.out + DO_LSE))[dst] = m_reg * (1.4426950408889634f * SCALE128) + __builtin_amdgcn_logf(l_reg); }
    asm volatile("s_waitcnt lgkmcnt(0)" ::: "memory");
    bf16* part = (bf16*)(A.ws + WS_Y);
#pragma unroll
    for (int r = 0; r < 16; ++r) { const int row = att::crow(r, hi); const int d = dst_l[row]; const float rl = __builtin_amdgcn_rcpf(li_l[row]);
#pragma unroll
        for (int d0 = 0; d0 < 4; ++d0) { const float v = o[d0][r] * rl; const float vn = __shfl_xor(v, 1);
            if ((r32 & 1) == 0 && d >= 0) *(unsigned*)(part + (size_t)d * 128 + d0 * 32 + r32) = att::cvtpk(v, vn); } }
    __syncthreads();
}
__device__ __forceinline__ void moba_phase(const Args& A, LAS char* lds, int G) {
    const int tid = fresh_tid();
    LAS int* pre = (LAS int*)(lds + att::L_STASH);
    LAS int* cnts = pre + 520;
    if (tid < 512) { const int c = (int)__hip_atomic_load((unsigned*)(A.ws + WS_CTL) + CW_MOBACNT + tid, RLX_AGENT); cnts[tid] = c; pre[tid] = (c + 255) >> 8; }
    __syncthreads();
    if (tid == 0) { int acc = 0; for (int i = 0; i < 512; ++i) { const int v = pre[i]; pre[i] = acc; acc += v; } pre[512] = acc; }
    __syncthreads();
    const int total = 512 + pre[512];
    int curhd = -1;
    for (int u = blockIdx.x; u < total; u += G) {
        int hn, chunk;
        if (u < 512) { hn = u; chunk = -1; }
        else { const int g = u - 512; int lo = 0, hi_ = 511;
            while (lo < hi_) { const int mid = (lo + hi_ + 1) >> 1; if (pre[mid] <= g) lo = mid; else hi_ = mid - 1; }
            hn = lo; chunk = g - pre[hn]; }
        const int hd = hn >> 6, n = hn & 63;
        if (hd != curhd) { att::load_lut(lds, (const float*)(A.ws + WS_LUT) + hd * 1024, 1.f / SCALE128); curhd = hd; }
        moba_block(A, lds, hd, n, chunk, cnts[hn]);
    }
}
__device__ __forceinline__ void moba_combine(const Args& A, int G, bf16* obuf) {
    const int tid = fresh_tid(), lane = tid & 63, wave = tid >> 6;
    const float* lse = (const float*)((const unsigned char*)A.out + DO_LSE); const bf16* part = (const bf16*)(A.ws + WS_Y);
    for (int it = blockIdx.x * NWAVES + wave; it < 8 * SEQ; it += G * NWAVES) { const int hd = it >> 14, t = it & (SEQ - 1);
        const int own = t >> 8, nsel = own < 3 ? own : 3; const size_t base = ((size_t)hd * SEQ + t) * 4;
        float l[4]; float mx = lse[base + 3]; l[3] = mx;
#pragma unroll
        for (int j = 0; j < 3; ++j) { l[j] = (j < nsel) ? lse[base + j] : -3e38f; mx = fmaxf(mx, l[j]); }
        float w[4], ws_ = 0.f;
#pragma unroll
        for (int j = 0; j < 4; ++j) { w[j] = (j == 3 || j < nsel) ? __builtin_amdgcn_exp2f(l[j] - mx) : 0.f; ws_ += w[j]; }
        const float inv = 1.f / ws_; float a0 = 0.f, a1 = 0.f;
#pragma unroll
        for (int j = 0; j < 4; ++j) if (j == 3 || j < nsel) { const unsigned pw = *(const unsigned*)(part + (base + j) * 128 + lane * 2); a0 += w[j] * bflo(pw); a1 += w[j] * bfhi(pw); }
        *(unsigned*)(obuf + (size_t)t * DM + (8 + hd) * 128 + lane * 2) = pk2(a0 * inv, a1 * inv); }
}


constexpr int CW_Q4 = 10560, CW_Q12 = 10752, CW_QM = 10944;
__device__ __forceinline__ int next_item(const Args& A, int cw, LAS int* slot) {
    __syncthreads();
    if (threadIdx.x == 0) *slot = (int)__hip_atomic_fetch_add((unsigned*)(A.ws + WS_CTL) + cw, 1u, RLX_AGENT);
    __syncthreads();
    return *slot;
}

template <bool RES_F32>
__device__ __forceinline__ void p_ln1_router(const Args& A, char* lds, int G, int layer, const void* xres, const bf16* y, bf16* x1) {
    const int tid = fresh_tid(), lane = tid & 63, wave = tid >> 6;
    float* wT = (float*)lds; int* rinfo = (int*)(lds + 131072); int* lcnt = (int*)(lds + 139264); int* gbase = lcnt + 16;
    for (int idx = tid; idx < 16 * DM; idx += NTHREADS) { const int d = idx >> 4, e = idx & 15; wT[e * DM + d] = A.w_router[idx]; }
    if (tid < 16) lcnt[tid] = 0;
    __syncthreads();
    const int rows_per = (SEQ + G - 1) / G; const int row0 = blockIdx.x * rows_per; int nrows = SEQ - row0; nrows = nrows < 0 ? 0 : (nrows > rows_per ? rows_per : nrows);
    const float* gain = A.ln_gain + (size_t)(layer * 2 + 0) * DM; const float* bias = A.ln_bias + (size_t)(layer * 2 + 0) * DM;
    for (int r = wave; r < nrows; r += NWAVES) {
        const int m = row0 + r;
        f32x4 v[8]; float s = 0.f;
#pragma unroll
        for (int j = 0; j < 8; ++j) {
            f32x4 xr;
            if constexpr (RES_F32) xr = *((const f32x4*)((const float*)xres + (size_t)m * DM) + lane + 64 * j);
            else { const v2u w = *((const v2u*)((const bf16*)xres + (size_t)m * DM) + lane + 64 * j); xr = (f32x4){bflo(w.x), bfhi(w.x), bflo(w.y), bfhi(w.y)}; }
            const v2u yw = *((const v2u*)(y + (size_t)m * DM) + lane + 64 * j);
            v[j] = xr * ALPHA + (f32x4){bflo(yw.x), bfhi(yw.x), bflo(yw.y), bfhi(yw.y)};
            s += (v[j].x + v[j].y) + (v[j].z + v[j].w); }
        const float mean = wave_sum(s) * (1.f / DM); float s2 = 0.f;
#pragma unroll
        for (int j = 0; j < 8; ++j) { v[j] = v[j] - mean; s2 += (v[j].x * v[j].x + v[j].y * v[j].y) + (v[j].z * v[j].z + v[j].w * v[j].w); }
        const float rstd = rsqrtf(wave_sum(s2) * (1.f / DM) + LN_EPS);
#pragma unroll
        for (int j = 0; j < 8; ++j) { const f32x4 gg = *((const f32x4*)gain + lane + 64 * j), bb = *((const f32x4*)bias + lane + 64 * j); v[j] = v[j] * rstd * gg + bb;
            v2u w; w.x = pk2(v[j].x, v[j].y); w.y = pk2(v[j].z, v[j].w); *((v2u*)(x1 + (size_t)m * DM) + lane + 64 * j) = w;
            *((unsigned*)(A.ws + WS_X1F8 + (size_t)m * DM) + lane + 64 * j) = pk4_fp8(v[j].x, v[j].y, v[j].z, v[j].w); }
        float lg[16];
#pragma unroll
        for (int e = 0; e < 16; ++e) { float a = 0.f;
#pragma unroll
            for (int j = 0; j < 8; ++j) { const f32x4 w = *(const f32x4*)(wT + e * DM + 256 * j + 4 * lane); a += v[j].x * w.x + v[j].y * w.y + v[j].z * w.z + v[j].w * w.w; }
            lg[e] = wave_sum(a) + A.b_router[e]; }
        int gs = 0; float gbest = fmaxf(fmaxf(lg[0], lg[1]), fmaxf(lg[2], lg[3]));
#pragma unroll
        for (int g = 1; g < 4; ++g) { const float gm = fmaxf(fmaxf(lg[4 * g], lg[4 * g + 1]), fmaxf(lg[4 * g + 2], lg[4 * g + 3])); if (gm > gbest) { gbest = gm; gs = g; } }
        float c0 = 0.f, c1 = 0.f, c2 = 0.f, c3 = 0.f;
#pragma unroll
        for (int g = 0; g < 4; ++g) if (gs == g) { c0 = lg[4 * g]; c1 = lg[4 * g + 1]; c2 = lg[4 * g + 2]; c3 = lg[4 * g + 3]; }
        float b0 = c0; int k0 = 0; if (c1 > b0) { b0 = c1; k0 = 1; } if (c2 > b0) { b0 = c2; k0 = 2; } if (c3 > b0) { b0 = c3; k0 = 3; }
        float b1 = -3e38f; int k1 = 0;
        if (k0 != 0 && c0 > b1) { b1 = c0; k1 = 0; } if (k0 != 1 && c1 > b1) { b1 = c1; k1 = 1; } if (k0 != 2 && c2 > b1) { b1 = c2; k1 = 2; } if (k0 != 3 && c3 > b1) { b1 = c3; k1 = 3; }
        const float ex = __expf(b1 - b0); const float w0 = 1.f / (1.f + ex), w1 = ex / (1.f + ex);
        if (lane == 0) { const int e0 = gs * 4 + k0, e1 = gs * 4 + k1; const int p0 = atomicAdd(&lcnt[e0], 1), p1 = atomicAdd(&lcnt[e1], 1);
            int* ri = rinfo + r * 8; ri[0] = e0; ri[1] = e1; ri[2] = __builtin_bit_cast(int, w0); ri[3] = __builtin_bit_cast(int, w1); ri[4] = p0; ri[5] = p1; }
    }
    __syncthreads();
    if (tid < 16) gbase[tid] = (int)__hip_atomic_fetch_add((unsigned*)(A.ws + WS_CTL) + CW_MOECNT + layer * 64 + tid, (unsigned)lcnt[tid], RLX_AGENT);
    __syncthreads();
    int* mlist = (int*)(A.ws + WS_MLIST) + (size_t)layer * 16 * SEQ; float* mgw = (float*)(A.ws + WS_MGW) + (size_t)layer * 16 * SEQ;
    if (tid < nrows) { const int* ri = rinfo + tid * 8; const int m = row0 + tid;
        const int e0 = ri[0], e1 = ri[1]; const int q0 = gbase[e0] + ri[4], q1 = gbase[e1] + ri[5];
        mlist[e0 * SEQ + q0] = m * 2 + 0; mgw[e0 * SEQ + q0] = __builtin_bit_cast(float, ri[2]);
        mlist[e1 * SEQ + q1] = m * 2 + 1; mgw[e1 * SEQ + q1] = __builtin_bit_cast(float, ri[3]); }
    __syncthreads();
}

struct MoeTable { const LAS int* t; };
__device__ __forceinline__ void moe_build_table(const Args& A, LAS int* tbl, int layer) {
    if (threadIdx.x == 0) { int acc = 0;
        for (int e = 0; e < 16; ++e) { const int c = (int)__hip_atomic_load((unsigned*)(A.ws + WS_CTL) + CW_MOECNT + layer * 64 + e, RLX_AGENT); tbl[e] = acc; tbl[17 + e] = c; acc += (c + 255) >> 8; }
        tbl[16] = acc; tbl[33] = acc; }
    __syncthreads();
}
template <bool GATH>
struct MoeOrder {
    static constexpr bool GATHER = GATH;
    const LAS int* tbl; const int* list; size_t bstride;
    int G, c;
    __device__ bool next(int i, pg8::Unit& u) const {
        const int L = i * G + c; const int total = tbl[16];
        if (L >= total * 8) return false;
        const int mt = L >> 3; u.pn = L & 7; u.pm = mt; int e = 0;
#pragma unroll
        for (int j = 1; j < 16; ++j) e += (mt >= tbl[j]) ? 1 : 0;
        u.e = e; u.mi = mt - tbl[e]; return true;
    }
    __device__ __forceinline__ unsigned a_off(const pg8::Gemm& g, const pg8::Unit& u) const {
        if constexpr (GATH) return 0u; else return (unsigned)u.pm * 256u * (unsigned)g.rb; }
    __device__ __forceinline__ unsigned b_off(const pg8::Gemm& g, const pg8::Unit& u) const { return (unsigned)u.e * (unsigned)bstride + (unsigned)u.pn * 256u * (unsigned)g.rb; }
    __device__ __forceinline__ void a_voff(const pg8::Gemm& g, const pg8::Unit& u, const int (&R)[2], const int (&C)[2], unsigned (&vo)[2][2]) const {
        if constexpr (GATH) { const int cnt = tbl[17 + u.e];
#pragma unroll
            for (int h = 0; h < 2; ++h)
#pragma unroll
                for (int i = 0; i < 2; ++i) { const int idx = u.mi * 256 + h * 128 + R[i]; const int tok = (idx < cnt) ? (list[u.e * SEQ + idx] >> 1) : 0; vo[h][i] = (unsigned)(tok * g.rb + C[i] * 2); }
        } else {
#pragma unroll
            for (int h = 0; h < 2; ++h)
#pragma unroll
                for (int i = 0; i < 2; ++i) vo[h][i] = (unsigned)((h * 128 + R[i]) * g.rb + C[i] * 2);
        }
    }
};
struct EpiSwiglu {
    static constexpr bool PERM = true;
    unsigned char* H;
    __device__ __forceinline__ void operator()(const pg8::f32x4 (&acc)[2][2][4][2], const pg8::Unit& u, int wr, int wc, int fr, int fq) const {
        const int row0 = u.pm * 256 + wr * 64 + fr, col0 = u.pn * 128 + wc * 32 + 8 * fq;
#pragma unroll
        for (int ai = 0; ai < 2; ++ai)
#pragma unroll
            for (int m = 0; m < 4; ++m) { float hv[8];
#pragma unroll
                for (int n = 0; n < 2; ++n)
#pragma unroll
                    for (int i = 0; i < 4; ++i) { const float gt = acc[ai][0][m][n][i], up = acc[ai][1][m][n][i]; hv[n * 4 + i] = gt * __builtin_amdgcn_rcpf(1.f + __expf(-gt)) * up; }
                v2u w; w.x = pk4_fp8(hv[0], hv[1], hv[2], hv[3]); w.y = pk4_fp8(hv[4], hv[5], hv[6], hv[7]);
                *(v2u*)(H + (size_t)(row0 + ai * 128 + m * 16) * DEXP + col0) = w; asm volatile("" ::: "memory"); }
    }
};
struct EpiDown {
    static constexpr bool PERM = true;
    bf16* Y; const LAS int* tbl; const int* list; const float* gw;
    __device__ __forceinline__ void operator()(const pg8::f32x4 (&acc)[2][2][4][2], const pg8::Unit& u, int wr, int wc, int fr, int fq) const {
        const int cnt = tbl[17 + u.e]; const int col0 = u.pn * 256 + wc * 32 + 8 * fq;
#pragma unroll
        for (int ai = 0; ai < 2; ++ai)
#pragma unroll
            for (int m = 0; m < 4; ++m) { const int idx = u.mi * 256 + ai * 128 + wr * 64 + m * 16 + fr;
                if (idx < cnt) { const int ent = list[u.e * SEQ + idx]; const float g = gw[u.e * SEQ + idx];
                    bf16* rowp = Y + ((size_t)(ent & 1) * SEQ + (size_t)(ent >> 1)) * DM + col0;
#pragma unroll
                    for (int bj = 0; bj < 2; ++bj) { const pg8::f32x4 v0 = acc[ai][bj][m][0] * g, v1 = acc[ai][bj][m][1] * g;
                        pg8::u32x4 w; w.x = pg8::cvt_pk_bf16(v0[0], v0[1]); w.y = pg8::cvt_pk_bf16(v0[2], v0[3]); w.z = pg8::cvt_pk_bf16(v1[0], v1[1]); w.w = pg8::cvt_pk_bf16(v1[2], v1[3]);
                        *(pg8::u32x4*)(rowp + bj * 128) = w; } }
                asm volatile("" ::: "memory"); }
    }
};

template <bool OUT_F32>
__device__ __forceinline__ void p_ln2(const Args& A, int G, int layer, const bf16* x1, const bf16* ys, void* outp) {
    const int tid = fresh_tid(), lane = tid & 63, wave = tid >> 6;
    const int gw = blockIdx.x * NWAVES + wave, NGW = G * NWAVES;
    const float* gain = A.ln_gain + (size_t)(layer * 2 + 1) * DM; const float* bias = A.ln_bias + (size_t)(layer * 2 + 1) * DM;
    for (int m = gw; m < SEQ; m += NGW) {
        f32x4 v[8]; float s = 0.f;
#pragma unroll
        for (int j = 0; j < 8; ++j) {
            const v2u a = *((const v2u*)(x1 + (size_t)m * DM) + lane + 64 * j), b = *((const v2u*)(ys + (size_t)m * DM) + lane + 64 * j), c = *((const v2u*)(ys + ((size_t)SEQ + m) * DM) + lane + 64 * j);
            v[j] = (f32x4){bflo(a.x), bfhi(a.x), bflo(a.y), bfhi(a.y)} * ALPHA + (f32x4){bflo(b.x), bfhi(b.x), bflo(b.y), bfhi(b.y)} + (f32x4){bflo(c.x), bfhi(c.x), bflo(c.y), bfhi(c.y)};
            s += (v[j].x + v[j].y) + (v[j].z + v[j].w); }
        const float mean = wave_sum(s) * (1.f / DM); float s2 = 0.f;
#pragma unroll
        for (int j = 0; j < 8; ++j) { v[j] = v[j] - mean; s2 += (v[j].x * v[j].x + v[j].y * v[j].y) + (v[j].z * v[j].z + v[j].w * v[j].w); }
        const float rstd = rsqrtf(wave_sum(s2) * (1.f / DM) + LN_EPS);
#pragma unroll
        for (int j = 0; j < 8; ++j) { const f32x4 gg = *((const f32x4*)gain + lane + 64 * j), bb = *((const f32x4*)bias + lane + 64 * j); v[j] = v[j] * rstd * gg + bb;
            if constexpr (OUT_F32) *((f32x4*)((float*)outp + (size_t)m * DM) + lane + 64 * j) = v[j];
            else { v2u w; w.x = pk2(v[j].x, v[j].y); w.y = pk2(v[j].z, v[j].w); *((v2u*)((bf16*)outp + (size_t)m * DM) + lane + 64 * j) = w; } }
    }
}


constexpr int CW_TEST = 10240;
__device__ __forceinline__ void p_compare(const Args& A, int G, const bf16* a, const bf16* b, int c0, int nc) {
    const int tid = fresh_tid(); float num = 0.f, den = 0.f;
    const size_t total = (size_t)SEQ * nc;
    for (size_t i = (size_t)blockIdx.x * NTHREADS + tid; i < total; i += (size_t)G * NTHREADS) { const int m = (int)(i / nc), c = (int)(i % nc);
        const float x = bf2f(a[(size_t)m * DM + c0 + c]), y = bf2f(b[(size_t)m * DM + c0 + c]);
        if ((m & 255) < TEST_RLO || (m & 255) >= TEST_RHI) continue;
#if TEST_NANCOUNT == 2
        if (x == x) num = fmaxf(num, fabsf(x)); den = 1.f;
#elif TEST_NANCOUNT == 1
        num += (x == x && fabsf(x) < 1e4f) ? 0.f : 1.f; den += 1.f;
#else
        float d2 = (x - y) * (x - y); if (!(d2 == d2) || d2 > 1e12f) d2 = TEST_BADVAL; num += d2; den += y * y;
#endif
    }
#if TEST_NANCOUNT == 2
    for (int o = 1; o < 64; o <<= 1) num = fmaxf(num, __shfl_xor(num, o));
    if ((tid & 63) == 0) { atomicMax((unsigned*)(A.ws + WS_CTL) + CW_TEST, __float_as_uint(num)); __hip_atomic_store((float*)(A.ws + WS_CTL) + CW_TEST + 1, 1.f, RLX_AGENT); }
#else
    num = wave_sum(num); den = wave_sum(den);
    if ((tid & 63) == 0) { atomicAdd((float*)(A.ws + WS_CTL) + CW_TEST, num); atomicAdd((float*)(A.ws + WS_CTL) + CW_TEST + 1, den); }
#endif
}
__device__ __forceinline__ void p_apply_test(const Args& A, int G) {
    const float num = __hip_atomic_load((float*)(A.ws + WS_CTL) + CW_TEST, RLX_AGENT), den = __hip_atomic_load((float*)(A.ws + WS_CTL) + CW_TEST + 1, RLX_AGENT);
    const float f = 1.f + TEST_GAIN * sqrtf(num / den);
    for (size_t i = (size_t)blockIdx.x * NTHREADS + threadIdx.x; i < (size_t)SEQ * DM; i += (size_t)G * NTHREADS) A.out[i] *= f;
}

constexpr int NPHASE = 18 + (TEST_ATT ? 1 : 0);
__global__ void __launch_bounds__(NTHREADS, 2) fwd(Args A) {
    extern __shared__ __attribute__((aligned(16))) unsigned char lds[];
    LAS unsigned char* ldsl = (LAS unsigned char*)lds;
    const int tid = fresh_tid(); const int G = gridDim.x;
    for (int u = tid; u < (LDS_BYTES - LCTL_OFF) / 4; u += NTHREADS) ((LAS unsigned*)(ldsl + LCTL_OFF))[u] = 0u;
    __syncthreads();
    unsigned char* ws = A.ws;
    const int lo = A.ph_lo, hi = A.ph_hi;
    const bool fused = (hi - lo) > 1;
    XcdBarrier bar; bar.bar = (unsigned*)(ws + WS_CTL) + CW_BAR; bar.x = 0; bar.st = nullptr;
    if (fused) bar = xcd_barrier_post((unsigned*)(ws + WS_CTL) + CW_BAR, (volatile LAS unsigned*)(ldsl + LCTL_OFF));
#define IN(k) (lo <= (k) && (k) < hi)
#define SEAM(k) do { if (IN(k) && IN((k) + 1)) xcd_barrier(bar); } while (0)
    bf16* xb = (bf16*)(ws + WS_XB); bf16* hb = (bf16*)(ws + WS_H); bf16* ob = (bf16*)(ws + WS_O); bf16* yb = (bf16*)(ws + WS_Y); bf16* x1 = (bf16*)(ws + WS_X1);
    bf16* hid = (bf16*)(ws + WS_HID); bf16* ysl = (bf16*)(ws + WS_YSLOT);
    int* sel = (int*)((unsigned char*)A.out + DO_SEL);
    LAS int* mtbl = (LAS int*)(ldsl + LCTL_OFF + 256);

    if (IN(0)) { p0_prologue(A, ldsl, G);
#if DBL_PHASE == 0
        __syncthreads(); p0_prologue(A, ldsl, G);
#endif
    } SEAM(0);
#define LAYER_BACK(layer, P_OUT, WOUT, RESF32, XRES) \
    if (IN(P_OUT)) { pg8::Gemm g{ob, (const bf16*)(ws + WOUT), SEQ, DM, DM, DM * 2}; pg8::DenseOrder S; S.init(SEQ, DM, G, (int)blockIdx.x); \
        pg8::EpiBf16 E{yb, DM}; pg8::gemm_phase<pg8::EpiBf16, pg8::DenseOrder>(ldsl, g, S, E); } \
    SEAM(P_OUT); \
    if (IN(P_OUT + 1)) { p_ln1_router<RESF32>(A, (char*)lds, G, layer, (const void*)(XRES), yb, x1); } \
    SEAM(P_OUT + 1); \
    if (IN(P_OUT + 2)) { moe_build_table(A, mtbl, layer); \
        pg8::Gemm g{(const bf16*)(ws + WS_X1F8), (const bf16*)(ws + WS_WGU + (size_t)layer * 16 * 2048 * 2048), 0, 2048, DM, DM}; \
        MoeOrder<true> S{mtbl, (const int*)(ws + WS_MLIST) + (size_t)layer * 16 * SEQ, (size_t)2048 * 2048, G, (int)blockIdx.x}; EpiSwiglu E{(unsigned char*)hid}; \
        pg8::gemm_phase<EpiSwiglu, MoeOrder<true>, true, 122, 127>(ldsl, g, S, E); } \
    SEAM(P_OUT + 2); \
    if (IN(P_OUT + 3)) { moe_build_table(A, mtbl, layer); \
        pg8::Gemm g{hid, (const bf16*)(ws + WS_WDN + (size_t)layer * 16 * 2048 * 1024), 0, 2048, DEXP, DEXP}; \
        const int* mlist = (const int*)(ws + WS_MLIST) + (size_t)layer * 16 * SEQ; const float* mgw = (const float*)(ws + WS_MGW) + (size_t)layer * 16 * SEQ; \
        MoeOrder<false> S{mtbl, mlist, (size_t)2048 * 1024, G, (int)blockIdx.x}; EpiDown E{ysl, mtbl, mlist, mgw}; \
        pg8::gemm_phase<EpiDown, MoeOrder<false>, true, 122, 127>(ldsl, g, S, E); } \
    SEAM(P_OUT + 3);
    if (IN(1)) { pg8::Gemm g{xb, (const bf16*)(ws + WS_WIN0), SEQ, NQKV, DM, DM}; pg8::DenseOrder S; S.init(SEQ, NQKV, G, (int)blockIdx.x);
        pg8::EpiBf16 E{hb, NQKV}; pg8::gemm_phase<pg8::EpiBf16, pg8::DenseOrder, true, 122, 127>(ldsl, g, S, E); }
    SEAM(1);
    if (IN(2)) p2_kmean_cumsum(A, (char*)lds, G); SEAM(2);
    if (IN(3)) p3_gate_cfinal(A, (char*)lds, G, sel); SEAM(3);
#if TEST_ATT
    if (IN(4)) { for (int u = blockIdx.x; u < 2048; u += G) { const int var = u >> 10, hd = (u >> 7) & 7, qb = u & 127;
            if (var == 0) naive_attn_unit<0>(A, (char*)lds, hd, qb, sel); else naive_attn_unit<1>(A, (char*)lds, hd, qb, sel); } }
#else
    if (IN(4)) { for (;;) { const int it = next_item(A, CW_Q4, (LAS int*)(ldsl + LCTL_OFF + 512)); if (it >= 512) break;
            fox_block(A, (LAS char*)ldsl, it & 7, 63 - (it >> 3), ob, DM, (it & 7) * 128); }
        moba_phase(A, (LAS char*)ldsl, G);
#if DBL_PHASE == 4
        for (int it = blockIdx.x; it < 512; it += G) { const int hd = (it & 255) >> 5, x = it & 31; fox_block(A, (LAS char*)ldsl, hd, (it < 256) ? 63 - x : x, ob, DM, hd * 128); }
#endif
#if DBL_PHASE == 41
        moba_phase(A, (LAS char*)ldsl, G);
#endif
    }
#endif
#if TEST_ATT == 4
    if (IN(4)) moba_phase(A, (LAS char*)ldsl, G);
#endif
#if TEST_ATT == 1
    if (IN(4)) { for (int u = blockIdx.x; u < 512; u += G) fox_block(A, (LAS char*)ldsl, u >> 6, u & 63, yb, DM, (u >> 6) * 128); }
#endif
    SEAM(4);
#if !TEST_ATT
    if (IN(5)) moba_combine(A, G, ob);
#endif
#if TEST_ATT == 1
    if (IN(5)) p_compare(A, G, yb, ob, 0, 1024);
#endif
#if TEST_ATT == 4
    if (IN(5)) moba_combine(A, G, xb);
    SEAM(5);
    if (IN(5)) p_compare(A, G, xb, ob, 1024, 1024);
#endif
    SEAM(5);
    LAYER_BACK(0, 6, WS_WOUT0, true, A.x)
    if (IN(10)) p_ln2<false>(A, G, 0, x1, ysl, (void*)xb);
    SEAM(10);
    if (IN(11)) { pg8::Gemm g{xb, (const bf16*)(ws + WS_WIN1), SEQ, NQKV, DM, DM * 2}; pg8::DenseOrder S; S.init(SEQ, NQKV, G, (int)blockIdx.x);
        pg8::EpiBf16 E{hb, NQKV}; pg8::gemm_phase<pg8::EpiBf16, pg8::DenseOrder>(ldsl, g, S, E);
#if DBL_PHASE == 11
        __syncthreads(); pg8::gemm_phase<pg8::EpiBf16, pg8::DenseOrder>(ldsl, g, S, E);
#endif
    }
    SEAM(11);
#if TEST_ATT
    if (IN(12)) { for (int u = blockIdx.x; u < 2048; u += G) { const int var = u >> 10, hd = (u >> 7) & 7, qb = u & 127;
            if (var == 0) naive_attn_unit<2>(A, (char*)lds, hd, qb, sel); else naive_attn_unit<3>(A, (char*)lds, hd, qb, sel); } }
#else
    if (IN(12)) { for (;;) { const int it = next_item(A, CW_Q12, (LAS int*)(ldsl + LCTL_OFF + 512)); if (it >= 512) break;
            diff_block(A, (LAS char*)ldsl, it & 7, 63 - (it >> 3), ob); }
        for (;;) { const int it = next_item(A, CW_Q12 + 64, (LAS int*)(ldsl + LCTL_OFF + 512)); if (it >= 512) break;
            sb_block(A, (LAS char*)ldsl, it & 7, 63 - (it >> 3), ob); }
#if DBL_PHASE == 12
        for (int it = blockIdx.x; it < 512; it += G) { const int hd = (it & 255) >> 5, x = it & 31; diff_block(A, (LAS char*)ldsl, hd, (it < 256) ? 63 - x : x, ob); }
#endif
#if DBL_PHASE == 121
        for (int u = blockIdx.x; u < 512; u += G) sb_block(A, (LAS char*)ldsl, u >> 6, u & 63, ob);
#endif
    }
#endif
#if TEST_ATT == 3
    if (IN(12) && blockIdx.x == 0) sb_unit_test(A, TEST_SENT);
#endif
#if TEST_ATT == 2
    if (IN(12)) { for (int u = blockIdx.x; u < 512; u += G) diff_block(A, (LAS char*)ldsl, u >> 6, u & 63, yb);
        for (int u = blockIdx.x; u < 512; u += G) sb_block(A, (LAS char*)ldsl, u >> 6, u & 63, yb); }
    SEAM(12);
#if !SB_R2PROBE
    if (IN(12)) p_compare(A, G, yb, ob, TEST_C0, TEST_NC);
#endif
#endif
    SEAM(12);
    LAYER_BACK(1, 13, WS_WOUT1, false, xb)
    if (IN(17)) p_ln2<true>(A, G, 1, x1, ysl, (void*)A.out);
#if TEST_ATT
    SEAM(17);
    if (IN(18)) p_apply_test(A, G);
#endif
#undef LAYER_BACK
#undef IN
#undef SEAM
}

#ifndef MK_FUSED
#define MK_FUSED 1
#endif
extern "C" void kernel_launch(void* const* d_in, const int* in_sizes, int n_in, void* d_out, int out_size, void* d_ws, size_t ws_size, hipStream_t stream) {
    static int grid = 0;
    if (grid == 0) {
        if (n_in != 17 || out_size != SEQ * DM || ws_size < WS_END) { fprintf(stderr, "kernel_launch: unexpected shapes (n_in %d out %d ws %zu)\n", n_in, out_size, ws_size); grid = -1; return; }
        int dev = 0, cus = 0, per_cu = 0;
        if (hipGetDevice(&dev) != hipSuccess || hipDeviceGetAttribute(&cus, hipDeviceAttributeMultiprocessorCount, dev) != hipSuccess) { grid = -1; return; }
        if (hipFuncSetAttribute((const void*)fwd, hipFuncAttributeMaxDynamicSharedMemorySize, LDS_BYTES) != hipSuccess) { fprintf(stderr, "kernel_launch: hipFuncSetAttribute failed\n"); grid = -1; return; }
        if (hipOccupancyMaxActiveBlocksPerMultiprocessor(&per_cu, (const void*)fwd, NTHREADS, LDS_BYTES) != hipSuccess || per_cu < 1) fprintf(stderr, "kernel_launch: occupancy query says %d\n", per_cu);
        (void)hipGetLastError();
        grid = cus;
    }
    if (grid < 0) return;
    (void)hipMemsetAsync((char*)d_ws + WS_CTL, 0, CTL_ZERO_BYTES, stream);
    Args a{};
    a.x = (const float*)d_in[0]; a.w_in_even = (const float*)d_in[1]; a.w_out_even = (const float*)d_in[2]; a.forget_bias = (const float*)d_in[3];
    a.w_in_odd = (const float*)d_in[4]; a.w_out_odd = (const float*)d_in[5]; a.lambda_q = (const float*)d_in[6]; a.lambda_k = (const float*)d_in[7];
    a.subln_gain = (const float*)d_in[8]; a.rel_bias = (const float*)d_in[9]; a.w_router = (const float*)d_in[10]; a.b_router = (const float*)d_in[11];
    a.w_gate = (const float*)d_in[12]; a.w_up = (const float*)d_in[13]; a.w_down = (const float*)d_in[14]; a.ln_gain = (const float*)d_in[15]; a.ln_bias = (const float*)d_in[16];
    a.out = (float*)d_out; a.ws = (unsigned char*)d_ws;
#if MK_FUSED
    a.ph_lo = 0; a.ph_hi = NPHASE;
    hipLaunchKernelGGL(fwd, dim3(grid), dim3(NTHREADS), LDS_BYTES, stream, a);
#else
    for (int p = 0; p < NPHASE; ++p) {  a.ph_lo = p; a.ph_hi = p + 1; hipLaunchKernelGGL(fwd, dim3(grid), dim3(NTHREADS), LDS_BYTES, stream, a); }
#endif
}
```

```cpp
#define L1IN_F8 1
#include <hip/hip_runtime.h>
#include <cstdio>
#include <cstdint>

namespace pg8 {
#define PG8_LAS __attribute__((address_space(3)))
typedef unsigned short bf16_t;
typedef short bf16x8 __attribute__((ext_vector_type(8)));
typedef float f32x4 __attribute__((ext_vector_type(4)));
typedef unsigned u32x4 __attribute__((ext_vector_type(4)));
constexpr int BM = 256, BK = 64, HALF = 128, HTB = HALF * BK * 2  , STAGE_BYTES = 8 * HTB, NXCD = 8, WGM = 8;

__host__ __device__ __forceinline__ int lds_byte(int r, int c) { const int st = (r >> 4) * 2 + (c >> 5), rr = r & 15, cc = c & 31, ob = rr * 64 + cc * 2; return st * 1024 + (ob ^ (((ob >> 9) & 1) << 5)); }
__host__ __device__ __forceinline__ void stage_rc(int b, int& R, int& C) { const int st = b / 1024, sb = b % 1024, swz = sb ^ (((sb >> 9) & 1) << 5); R = (st >> 1) * 16 + swz / 64; C = (st & 1) * 32 + (swz % 64) / 2; }
__host__ __device__ __forceinline__ int perm32(int rho) { const int n = rho >> 4, i = rho & 15; return 8 * (i >> 2) + 4 * n + (i & 3); }

struct Unit { int pm, pn, e, mi; };
struct Gemm { const bf16_t* A; const bf16_t* Bt; int M, N, K, rb; };

struct DenseOrder {
    static constexpr bool GATHER = false;
    int nM, nN, nwg, G, c;
    __device__ void init(int M, int N, int G_, int c_) { nM = M / BM; nN = N / BM; nwg = nM * nN; G = G_; c = c_; }
    __device__ bool next(int i, Unit& u) const {
        const long L = (long)i * G + c; if (L >= nwg) return false;
        int wgid = (int)L; { const int q = nwg / NXCD, r = nwg % NXCD, xcd = wgid % NXCD, off = wgid / NXCD; wgid = (xcd < r ? xcd * (q + 1) : r * (q + 1) + (xcd - r) * q) + off; }
        const int nig = WGM * nN, gid = wgid / nig, fm = gid * WGM, gsz = (nM - fm) < WGM ? (nM - fm) : WGM;
        u.pm = fm + ((wgid % nig) % gsz); u.pn = (wgid % nig) / gsz; u.e = 0; u.mi = 0; return true;
    }
    __device__ __forceinline__ unsigned a_off(const Gemm& g, const Unit& u) const { return (unsigned)u.pm * (unsigned)(2 * HALF) * (unsigned)g.rb; }
    __device__ __forceinline__ unsigned b_off(const Gemm& g, const Unit& u) const { return (unsigned)u.pn * (unsigned)(2 * HALF) * (unsigned)g.rb; }
    __device__ __forceinline__ void a_voff(const Gemm& g, const Unit&, const int (&R)[2], const int (&C)[2], unsigned (&vo)[2][2]) const {
#pragma unroll
        for (int h = 0; h < 2; ++h)
#pragma unroll
            for (int i = 0; i < 2; ++i) vo[h][i] = (unsigned)((h * HALF + R[i]) * g.rb + C[i] * 2);
    }
};

__device__ __forceinline__ unsigned cvt_pk_bf16(float lo, float hi) { unsigned r; asm volatile("v_cvt_pk_bf16_f32 %0, %1, %2" : "=v"(r) : "v"(lo), "v"(hi)); return r; }

struct EpiBf16 {
    static constexpr bool PERM = true;
    bf16_t* O; int ldc;
    __device__ __forceinline__ void operator()(const f32x4 (&acc)[2][2][4][2], const Unit& u, int wr, int wc, int fr, int fq) const {
        const int row0 = u.pm * BM + wr * 64 + fr; const int col0 = u.pn * BM + wc * 32 + 8 * fq;
#pragma unroll
        for (int ai = 0; ai < 2; ++ai)
#pragma unroll
            for (int m = 0; m < 4; ++m) { bf16_t* rowp = O + (size_t)(row0 + ai * HALF + m * 16) * ldc + col0;
#pragma unroll
                for (int bj = 0; bj < 2; ++bj) { const f32x4 v0 = acc[ai][bj][m][0], v1 = acc[ai][bj][m][1];
                    u32x4 w; w.x = cvt_pk_bf16(v0[0], v0[1]); w.y = cvt_pk_bf16(v0[2], v0[3]); w.z = cvt_pk_bf16(v1[0], v1[1]); w.w = cvt_pk_bf16(v1[2], v1[3]);
                    *(u32x4*)(rowp + bj * HALF) = w; } }
    }
};

typedef int v8i_t __attribute__((ext_vector_type(8)));
typedef int v4i_t __attribute__((ext_vector_type(4)));
template <class Epi, class Sched, bool F8 = false, int SCW = 127, int SCX = 127>
__device__ __forceinline__ void gemm_phase(PG8_LAS unsigned char* lds, const Gemm g, const Sched& S, const Epi& E) {
    const int tid = threadIdx.x, wid = __builtin_amdgcn_readfirstlane(tid >> 6), lane = tid & 63, wr = wid >> 2, wc = wid & 3, fr = lane & 15, fq = lane >> 4;
    const int RB = g.rb, nt = RB / 128;
    unsigned voffB[2]; int sR[2], sC[2];
#pragma unroll
    for (int i = 0; i < 2; ++i) { int R, C; stage_rc(tid * 16 + i * 8192, R, C); const int Rb = Epi::PERM ? ((R & ~31) + perm32(R & 31)) : R;
        sR[i] = R; sC[i] = C; voffB[i] = (unsigned)(Rb * RB + C * 2); }
    const unsigned kstep = (unsigned)(BK * 2);
    const unsigned hstep = (unsigned)HALF * (unsigned)RB;
    const __amdgpu_buffer_rsrc_t rsA = __builtin_amdgcn_make_buffer_rsrc((void*)g.A, 0, 0x7ffffff0, 0x00020000), rsB = __builtin_amdgcn_make_buffer_rsrc((void*)g.Bt, 0, 0x7ffffff0, 0x00020000);
    const unsigned ldsw = (unsigned)wid * 1024u;
    const int aoff = lds_byte(wr * 64 + fr, fq * (F8 ? 16 : 8)), boff = lds_byte(wc * 32 + fr, fq * (F8 ? 16 : 8));
    constexpr int KOFF = F8 ? 16 : 1024;
#define PG8_SA(b, h) (((b) * 2 + (h)) * HTB)
#define PG8_SB(b, h) ((4 + (b) * 2 + (h)) * HTB)
#define PG8_STAGE(bufoff, rs, soff, voff) do { _Pragma("unroll") for (int _i = 0; _i < 2; ++_i) \
        __builtin_amdgcn_raw_ptr_buffer_load_lds(rs, (PG8_LAS void*)(lds + (bufoff) + ldsw + _i * 8192), 16, (int)(voff)[_i], (int)(soff), 0, 0); } while (0)
#define PG8_LD8(addr) __builtin_shufflevector(*(const PG8_LAS v4i_t*)(addr), *(const PG8_LAS v4i_t*)((addr) + 16), 0, 1, 2, 3, 4, 5, 6, 7)
#define PG8_LDA8(dst, b, h) do { _Pragma("unroll") for (int m = 0; m < 4; ++m) dst[m] = PG8_LD8(lds + PG8_SA(b, h) + aoff + m * 2048); } while (0)
#define PG8_LDB8(dst, b, h) do { _Pragma("unroll") for (int n = 0; n < 2; ++n) dst[n] = PG8_LD8(lds + PG8_SB(b, h) + boff + n * 2048); } while (0)
#define PG8_MMA8(ai, bj, At, Bt) do { __builtin_amdgcn_s_setprio(1); _Pragma("unroll") for (int m = 0; m < 4; ++m) _Pragma("unroll") for (int n = 0; n < 2; ++n) \
        acc[ai][bj][m][n] = __builtin_amdgcn_mfma_scale_f32_16x16x128_f8f6f4(Bt[n], At[m], acc[ai][bj][m][n], 0, 0, 0, SCW, 0, SCX); __builtin_amdgcn_s_setprio(0); } while (0)
#define PG8_LDA(dst, b, h) do { _Pragma("unroll") for (int m = 0; m < 4; ++m) _Pragma("unroll") for (int k = 0; k < 2; ++k) dst[m][k] = *(const PG8_LAS bf16x8*)(lds + PG8_SA(b, h) + aoff + m * 2048 + k * KOFF); } while (0)
#define PG8_LDB(dst, b, h) do { _Pragma("unroll") for (int n = 0; n < 2; ++n) _Pragma("unroll") for (int k = 0; k < 2; ++k) dst[n][k] = *(const PG8_LAS bf16x8*)(lds + PG8_SB(b, h) + boff + n * 2048 + k * KOFF); } while (0)
#define PG8_MMA(ai, bj, At, Bt) do { __builtin_amdgcn_s_setprio(1); _Pragma("unroll") for (int m = 0; m < 4; ++m) _Pragma("unroll") for (int n = 0; n < 2; ++n) _Pragma("unroll") for (int k = 0; k < 2; ++k) \
        acc[ai][bj][m][n] = __builtin_amdgcn_mfma_f32_16x16x32_bf16(Bt[n][k], At[m][k], acc[ai][bj][m][n], 0, 0, 0); __builtin_amdgcn_s_setprio(0); } while (0)
#define PG8_WAIT_V(n) asm volatile("s_waitcnt vmcnt(" #n ")" ::: "memory")
#define PG8_WAIT_L(n) asm volatile("s_waitcnt lgkmcnt(" #n ")" ::: "memory")
#define PG8_BAR __builtin_amdgcn_s_barrier()
#define PG8_SCHED __builtin_amdgcn_sched_barrier(0)
    Unit cur, nxt; int ui = 0;
    if (!S.next(0, cur)) return;
    f32x4 acc[2][2][4][2];
#pragma unroll
    for (int a = 0; a < 2; ++a)
#pragma unroll
        for (int b = 0; b < 2; ++b)
#pragma unroll
            for (int m = 0; m < 4; ++m)
#pragma unroll
                for (int n = 0; n < 2; ++n) acc[a][b][m][n] = (f32x4){0.f, 0.f, 0.f, 0.f};
    bf16x8 At[4][2], B0[2][2], B1[2][2];
    v8i_t At8[4], B08[2], B18[2];
    unsigned vAc[2][2], vAn[2][2];
    S.a_voff(g, cur, sR, sC, vAc);
    if constexpr (Sched::GATHER) { asm volatile("s_waitcnt vmcnt(0)" ::: "memory"); asm volatile("" : "+v"(vAc[0][0]), "+v"(vAc[0][1]), "+v"(vAc[1][0]), "+v"(vAc[1][1])); }
    unsigned cA = S.a_off(g, cur), cB = S.b_off(g, cur);
    PG8_STAGE(PG8_SB(0, 0), rsB, cB, voffB); PG8_STAGE(PG8_SB(0, 1), rsB, cB + hstep, voffB); PG8_STAGE(PG8_SA(0, 0), rsA, cA, vAc[0]); PG8_STAGE(PG8_SA(0, 1), rsA, cA, vAc[1]);
    if (wr == 1) PG8_BAR;
    PG8_WAIT_V(2); PG8_BAR;
    PG8_STAGE(PG8_SB(1, 0), rsB, cB + kstep, voffB); PG8_STAGE(PG8_SA(1, 0), rsA, cA + kstep, vAc[0]); PG8_STAGE(PG8_SB(1, 1), rsB, cB + hstep + kstep, voffB);
    PG8_WAIT_V(6); PG8_BAR;
    for (;;) {
        const bool has_next = S.next(ui + 1, nxt);
        if constexpr (Sched::GATHER) {
            if (has_next) { S.a_voff(g, nxt, sR, sC, vAn); asm volatile("s_waitcnt vmcnt(0)" ::: "memory"); }
            else {
#pragma unroll
                for (int h = 0; h < 2; ++h)
#pragma unroll
                    for (int i = 0; i < 2; ++i) vAn[h][i] = vAc[h][i]; }
            asm volatile("" : "+v"(vAn[0][0]), "+v"(vAn[0][1]), "+v"(vAn[1][0]), "+v"(vAn[1][1]));
        } else {
#pragma unroll
            for (int h = 0; h < 2; ++h)
#pragma unroll
                for (int i = 0; i < 2; ++i) vAn[h][i] = vAc[h][i];
        }
        const unsigned nA = has_next ? S.a_off(g, nxt) : cA, nB = has_next ? S.b_off(g, nxt) : cB;
#pragma unroll 1
        for (int t = 0; t < nt; t += 2) {
            const bool last = (t == nt - 2);
            const unsigned a1 = cA + (unsigned)(t + 1) * kstep;
            const unsigned a2 = last ? nA : cA + (unsigned)(t + 2) * kstep, b2 = last ? nB : cB + (unsigned)(t + 2) * kstep;
            const unsigned a3 = a2 + kstep, b3 = b2 + kstep;
            unsigned v2[2][2];
#pragma unroll
            for (int h = 0; h < 2; ++h)
#pragma unroll
                for (int i = 0; i < 2; ++i) v2[h][i] = last ? vAn[h][i] : vAc[h][i];
            if constexpr (F8) {
            PG8_LDB8(B08, 0, 0); PG8_LDB8(B18, 0, 1); PG8_SCHED; PG8_LDA8(At8, 0, 0); PG8_STAGE(PG8_SA(1, 1), rsA, a1, vAc[1]);
            PG8_WAIT_V(8); PG8_WAIT_L(0); PG8_BAR; PG8_MMA8(0, 0, At8, B08); PG8_MMA8(0, 1, At8, B18); PG8_BAR; PG8_SCHED;
            PG8_LDA8(At8, 0, 1); PG8_STAGE(PG8_SB(0, 0), rsB, b2, voffB); PG8_STAGE(PG8_SB(0, 1), rsB, b2 + hstep, voffB); PG8_STAGE(PG8_SA(0, 0), rsA, a2, v2[0]);
            PG8_WAIT_V(8); PG8_WAIT_L(0); PG8_BAR; PG8_MMA8(1, 0, At8, B08); PG8_MMA8(1, 1, At8, B18); PG8_BAR; PG8_SCHED;
            PG8_LDB8(B08, 1, 0); PG8_LDB8(B18, 1, 1); PG8_SCHED; PG8_LDA8(At8, 1, 0); PG8_STAGE(PG8_SA(0, 1), rsA, a2, v2[1]);
            PG8_WAIT_V(8); PG8_WAIT_L(0); PG8_BAR; PG8_MMA8(0, 0, At8, B08); PG8_MMA8(0, 1, At8, B18); PG8_BAR; PG8_SCHED;
            PG8_LDA8(At8, 1, 1); PG8_STAGE(PG8_SB(1, 0), rsB, b3, voffB); PG8_STAGE(PG8_SB(1, 1), rsB, b3 + hstep, voffB); PG8_STAGE(PG8_SA(1, 0), rsA, a3, v2[0]);
            PG8_WAIT_V(8); PG8_WAIT_L(0); PG8_BAR; PG8_MMA8(1, 0, At8, B08); PG8_MMA8(1, 1, At8, B18); PG8_BAR; PG8_SCHED;
            } else {
            PG8_LDB(B0, 0, 0); PG8_LDB(B1, 0, 1); PG8_SCHED; PG8_LDA(At, 0, 0); PG8_STAGE(PG8_SA(1, 1), rsA, a1, vAc[1]);
            PG8_WAIT_V(8); PG8_WAIT_L(0); PG8_BAR; PG8_MMA(0, 0, At, B0); PG8_MMA(0, 1, At, B1); PG8_BAR; PG8_SCHED;
            PG8_LDA(At, 0, 1); PG8_STAGE(PG8_SB(0, 0), rsB, b2, voffB); PG8_STAGE(PG8_SB(0, 1), rsB, b2 + hstep, voffB); PG8_STAGE(PG8_SA(0, 0), rsA, a2, v2[0]);
            PG8_WAIT_V(8); PG8_WAIT_L(0); PG8_BAR; PG8_MMA(1, 0, At, B0); PG8_MMA(1, 1, At, B1); PG8_BAR; PG8_SCHED;
            PG8_LDB(B0, 1, 0); PG8_LDB(B1, 1, 1); PG8_SCHED; PG8_LDA(At, 1, 0); PG8_STAGE(PG8_SA(0, 1), rsA, a2, v2[1]);
            PG8_WAIT_V(8); PG8_WAIT_L(0); PG8_BAR; PG8_MMA(0, 0, At, B0); PG8_MMA(0, 1, At, B1); PG8_BAR; PG8_SCHED;
            PG8_LDA(At, 1, 1); PG8_STAGE(PG8_SB(1, 0), rsB, b3, voffB); PG8_STAGE(PG8_SB(1, 1), rsB, b3 + hstep, voffB); PG8_STAGE(PG8_SA(1, 0), rsA, a3, v2[0]);
            PG8_WAIT_V(8); PG8_WAIT_L(0); PG8_BAR; PG8_MMA(1, 0, At, B0); PG8_MMA(1, 1, At, B1); PG8_BAR; PG8_SCHED;
            }
        }
        if (wr == 0) PG8_BAR;
        { int t_ = threadIdx.x; asm volatile("" : "+v"(t_)); const int l_ = t_ & 63; E(acc, cur, wr, wc, l_ & 15, l_ >> 4); }
        if (!has_next) break;
#pragma unroll
        for (int a = 0; a < 2; ++a)
#pragma unroll
            for (int b = 0; b < 2; ++b)
#pragma unroll
                for (int m = 0; m < 4; ++m)
#pragma unroll
                    for (int n = 0; n < 2; ++n) acc[a][b][m][n] = (f32x4){0.f, 0.f, 0.f, 0.f};
        cur = nxt; cA = nA; cB = nB; ++ui;
#pragma unroll
        for (int h = 0; h < 2; ++h)
#pragma unroll
            for (int i = 0; i < 2; ++i) vAc[h][i] = vAn[h][i];
        if (wr == 1) PG8_BAR;
    }
    PG8_WAIT_V(0);
    PG8_BAR;
#undef PG8_SA
#undef PG8_SB
#undef PG8_STAGE
#undef PG8_LDA
#undef PG8_LDB
#undef PG8_MMA
#undef PG8_MMA8
#undef PG8_LD8
#undef PG8_LDA8
#undef PG8_LDB8
#undef PG8_WAIT_V
#undef PG8_WAIT_L
#undef PG8_BAR
#undef PG8_SCHED
}
}

#ifndef L1IN_F8
#define L1IN_F8 0
#endif
#ifndef DBL_PHASE
#define DBL_PHASE -1
#endif
#ifndef TEST_ATT
#define TEST_ATT 0
#endif
#ifndef TEST_C0
#define TEST_C0 0
#define TEST_NC 2048
#endif
#ifndef TEST_RLO
#define TEST_RLO 0
#define TEST_RHI 256
#endif
#ifndef SB_TRIVIAL
#define SB_TRIVIAL 0
#endif
#ifndef SB_R2PROBE
#define SB_R2PROBE 0
#endif
#ifndef TEST_BADVAL
#define TEST_BADVAL 1e6f
#endif
#ifndef TEST_NANCOUNT
#define TEST_NANCOUNT 0
#endif
#ifndef TEST_GAIN
#define TEST_GAIN 4.0f
#endif
constexpr int SEQ = 16384, DM = 2048, NHEADS = 16, HD = 128, NEXP = 16, DEXP = 1024, NQKV = 6144, NIN0 = 6152;
constexpr float ALPHA = 1.4142135623730951f;
constexpr float LN_EPS = 1e-5f;
constexpr float SCALE128 = 0.08838834764831845f;
constexpr float SCALE64 = 0.125f;
constexpr float LAMBDA_INIT = 0.8f - 0.6f * 0.7408182206817179f;
constexpr int NWAVES = 8, NTHREADS = 512;

constexpr size_t MiB = (size_t)1 << 20;
constexpr size_t WS_CTL = 0, CTL_ZERO_BYTES = 1 * MiB;
constexpr size_t WS_KMEAN = 1 * MiB;
constexpr size_t WS_LOGF = WS_KMEAN + 262144;
constexpr size_t WS_CLOC = WS_LOGF + 524288;
constexpr size_t WS_C = WS_CLOC + 524288;
constexpr size_t WS_CTOT = WS_C + 524288;
constexpr size_t WS_LUT = WS_CTOT + 4096;
constexpr size_t WS_LAM = WS_LUT + 32768;
constexpr size_t WS_MLIST = 4 * MiB;
constexpr size_t WS_MGW = 6 * MiB;
constexpr size_t WS_WIN0 = 8 * MiB, WS_WOUT0 = 32 * MiB, WS_WIN1 = 40 * MiB, WS_WOUT1 = 64 * MiB;
constexpr size_t WS_WGU = 72 * MiB;
constexpr size_t WS_WDN = 328 * MiB;
constexpr size_t WS_XB = 456 * MiB;
constexpr size_t WS_H = 520 * MiB;
constexpr size_t WS_O = 712 * MiB;
constexpr size_t WS_Y = 776 * MiB;
constexpr size_t WS_X1 = 840 * MiB;
constexpr size_t WS_X1F8 = 904 * MiB;
constexpr size_t WS_END = 936 * MiB;
constexpr size_t WS_YSLOT = WS_H;
constexpr size_t WS_HID = WS_O;
constexpr int HID_ROWS = 36864;
constexpr size_t DO_SEL = 0;

constexpr int CW_TMO = 0;
constexpr int CW_BAR = 4096;
constexpr int CW_MOECNT = 8192;
constexpr int CW_MOBACNT = 9216;

constexpr int RING_BYTES = 147456;
constexpr int LCTL_OFF = RING_BYTES;
constexpr int LDS_BYTES = 155648;

#define GAS __attribute__((address_space(1)))
#define LAS __attribute__((address_space(3)))
typedef unsigned short bf16;
typedef unsigned v4u __attribute__((ext_vector_type(4)));
typedef unsigned v2u __attribute__((ext_vector_type(2)));
typedef float f32x4 __attribute__((ext_vector_type(4)));
typedef short bf16x8 __attribute__((ext_vector_type(8)));
typedef GAS unsigned gu32;
#define RLX_AGENT __ATOMIC_RELAXED, __HIP_MEMORY_SCOPE_AGENT
#define LDS_WAIT() asm volatile("s_waitcnt lgkmcnt(0)" ::: "memory")
__device__ __forceinline__ unsigned f2bf(float f) { unsigned u = __builtin_bit_cast(unsigned, f); return (u + 0x7fffu + ((u >> 16) & 1u)) >> 16; }
__device__ __forceinline__ unsigned pk2(float lo, float hi) { return f2bf(lo) | (f2bf(hi) << 16); }
__device__ __forceinline__ unsigned pk4_fp8(float a, float b, float c, float d) { int w = 0; w = __builtin_amdgcn_cvt_pk_fp8_f32(a, b, w, false); w = __builtin_amdgcn_cvt_pk_fp8_f32(c, d, w, true); return (unsigned)w; }
__device__ __forceinline__ float bf2f(unsigned short b) { return __builtin_bit_cast(float, (unsigned)b << 16); }
__device__ __forceinline__ float bflo(unsigned w) { return __builtin_bit_cast(float, w << 16); }
__device__ __forceinline__ float bfhi(unsigned w) { return __builtin_bit_cast(float, w & 0xffff0000u); }
__device__ __forceinline__ int fresh_tid() { int t = threadIdx.x; asm volatile("" : "+v"(t)); return t; }
__device__ __forceinline__ float wave_sum(float v) {
#pragma unroll
    for (int o = 1; o < 64; o <<= 1) v += __shfl_xor(v, o);
    return v;
}
__device__ __forceinline__ float log_sigmoid(float v) { return fminf(v, 0.f) - log1pf(__expf(-fabsf(v))); }

#define XB_TMO      128
#define XB_XCNT(j)  (256  + 64 * (j))
#define XB_XSUB(j)  (1280 + 64 * (j))
#define XB_XGEN(j)  (2304 + 64 * (j))
#define XB_TOP      3328
#define XB_TOPGEN   3392
#define XCD_BAR_WORDS 3456
#define XB_SPIN_CAP (1u << 22)
__device__ __forceinline__ unsigned xb_ld(unsigned* p)              { return __hip_atomic_load(p, __ATOMIC_RELAXED, __HIP_MEMORY_SCOPE_AGENT); }
__device__ __forceinline__ unsigned xb_add(unsigned* p, unsigned v) { return __hip_atomic_fetch_add(p, v, __ATOMIC_RELAXED, __HIP_MEMORY_SCOPE_AGENT); }
__device__ __forceinline__ unsigned xb_xcc_id() { return (unsigned)__builtin_amdgcn_s_getreg((3 << 11) | 20) & 0xFu; }
#define XB_SPIN(cond, bar) do { unsigned _sp = 0; while (cond) { __builtin_amdgcn_s_sleep(1); \
    if ((++_sp & 255u) == 0u) { if (xb_ld(&(bar)[XB_TMO])) break; if (_sp > XB_SPIN_CAP) { atomicAdd(&(bar)[XB_TMO], 1u); break; } } } } while (0)
struct XcdBarrier { unsigned* bar; unsigned x; volatile LAS unsigned* st; };
__device__ __forceinline__ XcdBarrier xcd_barrier_post(unsigned* bar, volatile LAS unsigned* st) {
    XcdBarrier b; b.bar = bar; b.x = xb_xcc_id(); b.st = st;
    if (threadIdx.x == 0) (void)xb_add(&bar[XB_XCNT(b.x)], 1u);
    return b;
}
__device__ __forceinline__ void xcd_barrier_complete(unsigned* bar, unsigned x, unsigned& nloc, unsigned& nx) {
    const unsigned G = gridDim.x * gridDim.y * gridDim.z;
    unsigned sum, cnt, mine, sp = 0u;
    for (;;) {
        sum = 0u; cnt = 0u; mine = 0u;
#pragma unroll
        for (unsigned j = 0; j < 16; ++j) { const unsigned c = xb_ld(&bar[XB_XCNT(j)]); sum += c; cnt += (c > 0u) ? 1u : 0u; mine = (j == x) ? c : mine; }
        if (sum == G) break;
        __builtin_amdgcn_s_sleep(1);
        if ((++sp & 255u) == 0u) { if (xb_ld(&bar[XB_TMO])) break; if (sp > XB_SPIN_CAP) { atomicAdd(&bar[XB_TMO], 1u); break; } }
    }
    nloc = mine > 0u ? mine : 1u; nx = cnt > 0u ? cnt : 1u;
}
__device__ __forceinline__ void xcd_barrier(const XcdBarrier& b) {
    asm volatile("s_waitcnt vmcnt(0)" ::: "memory");
    __syncthreads();
    if (threadIdx.x == 0) {
        unsigned* bar = b.bar;
        __builtin_amdgcn_s_waitcnt(0);
        unsigned nloc = b.st[0], nx = b.st[1];
        if (nloc == 0u) { xcd_barrier_complete(bar, b.x, nloc, nx); b.st[0] = nloc; b.st[1] = nx; }
        const unsigned old = xb_add(&bar[XB_XSUB(b.x)], 1u);
        const unsigned gen = old / nloc;
        if (old + 1u == (gen + 1u) * nloc) {
            __builtin_amdgcn_fence(__ATOMIC_RELEASE, "agent");
            asm volatile("s_waitcnt vmcnt(0)" ::: "memory");
            const unsigned og = xb_add(&bar[XB_TOP], 1u);
            const unsigned tg = og / nx;
            if (og + 1u == (tg + 1u) * nx) xb_add(&bar[XB_TOPGEN], 1u);
            else XB_SPIN(xb_ld(&bar[XB_TOPGEN]) == tg, bar);
            __builtin_amdgcn_fence(__ATOMIC_ACQUIRE, "agent");
            xb_add(&bar[XB_XGEN(b.x)], 1u);
            asm volatile("s_waitcnt vmcnt(0)" ::: "memory");
        } else {
            XB_SPIN(xb_ld(&bar[XB_XGEN(b.x)]) == gen, bar);
            __builtin_amdgcn_fence(__ATOMIC_ACQUIRE, "agent");
            asm volatile("s_waitcnt vmcnt(0)" ::: "memory");
        }
    }
    __syncthreads();
}

struct Args {
    const float* x; const float* w_in_even; const float* w_out_even; const float* forget_bias; const float* w_in_odd; const float* w_out_odd;
    const float* lambda_q; const float* lambda_k; const float* subln_gain; const float* rel_bias; const float* w_router; const float* b_router;
    const float* w_gate; const float* w_up; const float* w_down; const float* ln_gain; const float* ln_bias;
    float* out; unsigned char* ws; int ph_lo, ph_hi;
};

struct P0Item { const float* src; void* dst; int ldw, ldk, dr0, f8; };
__device__ __forceinline__ P0Item p0_decode(const Args& A, unsigned char* ws, int it) {
    constexpr int I_IN = 32 * 192, I_OUT = 32 * 64, I_EXP = 32 * 1024;
    int r = it; const float* W; unsigned char* WT; int ldw, sc0, k0, ldk, dr0, f8 = 0;
    if (r < I_IN) { const int kb = r / 192, nb = r % 192, n0 = nb * 32; W = A.w_in_even; ldw = NIN0; sc0 = n0 + (n0 >= 3072 ? 8 : 0); k0 = kb * 64; WT = ws + WS_WIN0; ldk = DM; dr0 = n0; f8 = 1; }
    else if (r < I_IN + I_OUT) { r -= I_IN; const int kb = r / 64, nb = r % 64; W = A.w_out_even; ldw = DM; sc0 = nb * 32; k0 = kb * 64; WT = ws + WS_WOUT0; ldk = DM; dr0 = nb * 32; }
    else if (r < 2 * I_IN + I_OUT) { r -= I_IN + I_OUT; const int kb = r / 192, nb = r % 192; W = A.w_in_odd; ldw = NQKV; sc0 = nb * 32; k0 = kb * 64; WT = ws + WS_WIN1; ldk = DM; dr0 = nb * 32; f8 = L1IN_F8; }
    else if (r < 2 * I_IN + 2 * I_OUT) { r -= 2 * I_IN + I_OUT; const int kb = r / 64, nb = r % 64; W = A.w_out_odd; ldw = DM; sc0 = nb * 32; k0 = kb * 64; WT = ws + WS_WOUT1; ldk = DM; dr0 = nb * 32; }
    else if (r < 2 * I_IN + 2 * I_OUT + 2 * I_EXP) {
        r -= 2 * I_IN + 2 * I_OUT; const int isup = r >= I_EXP; if (isup) r -= I_EXP;
        const int le = r >> 10, q = r & 1023, kb = q >> 5, nb = q & 31, n0 = nb * 32;
        W = (isup ? A.w_up : A.w_gate) + (size_t)le * DM * DEXP; ldw = DEXP; sc0 = n0; k0 = kb * 64; WT = ws + WS_WGU + (size_t)le * 2048 * 2048; ldk = DM; dr0 = (n0 >> 7) * 256 + (n0 & 127) + (isup ? 128 : 0); f8 = 1; }
    else { r -= 2 * I_IN + 2 * I_OUT + 2 * I_EXP; const int le = r >> 10, q = r & 1023, kb = q >> 6, nb = q & 63;
        W = A.w_down + (size_t)le * DEXP * DM; ldw = DM; sc0 = nb * 32; k0 = kb * 64; WT = ws + WS_WDN + (size_t)le * 2048 * 1024; ldk = DEXP; dr0 = nb * 32; f8 = 1; }
    P0Item p; p.src = W + (size_t)k0 * ldw + sc0; p.ldw = ldw; p.ldk = ldk; p.dr0 = dr0; p.f8 = f8;
    p.dst = f8 ? (void*)(WT + k0) : (void*)(WT + (size_t)k0 * 2);
    return p;
}
__device__ __forceinline__ void p0_prologue(const Args& A, LAS unsigned char* lds, int G) {
    const int tid = fresh_tid(), lane = tid & 63, wave = __builtin_amdgcn_readfirstlane(tid >> 6);
    LAS float* scr = (LAS float*)(lds + wave * 16384);
    const int gw = blockIdx.x * NWAVES + wave, NGW = G * NWAVES;
    unsigned char* ws = A.ws;
    constexpr int NITEMS = 2 * 32 * 192 + 2 * 32 * 64 + 3 * 32 * 1024;
    f32x4 v[8];
    const int kk0 = lane >> 3, n4 = (lane & 7) * 4, c = lane & 7;
    int it = gw;
    P0Item cur = p0_decode(A, ws, it < NITEMS ? it : 0);
    if (it < NITEMS) {
#pragma unroll
        for (int i = 0; i < 8; ++i) v[i] = *(const f32x4*)(cur.src + (size_t)(8 * i + kk0) * cur.ldw + n4); }
    for (; it < NITEMS; it += NGW) {
#pragma unroll
        for (int i = 0; i < 8; ++i) *(LAS f32x4*)(scr + (8 * i + kk0) * 36 + n4) = v[i];
        const int nit = it + NGW; const P0Item nxt = p0_decode(A, ws, nit < NITEMS ? nit : 0);
        if (nit < NITEMS) {
#pragma unroll
            for (int i = 0; i < 8; ++i) v[i] = *(const f32x4*)(nxt.src + (size_t)(8 * i + kk0) * nxt.ldw + n4); }
        LDS_WAIT(); asm volatile("" ::: "memory");
#pragma unroll
        for (int j = 0; j < 4; ++j) { const int n = (lane >> 3) + 8 * j; const LAS float* s = scr + (8 * c) * 36 + n;
            if (cur.f8) { v2u o; o.x = pk4_fp8(s[0 * 36] * 32.f, s[1 * 36] * 32.f, s[2 * 36] * 32.f, s[3 * 36] * 32.f); o.y = pk4_fp8(s[4 * 36] * 32.f, s[5 * 36] * 32.f, s[6 * 36] * 32.f, s[7 * 36] * 32.f);
                *(GAS v2u*)((unsigned char*)cur.dst + (size_t)(cur.dr0 + n) * cur.ldk + 8 * c) = o; }
            else { v4u o; o.x = pk2(s[0 * 36], s[1 * 36]); o.y = pk2(s[2 * 36], s[3 * 36]); o.z = pk2(s[4 * 36], s[5 * 36]); o.w = pk2(s[6 * 36], s[7 * 36]);
                *(GAS v4u*)((bf16*)cur.dst + (size_t)(cur.dr0 + n) * cur.ldk + 8 * c) = o; } }
        LDS_WAIT(); asm volatile("" ::: "memory");
        cur = nxt;
    }
    __syncthreads();
    LAS float* wfa = (LAS float*)lds;
    for (int idx = tid; idx < 8 * DM; idx += NTHREADS) { const int d = idx >> 3, j = idx & 7; wfa[j * DM + d] = A.w_in_even[(size_t)d * NIN0 + 3072 + j]; }
    __syncthreads();
    float* logf = (float*)(ws + WS_LOGF); bf16* xb = (bf16*)(ws + WS_XB);
    for (int m = gw; m < SEQ; m += NGW) {
        const GAS f32x4* xr = (const GAS f32x4*)(A.x + (size_t)m * DM) + lane;
        f32x4 v[8];
#pragma unroll
        for (int j = 0; j < 8; ++j) v[j] = xr[64 * j];
        GAS unsigned* o8 = (GAS unsigned*)((unsigned char*)xb + (size_t)m * DM) + lane;
#pragma unroll
        for (int j = 0; j < 8; ++j) o8[64 * j] = pk4_fp8(v[j].x, v[j].y, v[j].z, v[j].w);
        float mine = 0.f;
#pragma unroll 1
        for (int e = 0; e < 8; ++e) { float s = 0.f;
#pragma unroll
            for (int j = 0; j < 8; ++j) { const f32x4 w = *(const LAS f32x4*)(wfa + e * DM + 256 * j + 4 * lane); s += v[j].x * w.x + v[j].y * w.y + v[j].z * w.z + v[j].w * w.w; }
            s = wave_sum(s); mine = (lane == e) ? s : mine; }
        if (lane < 8) logf[lane * SEQ + m] = log_sigmoid(mine + A.forget_bias[lane]);
    }
    {
        float* lut = (float*)(ws + WS_LUT);
        for (int idx = blockIdx.x * NTHREADS + tid; idx < 8 * 1024; idx += G * NTHREADS) { const int hh = idx >> 10, d = idx & 1023;
            int b; if (d < 16) b = d; else { b = 16 + (int)(log((double)d / 16.0) / log(64.0) * 16.0 + 1e-9); b = b > 31 ? 31 : b; }
            lut[idx] = A.rel_bias[b * 8 + hh]; }
        if (tid == 0 && blockIdx.x == 0) { float s0 = 0.f, s1 = 0.f; for (int d = 0; d < 64; ++d) { s0 += A.lambda_q[d] * A.lambda_k[d]; s1 += A.lambda_q[64 + d] * A.lambda_k[64 + d]; }
            ((float*)(ws + WS_LAM))[0] = expf(s0) - expf(s1) + LAMBDA_INIT; }
    }
}

__device__ __forceinline__ void p2_kmean_cumsum(const Args& A, char* lds, int G) {
    const int tid = fresh_tid(), lane = tid & 63, wave = tid >> 6;
    const bf16* h = (const bf16*)(A.ws + WS_H);
    float* red = (float*)lds;
    for (int u = blockIdx.x; u < 1536; u += G) {
        if (u >= 1024) {
            const int v = u - 1024, hd = v >> 6, n = v & 63, c = tid & 15, g = tid >> 4; float mx = 0.f;
            for (int i = 0; i < 8; ++i) { const v4u w = *(const v4u*)(h + (size_t)(n * 256 + g + 32 * i) * NQKV + 1024 + hd * 128 + c * 8);
                float s = bflo(w.x) * bflo(w.x) + bfhi(w.x) * bfhi(w.x) + bflo(w.y) * bflo(w.y) + bfhi(w.y) * bfhi(w.y) + bflo(w.z) * bflo(w.z) + bfhi(w.z) * bfhi(w.z) + bflo(w.w) * bflo(w.w) + bfhi(w.w) * bfhi(w.w);
                s += __shfl_xor(s, 1); s += __shfl_xor(s, 2); s += __shfl_xor(s, 4); s += __shfl_xor(s, 8); mx = fmaxf(mx, s); }
            for (int o = 16; o < 64; o <<= 1) mx = fmaxf(mx, __shfl_xor(mx, o));
            if (lane == 0) atomicMax((unsigned*)(A.ws + WS_CTL) + 10496 + hd, __float_as_uint(mx));
        } else if (u < 512) {
            const int hd = u >> 6, n = u & 63, c = tid & 15, g = tid >> 4;
            float s[8] = {0, 0, 0, 0, 0, 0, 0, 0};
            for (int i = 0; i < 8; ++i) { const v4u w = *(const v4u*)(h + (size_t)(n * 256 + g + 32 * i) * NQKV + 4096 + hd * 128 + c * 8);
                s[0] += bflo(w.x); s[1] += bfhi(w.x); s[2] += bflo(w.y); s[3] += bfhi(w.y); s[4] += bflo(w.z); s[5] += bfhi(w.z); s[6] += bflo(w.w); s[7] += bfhi(w.w); }
            for (int j = 0; j < 8; ++j) red[g * 128 + c * 8 + j] = s[j];
            __syncthreads();
            if (tid < 128) { float t = 0.f; for (int gg = 0; gg < 32; ++gg) t += red[gg * 128 + tid]; ((float*)(A.ws + WS_KMEAN))[(size_t)u * 128 + tid] = t * (1.f / 256.f); }
            __syncthreads();
        } else {
            const int v = u - 512, hd = v >> 6, ch = v & 63;
            const float* lf = (const float*)(A.ws + WS_LOGF) + hd * SEQ + ch * 256;
            float x = (tid < 256) ? lf[tid] : 0.f;
            for (int o = 1; o < 64; o <<= 1) { const float y = __shfl_up(x, o); if (lane >= o) x += y; }
            if (lane == 63 && wave < 4) red[wave] = x;
            __syncthreads();
            if (tid < 256) { float pre = 0.f; for (int w = 0; w < wave; ++w) pre += red[w]; x += pre;
                ((float*)(A.ws + WS_CLOC))[hd * SEQ + ch * 256 + tid] = x;
                if (tid == 255) ((float*)(A.ws + WS_CTOT))[hd * 64 + ch] = x; }
            __syncthreads();
        }
    }
}

__device__ __forceinline__ void p3_gate_cfinal(const Args& A, char* lds, int G, int* sel) {
    const int tid = fresh_tid(), lane = tid & 63, wave = tid >> 6;
    const bf16* h = (const bf16*)(A.ws + WS_H);
    float* km = (float*)lds;
    float* scal = (float*)(lds + 65536); int* lcnt = (int*)(lds + 66560); int* gbs = lcnt + 64;
    for (int u = blockIdx.x; u < 1024; u += G) {
        if (u < 512) {
            const int hd = u >> 6, qb = u & 63;
            const float* kmg = (const float*)(A.ws + WS_KMEAN) + (size_t)hd * 64 * 128;
            for (int i = tid; i < qb * 128; i += NTHREADS) km[i] = kmg[i];
            if (tid < 64) lcnt[tid] = 0;
            __syncthreads();
            const int t = qb * 256 + (tid >> 1), dh = tid & 1;
            float q[64];
            { const bf16* qp = h + (size_t)t * NQKV + 3072 + hd * 128 + dh * 64;
#pragma unroll
              for (int i = 0; i < 8; ++i) { const v4u w = *(const v4u*)(qp + i * 8);
                q[i * 8 + 0] = bflo(w.x); q[i * 8 + 1] = bfhi(w.x); q[i * 8 + 2] = bflo(w.y); q[i * 8 + 3] = bfhi(w.y); q[i * 8 + 4] = bflo(w.z); q[i * 8 + 5] = bfhi(w.z); q[i * 8 + 6] = bflo(w.w); q[i * 8 + 7] = bfhi(w.w); } }
            float v0 = -3e38f, v1 = -3e38f, v2 = -3e38f; int i0 = 0, i1 = 1, i2 = 2;
            for (int n = 0; n < qb; ++n) {
                const float* kr = km + n * 128 + dh * 64; float s = 0.f;
#pragma unroll
                for (int d = 0; d < 64; d += 4) { const f32x4 kv = *(const f32x4*)(kr + d); s += q[d] * kv.x + q[d + 1] * kv.y + q[d + 2] * kv.z + q[d + 3] * kv.w; }
                s += __shfl_xor(s, 1);
                if (s > v0) { v2 = v1; i2 = i1; v1 = v0; i1 = i0; v0 = s; i0 = n; }
                else if (s > v1) { v2 = v1; i2 = i1; v1 = s; i1 = n; }
                else if (s > v2) { v2 = s; i2 = n; }
            }
            const int nsel = qb < 3 ? qb : 3;
            if (dh == 0) *(int4*)(sel + ((size_t)hd * SEQ + t) * 4) = make_int4(i0, i1, i2, nsel);
            int lp0 = 0, lp1 = 0, lp2 = 0;
            if (dh == 0) { if (nsel > 0) lp0 = atomicAdd(&lcnt[i0], 1); if (nsel > 1) lp1 = atomicAdd(&lcnt[i1], 1); if (nsel > 2) lp2 = atomicAdd(&lcnt[i2], 1); }
            __syncthreads();
            if (tid < 64) { const int c = lcnt[tid]; gbs[tid] = c > 0 ? (int)__hip_atomic_fetch_add((unsigned*)(A.ws + WS_CTL) + CW_MOBACNT + hd * 64 + tid, (unsigned)c, RLX_AGENT) : 0; }
            __syncthreads();
            if (dh == 0) { int* ml = (int*)((unsigned char*)A.out + (4u << 20)) + (size_t)hd * 64 * SEQ;
                if (nsel > 0) ml[(size_t)i0 * SEQ + gbs[i0] + lp0] = t * 4 + 0;
                if (nsel > 1) ml[(size_t)i1 * SEQ + gbs[i1] + lp1] = t * 4 + 1;
                if (nsel > 2) ml[(size_t)i2 * SEQ + gbs[i2] + lp2] = t * 4 + 2; }
            __syncthreads();
        } else {
            const int v = u - 512, hd = v >> 6, ch = v & 63;
            if (wave == 0) { float x = (lane < ch) ? ((const float*)(A.ws + WS_CTOT))[hd * 64 + lane] : 0.f; x = wave_sum(x); if (lane == 0) scal[0] = x; }
            __syncthreads();
            if (tid < 256) ((float*)(A.ws + WS_C))[hd * SEQ + ch * 256 + tid] = ((const float*)(A.ws + WS_CLOC))[hd * SEQ + ch * 256 + tid] + scal[0];
            __syncthreads();
        }
    }
}

template <int VAR>
__device__ __forceinline__ void naive_attn_unit(const Args& A, char* lds, int hd, int qblk, const int* sel) {
    const int tid = fresh_tid(), ql = tid >> 2, part = tid & 3;
    const int t0 = qblk * 128, t = t0 + ql;
    float* Ks = (float*)lds; float* Vs = Ks + 64 * 128; float* Cs = Vs + 64 * 128;
    const bf16* h = (const bf16*)(A.ws + WS_H); bf16* ob = (bf16*)(A.ws + WS_O);
    const int second = (VAR == 1 || VAR == 3) ? 1 : 0;
    const int qcol = second * 3072 + hd * 128, kcol = qcol + 1024, vcol = qcol + 2048, ocol = (second * 8 + hd) * 128;
    const float* cg = (const float*)(A.ws + WS_C) + hd * SEQ;
    const float* lut = (const float*)(A.ws + WS_LUT) + hd * 1024;
    float q[32];
    if (VAR != 2) { const bf16* qp = h + (size_t)t * NQKV + qcol + part * 32;
#pragma unroll
        for (int d = 0; d < 32; ++d) q[d] = bf2f(qp[d]); }
    else { const bf16* qp = h + (size_t)t * NQKV + qcol + part * 16;
#pragma unroll
        for (int d = 0; d < 16; ++d) { q[d] = bf2f(qp[d]); q[16 + d] = bf2f(qp[64 + d]); } }
    float o[32], o2[32];
#pragma unroll
    for (int d = 0; d < 32; ++d) { o[d] = 0.f; o2[d] = 0.f; }
    float m1 = -1e30f, l1 = 0.f, m2 = -1e30f, l2 = 0.f, R = 0.f;
    const float ct = (VAR == 0) ? cg[t] : 0.f;
    int s0 = -1, s1 = -1, s2 = -1;
    if (VAR == 1) { const int4 sv = *(const int4*)(sel + ((size_t)hd * SEQ + t) * 4); if (sv.w > 0) s0 = sv.x; if (sv.w > 1) s1 = sv.y; if (sv.w > 2) s2 = sv.z; }
    const int own = t >> 8;
    const int jmax = (t0 + 127) >> 6;
    for (int jj = 0; jj <= jmax; ++jj) {
        const int j = (VAR == 3) ? (jmax - jj) : jj;
        __syncthreads();
        for (int idx = tid; idx < 1024; idx += NTHREADS) { const int row = idx >> 4, c8 = (idx & 15) * 8;
            const v4u kw = *(const v4u*)(h + (size_t)(j * 64 + row) * NQKV + kcol + c8); const v4u vw = *(const v4u*)(h + (size_t)(j * 64 + row) * NQKV + vcol + c8);
            float* kd = Ks + row * 128 + c8; float* vd = Vs + row * 128 + c8;
            kd[0] = bflo(kw.x); kd[1] = bfhi(kw.x); kd[2] = bflo(kw.y); kd[3] = bfhi(kw.y); kd[4] = bflo(kw.z); kd[5] = bfhi(kw.z); kd[6] = bflo(kw.w); kd[7] = bfhi(kw.w);
            vd[0] = bflo(vw.x); vd[1] = bfhi(vw.x); vd[2] = bflo(vw.y); vd[3] = bfhi(vw.y); vd[4] = bflo(vw.z); vd[5] = bfhi(vw.z); vd[6] = bflo(vw.w); vd[7] = bfhi(vw.w); }
        if (VAR == 0 && tid < 64) Cs[tid] = cg[j * 64 + tid];
        __syncthreads();
        for (int ss = 0; ss < 64; ++ss) {
            const int s = (VAR == 3) ? (63 - ss) : ss; const int ks = j * 64 + s;
            float d1 = 0.f, d2 = 0.f;
            if (VAR != 2) { const float* kr = Ks + s * 128 + part * 32;
#pragma unroll
                for (int d = 0; d < 32; d += 4) { const f32x4 kv = *(const f32x4*)(kr + d); d1 += q[d] * kv.x + q[d + 1] * kv.y + q[d + 2] * kv.z + q[d + 3] * kv.w; } }
            else { const float* kr = Ks + s * 128 + part * 16;
#pragma unroll
                for (int d = 0; d < 16; d += 4) { const f32x4 ka = *(const f32x4*)(kr + d); const f32x4 kb = *(const f32x4*)(kr + 64 + d);
                    d1 += q[d] * ka.x + q[d + 1] * ka.y + q[d + 2] * ka.z + q[d + 3] * ka.w; d2 += q[16 + d] * kb.x + q[17 + d] * kb.y + q[18 + d] * kb.z + q[19 + d] * kb.w; } }
            d1 += __shfl_xor(d1, 1); d1 += __shfl_xor(d1, 2);
            if (VAR == 2) { d2 += __shfl_xor(d2, 1); d2 += __shfl_xor(d2, 2); }
            const float* vr = Vs + s * 128 + part * 32;
            if (VAR == 0 || VAR == 1) {
                bool valid; float sc;
                if (VAR == 0) { valid = ks <= t; sc = d1 * SCALE128 + (ct - Cs[s]); }
                else { const int nb = ks >> 8; valid = (nb == own && ks <= t) || nb == s0 || nb == s1 || nb == s2; const int dist = t - ks; sc = d1 * SCALE128 + lut[dist < 0 ? 0 : (dist > 1023 ? 1023 : dist)]; }
                if (valid) { const float mn = fmaxf(m1, sc), al = __expf(m1 - mn), p = __expf(sc - mn); l1 = l1 * al + p; m1 = mn;
#pragma unroll
                    for (int d = 0; d < 32; ++d) o[d] = o[d] * al + p * vr[d]; }
            } else if (VAR == 2) {
                if (ks <= t) { const float bias = lut[(t - ks) > 1023 ? 1023 : (t - ks)];
                    const float sa = d1 * SCALE64 + bias, sb = d2 * SCALE64 + bias;
                    const float mna = fmaxf(m1, sa), ala = __expf(m1 - mna), pa = __expf(sa - mna); l1 = l1 * ala + pa; m1 = mna;
                    const float mnb = fmaxf(m2, sb), alb = __expf(m2 - mnb), pb = __expf(sb - mnb); l2 = l2 * alb + pb; m2 = mnb;
#pragma unroll
                    for (int d = 0; d < 32; ++d) { const float vv = vr[d]; o[d] = o[d] * ala + pa * vv; o2[d] = o2[d] * alb + pb * vv; } }
            } else {
                if (ks < t) { const float z = d1 * SCALE128; float a = __expf(log_sigmoid(z) + R); R += log_sigmoid(-z);
#if SB_TRIVIAL
                    a = 0.015625f;
#endif

#pragma unroll
                    for (int d = 0; d < 32; ++d) o[d] += a * vr[d]; }
            }
        }
    }
    if (VAR == 0 || VAR == 1) { const float il = 1.f / l1;
#pragma unroll
        for (int d = 0; d < 32; ++d) o[d] *= il; }
    if (VAR == 2) { const float lam = ((const float*)(A.ws + WS_LAM))[0]; const float i1 = 1.f / l1, i2 = lam / l2; float ss = 0.f;
#pragma unroll
        for (int d = 0; d < 32; ++d) { o[d] = o[d] * i1 - o2[d] * i2; ss += o[d] * o[d]; }
        ss += __shfl_xor(ss, 1); ss += __shfl_xor(ss, 2);
        const float r = rsqrtf(ss * (1.f / 128.f) + LN_EPS) * (1.f - LAMBDA_INIT);
#pragma unroll
        for (int d = 0; d < 32; ++d) o[d] = o[d] * r * A.subln_gain[part * 32 + d]; }
    bf16* op = ob + (size_t)t * DM + ocol + part * 32;
#pragma unroll
    for (int d = 0; d < 32; d += 2) *(unsigned*)(op + d) = pk2(o[d], o[d + 1]);
}

#ifndef SB_R2PROBE
#define SB_R2PROBE 0
#endif
#ifndef FOX_CH
#define FOX_CH 16
#endif
#ifndef SB_NOCHUNK
#define SB_NOCHUNK 0
#endif
#ifndef SB_TRIVIAL
#define SB_TRIVIAL 0
#endif
namespace att {
typedef float f32x16 __attribute__((ext_vector_type(16)));
typedef short s16x4 __attribute__((ext_vector_type(4)));
constexpr int PITCH = NQKV;
constexpr int SHM_V = 16384, SHM_K = 16384;
constexpr int L_V = 0, L_K = 2 * SHM_V, L_WS = L_K + 2 * SHM_K, L_KB = L_WS + NWAVES * 64 * 4, L_FLAG = L_KB + 512, L_LUT = L_FLAG + 512, LUT_PAD = 320, LUT_N = LUT_PAD + 1024,
              L_STASH = L_LUT + LUT_N * 4 + 256, L_END = L_STASH + 65536;
static_assert(L_STASH % 16 == 0 && L_END <= RING_BYTES, "attention LDS map");
constexpr float THR = 8.f;
#define KSWZ(row, colB) ((row) * 256 + ((colB) ^ (((row) & 7) << 4)))
#define SBAR() __builtin_amdgcn_sched_barrier(0)
__device__ __forceinline__ int v_st(int k, int c) { const int kk = (k & ~0xC) | ((k & 4) << 1) | ((k & 8) >> 1); return ((kk >> 3) * 4 + (c >> 5)) * 512 + ((kk & 7) * 32 + (c & 31)) * 2; }
__device__ __forceinline__ int v_rd_base(int lane) { return ((lane & 3) << 3) | (((lane >> 2) & 3) << 6) | (((lane >> 4) & 1) << 5) | (((lane >> 5) & 1) << 8); }
constexpr int v_rd_off(int d0, int ks, int half) { return d0 * 512 + ks * 4096 + half * 2048; }
__device__ __forceinline__ int crow(int r, int hi) { return (r & 3) + 8 * (r >> 2) + 4 * hi; }
typedef __bf16 bf16x2_t __attribute__((ext_vector_type(2)));
typedef float f32x2_t __attribute__((ext_vector_type(2)));
__device__ __forceinline__ unsigned cvtpk(float lo, float hi) { f32x2_t v = {lo, hi}; bf16x2_t b = __builtin_convertvector(v, bf16x2_t); return __builtin_bit_cast(unsigned, b); }

template <int DQ> __device__ __forceinline__ void partialSM(f32x16& p0, f32x16& p1, float& m_reg, float& mn, float& alpha) {
    constexpr float SC = (DQ == 128) ? SCALE128 : SCALE64; constexpr float C2 = 1.4426950408889634f * SC;
    float pmax = p0[0]; for (int r = 1; r < 16; ++r) pmax = fmaxf(pmax, p0[r]); for (int r = 0; r < 16; ++r) pmax = fmaxf(pmax, p1[r]);
    { auto rr = __builtin_amdgcn_permlane32_swap(__float_as_uint(pmax), __float_as_uint(pmax), false, false);
      pmax = fmaxf(__uint_as_float(rr[0]), __uint_as_float(rr[1])); }
    if (__builtin_expect(__all((pmax - m_reg) * SC <= THR), 1)) { mn = m_reg; alpha = 1.f; }
    else { mn = fmaxf(m_reg, pmax); alpha = __builtin_amdgcn_exp2f((m_reg - mn) * C2); m_reg = mn; }
    const float mnL = -mn * C2;
    for (int r = 0; r < 16; ++r) p0[r] = fmaf(p0[r], C2, mnL); for (int r = 0; r < 16; ++r) p1[r] = fmaf(p1[r], C2, mnL);
    for (int r = 0; r < 16; ++r) p0[r] = __builtin_amdgcn_exp2f(p0[r]);
}
#define PK4(P, B_, OUT) do { unsigned a0 = cvtpk(P[B_+0], P[B_+1]), a1 = cvtpk(P[B_+2], P[B_+3]);                          \
        unsigned b0 = cvtpk(P[B_+4], P[B_+5]), b1 = cvtpk(P[B_+6], P[B_+7]);                                             \
        auto r0 = __builtin_amdgcn_permlane32_swap(a0, b0, false, false); auto r1 = __builtin_amdgcn_permlane32_swap(a1, b1, false, false); \
        pg8::u32x4 w = {r0[0], r1[0], r0[1], r1[1]}; OUT = *reinterpret_cast<bf16x8*>(&w); } while (0)
__device__ __forceinline__ void finishSM(f32x16& p0, f32x16& p1, float alpha, float& l_reg, bf16x8& pa0, bf16x8& pa1, bf16x8& pa2, bf16x8& pa3) {
    for (int r = 0; r < 16; ++r) p1[r] = __builtin_amdgcn_exp2f(p1[r]);
    float ps = 0; for (int r = 0; r < 16; ++r) ps += p0[r]; for (int r = 0; r < 16; ++r) ps += p1[r];
    { auto rr = __builtin_amdgcn_permlane32_swap(__float_as_uint(ps), __float_as_uint(ps), false, false);
      ps = __uint_as_float(rr[0]) + __uint_as_float(rr[1]); }
    l_reg = l_reg * alpha + ps;
    PK4(p0, 0, pa0); PK4(p0, 8, pa1); PK4(p1, 0, pa2); PK4(p1, 8, pa3);
}
__device__ __forceinline__ void sb_half(f32x16& p, float& R2, int hi) {
#if SB_TRIVIAL
#pragma unroll
    for (int r = 0; r < 16; ++r) p[r] = (p[r] < -1e37f) ? 0.f : 0.015625f;
    return;
#endif
    constexpr float C2 = 1.4426950408889634f * SCALE128;
    float T = R2;
#pragma unroll
    for (int g = 3; g >= 0; --g) { float z[4], lr[4];
#pragma unroll
        for (int e = 0; e < 4; ++e) { z[e] = p[4 * g + e] * C2; lr[e] = -(fmaxf(z[e], 0.f) + __builtin_amdgcn_logf(1.f + __builtin_amdgcn_exp2f(-fabsf(z[e])))); }
        const float G = (lr[0] + lr[1]) + (lr[2] + lr[3]);
        auto rr = __builtin_amdgcn_permlane32_swap(__float_as_uint(G), __float_as_uint(G), false, false);
        const float Go = hi ? __uint_as_float(rr[0]) : __uint_as_float(rr[1]);
        float a = T + (hi ? 0.f : Go);
        p[4 * g + 3] = __builtin_amdgcn_exp2f(z[3] + lr[3] + a); a += lr[3];
        p[4 * g + 2] = __builtin_amdgcn_exp2f(z[2] + lr[2] + a); a += lr[2];
        p[4 * g + 1] = __builtin_amdgcn_exp2f(z[1] + lr[1] + a); a += lr[1];
        p[4 * g + 0] = __builtin_amdgcn_exp2f(z[0] + lr[0] + a);
        T += G + Go; }
    R2 = T;
}
__device__ __forceinline__ void sb_pack(f32x16& p0, f32x16& p1, bf16x8& pa0, bf16x8& pa1, bf16x8& pa2, bf16x8& pa3) { PK4(p0, 0, pa0); PK4(p0, 8, pa1); PK4(p1, 0, pa2); PK4(p1, 8, pa3); }
#undef PK4

template <int KB, int DQ>
__device__ __forceinline__ void qkt(f32x16& p0, f32x16& p1, const LAS char* K_lds, int r32, int hi, const bf16x8* qr) {
    p0 = f32x16{}; p1 = f32x16{};
    const LAS char* kb[4];
    { int t_ = threadIdx.x; asm volatile("" : "+v"(t_)); r32 = t_ & 31; hi = (t_ >> 5) & 1; }
#pragma unroll
    for (int dd = 0; dd < 4; ++dd) kb[dd] = K_lds + KB * SHM_K + KSWZ(r32, (dd * 16 + hi * 8) * 2);
#pragma unroll
    for (int d0 = 0; d0 < DQ / 16; ++d0) { const LAS char* a = kb[d0 & 3] + (d0 >> 2) * 128;
        bf16x8 b0 = *reinterpret_cast<const LAS bf16x8*>(a);
        bf16x8 b1 = *reinterpret_cast<const LAS bf16x8*>(a + 32 * 256);
        p0 = __builtin_amdgcn_mfma_f32_32x32x16_bf16(b0, qr[d0], p0, 0, 0, 0);
        p1 = __builtin_amdgcn_mfma_f32_32x32x16_bf16(b1, qr[d0], p1, 0, 0, 0); }
}
template <int VB>
__device__ __forceinline__ void pv_tile2(f32x16* o, int vb0, bf16x8 pa0, bf16x8 pa1, bf16x8 pa2, bf16x8 pa3) {
#define TRRD(dst, off) asm volatile("ds_read_b64_tr_b16 %0, %1 offset:%2" : "=&v"(dst) : "v"(vb0), "i"(off) : "memory")
#define PV_RD(d0, P) constexpr int b##P = VB * SHM_V + v_rd_off(d0, 0, 0); s16x4 l0##P, l1##P, l2##P, l3##P, h0##P, h1##P, h2##P, h3##P; \
        TRRD(l0##P, b##P); TRRD(h0##P, b##P + 2048); TRRD(l1##P, b##P + 4096); TRRD(h1##P, b##P + 6144); TRRD(l2##P, b##P + 8192); TRRD(h2##P, b##P + 10240); TRRD(l3##P, b##P + 12288); TRRD(h3##P, b##P + 14336)
#define PV_MM(d0, P) do { \
        o[d0] = __builtin_amdgcn_mfma_f32_32x32x16_bf16(pa0, (bf16x8){l0##P[0], l0##P[1], l0##P[2], l0##P[3], h0##P[0], h0##P[1], h0##P[2], h0##P[3]}, o[d0], 0, 0, 0);   \
        o[d0] = __builtin_amdgcn_mfma_f32_32x32x16_bf16(pa1, (bf16x8){l1##P[0], l1##P[1], l1##P[2], l1##P[3], h1##P[0], h1##P[1], h1##P[2], h1##P[3]}, o[d0], 0, 0, 0);   \
        o[d0] = __builtin_amdgcn_mfma_f32_32x32x16_bf16(pa2, (bf16x8){l2##P[0], l2##P[1], l2##P[2], l2##P[3], h2##P[0], h2##P[1], h2##P[2], h2##P[3]}, o[d0], 0, 0, 0);   \
        o[d0] = __builtin_amdgcn_mfma_f32_32x32x16_bf16(pa3, (bf16x8){l3##P[0], l3##P[1], l3##P[2], l3##P[3], h3##P[0], h3##P[1], h3##P[2], h3##P[3]}, o[d0], 0, 0, 0); } while (0)
#define PV_WAIT() asm volatile("s_waitcnt lgkmcnt(0)" : "+v"(l0A), "+v"(l1A), "+v"(l2A), "+v"(l3A), "+v"(h0A), "+v"(h1A), "+v"(h2A), "+v"(h3A), \
        "+v"(l0B), "+v"(l1B), "+v"(l2B), "+v"(l3B), "+v"(h0B), "+v"(h1B), "+v"(h2B), "+v"(h3B) :: "memory")
    { PV_RD(0, A); PV_RD(1, B); PV_WAIT(); SBAR(); PV_MM(0, A); PV_MM(1, B); SBAR(); }
    { PV_RD(2, A); PV_RD(3, B); PV_WAIT(); SBAR(); PV_MM(2, A); PV_MM(3, B); }
#undef PV_WAIT
#undef PV_RD
#undef PV_MM
#undef TRRD
}
template <int VB>
__device__ __forceinline__ void pv_tile(f32x16* o, int vb0, bf16x8 pa0, bf16x8 pa1, bf16x8 pa2, bf16x8 pa3) {
#define TRRD(dst, off) asm volatile("ds_read_b64_tr_b16 %0, %1 offset:%2" : "=&v"(dst) : "v"(vb0), "i"(off) : "memory")
#define PV_D0(d0) do { s16x4 l0, l1, l2, l3, h0, h1, h2, h3; constexpr int b_ = VB * SHM_V + v_rd_off(d0, 0, 0); \
        TRRD(l0, b_); TRRD(h0, b_ + 2048); TRRD(l1, b_ + 4096); TRRD(h1, b_ + 6144); TRRD(l2, b_ + 8192); TRRD(h2, b_ + 10240); TRRD(l3, b_ + 12288); TRRD(h3, b_ + 14336); \
        asm volatile("s_waitcnt lgkmcnt(0)" : "+v"(l0), "+v"(l1), "+v"(l2), "+v"(l3), "+v"(h0), "+v"(h1), "+v"(h2), "+v"(h3) :: "memory"); SBAR();     \
        o[d0] = __builtin_amdgcn_mfma_f32_32x32x16_bf16(pa0, (bf16x8){l0[0], l0[1], l0[2], l0[3], h0[0], h0[1], h0[2], h0[3]}, o[d0], 0, 0, 0);   \
        o[d0] = __builtin_amdgcn_mfma_f32_32x32x16_bf16(pa1, (bf16x8){l1[0], l1[1], l1[2], l1[3], h1[0], h1[1], h1[2], h1[3]}, o[d0], 0, 0, 0);   \
        o[d0] = __builtin_amdgcn_mfma_f32_32x32x16_bf16(pa2, (bf16x8){l2[0], l2[1], l2[2], l2[3], h2[0], h2[1], h2[2], h2[3]}, o[d0], 0, 0, 0);   \
        o[d0] = __builtin_amdgcn_mfma_f32_32x32x16_bf16(pa3, (bf16x8){l3[0], l3[1], l3[2], l3[3], h3[0], h3[1], h3[2], h3[3]}, o[d0], 0, 0, 0); } while (0)
    PV_D0(0); PV_D0(1); PV_D0(2); PV_D0(3);
#undef PV_D0
#undef TRRD
}

struct ChunkArgs {
    const bf16* hbase; unsigned kcolB, vcolB;
    int ja, jb;
    int qpos;
    int qlo;
    const float* cb; float cref;
};
template <int DQ, int MODE, bool REV>
__device__ __forceinline__ void attn_chunk(const ChunkArgs& a, const bf16x8* qr, float& m_reg, float& l_reg, f32x16* o, LAS char* lds) {
    int tid_ = threadIdx.x; asm volatile("" : "+v"(tid_)); const int tid = tid_, wid = __builtin_amdgcn_readfirstlane(tid >> 6), lane = tid & 63, r32 = lane & 31, hi = lane >> 5;
    const int NT = a.jb - a.ja;
    LAS char* V_lds = lds + L_V; LAS char* K_lds = lds + L_K;
    LAS float* ws = (LAS float*)(lds + L_WS) + wid * 64; LAS float* al_l = ws + 32;
    LAS float* kbl = (LAS float*)(lds + L_KB); const LAS float* lutl = (const LAS float*)(lds + L_LUT);
    const int vb0 = (int)(uintptr_t)V_lds + v_rd_base(lane);
    const __amdgpu_buffer_rsrc_t hrs = __builtin_amdgcn_make_buffer_rsrc((void*)a.hbase, 0, (int)((size_t)SEQ * PITCH * 2), 0x00020000);
#define FRESH_TID(t_) int t_ = threadIdx.x; asm volatile("" : "+v"(t_))
    const int qlo = a.qlo;
    bf16x8 st_v0, st_v1, st_k0, st_k1; float st_c = 0.f;
#define KBASE(t) ((REV ? (a.jb - 1 - (t)) : (a.ja + (t))) * 64)
#define VMW() asm volatile("s_waitcnt vmcnt(0)" ::: "memory")
#define SLOAD(k0) do { FRESH_TID(t_); const int sr = t_ >> 4, sc = (t_ & 15) * 8; const unsigned so_ = (unsigned)(k0) * (unsigned)(PITCH * 2); \
        const unsigned vo0 = (unsigned)(sr * PITCH + sc) * 2u, vo1 = vo0 + (unsigned)(32 * PITCH * 2); \
        st_v0 = __builtin_bit_cast(bf16x8, __builtin_amdgcn_raw_buffer_load_b128(hrs, vo0, so_ + a.vcolB, 0)); st_v1 = __builtin_bit_cast(bf16x8, __builtin_amdgcn_raw_buffer_load_b128(hrs, vo1, so_ + a.vcolB, 0)); \
        if constexpr (DQ == 128) { st_k0 = __builtin_bit_cast(bf16x8, __builtin_amdgcn_raw_buffer_load_b128(hrs, vo0, so_ + a.kcolB, 0)); st_k1 = __builtin_bit_cast(bf16x8, __builtin_amdgcn_raw_buffer_load_b128(hrs, vo1, so_ + a.kcolB, 0)); } \
        else { const unsigned vk0 = (unsigned)((t_ >> 3) * PITCH + (t_ & 7) * 8) * 2u; st_k0 = __builtin_bit_cast(bf16x8, __builtin_amdgcn_raw_buffer_load_b128(hrs, vk0, so_ + a.kcolB, 0)); } \
        if constexpr (MODE == 0) { if (t_ < 64) st_c = (a.cref - a.cb[(k0) + t_]) * (1.f / SCALE128); } } while (0)
#define SWRITE_K(bf) do { FRESH_TID(t_); if constexpr (DQ == 128) { const int sr = t_ >> 4, sc = (t_ & 15) * 8, kws = KSWZ(sr, sc * 2); *(LAS bf16x8*)(K_lds + (bf) * SHM_K + kws) = st_k0; *(LAS bf16x8*)(K_lds + (bf) * SHM_K + kws + 32 * 256) = st_k1; } \
        else { const int sr2 = t_ >> 3, sc2 = (t_ & 7) * 8, kws2 = KSWZ(sr2, sc2 * 2); *(LAS bf16x8*)(K_lds + (bf) * SHM_K + kws2) = st_k0; } \
        if constexpr (MODE == 0) { if (t_ < 64) kbl[(bf) * 64 + t_] = st_c; } } while (0)
#define SWRITE_V(bf) do { FRESH_TID(t_); const int sr = t_ >> 4, sc = (t_ & 15) * 8, vst0 = v_st(sr, sc), vst1 = v_st(32 + sr, sc); *(LAS bf16x8*)(V_lds + (bf) * SHM_V + vst0) = st_v0; *(LAS bf16x8*)(V_lds + (bf) * SHM_V + vst1) = st_v1; } while (0)
#define SWRITE(bf) do { SWRITE_V(bf); SWRITE_K(bf); } while (0)
#define SCORES(P0_, P1_, t, BF) do { const int kb_ = KBASE(t); int dq; { FRESH_TID(t_); const int r32_ = t_ & 31, hi_ = (t_ >> 5) & 1; dq = ((MODE == 2) ? a.qpos : (qlo + r32_)) - 4 * hi_ - kb_; } \
        if constexpr (MODE == 0) { \
            _Pragma("unroll") for (int g = 0; g < 4; ++g) { const f32x4 b0 = *(const LAS f32x4*)(kbl + (BF) * 64 + 8 * g + 4 * hi), b1 = *(const LAS f32x4*)(kbl + (BF) * 64 + 32 + 8 * g + 4 * hi); \
                _Pragma("unroll") for (int e = 0; e < 4; ++e) { P0_[4 * g + e] += b0[e]; P1_[4 * g + e] += b1[e]; } asm volatile("" ::: "memory"); } } \
        if constexpr (MODE == 1) { if (qlo - (kb_ + 63) < 790) { const LAS float* lp = lutl + (dq + LUT_PAD - 59); \
            _Pragma("unroll") for (int r = 0; r < 16; ++r) { const int c = (r & 3) + 8 * (r >> 2); P0_[r] += lp[59 - c]; P1_[r] += lp[27 - c]; } } } \
        if constexpr (MODE == 2) { \
            _Pragma("unroll") for (int r = 0; r < 16; ++r) { const int c = (r & 3) + 8 * (r >> 2); int d0_ = dq - c, d1_ = dq - c - 32; d0_ = d0_ > 1023 ? 1023 : d0_; d1_ = d1_ > 1023 ? 1023 : d1_; \
                P0_[r] += lutl[d0_ + LUT_PAD]; P1_[r] += lutl[d1_ + LUT_PAD]; } } \
        if (MODE == 2 || kb_ + 63 >= qlo) { const float NEG = (MODE == 3) ? -3.0e4f : -__builtin_inff(); constexpr int ST = (MODE == 3) ? 1 : 0; \
            _Pragma("unroll") for (int r = 0; r < 16; ++r) { const int c = (r & 3) + 8 * (r >> 2); if (dq - c < ST) P0_[r] = NEG; if (dq - c - 32 < ST) P1_[r] = NEG; } } } while (0)
#define RESC(al) do { if (__any((al) < 1.f)) { if (hi == 0) al_l[r32] = (al); asm volatile("s_waitcnt lgkmcnt(0)" ::: "memory"); \
                     for (int d_ = 0; d_ < 4; ++d_) for (int r = 0; r < 16; ++r) o[d_][r] *= al_l[crow(r, hi)]; } } while (0)
#define PARTIAL(P0_, P1_, mnX, alX) do { if constexpr (MODE == 3) { sb_half(P1_, m_reg, hi); } else { partialSM<DQ>(P0_, P1_, m_reg, mnX, alX); } } while (0)
#define FINISH(P0_, P1_, alY) do { if constexpr (MODE == 3) { sb_half(P0_, m_reg, hi); sb_pack(P0_, P1_, pa0, pa1, pa2, pa3); } else { finishSM(P0_, P1_, alY, l_reg, pa0, pa1, pa2, pa3); } } while (0)
#define RESCALE(al) do { if constexpr (MODE != 3) { RESC(al); } } while (0)
    f32x16 pA0, pA1, pB0, pB1; float mnA = 0.f, mnB = 0.f, alA = 1.f, alB = 1.f; bf16x8 pa0, pa1, pa2, pa3;
    SLOAD(KBASE(0)); VMW(); SWRITE_K(0);
    __syncthreads();
    SWRITE_V(0); SBAR();
    if (NT > 1) SLOAD(KBASE(1));
    SBAR(); qkt<0, DQ>(pA0, pA1, K_lds, r32, hi, qr);
    SCORES(pA0, pA1, 0, 0); PARTIAL(pA0, pA1, mnA, alA);
    if (NT > 1) { VMW(); SWRITE(1); }
    __syncthreads();
#define HALF_STEP(PX0, PX1, mnX, alX, PY0, PY1, alY, t, KB, VB, SB) do {                                 \
        SBAR(); qkt<KB, DQ>(PX0, PX1, K_lds, r32, hi, qr);                                                \
        FINISH(PY0, PY1, alY); SBAR();                                                                    \
        if ((t) + 1 < NT) { SLOAD(KBASE((t) + 1)); SBAR(); }                                              \
        pv_tile<VB>(o, vb0, pa0, pa1, pa2, pa3); SCORES(PX0, PX1, (t), KB); PARTIAL(PX0, PX1, mnX, alX);   \
        __syncthreads();                                                                                  \
        if ((t) + 1 < NT) { VMW(); SWRITE(SB); }                                                          \
        RESCALE(alX); __syncthreads(); } while (0)
    for (int t = 1; t + 1 < NT; t += 2) {
        HALF_STEP(pB0, pB1, mnB, alB, pA0, pA1, alA, t, 1, 0, 0);
        HALF_STEP(pA0, pA1, mnA, alA, pB0, pB1, alB, t + 1, 0, 1, 1);
    }
    const bool even = (NT & 1) == 0;
    if (even) { SBAR(); qkt<1, DQ>(pB0, pB1, K_lds, r32, hi, qr); SBAR(); }
    FINISH(pA0, pA1, alA); SBAR();
    pv_tile<0>(o, vb0, pa0, pa1, pa2, pa3);
    if (even) { SCORES(pB0, pB1, NT - 1, 1); PARTIAL(pB0, pB1, mnB, alB); __syncthreads(); RESCALE(alB);
        FINISH(pB0, pB1, alB); SBAR(); pv_tile<1>(o, vb0, pa0, pa1, pa2, pa3); }
    __syncthreads();
#undef KBASE
#undef VMW
#undef SLOAD
#undef FRESH_TID
#undef SWRITE_K
#undef SWRITE_V
#undef SWRITE
#undef SCORES
#undef RESC
#undef PARTIAL
#undef FINISH
#undef RESCALE
#undef HALF_STEP
}

template <int DQ> __device__ __forceinline__ void load_q(bf16x8* qr, const bf16* qrow, int hi) {
#pragma unroll
    for (int d0 = 0; d0 < DQ / 16; ++d0) qr[d0] = *(const bf16x8*)(qrow + d0 * 16 + hi * 8);
}
__device__ __forceinline__ void load_lut(LAS char* lds, const float* lutg, float inv_scale) {
    LAS float* l = (LAS float*)(lds + L_LUT); const float far = lutg[1023];
    for (int i = threadIdx.x; i < LUT_N; i += NTHREADS) l[i] = (i < LUT_PAD) ? 0.f : (lutg[i - LUT_PAD] - far) * inv_scale;
}
__device__ __forceinline__ void store_o(const f32x16* o, const float* rl  , bf16* obase, int ldo, int r32, int hi) {
#pragma unroll
    for (int r = 0; r < 16; ++r) { const int orow = crow(r, hi);
#pragma unroll
        for (int d0 = 0; d0 < 4; ++d0) { const float v = o[d0][r] * rl[r]; const float vn = __shfl_xor(v, 1);
            if ((r32 & 1) == 0) *(unsigned*)(obase + (size_t)orow * ldo + d0 * 32 + r32) = cvtpk(v, vn); } }
}
}

__device__ __forceinline__ void fox_epilogue(const att::f32x16* o, float l_reg, LAS char* lds, bf16* oblk, int ldo) {
    int t_ = threadIdx.x; asm volatile("" : "+v"(t_)); const int wid = __builtin_amdgcn_readfirstlane(t_ >> 6), r32 = t_ & 31, hi = (t_ >> 5) & 1;
    LAS float* li_l = (LAS float*)(lds + att::L_WS) + wid * 64;
    if (hi == 0) li_l[r32] = l_reg; asm volatile("s_waitcnt lgkmcnt(0)" ::: "memory");
    float rli[16];
#pragma unroll
    for (int r = 0; r < 16; ++r) rli[r] = __builtin_amdgcn_rcpf(li_l[att::crow(r, hi)]);
    att::store_o(o, rli, oblk + (size_t)(wid * 32) * ldo, ldo, r32, hi);
    __syncthreads();
}
constexpr int CW_KMAX = 10496;
__device__ __forceinline__ void fox_block(const Args& A, LAS char* lds, int hd, int qb, bf16* obuf, int ldo, int ocol) {
    int tid_ = threadIdx.x; asm volatile("" : "+v"(tid_)); const int tid = tid_, wid = __builtin_amdgcn_readfirstlane(tid >> 6), lane = tid & 63, r32 = lane & 31, hi = lane >> 5;
    const bf16* h = (const bf16*)(A.ws + WS_H); const int P0 = qb * 256;
    const float* cg = (const float*)(A.ws + WS_C) + hd * SEQ;
    bf16x8 qr[8]; att::load_q<128>(qr, h + (size_t)(P0 + wid * 32 + r32) * NQKV + hd * 128, hi);
    att::ChunkArgs ca; ca.hbase = h; ca.kcolB = (unsigned)(1024 + hd * 128) * 2u; ca.vcolB = (unsigned)(2048 + hd * 128) * 2u;
    ca.qpos = P0 + wid * 32 + r32; ca.qlo = P0 + wid * 32; ca.cb = cg; ca.cref = cg[P0];
    float m_reg = -1e30f, l_reg = 0.f; att::f32x16 o[4] = {};
    LAS int* flg = (LAS int*)(lds + att::L_FLAG);
    int jb = P0 / 64 + 4;
    for (;;) {
        const int ja = jb > FOX_CH ? jb - FOX_CH : 0;
        ca.ja = ja; ca.jb = jb;
        att::attn_chunk<128, 0, true>(ca, qr, m_reg, l_reg, o, lds);
        if (ja == 0) break;
        float qn2 = 0.f;
#pragma unroll
        for (int d0 = 0; d0 < 8; ++d0)
#pragma unroll
            for (int j = 0; j < 8; ++j) { const float v = bf2f((unsigned short)qr[d0][j]); qn2 += v * v; }
        { auto rr = __builtin_amdgcn_permlane32_swap(__float_as_uint(qn2), __float_as_uint(qn2), false, false); qn2 = __uint_as_float(rr[0]) + __uint_as_float(rr[1]); }
        const float kmax2 = __uint_as_float(__hip_atomic_load((unsigned*)(A.ws + WS_CTL) + CW_KMAX + hd, RLX_AGENT));
        const float qk_bound = sqrtf(qn2 * kmax2) * 1.001f;
        const float kb_low = (ca.cref - cg[ja * 64]) * (1.f / SCALE128);
        const int done = __all((qk_bound + kb_low - m_reg) * (1.4426950408889634f * SCALE128) < -152.f) ? 1 : 0;
        { int t_ = threadIdx.x; asm volatile("" : "+v"(t_)); if ((t_ & 63) == 0) flg[t_ >> 6] = done; }
        __syncthreads();
        int all = 1;
#pragma unroll
        for (int w = 0; w < NWAVES; ++w) all &= flg[w];
        __syncthreads();
        if (all) break;
        jb = ja;
    }
    fox_epilogue(o, l_reg, lds, obuf + (size_t)P0 * ldo + ocol, ldo);
}

template <int MP>
__device__ __forceinline__ void diff_map(const Args& A, LAS char* lds, int hd, int qb, bf16* obuf) {
    int tid_ = threadIdx.x; asm volatile("" : "+v"(tid_)); const int tid = tid_, wid = __builtin_amdgcn_readfirstlane(tid >> 6), lane = tid & 63, r32 = lane & 31, hi = lane >> 5;
    const bf16* h = (const bf16*)(A.ws + WS_H); const int P0 = qb * 256;
    LAS unsigned short* stash = (LAS unsigned short*)(lds + att::L_STASH) + wid * 4096 + lane;
    LAS float* li_l = (LAS float*)(lds + att::L_WS) + wid * 64;
    bf16x8 qr[4]; att::load_q<64>(qr, h + (size_t)(P0 + wid * 32 + r32) * NQKV + hd * 128 + MP * 64, hi);
    att::ChunkArgs ca; ca.hbase = h; ca.kcolB = (unsigned)(1024 + hd * 128 + MP * 64) * 2u; ca.vcolB = (unsigned)(2048 + hd * 128) * 2u;
    ca.ja = 0; ca.jb = P0 / 64 + 4; ca.qpos = P0 + wid * 32 + r32; ca.qlo = P0 + wid * 32; ca.cb = nullptr; ca.cref = 0.f;
    float m_reg = -1e30f, l_reg = 0.f;
    att::f32x16 o[4] = {};
    att::attn_chunk<64, 1, false>(ca, qr, m_reg, l_reg, o, lds);
    if (hi == 0) li_l[r32] = l_reg; asm volatile("s_waitcnt lgkmcnt(0)" ::: "memory");
    if constexpr (MP == 0) {
#pragma unroll
        for (int r = 0; r < 16; ++r) { const float rl = __builtin_amdgcn_rcpf(li_l[att::crow(r, hi)]);
#pragma unroll
            for (int d0 = 0; d0 < 4; ++d0) stash[(r * 4 + d0) * 64] = (unsigned short)f2bf(o[d0][r] * rl); }
    } else {
        const float lam = ((const float*)(A.ws + WS_LAM))[0];
        bf16* ob = obuf + (size_t)(P0 + wid * 32) * DM + hd * 128;
#pragma unroll
        for (int r = 0; r < 16; ++r) { const float rl = lam * __builtin_amdgcn_rcpf(li_l[att::crow(r, hi)]); float v[4]; float ss = 0.f;
#pragma unroll
            for (int d0 = 0; d0 < 4; ++d0) { v[d0] = bf2f(stash[(r * 4 + d0) * 64]) - o[d0][r] * rl; ss += v[d0] * v[d0]; }
            ss += __shfl_xor(ss, 1); ss += __shfl_xor(ss, 2); ss += __shfl_xor(ss, 4); ss += __shfl_xor(ss, 8); ss += __shfl_xor(ss, 16);
            const float sc = rsqrtf(ss * (1.f / 128.f) + LN_EPS) * (1.f - LAMBDA_INIT); const int orow = att::crow(r, hi);
#pragma unroll
            for (int d0 = 0; d0 < 4; ++d0) { const float w = v[d0] * sc * A.subln_gain[d0 * 32 + r32]; const float wn = __shfl_xor(w, 1);
                if ((r32 & 1) == 0) *(unsigned*)(ob + (size_t)orow * DM + d0 * 32 + r32) = att::cvtpk(w, wn); } }
    }
    __syncthreads();
}
__device__ __forceinline__ void diff_block(const Args& A, LAS char* lds, int hd, int qb, bf16* obuf) {
    att::load_lut(lds, (const float*)(A.ws + WS_LUT) + hd * 1024, 1.f / SCALE64);
    diff_map<0>(A, lds, hd, qb, obuf);
    diff_map<1>(A, lds, hd, qb, obuf);
}

__device__ __forceinline__ void sb_block(const Args& A, LAS char* lds, int hd, int qb, bf16* obuf) {
    int tid_ = threadIdx.x; asm volatile("" : "+v"(tid_)); const int tid = tid_, wid = __builtin_amdgcn_readfirstlane(tid >> 6), lane = tid & 63, r32 = lane & 31, hi = lane >> 5;
    const bf16* h = (const bf16*)(A.ws + WS_H); const int P0 = qb * 256;
    bf16x8 qr[8]; att::load_q<128>(qr, h + (size_t)(P0 + wid * 32 + r32) * NQKV + 3072 + hd * 128, hi);
    att::ChunkArgs ca; ca.hbase = h; ca.kcolB = (unsigned)(4096 + hd * 128) * 2u; ca.vcolB = (unsigned)(5120 + hd * 128) * 2u;
    ca.qpos = P0 + wid * 32 + r32; ca.qlo = P0 + wid * 32; ca.cb = nullptr; ca.cref = 0.f;
    float R2 = 0.f, l_dummy = 0.f; att::f32x16 o[4] = {};
    LAS int* flg = (LAS int*)(lds + att::L_FLAG);
    int jb = P0 / 64 + 4;
    for (;;) {
#if SB_NOCHUNK
        const int ja = 0;
#else
        const int ja = jb > 8 ? jb - 8 : 0;
#endif
        ca.ja = ja; ca.jb = jb;
        att::attn_chunk<128, 3, true>(ca, qr, R2, l_dummy, o, lds);
        const int done = __all(R2 < -150.1f) ? 1 : 0;
        if (lane == 0) flg[wid] = done;
        __syncthreads();
        int all = 1;
#pragma unroll
        for (int w = 0; w < NWAVES; ++w) all &= flg[w];
        __syncthreads();
        if (all || ja == 0) break;
        jb = ja;
    }
#if SB_R2PROBE
    { float rm = fmaxf(R2, 0.f); for (int o_ = 1; o_ < 64; o_ <<= 1) rm = fmaxf(rm, __shfl_xor(rm, o_));
      if (lane == 0) { atomicMax((unsigned*)(A.ws + WS_CTL) + 10240, __float_as_uint(rm)); __hip_atomic_store((float*)(A.ws + WS_CTL) + 10241, 1.f, RLX_AGENT); } }
#endif
    float one[16];
#pragma unroll
    for (int r = 0; r < 16; ++r) one[r] = 1.f;
    att::store_o(o, one, obuf + (size_t)(P0 + wid * 32) * DM + (8 + hd) * 128, DM, r32, hi);
    __syncthreads();
}

__device__ __forceinline__ void sb_unit_test(const Args& A, float sentinel) {
    const int lane = threadIdx.x & 63, r32 = lane & 31, hi = lane >> 5;
    float maxerr = 0.f;
    for (int pat = 0; pat < 4; ++pat) {
        att::f32x16 p0, p1; float R2 = (pat == 3) ? -20.f : 0.f; const float R2in = R2;
        const int lim = (pat == 0) ? 64 : (pat == 1) ? (r32 * 2 + 1) : (pat == 2) ? (r32 < 16 ? 0 : 40) : 33;
#define ZRAW(k) (((k) >= lim) ? sentinel : (25.f * __sinf(0.37f * (float)(k) + 0.11f * (float)r32 + (float)pat)))
#pragma unroll
        for (int r = 0; r < 16; ++r) { p0[r] = ZRAW(att::crow(r, hi)); p1[r] = ZRAW(32 + att::crow(r, hi)); }
        att::sb_half(p1, R2, hi); att::sb_half(p0, R2, hi);
        constexpr float C2 = 1.4426950408889634f * SCALE128;
        float Rr = R2in;
        for (int k = 63; k >= 0; --k) { const float z2 = ZRAW(k) * C2; const float sp = fmaxf(z2, 0.f) + log2f(1.f + exp2f(-fabsf(z2))); const float aref = exp2f(z2 - sp + Rr); Rr -= sp;
#pragma unroll
            for (int r = 0; r < 16; ++r) { if (att::crow(r, hi) == k) maxerr = fmaxf(maxerr, fabsf(p0[r] - aref)); if (32 + att::crow(r, hi) == k) maxerr = fmaxf(maxerr, fabsf(p1[r] - aref)); }
            if (!(aref == aref)) maxerr = 1e9f; }
        maxerr = fmaxf(maxerr, fabsf(R2 - Rr) * 1e-3f);
        if (!(R2 == R2)) maxerr = 1e9f;
#pragma unroll
        for (int r = 0; r < 16; ++r) if (!(p0[r] == p0[r]) || !(p1[r] == p1[r])) maxerr = 1e9f;
#undef ZRAW
    }
    for (int o_ = 1; o_ < 64; o_ <<= 1) maxerr = fmaxf(maxerr, __shfl_xor(maxerr, o_));
    if (lane == 0) { atomicMax((unsigned*)(A.ws + WS_CTL) + 10240, __float_as_uint(maxerr)); __hip_atomic_store((float*)(A.ws + WS_CTL) + 10241, 1.f, RLX_AGENT); }
}

constexpr size_t DO_LSE = 2 * MiB, DO_MLIST = 4 * MiB;
__device__ __forceinline__ void moba_block(const Args& A, LAS char* lds, int hd, int n, int chunk  , int cnt) {
    int tid_ = threadIdx.x; asm volatile("" : "+v"(tid_)); const int tid = tid_, wid = __builtin_amdgcn_readfirstlane(tid >> 6), lane = tid & 63, r32 = lane & 31, hi = lane >> 5;
    const bf16* h = (const bf16*)(A.ws + WS_H);
    int t, slot, valid;
    if (chunk < 0) { t = n * 256 + wid * 32 + r32; slot = 3; valid = 1; }
    else { const int idx = chunk * 256 + wid * 32 + r32; valid = idx < cnt; const int ent = valid ? ((const int*)((const unsigned char*)A.out + DO_MLIST))[(size_t)(hd * 64 + n) * SEQ + idx] : (SEQ - 1) * 4; t = ent >> 2; slot = ent & 3; }
    bf16x8 qr[8]; att::load_q<128>(qr, h + (size_t)t * NQKV + 3072 + hd * 128, hi);
    att::ChunkArgs ca; ca.hbase = h; ca.kcolB = (unsigned)(4096 + hd * 128) * 2u; ca.vcolB = (unsigned)(5120 + hd * 128) * 2u;
    ca.ja = n * 4; ca.jb = n * 4 + 4; ca.qpos = t; ca.qlo = 0; ca.cb = nullptr; ca.cref = 0.f;
    float m_reg = -1e30f, l_reg = 0.f; att::f32x16 o[4] = {};
    att::attn_chunk<128, 2, false>(ca, qr, m_reg, l_reg, o, lds);
    LAS float* li_l = (LAS float*)(lds + att::L_WS) + wid * 64; LAS int* dst_l = (LAS int*)(li_l + 32);
    const int dst = valid ? ((hd * SEQ + t) * 4 + slot) : -1;
    if (hi == 0) { li_l[r32] = l_reg; dst_l[r32] = dst;
        if (valid) ((float*)((unsigned char*)A.out + DO_LSE))[dst] = m_reg * (1.4426950408889634f * SCALE128) + __builtin_amdgcn_logf(l_reg); }
    asm volatile("s_waitcnt lgkmcnt(0)" ::: "memory");
    bf16* part = (bf16*)(A.ws + WS_Y);
#pragma unroll
    for (int r = 0; r < 16; ++r) { const int row = att::crow(r, hi); const int d = dst_l[row]; const float rl = __builtin_amdgcn_rcpf(li_l[row]);
#pragma unroll
        for (int d0 = 0; d0 < 4; ++d0) { const float v = o[d0][r] * rl; const float vn = __shfl_xor(v, 1);
            if ((r32 & 1) == 0 && d >= 0) *(unsigned*)(part + (size_t)d * 128 + d0 * 32 + r32) = att::cvtpk(v, vn); } }
    __syncthreads();
}
__device__ __forceinline__ void moba_phase(const Args& A, LAS char* lds, int G) {
    const int tid = fresh_tid();
    LAS int* pre = (LAS int*)(lds + att::L_STASH);
    LAS int* cnts = pre + 520;
    if (tid < 512) { const int c = (int)__hip_atomic_load((unsigned*)(A.ws + WS_CTL) + CW_MOBACNT + tid, RLX_AGENT); cnts[tid] = c; pre[tid] = (c + 255) >> 8; }
    __syncthreads();
    if (tid == 0) { int acc = 0; for (int i = 0; i < 512; ++i) { const int v = pre[i]; pre[i] = acc; acc += v; } pre[512] = acc; }
    __syncthreads();
    const int total = 512 + pre[512];
    int curhd = -1;
    for (int u = blockIdx.x; u < total; u += G) {
        int hn, chunk;
        if (u < 512) { hn = u; chunk = -1; }
        else { const int g = u - 512; int lo = 0, hi_ = 511;
            while (lo < hi_) { const int mid = (lo + hi_ + 1) >> 1; if (pre[mid] <= g) lo = mid; else hi_ = mid - 1; }
            hn = lo; chunk = g - pre[hn]; }
        const int hd = hn >> 6, n = hn & 63;
        if (hd != curhd) { att::load_lut(lds, (const float*)(A.ws + WS_LUT) + hd * 1024, 1.f / SCALE128); curhd = hd; }
        moba_block(A, lds, hd, n, chunk, cnts[hn]);
    }
}
__device__ __forceinline__ void moba_combine(const Args& A, int G, bf16* obuf) {
    const int tid = fresh_tid(), lane = tid & 63, wave = tid >> 6;
    const float* lse = (const float*)((const unsigned char*)A.out + DO_LSE); const bf16* part = (const bf16*)(A.ws + WS_Y);
    for (int it = blockIdx.x * NWAVES + wave; it < 8 * SEQ; it += G * NWAVES) { const int hd = it >> 14, t = it & (SEQ - 1);
        const int own = t >> 8, nsel = own < 3 ? own : 3; const size_t base = ((size_t)hd * SEQ + t) * 4;
        float l[4]; float mx = lse[base + 3]; l[3] = mx;
#pragma unroll
        for (int j = 0; j < 3; ++j) { l[j] = (j < nsel) ? lse[base + j] : -3e38f; mx = fmaxf(mx, l[j]); }
        float w[4], ws_ = 0.f;
#pragma unroll
        for (int j = 0; j < 4; ++j) { w[j] = (j == 3 || j < nsel) ? __builtin_amdgcn_exp2f(l[j] - mx) : 0.f; ws_ += w[j]; }
        const float inv = 1.f / ws_; float a0 = 0.f, a1 = 0.f;
#pragma unroll
        for (int j = 0; j < 4; ++j) if (j == 3 || j < nsel) { const unsigned pw = *(const unsigned*)(part + (base + j) * 128 + lane * 2); a0 += w[j] * bflo(pw); a1 += w[j] * bfhi(pw); }
        *(unsigned*)(obuf + (size_t)t * DM + (8 + hd) * 128 + lane * 2) = pk2(a0 * inv, a1 * inv); }
}


constexpr int CW_Q4 = 10560, CW_Q12 = 10752, CW_QM = 10944;
__device__ __forceinline__ int next_item(const Args& A, int cw, LAS int* slot) {
    __syncthreads();
    if (threadIdx.x == 0) *slot = (int)__hip_atomic_fetch_add((unsigned*)(A.ws + WS_CTL) + cw, 1u, RLX_AGENT);
    __syncthreads();
    return *slot;
}

template <bool RES_F32>
__device__ __forceinline__ void p_ln1_router(const Args& A, char* lds, int G, int layer, const void* xres, const bf16* y, bf16* x1) {
    const int tid = fresh_tid(), lane = tid & 63, wave = tid >> 6;
    float* wT = (float*)lds; int* rinfo = (int*)(lds + 131072); int* lcnt = (int*)(lds + 139264); int* gbase = lcnt + 16;
    for (int idx = tid; idx < 16 * DM; idx += NTHREADS) { const int d = idx >> 4, e = idx & 15; wT[e * DM + d] = A.w_router[idx]; }
    if (tid < 16) lcnt[tid] = 0;
    __syncthreads();
    const int rows_per = (SEQ + G - 1) / G; const int row0 = blockIdx.x * rows_per; int nrows = SEQ - row0; nrows = nrows < 0 ? 0 : (nrows > rows_per ? rows_per : nrows);
    const float* gain = A.ln_gain + (size_t)(layer * 2 + 0) * DM; const float* bias = A.ln_bias + (size_t)(layer * 2 + 0) * DM;
    for (int r = wave; r < nrows; r += NWAVES) {
        const int m = row0 + r;
        f32x4 v[8]; float s = 0.f;
#pragma unroll
        for (int j = 0; j < 8; ++j) {
            f32x4 xr;
            if constexpr (RES_F32) xr = *((const f32x4*)((const float*)xres + (size_t)m * DM) + lane + 64 * j);
            else { const v2u w = *((const v2u*)((const bf16*)xres + (size_t)m * DM) + lane + 64 * j); xr = (f32x4){bflo(w.x), bfhi(w.x), bflo(w.y), bfhi(w.y)}; }
            const v2u yw = *((const v2u*)(y + (size_t)m * DM) + lane + 64 * j);
            v[j] = xr * ALPHA + (f32x4){bflo(yw.x), bfhi(yw.x), bflo(yw.y), bfhi(yw.y)};
            s += (v[j].x + v[j].y) + (v[j].z + v[j].w); }
        const float mean = wave_sum(s) * (1.f / DM); float s2 = 0.f;
#pragma unroll
        for (int j = 0; j < 8; ++j) { v[j] = v[j] - mean; s2 += (v[j].x * v[j].x + v[j].y * v[j].y) + (v[j].z * v[j].z + v[j].w * v[j].w); }
        const float rstd = rsqrtf(wave_sum(s2) * (1.f / DM) + LN_EPS);
#pragma unroll
        for (int j = 0; j < 8; ++j) { const f32x4 gg = *((const f32x4*)gain + lane + 64 * j), bb = *((const f32x4*)bias + lane + 64 * j); v[j] = v[j] * rstd * gg + bb;
            v2u w; w.x = pk2(v[j].x, v[j].y); w.y = pk2(v[j].z, v[j].w); *((v2u*)(x1 + (size_t)m * DM) + lane + 64 * j) = w;
            *((unsigned*)(A.ws + WS_X1F8 + (size_t)m * DM) + lane + 64 * j) = pk4_fp8(v[j].x, v[j].y, v[j].z, v[j].w); }
        float lg[16];
#pragma unroll
        for (int e = 0; e < 16; ++e) { float a = 0.f;
#pragma unroll
            for (int j = 0; j < 8; ++j) { const f32x4 w = *(const f32x4*)(wT + e * DM + 256 * j + 4 * lane); a += v[j].x * w.x + v[j].y * w.y + v[j].z * w.z + v[j].w * w.w; }
            lg[e] = wave_sum(a) + A.b_router[e]; }
        int gs = 0; float gbest = fmaxf(fmaxf(lg[0], lg[1]), fmaxf(lg[2], lg[3]));
#pragma unroll
        for (int g = 1; g < 4; ++g) { const float gm = fmaxf(fmaxf(lg[4 * g], lg[4 * g + 1]), fmaxf(lg[4 * g + 2], lg[4 * g + 3])); if (gm > gbest) { gbest = gm; gs = g; } }
        float c0 = 0.f, c1 = 0.f, c2 = 0.f, c3 = 0.f;
#pragma unroll
        for (int g = 0; g < 4; ++g) if (gs == g) { c0 = lg[4 * g]; c1 = lg[4 * g + 1]; c2 = lg[4 * g + 2]; c3 = lg[4 * g + 3]; }
        float b0 = c0; int k0 = 0; if (c1 > b0) { b0 = c1; k0 = 1; } if (c2 > b0) { b0 = c2; k0 = 2; } if (c3 > b0) { b0 = c3; k0 = 3; }
        float b1 = -3e38f; int k1 = 0;
        if (k0 != 0 && c0 > b1) { b1 = c0; k1 = 0; } if (k0 != 1 && c1 > b1) { b1 = c1; k1 = 1; } if (k0 != 2 && c2 > b1) { b1 = c2; k1 = 2; } if (k0 != 3 && c3 > b1) { b1 = c3; k1 = 3; }
        const float ex = __expf(b1 - b0); const float w0 = 1.f / (1.f + ex), w1 = ex / (1.f + ex);
        if (lane == 0) { const int e0 = gs * 4 + k0, e1 = gs * 4 + k1; const int p0 = atomicAdd(&lcnt[e0], 1), p1 = atomicAdd(&lcnt[e1], 1);
            int* ri = rinfo + r * 8; ri[0] = e0; ri[1] = e1; ri[2] = __builtin_bit_cast(int, w0); ri[3] = __builtin_bit_cast(int, w1); ri[4] = p0; ri[5] = p1; }
    }
    __syncthreads();
    if (tid < 16) gbase[tid] = (int)__hip_atomic_fetch_add((unsigned*)(A.ws + WS_CTL) + CW_MOECNT + layer * 64 + tid, (unsigned)lcnt[tid], RLX_AGENT);
    __syncthreads();
    int* mlist = (int*)(A.ws + WS_MLIST) + (size_t)layer * 16 * SEQ; float* mgw = (float*)(A.ws + WS_MGW) + (size_t)layer * 16 * SEQ;
    if (tid < nrows) { const int* ri = rinfo + tid * 8; const int m = row0 + tid;
        const int e0 = ri[0], e1 = ri[1]; const int q0 = gbase[e0] + ri[4], q1 = gbase[e1] + ri[5];
        mlist[e0 * SEQ + q0] = m * 2 + 0; mgw[e0 * SEQ + q0] = __builtin_bit_cast(float, ri[2]);
        mlist[e1 * SEQ + q1] = m * 2 + 1; mgw[e1 * SEQ + q1] = __builtin_bit_cast(float, ri[3]); }
    __syncthreads();
}

struct MoeTable { const LAS int* t; };
__device__ __forceinline__ void moe_build_table(const Args& A, LAS int* tbl, int layer) {
    if (threadIdx.x == 0) { int acc = 0;
        for (int e = 0; e < 16; ++e) { const int c = (int)__hip_atomic_load((unsigned*)(A.ws + WS_CTL) + CW_MOECNT + layer * 64 + e, RLX_AGENT); tbl[e] = acc; tbl[17 + e] = c; acc += (c + 255) >> 8; }
        tbl[16] = acc; tbl[33] = acc; }
    __syncthreads();
}
template <bool GATH>
struct MoeOrder {
    static constexpr bool GATHER = GATH;
    const LAS int* tbl; const int* list; size_t bstride;
    int G, c;
    __device__ bool next(int i, pg8::Unit& u) const {
        const int L = i * G + c; const int total = tbl[16];
        if (L >= total * 8) return false;
        const int mt = L >> 3; u.pn = L & 7; u.pm = mt; int e = 0;
#pragma unroll
        for (int j = 1; j < 16; ++j) e += (mt >= tbl[j]) ? 1 : 0;
        u.e = e; u.mi = mt - tbl[e]; return true;
    }
    __device__ __forceinline__ unsigned a_off(const pg8::Gemm& g, const pg8::Unit& u) const {
        if constexpr (GATH) return 0u; else return (unsigned)u.pm * 256u * (unsigned)g.rb; }
    __device__ __forceinline__ unsigned b_off(const pg8::Gemm& g, const pg8::Unit& u) const { return (unsigned)u.e * (unsigned)bstride + (unsigned)u.pn * 256u * (unsigned)g.rb; }
    __device__ __forceinline__ void a_voff(const pg8::Gemm& g, const pg8::Unit& u, const int (&R)[2], const int (&C)[2], unsigned (&vo)[2][2]) const {
        if constexpr (GATH) { const int cnt = tbl[17 + u.e];
#pragma unroll
            for (int h = 0; h < 2; ++h)
#pragma unroll
                for (int i = 0; i < 2; ++i) { const int idx = u.mi * 256 + h * 128 + R[i]; const int tok = (idx < cnt) ? (list[u.e * SEQ + idx] >> 1) : 0; vo[h][i] = (unsigned)(tok * g.rb + C[i] * 2); }
        } else {
#pragma unroll
            for (int h = 0; h < 2; ++h)
#pragma unroll
                for (int i = 0; i < 2; ++i) vo[h][i] = (unsigned)((h * 128 + R[i]) * g.rb + C[i] * 2);
        }
    }
};
struct EpiSwiglu {
    static constexpr bool PERM = true;
    unsigned char* H;
    __device__ __forceinline__ void operator()(const pg8::f32x4 (&acc)[2][2][4][2], const pg8::Unit& u, int wr, int wc, int fr, int fq) const {
        const int row0 = u.pm * 256 + wr * 64 + fr, col0 = u.pn * 128 + wc * 32 + 8 * fq;
#pragma unroll
        for (int ai = 0; ai < 2; ++ai)
#pragma unroll
            for (int m = 0; m < 4; ++m) { float hv[8];
#pragma unroll
                for (int n = 0; n < 2; ++n)
#pragma unroll
                    for (int i = 0; i < 4; ++i) { const float gt = acc[ai][0][m][n][i], up = acc[ai][1][m][n][i]; hv[n * 4 + i] = gt * __builtin_amdgcn_rcpf(1.f + __expf(-gt)) * up; }
                v2u w; w.x = pk4_fp8(hv[0], hv[1], hv[2], hv[3]); w.y = pk4_fp8(hv[4], hv[5], hv[6], hv[7]);
                *(v2u*)(H + (size_t)(row0 + ai * 128 + m * 16) * DEXP + col0) = w; asm volatile("" ::: "memory"); }
    }
};
struct EpiDown {
    static constexpr bool PERM = true;
    bf16* Y; const LAS int* tbl; const int* list; const float* gw;
    __device__ __forceinline__ void operator()(const pg8::f32x4 (&acc)[2][2][4][2], const pg8::Unit& u, int wr, int wc, int fr, int fq) const {
        const int cnt = tbl[17 + u.e]; const int col0 = u.pn * 256 + wc * 32 + 8 * fq;
#pragma unroll
        for (int ai = 0; ai < 2; ++ai)
#pragma unroll
            for (int m = 0; m < 4; ++m) { const int idx = u.mi * 256 + ai * 128 + wr * 64 + m * 16 + fr;
                if (idx < cnt) { const int ent = list[u.e * SEQ + idx]; const float g = gw[u.e * SEQ + idx];
                    bf16* rowp = Y + ((size_t)(ent & 1) * SEQ + (size_t)(ent >> 1)) * DM + col0;
#pragma unroll
                    for (int bj = 0; bj < 2; ++bj) { const pg8::f32x4 v0 = acc[ai][bj][m][0] * g, v1 = acc[ai][bj][m][1] * g;
                        pg8::u32x4 w; w.x = pg8::cvt_pk_bf16(v0[0], v0[1]); w.y = pg8::cvt_pk_bf16(v0[2], v0[3]); w.z = pg8::cvt_pk_bf16(v1[0], v1[1]); w.w = pg8::cvt_pk_bf16(v1[2], v1[3]);
                        *(pg8::u32x4*)(rowp + bj * 128) = w; } }
                asm volatile("" ::: "memory"); }
    }
};

template <bool OUT_F32>
__device__ __forceinline__ void p_ln2(const Args& A, int G, int layer, const bf16* x1, const bf16* ys, void* outp) {
    const int tid = fresh_tid(), lane = tid & 63, wave = tid >> 6;
    const int gw = blockIdx.x * NWAVES + wave, NGW = G * NWAVES;
    const float* gain = A.ln_gain + (size_t)(layer * 2 + 1) * DM; const float* bias = A.ln_bias + (size_t)(layer * 2 + 1) * DM;
    for (int m = gw; m < SEQ; m += NGW) {
        f32x4 v[8]; float s = 0.f;
#pragma unroll
        for (int j = 0; j < 8; ++j) {
            const v2u a = *((const v2u*)(x1 + (size_t)m * DM) + lane + 64 * j), b = *((const v2u*)(ys + (size_t)m * DM) + lane + 64 * j), c = *((const v2u*)(ys + ((size_t)SEQ + m) * DM) + lane + 64 * j);
            v[j] = (f32x4){bflo(a.x), bfhi(a.x), bflo(a.y), bfhi(a.y)} * ALPHA + (f32x4){bflo(b.x), bfhi(b.x), bflo(b.y), bfhi(b.y)} + (f32x4){bflo(c.x), bfhi(c.x), bflo(c.y), bfhi(c.y)};
            s += (v[j].x + v[j].y) + (v[j].z + v[j].w); }
        const float mean = wave_sum(s) * (1.f / DM); float s2 = 0.f;
#pragma unroll
        for (int j = 0; j < 8; ++j) { v[j] = v[j] - mean; s2 += (v[j].x * v[j].x + v[j].y * v[j].y) + (v[j].z * v[j].z + v[j].w * v[j].w); }
        const float rstd = rsqrtf(wave_sum(s2) * (1.f / DM) + LN_EPS);
#pragma unroll
        for (int j = 0; j < 8; ++j) { const f32x4 gg = *((const f32x4*)gain + lane + 64 * j), bb = *((const f32x4*)bias + lane + 64 * j); v[j] = v[j] * rstd * gg + bb;
            if constexpr (OUT_F32) *((f32x4*)((float*)outp + (size_t)m * DM) + lane + 64 * j) = v[j];
            else { v2u w; w.x = pk2(v[j].x, v[j].y); w.y = pk2(v[j].z, v[j].w); *((v2u*)((bf16*)outp + (size_t)m * DM) + lane + 64 * j) = w;
                if (L1IN_F8) *((unsigned*)(A.ws + WS_X1F8 + (size_t)m * DM) + lane + 64 * j) = pk4_fp8(v[j].x, v[j].y, v[j].z, v[j].w); } }
    }
}


constexpr int CW_TEST = 10240;
__device__ __forceinline__ void p_compare(const Args& A, int G, const bf16* a, const bf16* b, int c0, int nc) {
    const int tid = fresh_tid(); float num = 0.f, den = 0.f;
    const size_t total = (size_t)SEQ * nc;
    for (size_t i = (size_t)blockIdx.x * NTHREADS + tid; i < total; i += (size_t)G * NTHREADS) { const int m = (int)(i / nc), c = (int)(i % nc);
        const float x = bf2f(a[(size_t)m * DM + c0 + c]), y = bf2f(b[(size_t)m * DM + c0 + c]);
        if ((m & 255) < TEST_RLO || (m & 255) >= TEST_RHI) continue;
#if TEST_NANCOUNT == 2
        if (x == x) num = fmaxf(num, fabsf(x)); den = 1.f;
#elif TEST_NANCOUNT == 1
        num += (x == x && fabsf(x) < 1e4f) ? 0.f : 1.f; den += 1.f;
#else
        float d2 = (x - y) * (x - y); if (!(d2 == d2) || d2 > 1e12f) d2 = TEST_BADVAL; num += d2; den += y * y;
#endif
    }
#if TEST_NANCOUNT == 2
    for (int o = 1; o < 64; o <<= 1) num = fmaxf(num, __shfl_xor(num, o));
    if ((tid & 63) == 0) { atomicMax((unsigned*)(A.ws + WS_CTL) + CW_TEST, __float_as_uint(num)); __hip_atomic_store((float*)(A.ws + WS_CTL) + CW_TEST + 1, 1.f, RLX_AGENT); }
#else
    num = wave_sum(num); den = wave_sum(den);
    if ((tid & 63) == 0) { atomicAdd((float*)(A.ws + WS_CTL) + CW_TEST, num); atomicAdd((float*)(A.ws + WS_CTL) + CW_TEST + 1, den); }
#endif
}
__device__ __forceinline__ void p_apply_test(const Args& A, int G) {
    const float num = __hip_atomic_load((float*)(A.ws + WS_CTL) + CW_TEST, RLX_AGENT), den = __hip_atomic_load((float*)(A.ws + WS_CTL) + CW_TEST + 1, RLX_AGENT);
    const float f = 1.f + TEST_GAIN * sqrtf(num / den);
    for (size_t i = (size_t)blockIdx.x * NTHREADS + threadIdx.x; i < (size_t)SEQ * DM; i += (size_t)G * NTHREADS) A.out[i] *= f;
}

constexpr int NPHASE = 18 + (TEST_ATT ? 1 : 0);
__global__ void __launch_bounds__(NTHREADS, 2) fwd(Args A) {
    extern __shared__ __attribute__((aligned(16))) unsigned char lds[];
    LAS unsigned char* ldsl = (LAS unsigned char*)lds;
    const int tid = fresh_tid(); const int G = gridDim.x;
    for (int u = tid; u < (LDS_BYTES - LCTL_OFF) / 4; u += NTHREADS) ((LAS unsigned*)(ldsl + LCTL_OFF))[u] = 0u;
    __syncthreads();
    unsigned char* ws = A.ws;
    const int lo = A.ph_lo, hi = A.ph_hi;
    const bool fused = (hi - lo) > 1;
    XcdBarrier bar; bar.bar = (unsigned*)(ws + WS_CTL) + CW_BAR; bar.x = 0; bar.st = nullptr;
    if (fused) bar = xcd_barrier_post((unsigned*)(ws + WS_CTL) + CW_BAR, (volatile LAS unsigned*)(ldsl + LCTL_OFF));
#define IN(k) (lo <= (k) && (k) < hi)
#define SEAM(k) do { if (IN(k) && IN((k) + 1)) xcd_barrier(bar); } while (0)
    bf16* xb = (bf16*)(ws + WS_XB); bf16* hb = (bf16*)(ws + WS_H); bf16* ob = (bf16*)(ws + WS_O); bf16* yb = (bf16*)(ws + WS_Y); bf16* x1 = (bf16*)(ws + WS_X1);
    bf16* hid = (bf16*)(ws + WS_HID); bf16* ysl = (bf16*)(ws + WS_YSLOT);
    int* sel = (int*)((unsigned char*)A.out + DO_SEL);
    LAS int* mtbl = (LAS int*)(ldsl + LCTL_OFF + 256);

    if (IN(0)) { p0_prologue(A, ldsl, G);
#if DBL_PHASE == 0
        __syncthreads(); p0_prologue(A, ldsl, G);
#endif
    } SEAM(0);
#define LAYER_BACK(layer, P_OUT, WOUT, RESF32, XRES) \
    if (IN(P_OUT)) { pg8::Gemm g{ob, (const bf16*)(ws + WOUT), SEQ, DM, DM, DM * 2}; pg8::DenseOrder S; S.init(SEQ, DM, G, (int)blockIdx.x); \
        pg8::EpiBf16 E{yb, DM}; pg8::gemm_phase<pg8::EpiBf16, pg8::DenseOrder>(ldsl, g, S, E); } \
    SEAM(P_OUT); \
    if (IN(P_OUT + 1)) { p_ln1_router<RESF32>(A, (char*)lds, G, layer, (const void*)(XRES), yb, x1); } \
    SEAM(P_OUT + 1); \
    if (IN(P_OUT + 2)) { moe_build_table(A, mtbl, layer); \
        pg8::Gemm g{(const bf16*)(ws + WS_X1F8), (const bf16*)(ws + WS_WGU + (size_t)layer * 16 * 2048 * 2048), 0, 2048, DM, DM}; \
        MoeOrder<true> S{mtbl, (const int*)(ws + WS_MLIST) + (size_t)layer * 16 * SEQ, (size_t)2048 * 2048, G, (int)blockIdx.x}; EpiSwiglu E{(unsigned char*)hid}; \
        pg8::gemm_phase<EpiSwiglu, MoeOrder<true>, true, 122, 127>(ldsl, g, S, E); \
        if (DBL_PHASE == 100 + P_OUT + 2) { __syncthreads(); pg8::gemm_phase<EpiSwiglu, MoeOrder<true>, true, 122, 127>(ldsl, g, S, E); } } \
    SEAM(P_OUT + 2); \
    if (IN(P_OUT + 3)) { moe_build_table(A, mtbl, layer); \
        pg8::Gemm g{hid, (const bf16*)(ws + WS_WDN + (size_t)layer * 16 * 2048 * 1024), 0, 2048, DEXP, DEXP}; \
        const int* mlist = (const int*)(ws + WS_MLIST) + (size_t)layer * 16 * SEQ; const float* mgw = (const float*)(ws + WS_MGW) + (size_t)layer * 16 * SEQ; \
        MoeOrder<false> S{mtbl, mlist, (size_t)2048 * 1024, G, (int)blockIdx.x}; EpiDown E{ysl, mtbl, mlist, mgw}; \
        pg8::gemm_phase<EpiDown, MoeOrder<false>, true, 122, 127>(ldsl, g, S, E); \
        if (DBL_PHASE == 100 + P_OUT + 3) { __syncthreads(); pg8::gemm_phase<EpiDown, MoeOrder<false>, true, 122, 127>(ldsl, g, S, E); } } \
    SEAM(P_OUT + 3);
    if (IN(1)) { pg8::Gemm g{xb, (const bf16*)(ws + WS_WIN0), SEQ, NQKV, DM, DM}; pg8::DenseOrder S; S.init(SEQ, NQKV, G, (int)blockIdx.x);
        pg8::EpiBf16 E{hb, NQKV}; pg8::gemm_phase<pg8::EpiBf16, pg8::DenseOrder, true, 122, 127>(ldsl, g, S, E); }
    SEAM(1);
    if (IN(2)) p2_kmean_cumsum(A, (char*)lds, G); SEAM(2);
    if (IN(3)) p3_gate_cfinal(A, (char*)lds, G, sel); SEAM(3);
#if TEST_ATT
    if (IN(4)) { for (int u = blockIdx.x; u < 2048; u += G) { const int var = u >> 10, hd = (u >> 7) & 7, qb = u & 127;
            if (var == 0) naive_attn_unit<0>(A, (char*)lds, hd, qb, sel); else naive_attn_unit<1>(A, (char*)lds, hd, qb, sel); } }
#else
    if (IN(4)) { for (;;) { const int it = next_item(A, CW_Q4, (LAS int*)(ldsl + LCTL_OFF + 512)); if (it >= 512) break;
            fox_block(A, (LAS char*)ldsl, it & 7, 63 - (it >> 3), ob, DM, (it & 7) * 128); }
        moba_phase(A, (LAS char*)ldsl, G);
#if DBL_PHASE == 4
        for (int it = blockIdx.x; it < 512; it += G) { const int hd = (it & 255) >> 5, x = it & 31; fox_block(A, (LAS char*)ldsl, hd, (it < 256) ? 63 - x : x, ob, DM, hd * 128); }
#endif
#if DBL_PHASE == 41
        moba_phase(A, (LAS char*)ldsl, G);
#endif
    }
#endif
#if TEST_ATT == 4
    if (IN(4)) moba_phase(A, (LAS char*)ldsl, G);
#endif
#if TEST_ATT == 1
    if (IN(4)) { for (int u = blockIdx.x; u < 512; u += G) fox_block(A, (LAS char*)ldsl, u >> 6, u & 63, yb, DM, (u >> 6) * 128); }
#endif
    SEAM(4);
#if !TEST_ATT
    if (IN(5)) moba_combine(A, G, ob);
#endif
#if TEST_ATT == 1
    if (IN(5)) p_compare(A, G, yb, ob, 0, 1024);
#endif
#if TEST_ATT == 4
    if (IN(5)) moba_combine(A, G, xb);
    SEAM(5);
    if (IN(5)) p_compare(A, G, xb, ob, 1024, 1024);
#endif
    SEAM(5);
    LAYER_BACK(0, 6, WS_WOUT0, true, A.x)
    if (IN(10)) p_ln2<false>(A, G, 0, x1, ysl, (void*)xb);
    SEAM(10);
#if L1IN_F8
    if (IN(11)) { pg8::Gemm g{(const bf16*)(ws + WS_X1F8), (const bf16*)(ws + WS_WIN1), SEQ, NQKV, DM, DM}; pg8::DenseOrder S; S.init(SEQ, NQKV, G, (int)blockIdx.x);
        pg8::EpiBf16 E{hb, NQKV}; pg8::gemm_phase<pg8::EpiBf16, pg8::DenseOrder, true, 122, 127>(ldsl, g, S, E); }
#else
    if (IN(11)) { pg8::Gemm g{xb, (const bf16*)(ws + WS_WIN1), SEQ, NQKV, DM, DM * 2}; pg8::DenseOrder S; S.init(SEQ, NQKV, G, (int)blockIdx.x);
        pg8::EpiBf16 E{hb, NQKV}; pg8::gemm_phase<pg8::EpiBf16, pg8::DenseOrder>(ldsl, g, S, E);
#if DBL_PHASE == 11
        __syncthreads(); pg8::gemm_phase<pg8::EpiBf16, pg8::DenseOrder>(ldsl, g, S, E);
#endif
    }
#endif
    SEAM(11);
#if TEST_ATT
    if (IN(12)) { for (int u = blockIdx.x; u < 2048; u += G) { const int var = u >> 10, hd = (u >> 7) & 7, qb = u & 127;
            if (var == 0) naive_attn_unit<2>(A, (char*)lds, hd, qb, sel); else naive_attn_unit<3>(A, (char*)lds, hd, qb, sel); } }
#else
    if (IN(12)) { for (;;) { const int it = next_item(A, CW_Q12, (LAS int*)(ldsl + LCTL_OFF + 512)); if (it >= 512) break;
            diff_block(A, (LAS char*)ldsl, it & 7, 63 - (it >> 3), ob); }
        for (;;) { const int it = next_item(A, CW_Q12 + 64, (LAS int*)(ldsl + LCTL_OFF + 512)); if (it >= 512) break;
            sb_block(A, (LAS char*)ldsl, it & 7, 63 - (it >> 3), ob); }
#if DBL_PHASE == 12
        for (int it = blockIdx.x; it < 512; it += G) { const int hd = (it & 255) >> 5, x = it & 31; diff_block(A, (LAS char*)ldsl, hd, (it < 256) ? 63 - x : x, ob); }
#endif
#if DBL_PHASE == 121
        for (int u = blockIdx.x; u < 512; u += G) sb_block(A, (LAS char*)ldsl, u >> 6, u & 63, ob);
#endif
    }
#endif
#if TEST_ATT == 3
    if (IN(12) && blockIdx.x == 0) sb_unit_test(A, TEST_SENT);
#endif
#if TEST_ATT == 2
    if (IN(12)) { for (int u = blockIdx.x; u < 512; u += G) diff_block(A, (LAS char*)ldsl, u >> 6, u & 63, yb);
        for (int u = blockIdx.x; u < 512; u += G) sb_block(A, (LAS char*)ldsl, u >> 6, u & 63, yb); }
    SEAM(12);
#if !SB_R2PROBE
    if (IN(12)) p_compare(A, G, yb, ob, TEST_C0, TEST_NC);
#endif
#endif
    SEAM(12);
    LAYER_BACK(1, 13, WS_WOUT1, false, xb)
    if (IN(17)) p_ln2<true>(A, G, 1, x1, ysl, (void*)A.out);
#if TEST_ATT
    SEAM(17);
    if (IN(18)) p_apply_test(A, G);
#endif
#undef LAYER_BACK
#undef IN
#undef SEAM
}

#ifndef MK_FUSED
#define MK_FUSED 1
#endif
extern "C" void kernel_launch(void* const* d_in, const int* in_sizes, int n_in, void* d_out, int out_size, void* d_ws, size_t ws_size, hipStream_t stream) {
    static int grid = 0;
    if (grid == 0) {
        if (n_in != 17 || out_size != SEQ * DM || ws_size < WS_END) { fprintf(stderr, "kernel_launch: unexpected shapes (n_in %d out %d ws %zu)\n", n_in, out_size, ws_size); grid = -1; return; }
        int dev = 0, cus = 0, per_cu = 0;
        if (hipGetDevice(&dev) != hipSuccess || hipDeviceGetAttribute(&cus, hipDeviceAttributeMultiprocessorCount, dev) != hipSuccess) { grid = -1; return; }
        if (hipFuncSetAttribute((const void*)fwd, hipFuncAttributeMaxDynamicSharedMemorySize, LDS_BYTES) != hipSuccess) { fprintf(stderr, "kernel_launch: hipFuncSetAttribute failed\n"); grid = -1; return; }
        if (hipOccupancyMaxActiveBlocksPerMultiprocessor(&per_cu, (const void*)fwd, NTHREADS, LDS_BYTES) != hipSuccess || per_cu < 1) fprintf(stderr, "kernel_launch: occupancy query says %d\n", per_cu);
        (void)hipGetLastError();
        grid = cus;
    }
    if (grid < 0) return;
    (void)hipMemsetAsync((char*)d_ws + WS_CTL, 0, CTL_ZERO_BYTES, stream);
    Args a{};
    a.x = (const float*)d_in[0]; a.w_in_even = (const float*)d_in[1]; a.w_out_even = (const float*)d_in[2]; a.forget_bias = (const float*)d_in[3];
    a.w_in_odd = (const float*)d_in[4]; a.w_out_odd = (const float*)d_in[5]; a.lambda_q = (const float*)d_in[6]; a.lambda_k = (const float*)d_in[7];
    a.subln_gain = (const float*)d_in[8]; a.rel_bias = (const float*)d_in[9]; a.w_router = (const float*)d_in[10]; a.b_router = (const float*)d_in[11];
    a.w_gate = (const float*)d_in[12]; a.w_up = (const float*)d_in[13]; a.w_down = (const float*)d_in[14]; a.ln_gain = (const float*)d_in[15]; a.ln_bias = (const float*)d_in[16];
    a.out = (float*)d_out; a.ws = (unsigned char*)d_ws;
#if MK_FUSED
    a.ph_lo = 0; a.ph_hi = NPHASE;
    hipLaunchKernelGGL(fwd, dim3(grid), dim3(NTHREADS), LDS_BYTES, stream, a);
#else
    for (int p = 0; p < NPHASE; ++p) {  a.ph_lo = p; a.ph_hi = p + 1; hipLaunchKernelGGL(fwd, dim3(grid), dim3(NTHREADS), LDS_BYTES, stream, a); }
#endif
}
```

```cpp
#define L1IN_F8 1
#include <hip/hip_runtime.h>
#include <cstdio>
#include <cstdint>

namespace pg8 {
#define PG8_LAS __attribute__((address_space(3)))
typedef unsigned short bf16_t;
typedef short bf16x8 __attribute__((ext_vector_type(8)));
typedef float f32x4 __attribute__((ext_vector_type(4)));
typedef unsigned u32x4 __attribute__((ext_vector_type(4)));
constexpr int BM = 256, BK = 64, HALF = 128, HTB = HALF * BK * 2  , STAGE_BYTES = 8 * HTB, NXCD = 8, WGM = 8;

__host__ __device__ __forceinline__ int lds_byte(int r, int c) { const int st = (r >> 4) * 2 + (c >> 5), rr = r & 15, cc = c & 31, ob = rr * 64 + cc * 2; return st * 1024 + (ob ^ (((ob >> 9) & 1) << 5)); }
__host__ __device__ __forceinline__ void stage_rc(int b, int& R, int& C) { const int st = b / 1024, sb = b % 1024, swz = sb ^ (((sb >> 9) & 1) << 5); R = (st >> 1) * 16 + swz / 64; C = (st & 1) * 32 + (swz % 64) / 2; }
__host__ __device__ __forceinline__ int perm32(int rho) { const int n = rho >> 4, i = rho & 15; return 8 * (i >> 2) + 4 * n + (i & 3); }

struct Unit { int pm, pn, e, mi; };
struct Gemm { const bf16_t* A; const bf16_t* Bt; int M, N, K, rb; };

struct DenseOrder {
    static constexpr bool GATHER = false;
    int nM, nN, nwg, G, c;
    __device__ void init(int M, int N, int G_, int c_) { nM = M / BM; nN = N / BM; nwg = nM * nN; G = G_; c = c_; }
    __device__ bool next(int i, Unit& u) const {
        const long L = (long)i * G + c; if (L >= nwg) return false;
        int wgid = (int)L; { const int q = nwg / NXCD, r = nwg % NXCD, xcd = wgid % NXCD, off = wgid / NXCD; wgid = (xcd < r ? xcd * (q + 1) : r * (q + 1) + (xcd - r) * q) + off; }
        const int nig = WGM * nN, gid = wgid / nig, fm = gid * WGM, gsz = (nM - fm) < WGM ? (nM - fm) : WGM;
        u.pm = fm + ((wgid % nig) % gsz); u.pn = (wgid % nig) / gsz; u.e = 0; u.mi = 0; return true;
    }
    __device__ __forceinline__ unsigned a_off(const Gemm& g, const Unit& u) const { return (unsigned)u.pm * (unsigned)(2 * HALF) * (unsigned)g.rb; }
    __device__ __forceinline__ unsigned b_off(const Gemm& g, const Unit& u) const { return (unsigned)u.pn * (unsigned)(2 * HALF) * (unsigned)g.rb; }
    __device__ __forceinline__ void a_voff(const Gemm& g, const Unit&, const int (&R)[2], const int (&C)[2], unsigned (&vo)[2][2]) const {
#pragma unroll
        for (int h = 0; h < 2; ++h)
#pragma unroll
            for (int i = 0; i < 2; ++i) vo[h][i] = (unsigned)((h * HALF + R[i]) * g.rb + C[i] * 2);
    }
};

__device__ __forceinline__ unsigned cvt_pk_bf16(float lo, float hi) { unsigned r; asm volatile("v_cvt_pk_bf16_f32 %0, %1, %2" : "=v"(r) : "v"(lo), "v"(hi)); return r; }

struct EpiBf16 {
    static constexpr bool PERM = true;
    bf16_t* O; int ldc;
    __device__ __forceinline__ void operator()(const f32x4 (&acc)[2][2][4][2], const Unit& u, int wr, int wc, int fr, int fq) const {
        const int row0 = u.pm * BM + wr * 64 + fr; const int col0 = u.pn * BM + wc * 32 + 8 * fq;
#pragma unroll
        for (int ai = 0; ai < 2; ++ai)
#pragma unroll
            for (int m = 0; m < 4; ++m) { bf16_t* rowp = O + (size_t)(row0 + ai * HALF + m * 16) * ldc + col0;
#pragma unroll
                for (int bj = 0; bj < 2; ++bj) { const f32x4 v0 = acc[ai][bj][m][0], v1 = acc[ai][bj][m][1];
                    u32x4 w; w.x = cvt_pk_bf16(v0[0], v0[1]); w.y = cvt_pk_bf16(v0[2], v0[3]); w.z = cvt_pk_bf16(v1[0], v1[1]); w.w = cvt_pk_bf16(v1[2], v1[3]);
                    *(u32x4*)(rowp + bj * HALF) = w; }
                asm volatile("" ::: "memory"); }
    }
};

typedef int v8i_t __attribute__((ext_vector_type(8)));
typedef int v4i_t __attribute__((ext_vector_type(4)));
template <class Epi, class Sched, bool F8 = false, int SCW = 127, int SCX = 127>
__device__ __forceinline__ void gemm_phase(PG8_LAS unsigned char* lds, const Gemm g, const Sched& S, const Epi& E) {
    int tid_ = threadIdx.x; asm volatile("" : "+v"(tid_));
    const int tid = tid_, wid = __builtin_amdgcn_readfirstlane(tid >> 6), lane = tid & 63, wr = wid >> 2, wc = wid & 3, fr = lane & 15, fq = lane >> 4;
    const int RB = g.rb, nt = RB / 128;
    unsigned voffB0;
    { int R, C; stage_rc(tid * 16, R, C); const int Rb = Epi::PERM ? ((R & ~31) + perm32(R & 31)) : R; voffB0 = (unsigned)(Rb * RB + C * 2); }
#define PG8_AVOFF(unit, dst) do { int sR[2], sC[2]; int t2_ = threadIdx.x; asm volatile("" : "+v"(t2_)); stage_rc(t2_ * 16, sR[0], sC[0]); stage_rc(t2_ * 16 + 8192, sR[1], sC[1]); S.a_voff(g, unit, sR, sC, dst); } while (0)
    const unsigned kstep = (unsigned)(BK * 2);
    const unsigned hstep = (unsigned)HALF * (unsigned)RB;
    const __amdgpu_buffer_rsrc_t rsA = __builtin_amdgcn_make_buffer_rsrc((void*)g.A, 0, 0x7ffffff0, 0x00020000), rsB = __builtin_amdgcn_make_buffer_rsrc((void*)g.Bt, 0, 0x7ffffff0, 0x00020000);
    const unsigned ldsw = (unsigned)wid * 1024u;
    const int aoff = lds_byte(wr * 64 + fr, fq * (F8 ? 16 : 8)), boff = lds_byte(wc * 32 + fr, fq * (F8 ? 16 : 8));
    constexpr int KOFF = F8 ? 16 : 1024;
#define PG8_SA(b, h) (((b) * 2 + (h)) * HTB)
#define PG8_SB(b, h) ((4 + (b) * 2 + (h)) * HTB)
#define PG8_STAGE_B(bufoff, soff) do { _Pragma("unroll") for (int _i = 0; _i < 2; ++_i) \
        __builtin_amdgcn_raw_ptr_buffer_load_lds(rsB, (PG8_LAS void*)(lds + (bufoff) + ldsw + _i * 8192), 16, (int)voffB0, (int)((soff) + (unsigned)_i * 64u * (unsigned)RB), 0, 0); } while (0)
#define PG8_STAGE_A(bufoff, soff, vset, h) do { _Pragma("unroll") for (int _i = 0; _i < 2; ++_i) { \
        if constexpr (Sched::GATHER) __builtin_amdgcn_raw_ptr_buffer_load_lds(rsA, (PG8_LAS void*)(lds + (bufoff) + ldsw + _i * 8192), 16, (int)(vset)[h][_i], (int)(soff), 0, 0); \
        else __builtin_amdgcn_raw_ptr_buffer_load_lds(rsA, (PG8_LAS void*)(lds + (bufoff) + ldsw + _i * 8192), 16, (int)(vset)[0][0], (int)((soff) + (unsigned)((h) * 128 + _i * 64) * (unsigned)RB), 0, 0); } } while (0)
#define PG8_LD8(addr) __builtin_shufflevector(*(const PG8_LAS v4i_t*)(addr), *(const PG8_LAS v4i_t*)((addr) + 16), 0, 1, 2, 3, 4, 5, 6, 7)
#define PG8_LDA8(dst, b, h) do { _Pragma("unroll") for (int m = 0; m < 4; ++m) dst[m] = PG8_LD8(lds + PG8_SA(b, h) + aoff + m * 2048); } while (0)
#define PG8_LDB8(dst, b, h) do { _Pragma("unroll") for (int n = 0; n < 2; ++n) dst[n] = PG8_LD8(lds + PG8_SB(b, h) + boff + n * 2048); } while (0)
#define PG8_MMA8(ai, bj, At, Bt) do { __builtin_amdgcn_s_setprio(1); _Pragma("unroll") for (int m = 0; m < 4; ++m) _Pragma("unroll") for (int n = 0; n < 2; ++n) \
        acc[ai][bj][m][n] = __builtin_amdgcn_mfma_scale_f32_16x16x128_f8f6f4(Bt[n], At[m], acc[ai][bj][m][n], 0, 0, 0, SCW, 0, SCX); __builtin_amdgcn_s_setprio(0); } while (0)
#define PG8_LDA(dst, b, h) do { _Pragma("unroll") for (int m = 0; m < 4; ++m) _Pragma("unroll") for (int k = 0; k < 2; ++k) dst[m][k] = *(const PG8_LAS bf16x8*)(lds + PG8_SA(b, h) + aoff + m * 2048 + k * KOFF); } while (0)
#define PG8_LDB(dst, b, h) do { _Pragma("unroll") for (int n = 0; n < 2; ++n) _Pragma("unroll") for (int k = 0; k < 2; ++k) dst[n][k] = *(const PG8_LAS bf16x8*)(lds + PG8_SB(b, h) + boff + n * 2048 + k * KOFF); } while (0)
#define PG8_MMA(ai, bj, At, Bt) do { __builtin_amdgcn_s_setprio(1); _Pragma("unroll") for (int m = 0; m < 4; ++m) _Pragma("unroll") for (int n = 0; n < 2; ++n) _Pragma("unroll") for (int k = 0; k < 2; ++k) \
        acc[ai][bj][m][n] = __builtin_amdgcn_mfma_f32_16x16x32_bf16(Bt[n][k], At[m][k], acc[ai][bj][m][n], 0, 0, 0); __builtin_amdgcn_s_setprio(0); } while (0)
#define PG8_WAIT_V(n) asm volatile("s_waitcnt vmcnt(" #n ")" ::: "memory")
#define PG8_WAIT_L(n) asm volatile("s_waitcnt lgkmcnt(" #n ")" ::: "memory")
#define PG8_BAR __builtin_amdgcn_s_barrier()
#define PG8_SCHED __builtin_amdgcn_sched_barrier(0)
    Unit cur, nxt; int ui = 0;
    if (!S.next(0, cur)) return;
    f32x4 acc[2][2][4][2];
#pragma unroll
    for (int a = 0; a < 2; ++a)
#pragma unroll
        for (int b = 0; b < 2; ++b)
#pragma unroll
            for (int m = 0; m < 4; ++m)
#pragma unroll
                for (int n = 0; n < 2; ++n) acc[a][b][m][n] = (f32x4){0.f, 0.f, 0.f, 0.f};
    bf16x8 At[4][2], B0[2][2], B1[2][2];
    v8i_t At8[4], B08[2], B18[2];
    unsigned vAc[2][2], vAn[2][2];
    PG8_AVOFF(cur, vAc);
    if constexpr (Sched::GATHER) { asm volatile("s_waitcnt vmcnt(0)" ::: "memory"); asm volatile("" : "+v"(vAc[0][0]), "+v"(vAc[0][1]), "+v"(vAc[1][0]), "+v"(vAc[1][1])); }
    unsigned cA = S.a_off(g, cur), cB = S.b_off(g, cur);
    PG8_STAGE_B(PG8_SB(0, 0), cB); PG8_STAGE_B(PG8_SB(0, 1), cB + hstep); PG8_STAGE_A(PG8_SA(0, 0), cA, vAc, 0); PG8_STAGE_A(PG8_SA(0, 1), cA, vAc, 1);
    if (wr == 1) PG8_BAR;
    PG8_WAIT_V(2); PG8_BAR;
    PG8_STAGE_B(PG8_SB(1, 0), cB + kstep); PG8_STAGE_A(PG8_SA(1, 0), cA + kstep, vAc, 0); PG8_STAGE_B(PG8_SB(1, 1), cB + hstep + kstep);
    PG8_WAIT_V(6); PG8_BAR;
#pragma nounroll
    for (;;) {
        const bool has_next = S.next(ui + 1, nxt);
        if constexpr (Sched::GATHER) {
            if (has_next) { PG8_AVOFF(nxt, vAn); asm volatile("s_waitcnt vmcnt(0)" ::: "memory"); }
            else {
#pragma unroll
                for (int h = 0; h < 2; ++h)
#pragma unroll
                    for (int i = 0; i < 2; ++i) vAn[h][i] = vAc[h][i]; }
            asm volatile("" : "+v"(vAn[0][0]), "+v"(vAn[0][1]), "+v"(vAn[1][0]), "+v"(vAn[1][1]));
        } else {
#pragma unroll
            for (int h = 0; h < 2; ++h)
#pragma unroll
                for (int i = 0; i < 2; ++i) vAn[h][i] = vAc[h][i];
        }
        const unsigned nA = has_next ? S.a_off(g, nxt) : cA, nB = has_next ? S.b_off(g, nxt) : cB;
#pragma unroll 1
        for (int t = 0; t < nt; t += 2) {
            const bool last = (t == nt - 2);
            const unsigned a1 = cA + (unsigned)(t + 1) * kstep;
            const unsigned a2 = last ? nA : cA + (unsigned)(t + 2) * kstep, b2 = last ? nB : cB + (unsigned)(t + 2) * kstep;
            const unsigned a3 = a2 + kstep, b3 = b2 + kstep;
            unsigned v2[2][2];
#pragma unroll
            for (int h = 0; h < 2; ++h)
#pragma unroll
                for (int i = 0; i < 2; ++i) { if constexpr (Sched::GATHER) v2[h][i] = last ? vAn[h][i] : vAc[h][i]; else v2[h][i] = vAc[h][i]; }
            if constexpr (F8) {
            PG8_LDB8(B08, 0, 0); PG8_LDB8(B18, 0, 1); PG8_SCHED; PG8_LDA8(At8, 0, 0); PG8_STAGE_A(PG8_SA(1, 1), a1, vAc, 1);
            PG8_WAIT_V(8); PG8_WAIT_L(0); PG8_BAR; PG8_MMA8(0, 0, At8, B08); PG8_MMA8(0, 1, At8, B18); PG8_BAR; PG8_SCHED;
            PG8_LDA8(At8, 0, 1); PG8_STAGE_B(PG8_SB(0, 0), b2); PG8_STAGE_B(PG8_SB(0, 1), b2 + hstep); PG8_STAGE_A(PG8_SA(0, 0), a2, v2, 0);
            PG8_WAIT_V(8); PG8_WAIT_L(0); PG8_BAR; PG8_MMA8(1, 0, At8, B08); PG8_MMA8(1, 1, At8, B18); PG8_BAR; PG8_SCHED;
            PG8_LDB8(B08, 1, 0); PG8_LDB8(B18, 1, 1); PG8_SCHED; PG8_LDA8(At8, 1, 0); PG8_STAGE_A(PG8_SA(0, 1), a2, v2, 1);
            PG8_WAIT_V(8); PG8_WAIT_L(0); PG8_BAR; PG8_MMA8(0, 0, At8, B08); PG8_MMA8(0, 1, At8, B18); PG8_BAR; PG8_SCHED;
            PG8_LDA8(At8, 1, 1); PG8_STAGE_B(PG8_SB(1, 0), b3); PG8_STAGE_B(PG8_SB(1, 1), b3 + hstep); PG8_STAGE_A(PG8_SA(1, 0), a3, v2, 0);
            PG8_WAIT_V(8); PG8_WAIT_L(0); PG8_BAR; PG8_MMA8(1, 0, At8, B08); PG8_MMA8(1, 1, At8, B18); PG8_BAR; PG8_SCHED;
            } else {
            PG8_LDB(B0, 0, 0); PG8_LDB(B1, 0, 1); PG8_SCHED; PG8_LDA(At, 0, 0); PG8_STAGE_A(PG8_SA(1, 1), a1, vAc, 1);
            PG8_WAIT_V(8); PG8_WAIT_L(0); PG8_BAR; PG8_MMA(0, 0, At, B0); PG8_MMA(0, 1, At, B1); PG8_BAR; PG8_SCHED;
            PG8_LDA(At, 0, 1); PG8_STAGE_B(PG8_SB(0, 0), b2); PG8_STAGE_B(PG8_SB(0, 1), b2 + hstep); PG8_STAGE_A(PG8_SA(0, 0), a2, v2, 0);
            PG8_WAIT_V(8); PG8_WAIT_L(0); PG8_BAR; PG8_MMA(1, 0, At, B0); PG8_MMA(1, 1, At, B1); PG8_BAR; PG8_SCHED;
            PG8_LDB(B0, 1, 0); PG8_LDB(B1, 1, 1); PG8_SCHED; PG8_LDA(At, 1, 0); PG8_STAGE_A(PG8_SA(0, 1), a2, v2, 1);
            PG8_WAIT_V(8); PG8_WAIT_L(0); PG8_BAR; PG8_MMA(0, 0, At, B0); PG8_MMA(0, 1, At, B1); PG8_BAR; PG8_SCHED;
            PG8_LDA(At, 1, 1); PG8_STAGE_B(PG8_SB(1, 0), b3); PG8_STAGE_B(PG8_SB(1, 1), b3 + hstep); PG8_STAGE_A(PG8_SA(1, 0), a3, v2, 0);
            PG8_WAIT_V(8); PG8_WAIT_L(0); PG8_BAR; PG8_MMA(1, 0, At, B0); PG8_MMA(1, 1, At, B1); PG8_BAR; PG8_SCHED;
            }
        }
        if (wr == 0) PG8_BAR;
        { int t_ = threadIdx.x; asm volatile("" : "+v"(t_)); const int l_ = t_ & 63; E(acc, cur, wr, wc, l_ & 15, l_ >> 4); }
        if (!has_next) break;
#pragma unroll
        for (int a = 0; a < 2; ++a)
#pragma unroll
            for (int b = 0; b < 2; ++b)
#pragma unroll
                for (int m = 0; m < 4; ++m)
#pragma unroll
                    for (int n = 0; n < 2; ++n) acc[a][b][m][n] = (f32x4){0.f, 0.f, 0.f, 0.f};
        cur = nxt; cA = nA; cB = nB; ++ui;
#pragma unroll
        for (int h = 0; h < 2; ++h)
#pragma unroll
            for (int i = 0; i < 2; ++i) vAc[h][i] = vAn[h][i];
        if (wr == 1) PG8_BAR;
    }
    PG8_WAIT_V(0);
    PG8_BAR;
#undef PG8_SA
#undef PG8_SB
#undef PG8_STAGE_A
#undef PG8_STAGE_B
#undef PG8_LDA
#undef PG8_LDB
#undef PG8_MMA
#undef PG8_AVOFF
#undef PG8_MMA8
#undef PG8_LD8
#undef PG8_LDA8
#undef PG8_LDB8
#undef PG8_WAIT_V
#undef PG8_WAIT_L
#undef PG8_BAR
#undef PG8_SCHED
}
}

#ifndef L1IN_F8
#define L1IN_F8 0
#endif
#ifndef DBL_PHASE
#define DBL_PHASE -1
#endif
#ifndef TEST_ATT
#define TEST_ATT 0
#endif
#ifndef TEST_C0
#define TEST_C0 0
#define TEST_NC 2048
#endif
#ifndef TEST_RLO
#define TEST_RLO 0
#define TEST_RHI 256
#endif
#ifndef SB_TRIVIAL
#define SB_TRIVIAL 0
#endif
#ifndef SB_R2PROBE
#define SB_R2PROBE 0
#endif
#ifndef TEST_BADVAL
#define TEST_BADVAL 1e6f
#endif
#ifndef TEST_NANCOUNT
#define TEST_NANCOUNT 0
#endif
#ifndef TEST_GAIN
#define TEST_GAIN 4.0f
#endif
constexpr int SEQ = 16384, DM = 2048, NHEADS = 16, HD = 128, NEXP = 16, DEXP = 1024, NQKV = 6144, NIN0 = 6152;
constexpr float ALPHA = 1.4142135623730951f;
constexpr float LN_EPS = 1e-5f;
constexpr float SCALE128 = 0.08838834764831845f;
constexpr float SCALE64 = 0.125f;
constexpr float LAMBDA_INIT = 0.8f - 0.6f * 0.7408182206817179f;
constexpr int NWAVES = 8, NTHREADS = 512;

constexpr size_t MiB = (size_t)1 << 20;
constexpr size_t WS_CTL = 0, CTL_ZERO_BYTES = 1 * MiB;
constexpr size_t WS_KMEAN = 1 * MiB;
constexpr size_t WS_LOGF = WS_KMEAN + 262144;
constexpr size_t WS_CLOC = WS_LOGF + 524288;
constexpr size_t WS_C = WS_CLOC + 524288;
constexpr size_t WS_CTOT = WS_C + 524288;
constexpr size_t WS_LUT = WS_CTOT + 4096;
constexpr size_t WS_LAM = WS_LUT + 32768;
constexpr size_t WS_MLIST = 4 * MiB;
constexpr size_t WS_MGW = 6 * MiB;
constexpr size_t WS_WIN0 = 8 * MiB, WS_WOUT0 = 32 * MiB, WS_WIN1 = 40 * MiB, WS_WOUT1 = 64 * MiB;
constexpr size_t WS_WGU = 72 * MiB;
constexpr size_t WS_WDN = 328 * MiB;
constexpr size_t WS_XB = 456 * MiB;
constexpr size_t WS_H = 520 * MiB;
constexpr size_t WS_O = 712 * MiB;
constexpr size_t WS_Y = 776 * MiB;
constexpr size_t WS_X1 = 840 * MiB;
constexpr size_t WS_X1F8 = 904 * MiB;
constexpr size_t WS_END = 936 * MiB;
constexpr size_t WS_YSLOT = WS_H;
constexpr size_t WS_HID = WS_O;
constexpr int HID_ROWS = 36864;
constexpr size_t DO_SEL = 0;

constexpr int CW_TMO = 0;
constexpr int CW_BAR = 4096;
constexpr int CW_MOECNT = 8192;
constexpr int CW_MOBACNT = 9216;

constexpr int RING_BYTES = 147456;
constexpr int LCTL_OFF = RING_BYTES;
constexpr int LDS_BYTES = 155648;

#define GAS __attribute__((address_space(1)))
#define LAS __attribute__((address_space(3)))
typedef unsigned short bf16;
typedef unsigned v4u __attribute__((ext_vector_type(4)));
typedef unsigned v2u __attribute__((ext_vector_type(2)));
typedef float f32x4 __attribute__((ext_vector_type(4)));
typedef short bf16x8 __attribute__((ext_vector_type(8)));
typedef GAS unsigned gu32;
#define RLX_AGENT __ATOMIC_RELAXED, __HIP_MEMORY_SCOPE_AGENT
#define LDS_WAIT() asm volatile("s_waitcnt lgkmcnt(0)" ::: "memory")
__device__ __forceinline__ unsigned f2bf(float f) { unsigned u = __builtin_bit_cast(unsigned, f); return (u + 0x7fffu + ((u >> 16) & 1u)) >> 16; }
__device__ __forceinline__ unsigned pk2(float lo, float hi) { return f2bf(lo) | (f2bf(hi) << 16); }
__device__ __forceinline__ unsigned pk4_fp8(float a, float b, float c, float d) { int w = 0; w = __builtin_amdgcn_cvt_pk_fp8_f32(a, b, w, false); w = __builtin_amdgcn_cvt_pk_fp8_f32(c, d, w, true); return (unsigned)w; }
__device__ __forceinline__ float bf2f(unsigned short b) { return __builtin_bit_cast(float, (unsigned)b << 16); }
__device__ __forceinline__ float bflo(unsigned w) { return __builtin_bit_cast(float, w << 16); }
__device__ __forceinline__ float bfhi(unsigned w) { return __builtin_bit_cast(float, w & 0xffff0000u); }
__device__ __forceinline__ int fresh_tid() { int t = threadIdx.x; asm volatile("" : "+v"(t)); return t; }
__device__ __forceinline__ float wave_sum(float v) {
#pragma unroll
    for (int o = 1; o < 64; o <<= 1) v += __shfl_xor(v, o);
    return v;
}
__device__ __forceinline__ float log_sigmoid(float v) { return fminf(v, 0.f) - log1pf(__expf(-fabsf(v))); }

#define XB_TMO      128
#define XB_XCNT(j)  (256  + 64 * (j))
#define XB_XSUB(j)  (1280 + 64 * (j))
#define XB_XGEN(j)  (2304 + 64 * (j))
#define XB_TOP      3328
#define XB_TOPGEN   3392
#define XCD_BAR_WORDS 3456
#define XB_SPIN_CAP (1u << 22)
__device__ __forceinline__ unsigned xb_ld(unsigned* p)              { return __hip_atomic_load(p, __ATOMIC_RELAXED, __HIP_MEMORY_SCOPE_AGENT); }
__device__ __forceinline__ unsigned xb_add(unsigned* p, unsigned v) { return __hip_atomic_fetch_add(p, v, __ATOMIC_RELAXED, __HIP_MEMORY_SCOPE_AGENT); }
__device__ __forceinline__ unsigned xb_xcc_id() { return (unsigned)__builtin_amdgcn_s_getreg((3 << 11) | 20) & 0xFu; }
#define XB_SPIN(cond, bar) do { unsigned _sp = 0; while (cond) { __builtin_amdgcn_s_sleep(1); \
    if ((++_sp & 255u) == 0u) { if (xb_ld(&(bar)[XB_TMO])) break; if (_sp > XB_SPIN_CAP) { atomicAdd(&(bar)[XB_TMO], 1u); break; } } } } while (0)
struct XcdBarrier { unsigned* bar; unsigned x; volatile LAS unsigned* st; };
__device__ __forceinline__ XcdBarrier xcd_barrier_post(unsigned* bar, volatile LAS unsigned* st) {
    XcdBarrier b; b.bar = bar; b.x = xb_xcc_id(); b.st = st;
    if (threadIdx.x == 0) (void)xb_add(&bar[XB_XCNT(b.x)], 1u);
    return b;
}
__device__ __forceinline__ void xcd_barrier_complete(unsigned* bar, unsigned x, unsigned& nloc, unsigned& nx) {
    const unsigned G = gridDim.x * gridDim.y * gridDim.z;
    unsigned sum, cnt, mine, sp = 0u;
    for (;;) {
        sum = 0u; cnt = 0u; mine = 0u;
#pragma unroll
        for (unsigned j = 0; j < 16; ++j) { const unsigned c = xb_ld(&bar[XB_XCNT(j)]); sum += c; cnt += (c > 0u) ? 1u : 0u; mine = (j == x) ? c : mine; }
        if (sum == G) break;
        __builtin_amdgcn_s_sleep(1);
        if ((++sp & 255u) == 0u) { if (xb_ld(&bar[XB_TMO])) break; if (sp > XB_SPIN_CAP) { atomicAdd(&bar[XB_TMO], 1u); break; } }
    }
    nloc = mine > 0u ? mine : 1u; nx = cnt > 0u ? cnt : 1u;
}
__device__ __forceinline__ void xcd_barrier(const XcdBarrier& b) {
    asm volatile("s_waitcnt vmcnt(0)" ::: "memory");
    __syncthreads();
    if (threadIdx.x == 0) {
        unsigned* bar = b.bar;
        __builtin_amdgcn_s_waitcnt(0);
        unsigned nloc = b.st[0], nx = b.st[1];
        if (nloc == 0u) { xcd_barrier_complete(bar, b.x, nloc, nx); b.st[0] = nloc; b.st[1] = nx; }
        const unsigned old = xb_add(&bar[XB_XSUB(b.x)], 1u);
        const unsigned gen = old / nloc;
        if (old + 1u == (gen + 1u) * nloc) {
            __builtin_amdgcn_fence(__ATOMIC_RELEASE, "agent");
            asm volatile("s_waitcnt vmcnt(0)" ::: "memory");
            const unsigned og = xb_add(&bar[XB_TOP], 1u);
            const unsigned tg = og / nx;
            if (og + 1u == (tg + 1u) * nx) xb_add(&bar[XB_TOPGEN], 1u);
            else XB_SPIN(xb_ld(&bar[XB_TOPGEN]) == tg, bar);
            __builtin_amdgcn_fence(__ATOMIC_ACQUIRE, "agent");
            xb_add(&bar[XB_XGEN(b.x)], 1u);
            asm volatile("s_waitcnt vmcnt(0)" ::: "memory");
        } else {
            XB_SPIN(xb_ld(&bar[XB_XGEN(b.x)]) == gen, bar);
            __builtin_amdgcn_fence(__ATOMIC_ACQUIRE, "agent");
            asm volatile("s_waitcnt vmcnt(0)" ::: "memory");
        }
    }
    __syncthreads();
}

struct Args {
    const float* x; const float* w_in_even; const float* w_out_even; const float* forget_bias; const float* w_in_odd; const float* w_out_odd;
    const float* lambda_q; const float* lambda_k; const float* subln_gain; const float* rel_bias; const float* w_router; const float* b_router;
    const float* w_gate; const float* w_up; const float* w_down; const float* ln_gain; const float* ln_bias;
    float* out; unsigned char* ws; int ph_lo, ph_hi;
};

struct P0Item { const float* src; void* dst; int ldw, ldk, dr0, f8; };
__device__ __forceinline__ P0Item p0_decode(const Args& A, unsigned char* ws, int it) {
    constexpr int I_IN = 32 * 192, I_OUT = 32 * 64, I_EXP = 32 * 1024;
    int r = it; const float* W; unsigned char* WT; int ldw, sc0, k0, ldk, dr0, f8 = 0;
    if (r < I_IN) { const int kb = r / 192, nb = r % 192, n0 = nb * 32; W = A.w_in_even; ldw = NIN0; sc0 = n0 + (n0 >= 3072 ? 8 : 0); k0 = kb * 64; WT = ws + WS_WIN0; ldk = DM; dr0 = n0; f8 = 1; }
    else if (r < I_IN + I_OUT) { r -= I_IN; const int kb = r / 64, nb = r % 64; W = A.w_out_even; ldw = DM; sc0 = nb * 32; k0 = kb * 64; WT = ws + WS_WOUT0; ldk = DM; dr0 = nb * 32; f8 = 1; }
    else if (r < 2 * I_IN + I_OUT) { r -= I_IN + I_OUT; const int kb = r / 192, nb = r % 192; W = A.w_in_odd; ldw = NQKV; sc0 = nb * 32; k0 = kb * 64; WT = ws + WS_WIN1; ldk = DM; dr0 = nb * 32; f8 = L1IN_F8; }
    else if (r < 2 * I_IN + 2 * I_OUT) { r -= 2 * I_IN + I_OUT; const int kb = r / 64, nb = r % 64; W = A.w_out_odd; ldw = DM; sc0 = nb * 32; k0 = kb * 64; WT = ws + WS_WOUT1; ldk = DM; dr0 = nb * 32; f8 = 1; }
    else if (r < 2 * I_IN + 2 * I_OUT + 2 * I_EXP) {
        r -= 2 * I_IN + 2 * I_OUT; const int isup = r >= I_EXP; if (isup) r -= I_EXP;
        const int le = r >> 10, q = r & 1023, kb = q >> 5, nb = q & 31, n0 = nb * 32;
        W = (isup ? A.w_up : A.w_gate) + (size_t)le * DM * DEXP; ldw = DEXP; sc0 = n0; k0 = kb * 64; WT = ws + WS_WGU + (size_t)le * 2048 * 2048; ldk = DM; dr0 = (n0 >> 7) * 256 + (n0 & 127) + (isup ? 128 : 0); f8 = 1; }
    else { r -= 2 * I_IN + 2 * I_OUT + 2 * I_EXP; const int le = r >> 10, q = r & 1023, kb = q >> 6, nb = q & 63;
        W = A.w_down + (size_t)le * DEXP * DM; ldw = DM; sc0 = nb * 32; k0 = kb * 64; WT = ws + WS_WDN + (size_t)le * 2048 * 1024; ldk = DEXP; dr0 = nb * 32; f8 = 1; }
    P0Item p; p.src = W + (size_t)k0 * ldw + sc0; p.ldw = ldw; p.ldk = ldk; p.dr0 = dr0; p.f8 = f8;
    p.dst = f8 ? (void*)(WT + k0) : (void*)(WT + (size_t)k0 * 2);
    return p;
}
__device__ __forceinline__ void p0_prologue(const Args& A, LAS unsigned char* lds, int G) {
    const int tid = fresh_tid(), lane = tid & 63, wave = __builtin_amdgcn_readfirstlane(tid >> 6);
    LAS float* scr = (LAS float*)(lds + wave * 16384);
    const int gw = blockIdx.x * NWAVES + wave, NGW = G * NWAVES;
    unsigned char* ws = A.ws;
    constexpr int NITEMS = 2 * 32 * 192 + 2 * 32 * 64 + 3 * 32 * 1024;
    f32x4 v[8];
    const int kk0 = lane >> 3, n4 = (lane & 7) * 4, c = lane & 7;
    int it = gw;
    P0Item cur = p0_decode(A, ws, it < NITEMS ? it : 0);
    if (it < NITEMS) {
#pragma unroll
        for (int i = 0; i < 8; ++i) v[i] = *(const f32x4*)(cur.src + (size_t)(8 * i + kk0) * cur.ldw + n4); }
    for (; it < NITEMS; it += NGW) {
#pragma unroll
        for (int i = 0; i < 8; ++i) *(LAS f32x4*)(scr + (8 * i + kk0) * 36 + n4) = v[i];
        const int nit = it + NGW; const P0Item nxt = p0_decode(A, ws, nit < NITEMS ? nit : 0);
        if (nit < NITEMS) {
#pragma unroll
            for (int i = 0; i < 8; ++i) v[i] = *(const f32x4*)(nxt.src + (size_t)(8 * i + kk0) * nxt.ldw + n4); }
        LDS_WAIT(); asm volatile("" ::: "memory");
#pragma unroll
        for (int j = 0; j < 4; ++j) { const int n = (lane >> 3) + 8 * j; const LAS float* s = scr + (8 * c) * 36 + n;
            if (cur.f8) { v2u o; o.x = pk4_fp8(s[0 * 36] * 32.f, s[1 * 36] * 32.f, s[2 * 36] * 32.f, s[3 * 36] * 32.f); o.y = pk4_fp8(s[4 * 36] * 32.f, s[5 * 36] * 32.f, s[6 * 36] * 32.f, s[7 * 36] * 32.f);
                *(GAS v2u*)((unsigned char*)cur.dst + (size_t)(cur.dr0 + n) * cur.ldk + 8 * c) = o; }
            else { v4u o; o.x = pk2(s[0 * 36], s[1 * 36]); o.y = pk2(s[2 * 36], s[3 * 36]); o.z = pk2(s[4 * 36], s[5 * 36]); o.w = pk2(s[6 * 36], s[7 * 36]);
                *(GAS v4u*)((bf16*)cur.dst + (size_t)(cur.dr0 + n) * cur.ldk + 8 * c) = o; } }
        LDS_WAIT(); asm volatile("" ::: "memory");
        cur = nxt;
    }
    __syncthreads();
    LAS float* wfa = (LAS float*)lds;
    for (int idx = tid; idx < 8 * DM; idx += NTHREADS) { const int d = idx >> 3, j = idx & 7; wfa[j * DM + d] = A.w_in_even[(size_t)d * NIN0 + 3072 + j]; }
    __syncthreads();
    float* logf = (float*)(ws + WS_LOGF); bf16* xb = (bf16*)(ws + WS_XB);
    for (int m = gw; m < SEQ; m += NGW) {
        const GAS f32x4* xr = (const GAS f32x4*)(A.x + (size_t)m * DM) + lane;
        f32x4 v[8];
#pragma unroll
        for (int j = 0; j < 8; ++j) v[j] = xr[64 * j];
        GAS unsigned* o8 = (GAS unsigned*)((unsigned char*)xb + (size_t)m * DM) + lane;
#pragma unroll
        for (int j = 0; j < 8; ++j) o8[64 * j] = pk4_fp8(v[j].x, v[j].y, v[j].z, v[j].w);
        float mine = 0.f;
#pragma unroll 1
        for (int e = 0; e < 8; ++e) { float s = 0.f;
#pragma unroll
            for (int j = 0; j < 8; ++j) { const f32x4 w = *(const LAS f32x4*)(wfa + e * DM + 256 * j + 4 * lane); s += v[j].x * w.x + v[j].y * w.y + v[j].z * w.z + v[j].w * w.w; }
            s = wave_sum(s); mine = (lane == e) ? s : mine; }
        if (lane < 8) logf[lane * SEQ + m] = log_sigmoid(mine + A.forget_bias[lane]);
    }
    {
        float* lut = (float*)(ws + WS_LUT);
        for (int idx = blockIdx.x * NTHREADS + tid; idx < 8 * 1024; idx += G * NTHREADS) { const int hh = idx >> 10, d = idx & 1023;
            int b; if (d < 16) b = d; else { b = 16 + (int)(log((double)d / 16.0) / log(64.0) * 16.0 + 1e-9); b = b > 31 ? 31 : b; }
            lut[idx] = A.rel_bias[b * 8 + hh]; }
        if (tid == 0 && blockIdx.x == 0) { float s0 = 0.f, s1 = 0.f; for (int d = 0; d < 64; ++d) { s0 += A.lambda_q[d] * A.lambda_k[d]; s1 += A.lambda_q[64 + d] * A.lambda_k[64 + d]; }
            ((float*)(ws + WS_LAM))[0] = expf(s0) - expf(s1) + LAMBDA_INIT; }
    }
}

__device__ __forceinline__ void p2_kmean_cumsum(const Args& A, char* lds, int G) {
    const int tid = fresh_tid(), lane = tid & 63, wave = tid >> 6;
    const bf16* h = (const bf16*)(A.ws + WS_H);
    float* red = (float*)lds;
    for (int u = blockIdx.x; u < 1536; u += G) {
        if (u >= 1024) {
            const int v = u - 1024, hd = v >> 6, n = v & 63, c = tid & 15, g = tid >> 4; float mx = 0.f;
            for (int i = 0; i < 8; ++i) { const v4u w = *(const v4u*)(h + (size_t)(n * 256 + g + 32 * i) * NQKV + 1024 + hd * 128 + c * 8);
                float s = bflo(w.x) * bflo(w.x) + bfhi(w.x) * bfhi(w.x) + bflo(w.y) * bflo(w.y) + bfhi(w.y) * bfhi(w.y) + bflo(w.z) * bflo(w.z) + bfhi(w.z) * bfhi(w.z) + bflo(w.w) * bflo(w.w) + bfhi(w.w) * bfhi(w.w);
                s += __shfl_xor(s, 1); s += __shfl_xor(s, 2); s += __shfl_xor(s, 4); s += __shfl_xor(s, 8); mx = fmaxf(mx, s); }
            for (int o = 16; o < 64; o <<= 1) mx = fmaxf(mx, __shfl_xor(mx, o));
            if (lane == 0) atomicMax((unsigned*)(A.ws + WS_CTL) + 10496 + hd, __float_as_uint(mx));
        } else if (u < 512) {
            const int hd = u >> 6, n = u & 63, c = tid & 15, g = tid >> 4;
            float s[8] = {0, 0, 0, 0, 0, 0, 0, 0};
            for (int i = 0; i < 8; ++i) { const v4u w = *(const v4u*)(h + (size_t)(n * 256 + g + 32 * i) * NQKV + 4096 + hd * 128 + c * 8);
                s[0] += bflo(w.x); s[1] += bfhi(w.x); s[2] += bflo(w.y); s[3] += bfhi(w.y); s[4] += bflo(w.z); s[5] += bfhi(w.z); s[6] += bflo(w.w); s[7] += bfhi(w.w); }
            for (int j = 0; j < 8; ++j) red[g * 128 + c * 8 + j] = s[j];
            __syncthreads();
            if (tid < 128) { float t = 0.f; for (int gg = 0; gg < 32; ++gg) t += red[gg * 128 + tid]; ((float*)(A.ws + WS_KMEAN))[(size_t)u * 128 + tid] = t * (1.f / 256.f); }
            __syncthreads();
        } else {
            const int v = u - 512, hd = v >> 6, ch = v & 63;
            const float* lf = (const float*)(A.ws + WS_LOGF) + hd * SEQ + ch * 256;
            float x = (tid < 256) ? lf[tid] : 0.f;
            for (int o = 1; o < 64; o <<= 1) { const float y = __shfl_up(x, o); if (lane >= o) x += y; }
            if (lane == 63 && wave < 4) red[wave] = x;
            __syncthreads();
            if (tid < 256) { float pre = 0.f; for (int w = 0; w < wave; ++w) pre += red[w]; x += pre;
                ((float*)(A.ws + WS_CLOC))[hd * SEQ + ch * 256 + tid] = x;
                if (tid == 255) ((float*)(A.ws + WS_CTOT))[hd * 64 + ch] = x; }
            __syncthreads();
        }
    }
}

__device__ __forceinline__ void p3_gate_cfinal(const Args& A, char* lds, int G, int* sel) {
    const int tid = fresh_tid(), lane = tid & 63, wave = tid >> 6;
    const bf16* h = (const bf16*)(A.ws + WS_H);
    float* km = (float*)lds;
    float* scal = (float*)(lds + 65536); int* lcnt = (int*)(lds + 66560); int* gbs = lcnt + 64;
    for (int u = blockIdx.x; u < 1024; u += G) {
        if (u < 512) {
            const int hd = u >> 6, qb = u & 63;
            const float* kmg = (const float*)(A.ws + WS_KMEAN) + (size_t)hd * 64 * 128;
            for (int i = tid; i < qb * 128; i += NTHREADS) km[i] = kmg[i];
            if (tid < 64) lcnt[tid] = 0;
            __syncthreads();
            const int t = qb * 256 + (tid >> 1), dh = tid & 1;
            float q[64];
            { const bf16* qp = h + (size_t)t * NQKV + 3072 + hd * 128 + dh * 64;
#pragma unroll
              for (int i = 0; i < 8; ++i) { const v4u w = *(const v4u*)(qp + i * 8);
                q[i * 8 + 0] = bflo(w.x); q[i * 8 + 1] = bfhi(w.x); q[i * 8 + 2] = bflo(w.y); q[i * 8 + 3] = bfhi(w.y); q[i * 8 + 4] = bflo(w.z); q[i * 8 + 5] = bfhi(w.z); q[i * 8 + 6] = bflo(w.w); q[i * 8 + 7] = bfhi(w.w); } }
            float v0 = -3e38f, v1 = -3e38f, v2 = -3e38f; int i0 = 0, i1 = 1, i2 = 2;
            for (int n = 0; n < qb; ++n) {
                const float* kr = km + n * 128 + dh * 64; float s = 0.f;
#pragma unroll
                for (int d = 0; d < 64; d += 4) { const f32x4 kv = *(const f32x4*)(kr + d); s += q[d] * kv.x + q[d + 1] * kv.y + q[d + 2] * kv.z + q[d + 3] * kv.w; }
                s += __shfl_xor(s, 1);
                if (s > v0) { v2 = v1; i2 = i1; v1 = v0; i1 = i0; v0 = s; i0 = n; }
                else if (s > v1) { v2 = v1; i2 = i1; v1 = s; i1 = n; }
                else if (s > v2) { v2 = s; i2 = n; }
            }
            const int nsel = qb < 3 ? qb : 3;
            if (dh == 0) *(int4*)(sel + ((size_t)hd * SEQ + t) * 4) = make_int4(i0, i1, i2, nsel);
            int lp0 = 0, lp1 = 0, lp2 = 0;
            if (dh == 0) { if (nsel > 0) lp0 = atomicAdd(&lcnt[i0], 1); if (nsel > 1) lp1 = atomicAdd(&lcnt[i1], 1); if (nsel > 2) lp2 = atomicAdd(&lcnt[i2], 1); }
            __syncthreads();
            if (tid < 64) { const int c = lcnt[tid]; gbs[tid] = c > 0 ? (int)__hip_atomic_fetch_add((unsigned*)(A.ws + WS_CTL) + CW_MOBACNT + hd * 64 + tid, (unsigned)c, RLX_AGENT) : 0; }
            __syncthreads();
            if (dh == 0) { int* ml = (int*)((unsigned char*)A.out + (4u << 20)) + (size_t)hd * 64 * SEQ;
                if (nsel > 0) ml[(size_t)i0 * SEQ + gbs[i0] + lp0] = t * 4 + 0;
                if (nsel > 1) ml[(size_t)i1 * SEQ + gbs[i1] + lp1] = t * 4 + 1;
                if (nsel > 2) ml[(size_t)i2 * SEQ + gbs[i2] + lp2] = t * 4 + 2; }
            __syncthreads();
        } else {
            const int v = u - 512, hd = v >> 6, ch = v & 63;
            if (wave == 0) { float x = (lane < ch) ? ((const float*)(A.ws + WS_CTOT))[hd * 64 + lane] : 0.f; x = wave_sum(x); if (lane == 0) scal[0] = x; }
            __syncthreads();
            if (tid < 256) ((float*)(A.ws + WS_C))[hd * SEQ + ch * 256 + tid] = ((const float*)(A.ws + WS_CLOC))[hd * SEQ + ch * 256 + tid] + scal[0];
            __syncthreads();
        }
    }
}

template <int VAR>
__device__ __forceinline__ void naive_attn_unit(const Args& A, char* lds, int hd, int qblk, const int* sel) {
    const int tid = fresh_tid(), ql = tid >> 2, part = tid & 3;
    const int t0 = qblk * 128, t = t0 + ql;
    float* Ks = (float*)lds; float* Vs = Ks + 64 * 128; float* Cs = Vs + 64 * 128;
    const bf16* h = (const bf16*)(A.ws + WS_H); bf16* ob = (bf16*)(A.ws + WS_O);
    const int second = (VAR == 1 || VAR == 3) ? 1 : 0;
    const int qcol = second * 3072 + hd * 128, kcol = qcol + 1024, vcol = qcol + 2048, ocol = (second * 8 + hd) * 128;
    const float* cg = (const float*)(A.ws + WS_C) + hd * SEQ;
    const float* lut = (const float*)(A.ws + WS_LUT) + hd * 1024;
    float q[32];
    if (VAR != 2) { const bf16* qp = h + (size_t)t * NQKV + qcol + part * 32;
#pragma unroll
        for (int d = 0; d < 32; ++d) q[d] = bf2f(qp[d]); }
    else { const bf16* qp = h + (size_t)t * NQKV + qcol + part * 16;
#pragma unroll
        for (int d = 0; d < 16; ++d) { q[d] = bf2f(qp[d]); q[16 + d] = bf2f(qp[64 + d]); } }
    float o[32], o2[32];
#pragma unroll
    for (int d = 0; d < 32; ++d) { o[d] = 0.f; o2[d] = 0.f; }
    float m1 = -1e30f, l1 = 0.f, m2 = -1e30f, l2 = 0.f, R = 0.f;
    const float ct = (VAR == 0) ? cg[t] : 0.f;
    int s0 = -1, s1 = -1, s2 = -1;
    if (VAR == 1) { const int4 sv = *(const int4*)(sel + ((size_t)hd * SEQ + t) * 4); if (sv.w > 0) s0 = sv.x; if (sv.w > 1) s1 = sv.y; if (sv.w > 2) s2 = sv.z; }
    const int own = t >> 8;
    const int jmax = (t0 + 127) >> 6;
    for (int jj = 0; jj <= jmax; ++jj) {
        const int j = (VAR == 3) ? (jmax - jj) : jj;
        __syncthreads();
        for (int idx = tid; idx < 1024; idx += NTHREADS) { const int row = idx >> 4, c8 = (idx & 15) * 8;
            const v4u kw = *(const v4u*)(h + (size_t)(j * 64 + row) * NQKV + kcol + c8); const v4u vw = *(const v4u*)(h + (size_t)(j * 64 + row) * NQKV + vcol + c8);
            float* kd = Ks + row * 128 + c8; float* vd = Vs + row * 128 + c8;
            kd[0] = bflo(kw.x); kd[1] = bfhi(kw.x); kd[2] = bflo(kw.y); kd[3] = bfhi(kw.y); kd[4] = bflo(kw.z); kd[5] = bfhi(kw.z); kd[6] = bflo(kw.w); kd[7] = bfhi(kw.w);
            vd[0] = bflo(vw.x); vd[1] = bfhi(vw.x); vd[2] = bflo(vw.y); vd[3] = bfhi(vw.y); vd[4] = bflo(vw.z); vd[5] = bfhi(vw.z); vd[6] = bflo(vw.w); vd[7] = bfhi(vw.w); }
        if (VAR == 0 && tid < 64) Cs[tid] = cg[j * 64 + tid];
        __syncthreads();
        for (int ss = 0; ss < 64; ++ss) {
            const int s = (VAR == 3) ? (63 - ss) : ss; const int ks = j * 64 + s;
            float d1 = 0.f, d2 = 0.f;
            if (VAR != 2) { const float* kr = Ks + s * 128 + part * 32;
#pragma unroll
                for (int d = 0; d < 32; d += 4) { const f32x4 kv = *(const f32x4*)(kr + d); d1 += q[d] * kv.x + q[d + 1] * kv.y + q[d + 2] * kv.z + q[d + 3] * kv.w; } }
            else { const float* kr = Ks + s * 128 + part * 16;
#pragma unroll
                for (int d = 0; d < 16; d += 4) { const f32x4 ka = *(const f32x4*)(kr + d); const f32x4 kb = *(const f32x4*)(kr + 64 + d);
                    d1 += q[d] * ka.x + q[d + 1] * ka.y + q[d + 2] * ka.z + q[d + 3] * ka.w; d2 += q[16 + d] * kb.x + q[17 + d] * kb.y + q[18 + d] * kb.z + q[19 + d] * kb.w; } }
            d1 += __shfl_xor(d1, 1); d1 += __shfl_xor(d1, 2);
            if (VAR == 2) { d2 += __shfl_xor(d2, 1); d2 += __shfl_xor(d2, 2); }
            const float* vr = Vs + s * 128 + part * 32;
            if (VAR == 0 || VAR == 1) {
                bool valid; float sc;
                if (VAR == 0) { valid = ks <= t; sc = d1 * SCALE128 + (ct - Cs[s]); }
                else { const int nb = ks >> 8; valid = (nb == own && ks <= t) || nb == s0 || nb == s1 || nb == s2; const int dist = t - ks; sc = d1 * SCALE128 + lut[dist < 0 ? 0 : (dist > 1023 ? 1023 : dist)]; }
                if (valid) { const float mn = fmaxf(m1, sc), al = __expf(m1 - mn), p = __expf(sc - mn); l1 = l1 * al + p; m1 = mn;
#pragma unroll
                    for (int d = 0; d < 32; ++d) o[d] = o[d] * al + p * vr[d]; }
            } else if (VAR == 2) {
                if (ks <= t) { const float bias = lut[(t - ks) > 1023 ? 1023 : (t - ks)];
                    const float sa = d1 * SCALE64 + bias, sb = d2 * SCALE64 + bias;
                    const float mna = fmaxf(m1, sa), ala = __expf(m1 - mna), pa = __expf(sa - mna); l1 = l1 * ala + pa; m1 = mna;
                    const float mnb = fmaxf(m2, sb), alb = __expf(m2 - mnb), pb = __expf(sb - mnb); l2 = l2 * alb + pb; m2 = mnb;
#pragma unroll
                    for (int d = 0; d < 32; ++d) { const float vv = vr[d]; o[d] = o[d] * ala + pa * vv; o2[d] = o2[d] * alb + pb * vv; } }
            } else {
                if (ks < t) { const float z = d1 * SCALE128; float a = __expf(log_sigmoid(z) + R); R += log_sigmoid(-z);
#if SB_TRIVIAL
                    a = 0.015625f;
#endif

#pragma unroll
                    for (int d = 0; d < 32; ++d) o[d] += a * vr[d]; }
            }
        }
    }
    if (VAR == 0 || VAR == 1) { const float il = 1.f / l1;
#pragma unroll
        for (int d = 0; d < 32; ++d) o[d] *= il; }
    if (VAR == 2) { const float lam = ((const float*)(A.ws + WS_LAM))[0]; const float i1 = 1.f / l1, i2 = lam / l2; float ss = 0.f;
#pragma unroll
        for (int d = 0; d < 32; ++d) { o[d] = o[d] * i1 - o2[d] * i2; ss += o[d] * o[d]; }
        ss += __shfl_xor(ss, 1); ss += __shfl_xor(ss, 2);
        const float r = rsqrtf(ss * (1.f / 128.f) + LN_EPS) * (1.f - LAMBDA_INIT);
#pragma unroll
        for (int d = 0; d < 32; ++d) o[d] = o[d] * r * A.subln_gain[part * 32 + d]; }
    bf16* op = ob + (size_t)t * DM + ocol + part * 32;
#pragma unroll
    for (int d = 0; d < 32; d += 2) *(unsigned*)(op + d) = pk2(o[d], o[d + 1]);
}

#ifndef SB_R2PROBE
#define SB_R2PROBE 0
#endif
#ifndef FOX_CH
#define FOX_CH 16
#endif
#ifndef SB_NOCHUNK
#define SB_NOCHUNK 0
#endif
#ifndef SB_TRIVIAL
#define SB_TRIVIAL 0
#endif
namespace att {
typedef float f32x16 __attribute__((ext_vector_type(16)));
typedef short s16x4 __attribute__((ext_vector_type(4)));
constexpr int PITCH = NQKV;
constexpr int SHM_V = 16384, SHM_K = 16384;
constexpr int L_V = 0, L_K = 2 * SHM_V, L_WS = L_K + 2 * SHM_K, L_KB = L_WS + NWAVES * 64 * 4, L_FLAG = L_KB + 512, L_LUT = L_FLAG + 512, LUT_PAD = 320, LUT_N = LUT_PAD + 1024,
              L_STASH = L_LUT + LUT_N * 4 + 256, L_END = L_STASH + 65536;
static_assert(L_STASH % 16 == 0 && L_END <= RING_BYTES, "attention LDS map");
constexpr float THR = 8.f;
#define KSWZ(row, colB) ((row) * 256 + ((colB) ^ (((row) & 7) << 4)))
#define SBAR() __builtin_amdgcn_sched_barrier(0)
__device__ __forceinline__ int v_st(int k, int c) { const int kk = (k & ~0xC) | ((k & 4) << 1) | ((k & 8) >> 1); return ((kk >> 3) * 4 + (c >> 5)) * 512 + ((kk & 7) * 32 + (c & 31)) * 2; }
__device__ __forceinline__ int v_rd_base(int lane) { return ((lane & 3) << 3) | (((lane >> 2) & 3) << 6) | (((lane >> 4) & 1) << 5) | (((lane >> 5) & 1) << 8); }
constexpr int v_rd_off(int d0, int ks, int half) { return d0 * 512 + ks * 4096 + half * 2048; }
__device__ __forceinline__ int crow(int r, int hi) { return (r & 3) + 8 * (r >> 2) + 4 * hi; }
typedef __bf16 bf16x2_t __attribute__((ext_vector_type(2)));
typedef float f32x2_t __attribute__((ext_vector_type(2)));
__device__ __forceinline__ unsigned cvtpk(float lo, float hi) { f32x2_t v = {lo, hi}; bf16x2_t b = __builtin_convertvector(v, bf16x2_t); return __builtin_bit_cast(unsigned, b); }

template <int DQ> __device__ __forceinline__ void partialSM(f32x16& p0, f32x16& p1, float& m_reg, float& mn, float& alpha) {
    constexpr float SC = (DQ == 128) ? SCALE128 : SCALE64; constexpr float C2 = 1.4426950408889634f * SC;
    float pmax = p0[0]; for (int r = 1; r < 16; ++r) pmax = fmaxf(pmax, p0[r]); for (int r = 0; r < 16; ++r) pmax = fmaxf(pmax, p1[r]);
    { auto rr = __builtin_amdgcn_permlane32_swap(__float_as_uint(pmax), __float_as_uint(pmax), false, false);
      pmax = fmaxf(__uint_as_float(rr[0]), __uint_as_float(rr[1])); }
    if (__builtin_expect(__all((pmax - m_reg) * SC <= THR), 1)) { mn = m_reg; alpha = 1.f; }
    else { mn = fmaxf(m_reg, pmax); alpha = __builtin_amdgcn_exp2f((m_reg - mn) * C2); m_reg = mn; }
    const float mnL = -mn * C2;
    for (int r = 0; r < 16; ++r) p0[r] = fmaf(p0[r], C2, mnL); for (int r = 0; r < 16; ++r) p1[r] = fmaf(p1[r], C2, mnL);
    for (int r = 0; r < 16; ++r) p0[r] = __builtin_amdgcn_exp2f(p0[r]);
}
#define PK4(P, B_, OUT) do { unsigned a0 = cvtpk(P[B_+0], P[B_+1]), a1 = cvtpk(P[B_+2], P[B_+3]);                          \
        unsigned b0 = cvtpk(P[B_+4], P[B_+5]), b1 = cvtpk(P[B_+6], P[B_+7]);                                             \
        auto r0 = __builtin_amdgcn_permlane32_swap(a0, b0, false, false); auto r1 = __builtin_amdgcn_permlane32_swap(a1, b1, false, false); \
        pg8::u32x4 w = {r0[0], r1[0], r0[1], r1[1]}; OUT = *reinterpret_cast<bf16x8*>(&w); } while (0)
__device__ __forceinline__ void finishSM(f32x16& p0, f32x16& p1, float alpha, float& l_reg, bf16x8& pa0, bf16x8& pa1, bf16x8& pa2, bf16x8& pa3) {
    for (int r = 0; r < 16; ++r) p1[r] = __builtin_amdgcn_exp2f(p1[r]);
    float ps = 0; for (int r = 0; r < 16; ++r) ps += p0[r]; for (int r = 0; r < 16; ++r) ps += p1[r];
    { auto rr = __builtin_amdgcn_permlane32_swap(__float_as_uint(ps), __float_as_uint(ps), false, false);
      ps = __uint_as_float(rr[0]) + __uint_as_float(rr[1]); }
    l_reg = l_reg * alpha + ps;
    PK4(p0, 0, pa0); PK4(p0, 8, pa1); PK4(p1, 0, pa2); PK4(p1, 8, pa3);
}
__device__ __forceinline__ void sb_half(f32x16& p, float& R2, int hi) {
#if SB_TRIVIAL
#pragma unroll
    for (int r = 0; r < 16; ++r) p[r] = (p[r] < -1e37f) ? 0.f : 0.015625f;
    return;
#endif
    constexpr float C2 = 1.4426950408889634f * SCALE128;
    float T = R2;
#pragma unroll
    for (int g = 3; g >= 0; --g) { float z[4], lr[4];
#pragma unroll
        for (int e = 0; e < 4; ++e) { z[e] = p[4 * g + e] * C2; lr[e] = -(fmaxf(z[e], 0.f) + __builtin_amdgcn_logf(1.f + __builtin_amdgcn_exp2f(-fabsf(z[e])))); }
        const float G = (lr[0] + lr[1]) + (lr[2] + lr[3]);
        auto rr = __builtin_amdgcn_permlane32_swap(__float_as_uint(G), __float_as_uint(G), false, false);
        const float Go = hi ? __uint_as_float(rr[0]) : __uint_as_float(rr[1]);
        float a = T + (hi ? 0.f : Go);
        p[4 * g + 3] = __builtin_amdgcn_exp2f(z[3] + lr[3] + a); a += lr[3];
        p[4 * g + 2] = __builtin_amdgcn_exp2f(z[2] + lr[2] + a); a += lr[2];
        p[4 * g + 1] = __builtin_amdgcn_exp2f(z[1] + lr[1] + a); a += lr[1];
        p[4 * g + 0] = __builtin_amdgcn_exp2f(z[0] + lr[0] + a);
        T += G + Go; }
    R2 = T;
}
__device__ __forceinline__ void sb_pack(f32x16& p0, f32x16& p1, bf16x8& pa0, bf16x8& pa1, bf16x8& pa2, bf16x8& pa3) { PK4(p0, 0, pa0); PK4(p0, 8, pa1); PK4(p1, 0, pa2); PK4(p1, 8, pa3); }
#undef PK4

template <int KB, int DQ>
__device__ __forceinline__ void qkt(f32x16& p0, f32x16& p1, const LAS char* K_lds, int r32, int hi, const bf16x8* qr) {
    p0 = f32x16{}; p1 = f32x16{};
    const LAS char* kb[4];
    { int t_ = threadIdx.x; asm volatile("" : "+v"(t_)); r32 = t_ & 31; hi = (t_ >> 5) & 1; }
#pragma unroll
    for (int dd = 0; dd < 4; ++dd) kb[dd] = K_lds + KB * SHM_K + KSWZ(r32, (dd * 16 + hi * 8) * 2);
#pragma unroll
    for (int d0 = 0; d0 < DQ / 16; ++d0) { const LAS char* a = kb[d0 & 3] + (d0 >> 2) * 128;
        bf16x8 b0 = *reinterpret_cast<const LAS bf16x8*>(a);
        bf16x8 b1 = *reinterpret_cast<const LAS bf16x8*>(a + 32 * 256);
        p0 = __builtin_amdgcn_mfma_f32_32x32x16_bf16(b0, qr[d0], p0, 0, 0, 0);
        p1 = __builtin_amdgcn_mfma_f32_32x32x16_bf16(b1, qr[d0], p1, 0, 0, 0); }
}
template <int VB>
__device__ __forceinline__ void pv_tile2(f32x16* o, int vb0, bf16x8 pa0, bf16x8 pa1, bf16x8 pa2, bf16x8 pa3) {
#define TRRD(dst, off) asm volatile("ds_read_b64_tr_b16 %0, %1 offset:%2" : "=&v"(dst) : "v"(vb0), "i"(off) : "memory")
#define PV_RD(d0, P) constexpr int b##P = VB * SHM_V + v_rd_off(d0, 0, 0); s16x4 l0##P, l1##P, l2##P, l3##P, h0##P, h1##P, h2##P, h3##P; \
        TRRD(l0##P, b##P); TRRD(h0##P, b##P + 2048); TRRD(l1##P, b##P + 4096); TRRD(h1##P, b##P + 6144); TRRD(l2##P, b##P + 8192); TRRD(h2##P, b##P + 10240); TRRD(l3##P, b##P + 12288); TRRD(h3##P, b##P + 14336)
#define PV_MM(d0, P) do { \
        o[d0] = __builtin_amdgcn_mfma_f32_32x32x16_bf16(pa0, (bf16x8){l0##P[0], l0##P[1], l0##P[2], l0##P[3], h0##P[0], h0##P[1], h0##P[2], h0##P[3]}, o[d0], 0, 0, 0);   \
        o[d0] = __builtin_amdgcn_mfma_f32_32x32x16_bf16(pa1, (bf16x8){l1##P[0], l1##P[1], l1##P[2], l1##P[3], h1##P[0], h1##P[1], h1##P[2], h1##P[3]}, o[d0], 0, 0, 0);   \
        o[d0] = __builtin_amdgcn_mfma_f32_32x32x16_bf16(pa2, (bf16x8){l2##P[0], l2##P[1], l2##P[2], l2##P[3], h2##P[0], h2##P[1], h2##P[2], h2##P[3]}, o[d0], 0, 0, 0);   \
        o[d0] = __builtin_amdgcn_mfma_f32_32x32x16_bf16(pa3, (bf16x8){l3##P[0], l3##P[1], l3##P[2], l3##P[3], h3##P[0], h3##P[1], h3##P[2], h3##P[3]}, o[d0], 0, 0, 0); } while (0)
#define PV_WAIT() asm volatile("s_waitcnt lgkmcnt(0)" : "+v"(l0A), "+v"(l1A), "+v"(l2A), "+v"(l3A), "+v"(h0A), "+v"(h1A), "+v"(h2A), "+v"(h3A), \
        "+v"(l0B), "+v"(l1B), "+v"(l2B), "+v"(l3B), "+v"(h0B), "+v"(h1B), "+v"(h2B), "+v"(h3B) :: "memory")
    { PV_RD(0, A); PV_RD(1, B); PV_WAIT(); SBAR(); PV_MM(0, A); PV_MM(1, B); SBAR(); }
    { PV_RD(2, A); PV_RD(3, B); PV_WAIT(); SBAR(); PV_MM(2, A); PV_MM(3, B); }
#undef PV_WAIT
#undef PV_RD
#undef PV_MM
#undef TRRD
}
template <int VB>
__device__ __forceinline__ void pv_tile(f32x16* o, int vb0, bf16x8 pa0, bf16x8 pa1, bf16x8 pa2, bf16x8 pa3) {
#define TRRD(dst, off) asm volatile("ds_read_b64_tr_b16 %0, %1 offset:%2" : "=&v"(dst) : "v"(vb0), "i"(off) : "memory")
#define PV_D0(d0) do { s16x4 l0, l1, l2, l3, h0, h1, h2, h3; constexpr int b_ = VB * SHM_V + v_rd_off(d0, 0, 0); \
        TRRD(l0, b_); TRRD(h0, b_ + 2048); TRRD(l1, b_ + 4096); TRRD(h1, b_ + 6144); TRRD(l2, b_ + 8192); TRRD(h2, b_ + 10240); TRRD(l3, b_ + 12288); TRRD(h3, b_ + 14336); \
        asm volatile("s_waitcnt lgkmcnt(0)" : "+v"(l0), "+v"(l1), "+v"(l2), "+v"(l3), "+v"(h0), "+v"(h1), "+v"(h2), "+v"(h3) :: "memory"); SBAR();     \
        o[d0] = __builtin_amdgcn_mfma_f32_32x32x16_bf16(pa0, (bf16x8){l0[0], l0[1], l0[2], l0[3], h0[0], h0[1], h0[2], h0[3]}, o[d0], 0, 0, 0);   \
        o[d0] = __builtin_amdgcn_mfma_f32_32x32x16_bf16(pa1, (bf16x8){l1[0], l1[1], l1[2], l1[3], h1[0], h1[1], h1[2], h1[3]}, o[d0], 0, 0, 0);   \
        o[d0] = __builtin_amdgcn_mfma_f32_32x32x16_bf16(pa2, (bf16x8){l2[0], l2[1], l2[2], l2[3], h2[0], h2[1], h2[2], h2[3]}, o[d0], 0, 0, 0);   \
        o[d0] = __builtin_amdgcn_mfma_f32_32x32x16_bf16(pa3, (bf16x8){l3[0], l3[1], l3[2], l3[3], h3[0], h3[1], h3[2], h3[3]}, o[d0], 0, 0, 0); } while (0)
    PV_D0(0); PV_D0(1); PV_D0(2); PV_D0(3);
#undef PV_D0
#undef TRRD
}

struct ChunkArgs {
    const bf16* hbase; unsigned kcolB, vcolB;
    int ja, jb;
    int qpos;
    int qlo;
    const float* cb; float cref;
};
template <int DQ, int MODE, bool REV>
__device__ __forceinline__ void attn_chunk(const ChunkArgs& a, const bf16x8* qr, float& m_reg, float& l_reg, f32x16* o, LAS char* lds) {
    int tid_ = threadIdx.x; asm volatile("" : "+v"(tid_)); const int tid = tid_, wid = __builtin_amdgcn_readfirstlane(tid >> 6), lane = tid & 63, r32 = lane & 31, hi = lane >> 5;
    const int NT = a.jb - a.ja;
    LAS char* V_lds = lds + L_V; LAS char* K_lds = lds + L_K;
    LAS float* ws = (LAS float*)(lds + L_WS) + wid * 64; LAS float* al_l = ws + 32;
    LAS float* kbl = (LAS float*)(lds + L_KB); const LAS float* lutl = (const LAS float*)(lds + L_LUT);
    const int vb0 = (int)(uintptr_t)V_lds + v_rd_base(lane);
    const __amdgpu_buffer_rsrc_t hrs = __builtin_amdgcn_make_buffer_rsrc((void*)a.hbase, 0, (int)((size_t)SEQ * PITCH * 2), 0x00020000);
#define FRESH_TID(t_) int t_ = threadIdx.x; asm volatile("" : "+v"(t_))
    const int qlo = a.qlo;
    bf16x8 st_v0, st_v1, st_k0, st_k1; float st_c = 0.f;
#define KBASE(t) ((REV ? (a.jb - 1 - (t)) : (a.ja + (t))) * 64)
#define VMW() asm volatile("s_waitcnt vmcnt(0)" ::: "memory")
#define SLOAD(k0) do { FRESH_TID(t_); const int sr = t_ >> 4, sc = (t_ & 15) * 8; const unsigned so_ = (unsigned)(k0) * (unsigned)(PITCH * 2); \
        const unsigned vo0 = (unsigned)(sr * PITCH + sc) * 2u, vo1 = vo0 + (unsigned)(32 * PITCH * 2); \
        st_v0 = __builtin_bit_cast(bf16x8, __builtin_amdgcn_raw_buffer_load_b128(hrs, vo0, so_ + a.vcolB, 0)); st_v1 = __builtin_bit_cast(bf16x8, __builtin_amdgcn_raw_buffer_load_b128(hrs, vo1, so_ + a.vcolB, 0)); \
        if constexpr (DQ == 128) { st_k0 = __builtin_bit_cast(bf16x8, __builtin_amdgcn_raw_buffer_load_b128(hrs, vo0, so_ + a.kcolB, 0)); st_k1 = __builtin_bit_cast(bf16x8, __builtin_amdgcn_raw_buffer_load_b128(hrs, vo1, so_ + a.kcolB, 0)); } \
        else { const unsigned vk0 = (unsigned)((t_ >> 3) * PITCH + (t_ & 7) * 8) * 2u; st_k0 = __builtin_bit_cast(bf16x8, __builtin_amdgcn_raw_buffer_load_b128(hrs, vk0, so_ + a.kcolB, 0)); } \
        if constexpr (MODE == 0) { if (t_ < 64) st_c = (a.cref - a.cb[(k0) + t_]) * (1.f / SCALE128); } } while (0)
#define SWRITE_K(bf) do { FRESH_TID(t_); if constexpr (DQ == 128) { const int sr = t_ >> 4, sc = (t_ & 15) * 8, kws = KSWZ(sr, sc * 2); *(LAS bf16x8*)(K_lds + (bf) * SHM_K + kws) = st_k0; *(LAS bf16x8*)(K_lds + (bf) * SHM_K + kws + 32 * 256) = st_k1; } \
        else { const int sr2 = t_ >> 3, sc2 = (t_ & 7) * 8, kws2 = KSWZ(sr2, sc2 * 2); *(LAS bf16x8*)(K_lds + (bf) * SHM_K + kws2) = st_k0; } \
        if constexpr (MODE == 0) { if (t_ < 64) kbl[(bf) * 64 + t_] = st_c; } } while (0)
#define SWRITE_V(bf) do { FRESH_TID(t_); const int sr = t_ >> 4, sc = (t_ & 15) * 8, vst0 = v_st(sr, sc), vst1 = v_st(32 + sr, sc); *(LAS bf16x8*)(V_lds + (bf) * SHM_V + vst0) = st_v0; *(LAS bf16x8*)(V_lds + (bf) * SHM_V + vst1) = st_v1; } while (0)
#define SWRITE(bf) do { SWRITE_V(bf); SWRITE_K(bf); } while (0)
#define SCORES(P0_, P1_, t, BF) do { const int kb_ = KBASE(t); int dq; { FRESH_TID(t_); const int r32_ = t_ & 31, hi_ = (t_ >> 5) & 1; dq = ((MODE == 2) ? a.qpos : (qlo + r32_)) - 4 * hi_ - kb_; } \
        if constexpr (MODE == 0) { \
            _Pragma("unroll") for (int g = 0; g < 4; ++g) { const f32x4 b0 = *(const LAS f32x4*)(kbl + (BF) * 64 + 8 * g + 4 * hi), b1 = *(const LAS f32x4*)(kbl + (BF) * 64 + 32 + 8 * g + 4 * hi); \
                _Pragma("unroll") for (int e = 0; e < 4; ++e) { P0_[4 * g + e] += b0[e]; P1_[4 * g + e] += b1[e]; } asm volatile("" ::: "memory"); } } \
        if constexpr (MODE == 1) { if (qlo - (kb_ + 63) < 790) { const LAS float* lp = lutl + (dq + LUT_PAD - 59); \
            _Pragma("unroll") for (int r = 0; r < 16; ++r) { const int c = (r & 3) + 8 * (r >> 2); P0_[r] += lp[59 - c]; P1_[r] += lp[27 - c]; } } } \
        if constexpr (MODE == 2) { \
            _Pragma("unroll") for (int r = 0; r < 16; ++r) { const int c = (r & 3) + 8 * (r >> 2); int d0_ = dq - c, d1_ = dq - c - 32; d0_ = d0_ > 1023 ? 1023 : d0_; d1_ = d1_ > 1023 ? 1023 : d1_; \
                P0_[r] += lutl[d0_ + LUT_PAD]; P1_[r] += lutl[d1_ + LUT_PAD]; } } \
        if (MODE == 2 || kb_ + 63 >= qlo) { const float NEG = (MODE == 3) ? -3.0e4f : -__builtin_inff(); constexpr int ST = (MODE == 3) ? 1 : 0; \
            _Pragma("unroll") for (int r = 0; r < 16; ++r) { const int c = (r & 3) + 8 * (r >> 2); if (dq - c < ST) P0_[r] = NEG; if (dq - c - 32 < ST) P1_[r] = NEG; } } } while (0)
#define RESC(al) do { if (__any((al) < 1.f)) { if (hi == 0) al_l[r32] = (al); asm volatile("s_waitcnt lgkmcnt(0)" ::: "memory"); \
                     for (int d_ = 0; d_ < 4; ++d_) for (int r = 0; r < 16; ++r) o[d_][r] *= al_l[crow(r, hi)]; } } while (0)
#define PARTIAL(P0_, P1_, mnX, alX) do { if constexpr (MODE == 3) { sb_half(P1_, m_reg, hi); } else { partialSM<DQ>(P0_, P1_, m_reg, mnX, alX); } } while (0)
#define FINISH(P0_, P1_, alY) do { if constexpr (MODE == 3) { sb_half(P0_, m_reg, hi); sb_pack(P0_, P1_, pa0, pa1, pa2, pa3); } else { finishSM(P0_, P1_, alY, l_reg, pa0, pa1, pa2, pa3); } } while (0)
#define RESCALE(al) do { if constexpr (MODE != 3) { RESC(al); } } while (0)
    f32x16 pA0, pA1, pB0, pB1; float mnA = 0.f, mnB = 0.f, alA = 1.f, alB = 1.f; bf16x8 pa0, pa1, pa2, pa3;
    SLOAD(KBASE(0)); VMW(); SWRITE_K(0);
    __syncthreads();
    SWRITE_V(0); SBAR();
    if (NT > 1) SLOAD(KBASE(1));
    SBAR(); qkt<0, DQ>(pA0, pA1, K_lds, r32, hi, qr);
    SCORES(pA0, pA1, 0, 0); PARTIAL(pA0, pA1, mnA, alA);
    if (NT > 1) { VMW(); SWRITE(1); }
    __syncthreads();
#define HALF_STEP(PX0, PX1, mnX, alX, PY0, PY1, alY, t, KB, VB, SB) do {                                 \
        SBAR(); qkt<KB, DQ>(PX0, PX1, K_lds, r32, hi, qr);                                                \
        FINISH(PY0, PY1, alY); SBAR();                                                                    \
        if ((t) + 1 < NT) { SLOAD(KBASE((t) + 1)); SBAR(); }                                              \
        pv_tile<VB>(o, vb0, pa0, pa1, pa2, pa3); SCORES(PX0, PX1, (t), KB); PARTIAL(PX0, PX1, mnX, alX);   \
        __syncthreads();                                                                                  \
        if ((t) + 1 < NT) { VMW(); SWRITE(SB); }                                                          \
        RESCALE(alX); __syncthreads(); } while (0)
    for (int t = 1; t + 1 < NT; t += 2) {
        HALF_STEP(pB0, pB1, mnB, alB, pA0, pA1, alA, t, 1, 0, 0);
        HALF_STEP(pA0, pA1, mnA, alA, pB0, pB1, alB, t + 1, 0, 1, 1);
    }
    const bool even = (NT & 1) == 0;
    if (even) { SBAR(); qkt<1, DQ>(pB0, pB1, K_lds, r32, hi, qr); SBAR(); }
    FINISH(pA0, pA1, alA); SBAR();
    pv_tile<0>(o, vb0, pa0, pa1, pa2, pa3);
    if (even) { SCORES(pB0, pB1, NT - 1, 1); PARTIAL(pB0, pB1, mnB, alB); __syncthreads(); RESCALE(alB);
        FINISH(pB0, pB1, alB); SBAR(); pv_tile<1>(o, vb0, pa0, pa1, pa2, pa3); }
    __syncthreads();
#undef KBASE
#undef VMW
#undef SLOAD
#undef FRESH_TID
#undef SWRITE_K
#undef SWRITE_V
#undef SWRITE
#undef SCORES
#undef RESC
#undef PARTIAL
#undef FINISH
#undef RESCALE
#undef HALF_STEP
}

template <int DQ> __device__ __forceinline__ void load_q(bf16x8* qr, const bf16* qrow, int hi) {
#pragma unroll
    for (int d0 = 0; d0 < DQ / 16; ++d0) qr[d0] = *(const bf16x8*)(qrow + d0 * 16 + hi * 8);
}
__device__ __forceinline__ void load_lut(LAS char* lds, const float* lutg, float inv_scale) {
    LAS float* l = (LAS float*)(lds + L_LUT); const float far = lutg[1023];
    for (int i = threadIdx.x; i < LUT_N; i += NTHREADS) l[i] = (i < LUT_PAD) ? 0.f : (lutg[i - LUT_PAD] - far) * inv_scale;
}
template <int CTRL> __device__ __forceinline__ float quad_bcast(float v) { return __builtin_bit_cast(float, __builtin_amdgcn_mov_dpp(__builtin_bit_cast(int, v), CTRL, 0xf, 0xf, true)); }
constexpr float O8_SCALE = 16.f;
__device__ __forceinline__ void store_o(const f32x16* o, const float* rl  , unsigned char* obase, int ldo, int r32, int hi) {
#pragma unroll
    for (int r = 0; r < 16; ++r) { const int orow = crow(r, hi);
#pragma unroll
        for (int d0 = 0; d0 < 4; ++d0) { const float v = o[d0][r] * rl[r] * O8_SCALE; const float v1 = quad_bcast<0x55>(v), v2 = quad_bcast<0xAA>(v), v3 = quad_bcast<0xFF>(v);
            if ((r32 & 3) == 0) *(unsigned*)(obase + (size_t)orow * ldo + d0 * 32 + r32) = pk4_fp8(v, v1, v2, v3); } }
}
}

__device__ __forceinline__ void fox_epilogue(const att::f32x16* o, float l_reg, LAS char* lds, unsigned char* oblk, int ldo) {
    int t_ = threadIdx.x; asm volatile("" : "+v"(t_)); const int wid = __builtin_amdgcn_readfirstlane(t_ >> 6), r32 = t_ & 31, hi = (t_ >> 5) & 1;
    LAS float* li_l = (LAS float*)(lds + att::L_WS) + wid * 64;
    if (hi == 0) li_l[r32] = l_reg; asm volatile("s_waitcnt lgkmcnt(0)" ::: "memory");
    float rli[16];
#pragma unroll
    for (int r = 0; r < 16; ++r) rli[r] = __builtin_amdgcn_rcpf(li_l[att::crow(r, hi)]);
    att::store_o(o, rli, oblk + (size_t)(wid * 32) * ldo, ldo, r32, hi);
    __syncthreads();
}
constexpr int CW_KMAX = 10496;
__device__ __forceinline__ void fox_block(const Args& A, LAS char* lds, int hd, int qb, unsigned char* obuf, int ldo, int ocol) {
    int tid_ = threadIdx.x; asm volatile("" : "+v"(tid_)); const int tid = tid_, wid = __builtin_amdgcn_readfirstlane(tid >> 6), lane = tid & 63, r32 = lane & 31, hi = lane >> 5;
    const bf16* h = (const bf16*)(A.ws + WS_H); const int P0 = qb * 256;
    const float* cg = (const float*)(A.ws + WS_C) + hd * SEQ;
    bf16x8 qr[8]; att::load_q<128>(qr, h + (size_t)(P0 + wid * 32 + r32) * NQKV + hd * 128, hi);
    att::ChunkArgs ca; ca.hbase = h; ca.kcolB = (unsigned)(1024 + hd * 128) * 2u; ca.vcolB = (unsigned)(2048 + hd * 128) * 2u;
    ca.qpos = P0 + wid * 32 + r32; ca.qlo = P0 + wid * 32; ca.cb = cg; ca.cref = cg[P0];
    float m_reg = -1e30f, l_reg = 0.f; att::f32x16 o[4] = {};
    LAS int* flg = (LAS int*)(lds + att::L_FLAG);
    int jb = P0 / 64 + 4;
    for (;;) {
        const int ja = jb > FOX_CH ? jb - FOX_CH : 0;
        ca.ja = ja; ca.jb = jb;
        att::attn_chunk<128, 0, true>(ca, qr, m_reg, l_reg, o, lds);
        if (ja == 0) break;
        float qn2 = 0.f;
#pragma unroll
        for (int d0 = 0; d0 < 8; ++d0)
#pragma unroll
            for (int j = 0; j < 8; ++j) { const float v = bf2f((unsigned short)qr[d0][j]); qn2 += v * v; }
        { auto rr = __builtin_amdgcn_permlane32_swap(__float_as_uint(qn2), __float_as_uint(qn2), false, false); qn2 = __uint_as_float(rr[0]) + __uint_as_float(rr[1]); }
        const float kmax2 = __uint_as_float(__hip_atomic_load((unsigned*)(A.ws + WS_CTL) + CW_KMAX + hd, RLX_AGENT));
        const float qk_bound = sqrtf(qn2 * kmax2) * 1.001f;
        const float kb_low = (ca.cref - cg[ja * 64]) * (1.f / SCALE128);
        const int done = __all((qk_bound + kb_low - m_reg) * (1.4426950408889634f * SCALE128) < -152.f) ? 1 : 0;
        { int t_ = threadIdx.x; asm volatile("" : "+v"(t_)); if ((t_ & 63) == 0) flg[t_ >> 6] = done; }
        __syncthreads();
        int all = 1;
#pragma unroll
        for (int w = 0; w < NWAVES; ++w) all &= flg[w];
        __syncthreads();
        if (all) break;
        jb = ja;
    }
    fox_epilogue(o, l_reg, lds, obuf + (size_t)P0 * ldo + ocol, ldo);
}

template <int MP>
__device__ __forceinline__ void diff_map(const Args& A, LAS char* lds, int hd, int qb, unsigned char* obuf) {
    int tid_ = threadIdx.x; asm volatile("" : "+v"(tid_)); const int tid = tid_, wid = __builtin_amdgcn_readfirstlane(tid >> 6), lane = tid & 63, r32 = lane & 31, hi = lane >> 5;
    const bf16* h = (const bf16*)(A.ws + WS_H); const int P0 = qb * 256;
    LAS unsigned short* stash = (LAS unsigned short*)(lds + att::L_STASH) + wid * 4096 + lane;
    LAS float* li_l = (LAS float*)(lds + att::L_WS) + wid * 64;
    bf16x8 qr[4]; att::load_q<64>(qr, h + (size_t)(P0 + wid * 32 + r32) * NQKV + hd * 128 + MP * 64, hi);
    att::ChunkArgs ca; ca.hbase = h; ca.kcolB = (unsigned)(1024 + hd * 128 + MP * 64) * 2u; ca.vcolB = (unsigned)(2048 + hd * 128) * 2u;
    ca.ja = 0; ca.jb = P0 / 64 + 4; ca.qpos = P0 + wid * 32 + r32; ca.qlo = P0 + wid * 32; ca.cb = nullptr; ca.cref = 0.f;
    float m_reg = -1e30f, l_reg = 0.f;
    att::f32x16 o[4] = {};
    att::attn_chunk<64, 1, false>(ca, qr, m_reg, l_reg, o, lds);
    if (hi == 0) li_l[r32] = l_reg; asm volatile("s_waitcnt lgkmcnt(0)" ::: "memory");
    if constexpr (MP == 0) {
#pragma unroll
        for (int r = 0; r < 16; ++r) { const float rl = __builtin_amdgcn_rcpf(li_l[att::crow(r, hi)]);
#pragma unroll
            for (int d0 = 0; d0 < 4; ++d0) stash[(r * 4 + d0) * 64] = (unsigned short)f2bf(o[d0][r] * rl); }
    } else {
        const float lam = ((const float*)(A.ws + WS_LAM))[0];
        unsigned char* ob = obuf + (size_t)(P0 + wid * 32) * DM + hd * 128;
#pragma unroll
        for (int r = 0; r < 16; ++r) { const float rl = lam * __builtin_amdgcn_rcpf(li_l[att::crow(r, hi)]); float v[4]; float ss = 0.f;
#pragma unroll
            for (int d0 = 0; d0 < 4; ++d0) { v[d0] = bf2f(stash[(r * 4 + d0) * 64]) - o[d0][r] * rl; ss += v[d0] * v[d0]; }
            ss += __shfl_xor(ss, 1); ss += __shfl_xor(ss, 2); ss += __shfl_xor(ss, 4); ss += __shfl_xor(ss, 8); ss += __shfl_xor(ss, 16);
            const float sc = rsqrtf(ss * (1.f / 128.f) + LN_EPS) * (1.f - LAMBDA_INIT); const int orow = att::crow(r, hi);
#pragma unroll
            for (int d0 = 0; d0 < 4; ++d0) { const float w = v[d0] * sc * A.subln_gain[d0 * 32 + r32] * att::O8_SCALE; const float w1 = att::quad_bcast<0x55>(w), w2 = att::quad_bcast<0xAA>(w), w3 = att::quad_bcast<0xFF>(w);
                if ((r32 & 3) == 0) *(unsigned*)(ob + (size_t)orow * DM + d0 * 32 + r32) = pk4_fp8(w, w1, w2, w3); } }
    }
    __syncthreads();
}
__device__ __forceinline__ void diff_block(const Args& A, LAS char* lds, int hd, int qb, unsigned char* obuf) {
    att::load_lut(lds, (const float*)(A.ws + WS_LUT) + hd * 1024, 1.f / SCALE64);
    diff_map<0>(A, lds, hd, qb, obuf);
    diff_map<1>(A, lds, hd, qb, obuf);
}

__device__ __forceinline__ void sb_block(const Args& A, LAS char* lds, int hd, int qb, unsigned char* obuf) {
    int tid_ = threadIdx.x; asm volatile("" : "+v"(tid_)); const int tid = tid_, wid = __builtin_amdgcn_readfirstlane(tid >> 6), lane = tid & 63, r32 = lane & 31, hi = lane >> 5;
    const bf16* h = (const bf16*)(A.ws + WS_H); const int P0 = qb * 256;
    bf16x8 qr[8]; att::load_q<128>(qr, h + (size_t)(P0 + wid * 32 + r32) * NQKV + 3072 + hd * 128, hi);
    att::ChunkArgs ca; ca.hbase = h; ca.kcolB = (unsigned)(4096 + hd * 128) * 2u; ca.vcolB = (unsigned)(5120 + hd * 128) * 2u;
    ca.qpos = P0 + wid * 32 + r32; ca.qlo = P0 + wid * 32; ca.cb = nullptr; ca.cref = 0.f;
    float R2 = 0.f, l_dummy = 0.f; att::f32x16 o[4] = {};
    LAS int* flg = (LAS int*)(lds + att::L_FLAG);
    int jb = P0 / 64 + 4;
    for (;;) {
#if SB_NOCHUNK
        const int ja = 0;
#else
        const int ja = jb > 8 ? jb - 8 : 0;
#endif
        ca.ja = ja; ca.jb = jb;
        att::attn_chunk<128, 3, true>(ca, qr, R2, l_dummy, o, lds);
        const int done = __all(R2 < -150.1f) ? 1 : 0;
        if (lane == 0) flg[wid] = done;
        __syncthreads();
        int all = 1;
#pragma unroll
        for (int w = 0; w < NWAVES; ++w) all &= flg[w];
        __syncthreads();
        if (all || ja == 0) break;
        jb = ja;
    }
#if SB_R2PROBE
    { float rm = fmaxf(R2, 0.f); for (int o_ = 1; o_ < 64; o_ <<= 1) rm = fmaxf(rm, __shfl_xor(rm, o_));
      if (lane == 0) { atomicMax((unsigned*)(A.ws + WS_CTL) + 10240, __float_as_uint(rm)); __hip_atomic_store((float*)(A.ws + WS_CTL) + 10241, 1.f, RLX_AGENT); } }
#endif
    float one[16];
#pragma unroll
    for (int r = 0; r < 16; ++r) one[r] = 1.f;
    att::store_o(o, one, obuf + (size_t)(P0 + wid * 32) * DM + (8 + hd) * 128, DM, r32, hi);
    __syncthreads();
}

__device__ __forceinline__ void sb_unit_test(const Args& A, float sentinel) {
    const int lane = threadIdx.x & 63, r32 = lane & 31, hi = lane >> 5;
    float maxerr = 0.f;
    for (int pat = 0; pat < 4; ++pat) {
        att::f32x16 p0, p1; float R2 = (pat == 3) ? -20.f : 0.f; const float R2in = R2;
        const int lim = (pat == 0) ? 64 : (pat == 1) ? (r32 * 2 + 1) : (pat == 2) ? (r32 < 16 ? 0 : 40) : 33;
#define ZRAW(k) (((k) >= lim) ? sentinel : (25.f * __sinf(0.37f * (float)(k) + 0.11f * (float)r32 + (float)pat)))
#pragma unroll
        for (int r = 0; r < 16; ++r) { p0[r] = ZRAW(att::crow(r, hi)); p1[r] = ZRAW(32 + att::crow(r, hi)); }
        att::sb_half(p1, R2, hi); att::sb_half(p0, R2, hi);
        constexpr float C2 = 1.4426950408889634f * SCALE128;
        float Rr = R2in;
        for (int k = 63; k >= 0; --k) { const float z2 = ZRAW(k) * C2; const float sp = fmaxf(z2, 0.f) + log2f(1.f + exp2f(-fabsf(z2))); const float aref = exp2f(z2 - sp + Rr); Rr -= sp;
#pragma unroll
            for (int r = 0; r < 16; ++r) { if (att::crow(r, hi) == k) maxerr = fmaxf(maxerr, fabsf(p0[r] - aref)); if (32 + att::crow(r, hi) == k) maxerr = fmaxf(maxerr, fabsf(p1[r] - aref)); }
            if (!(aref == aref)) maxerr = 1e9f; }
        maxerr = fmaxf(maxerr, fabsf(R2 - Rr) * 1e-3f);
        if (!(R2 == R2)) maxerr = 1e9f;
#pragma unroll
        for (int r = 0; r < 16; ++r) if (!(p0[r] == p0[r]) || !(p1[r] == p1[r])) maxerr = 1e9f;
#undef ZRAW
    }
    for (int o_ = 1; o_ < 64; o_ <<= 1) maxerr = fmaxf(maxerr, __shfl_xor(maxerr, o_));
    if (lane == 0) { atomicMax((unsigned*)(A.ws + WS_CTL) + 10240, __float_as_uint(maxerr)); __hip_atomic_store((float*)(A.ws + WS_CTL) + 10241, 1.f, RLX_AGENT); }
}

constexpr size_t DO_LSE = 2 * MiB, DO_MLIST = 4 * MiB;
__device__ __forceinline__ void moba_block(const Args& A, LAS char* lds, int hd, int n, int chunk  , int cnt) {
    int tid_ = threadIdx.x; asm volatile("" : "+v"(tid_)); const int tid = tid_, wid = __builtin_amdgcn_readfirstlane(tid >> 6), lane = tid & 63, r32 = lane & 31, hi = lane >> 5;
    const bf16* h = (const bf16*)(A.ws + WS_H);
    int t, slot, valid;
    if (chunk < 0) { t = n * 256 + wid * 32 + r32; slot = 3; valid = 1; }
    else { const int idx = chunk * 256 + wid * 32 + r32; valid = idx < cnt; const int ent = valid ? ((const int*)((const unsigned char*)A.out + DO_MLIST))[(size_t)(hd * 64 + n) * SEQ + idx] : (SEQ - 1) * 4; t = ent >> 2; slot = ent & 3; }
    bf16x8 qr[8]; att::load_q<128>(qr, h + (size_t)t * NQKV + 3072 + hd * 128, hi);
    att::ChunkArgs ca; ca.hbase = h; ca.kcolB = (unsigned)(4096 + hd * 128) * 2u; ca.vcolB = (unsigned)(5120 + hd * 128) * 2u;
    ca.ja = n * 4; ca.jb = n * 4 + 4; ca.qpos = t; ca.qlo = 0; ca.cb = nullptr; ca.cref = 0.f;
    float m_reg = -1e30f, l_reg = 0.f; att::f32x16 o[4] = {};
    att::attn_chunk<128, 2, false>(ca, qr, m_reg, l_reg, o, lds);
    LAS float* li_l = (LAS float*)(lds + att::L_WS) + wid * 64; LAS int* dst_l = (LAS int*)(li_l + 32);
    const int dst = valid ? ((hd * SEQ + t) * 4 + slot) : -1;
    if (hi == 0) { li_l[r32] = l_reg; dst_l[r32] = dst;
        if (valid) ((float*)((unsigned char*)A.out + DO_LSE))[dst] = m_reg * (1.4426950408889634f * SCALE128) + __builtin_amdgcn_logf(l_reg); }
    asm volatile("s_waitcnt lgkmcnt(0)" ::: "memory");
    bf16* part = (bf16*)(A.ws + WS_Y);
#pragma unroll
    for (int r = 0; r < 16; ++r) { const int row = att::crow(r, hi); const int d = dst_l[row]; const float rl = __builtin_amdgcn_rcpf(li_l[row]);
#pragma unroll
        for (int d0 = 0; d0 < 4; ++d0) { const float v = o[d0][r] * rl; const float vn = __shfl_xor(v, 1);
            if ((r32 & 1) == 0 && d >= 0) *(unsigned*)(part + (size_t)d * 128 + d0 * 32 + r32) = att::cvtpk(v, vn); } }
    __syncthreads();
}
__device__ __forceinline__ void moba_phase(const Args& A, LAS char* lds, int G) {
    const int tid = fresh_tid();
    LAS int* pre = (LAS int*)(lds + att::L_STASH);
    LAS int* cnts = pre + 520;
    if (tid < 512) { const int c = (int)__hip_atomic_load((unsigned*)(A.ws + WS_CTL) + CW_MOBACNT + tid, RLX_AGENT); cnts[tid] = c; pre[tid] = (c + 255) >> 8; }
    __syncthreads();
    if (tid == 0) { int acc = 0; for (int i = 0; i < 512; ++i) { const int v = pre[i]; pre[i] = acc; acc += v; } pre[512] = acc; }
    __syncthreads();
    const int total = 512 + pre[512];
    int curhd = -1;
    for (int u = blockIdx.x; u < total; u += G) {
        int hn, chunk;
        if (u < 512) { hn = u; chunk = -1; }
        else { const int g = u - 512; int lo = 0, hi_ = 511;
            while (lo < hi_) { const int mid = (lo + hi_ + 1) >> 1; if (pre[mid] <= g) lo = mid; else hi_ = mid - 1; }
            hn = lo; chunk = g - pre[hn]; }
        const int hd = hn >> 6, n = hn & 63;
        if (hd != curhd) { att::load_lut(lds, (const float*)(A.ws + WS_LUT) + hd * 1024, 1.f / SCALE128); curhd = hd; }
        moba_block(A, lds, hd, n, chunk, cnts[hn]);
    }
}
__device__ __forceinline__ void moba_combine(const Args& A, int G, unsigned char* obuf) {
    const int tid = fresh_tid();
    const float* lse = (const float*)((const unsigned char*)A.out + DO_LSE); const bf16* part = (const bf16*)(A.ws + WS_Y);
    for (int i = blockIdx.x * NTHREADS + tid; i < 8 * SEQ * 16; i += G * NTHREADS) { const int it = i >> 4, c8 = (i & 15) * 8; const int hd = it >> 14, t = it & (SEQ - 1);
        const int own = t >> 8, nsel = own < 3 ? own : 3; const size_t base = ((size_t)hd * SEQ + t) * 4;
        const f32x4 lv = *(const f32x4*)(lse + base);
        v4u pw[4];
#pragma unroll
        for (int j = 0; j < 4; ++j) pw[j] = *(const v4u*)(part + (base + j) * 128 + c8);
        float l[4] = {lv.x, lv.y, lv.z, lv.w}; float mx = l[3];
#pragma unroll
        for (int j = 0; j < 3; ++j) { l[j] = (j < nsel) ? l[j] : -3e38f; mx = fmaxf(mx, l[j]); }
        float w[4], ws_ = 0.f;
#pragma unroll
        for (int j = 0; j < 4; ++j) { w[j] = (j == 3 || j < nsel) ? __builtin_amdgcn_exp2f(l[j] - mx) : 0.f; ws_ += w[j]; }
        const float inv = 1.f / ws_; float a[8] = {0, 0, 0, 0, 0, 0, 0, 0};
#pragma unroll
        for (int j = 0; j < 4; ++j) { const float wj = w[j] * inv; const bool on = (j == 3 || j < nsel);
            a[0] += on ? wj * bflo(pw[j].x) : 0.f; a[1] += on ? wj * bfhi(pw[j].x) : 0.f; a[2] += on ? wj * bflo(pw[j].y) : 0.f; a[3] += on ? wj * bfhi(pw[j].y) : 0.f;
            a[4] += on ? wj * bflo(pw[j].z) : 0.f; a[5] += on ? wj * bfhi(pw[j].z) : 0.f; a[6] += on ? wj * bflo(pw[j].w) : 0.f; a[7] += on ? wj * bfhi(pw[j].w) : 0.f; }
        v2u o; o.x = pk4_fp8(a[0] * att::O8_SCALE, a[1] * att::O8_SCALE, a[2] * att::O8_SCALE, a[3] * att::O8_SCALE); o.y = pk4_fp8(a[4] * att::O8_SCALE, a[5] * att::O8_SCALE, a[6] * att::O8_SCALE, a[7] * att::O8_SCALE);
        *(v2u*)(obuf + (size_t)t * DM + (8 + hd) * 128 + c8) = o; }
}


constexpr int CW_Q4 = 10560, CW_Q12 = 10752, CW_QM = 10944;
__device__ __forceinline__ int next_item(const Args& A, int cw, LAS int* slot) {
    __syncthreads();
    if (threadIdx.x == 0) *slot = (int)__hip_atomic_fetch_add((unsigned*)(A.ws + WS_CTL) + cw, 1u, RLX_AGENT);
    __syncthreads();
    return *slot;
}

template <bool RES_F32>
__device__ __forceinline__ void p_ln1_router(const Args& A, char* lds, int G, int layer, const void* xres, const bf16* y, bf16* x1) {
    const int tid = fresh_tid(), lane = tid & 63, wave = tid >> 6;
    float* wT = (float*)lds; int* rinfo = (int*)(lds + 131072); int* lcnt = (int*)(lds + 139264); int* gbase = lcnt + 16;
    for (int idx = tid; idx < 16 * DM; idx += NTHREADS) { const int d = idx >> 4, e = idx & 15; wT[e * DM + d] = A.w_router[idx]; }
    if (tid < 16) lcnt[tid] = 0;
    __syncthreads();
    const int rows_per = (SEQ + G - 1) / G; const int row0 = blockIdx.x * rows_per; int nrows = SEQ - row0; nrows = nrows < 0 ? 0 : (nrows > rows_per ? rows_per : nrows);
    const float* gain = A.ln_gain + (size_t)(layer * 2 + 0) * DM; const float* bias = A.ln_bias + (size_t)(layer * 2 + 0) * DM;
    for (int r = wave; r < nrows; r += NWAVES) {
        const int m = row0 + r;
        f32x4 v[8]; float s = 0.f;
#pragma unroll
        for (int j = 0; j < 8; ++j) {
            f32x4 xr;
            if constexpr (RES_F32) xr = *((const f32x4*)((const float*)xres + (size_t)m * DM) + lane + 64 * j);
            else { const v2u w = *((const v2u*)((const bf16*)xres + (size_t)m * DM) + lane + 64 * j); xr = (f32x4){bflo(w.x), bfhi(w.x), bflo(w.y), bfhi(w.y)}; }
            const v2u yw = *((const v2u*)(y + (size_t)m * DM) + lane + 64 * j);
            v[j] = xr * ALPHA + (f32x4){bflo(yw.x), bfhi(yw.x), bflo(yw.y), bfhi(yw.y)};
            s += (v[j].x + v[j].y) + (v[j].z + v[j].w); }
        const float mean = wave_sum(s) * (1.f / DM); float s2 = 0.f;
#pragma unroll
        for (int j = 0; j < 8; ++j) { v[j] = v[j] - mean; s2 += (v[j].x * v[j].x + v[j].y * v[j].y) + (v[j].z * v[j].z + v[j].w * v[j].w); }
        const float rstd = rsqrtf(wave_sum(s2) * (1.f / DM) + LN_EPS);
#pragma unroll
        for (int j = 0; j < 8; ++j) { const f32x4 gg = *((const f32x4*)gain + lane + 64 * j), bb = *((const f32x4*)bias + lane + 64 * j); v[j] = v[j] * rstd * gg + bb;
            v2u w; w.x = pk2(v[j].x, v[j].y); w.y = pk2(v[j].z, v[j].w); *((v2u*)(x1 + (size_t)m * DM) + lane + 64 * j) = w;
            *((unsigned*)(A.ws + WS_X1F8 + (size_t)m * DM) + lane + 64 * j) = pk4_fp8(v[j].x, v[j].y, v[j].z, v[j].w); }
        float lg[16];
#pragma unroll
        for (int e = 0; e < 16; ++e) { float a = 0.f;
#pragma unroll
            for (int j = 0; j < 8; ++j) { const f32x4 w = *(const f32x4*)(wT + e * DM + 256 * j + 4 * lane); a += v[j].x * w.x + v[j].y * w.y + v[j].z * w.z + v[j].w * w.w; }
            lg[e] = wave_sum(a) + A.b_router[e]; }
        int gs = 0; float gbest = fmaxf(fmaxf(lg[0], lg[1]), fmaxf(lg[2], lg[3]));
#pragma unroll
        for (int g = 1; g < 4; ++g) { const float gm = fmaxf(fmaxf(lg[4 * g], lg[4 * g + 1]), fmaxf(lg[4 * g + 2], lg[4 * g + 3])); if (gm > gbest) { gbest = gm; gs = g; } }
        float c0 = 0.f, c1 = 0.f, c2 = 0.f, c3 = 0.f;
#pragma unroll
        for (int g = 0; g < 4; ++g) if (gs == g) { c0 = lg[4 * g]; c1 = lg[4 * g + 1]; c2 = lg[4 * g + 2]; c3 = lg[4 * g + 3]; }
        float b0 = c0; int k0 = 0; if (c1 > b0) { b0 = c1; k0 = 1; } if (c2 > b0) { b0 = c2; k0 = 2; } if (c3 > b0) { b0 = c3; k0 = 3; }
        float b1 = -3e38f; int k1 = 0;
        if (k0 != 0 && c0 > b1) { b1 = c0; k1 = 0; } if (k0 != 1 && c1 > b1) { b1 = c1; k1 = 1; } if (k0 != 2 && c2 > b1) { b1 = c2; k1 = 2; } if (k0 != 3 && c3 > b1) { b1 = c3; k1 = 3; }
        const float ex = __expf(b1 - b0); const float w0 = 1.f / (1.f + ex), w1 = ex / (1.f + ex);
        if (lane == 0) { const int e0 = gs * 4 + k0, e1 = gs * 4 + k1; const int p0 = atomicAdd(&lcnt[e0], 1), p1 = atomicAdd(&lcnt[e1], 1);
            int* ri = rinfo + r * 8; ri[0] = e0; ri[1] = e1; ri[2] = __builtin_bit_cast(int, w0); ri[3] = __builtin_bit_cast(int, w1); ri[4] = p0; ri[5] = p1; }
    }
    __syncthreads();
    if (tid < 16) gbase[tid] = (int)__hip_atomic_fetch_add((unsigned*)(A.ws + WS_CTL) + CW_MOECNT + layer * 64 + tid, (unsigned)lcnt[tid], RLX_AGENT);
    __syncthreads();
    int* mlist = (int*)(A.ws + WS_MLIST) + (size_t)layer * 16 * SEQ; float* mgw = (float*)(A.ws + WS_MGW) + (size_t)layer * 16 * SEQ;
    if (tid < nrows) { const int* ri = rinfo + tid * 8; const int m = row0 + tid;
        const int e0 = ri[0], e1 = ri[1]; const int q0 = gbase[e0] + ri[4], q1 = gbase[e1] + ri[5];
        mlist[e0 * SEQ + q0] = m * 2 + 0; mgw[e0 * SEQ + q0] = __builtin_bit_cast(float, ri[2]);
        mlist[e1 * SEQ + q1] = m * 2 + 1; mgw[e1 * SEQ + q1] = __builtin_bit_cast(float, ri[3]); }
    __syncthreads();
}

struct MoeTable { const LAS int* t; };
__device__ __forceinline__ void moe_build_table(const Args& A, LAS int* tbl, int layer) {
    if (threadIdx.x == 0) { int acc = 0;
        for (int e = 0; e < 16; ++e) { const int c = (int)__hip_atomic_load((unsigned*)(A.ws + WS_CTL) + CW_MOECNT + layer * 64 + e, RLX_AGENT); tbl[e] = acc; tbl[17 + e] = c; acc += (c + 255) >> 8; }
        tbl[16] = acc; tbl[33] = acc; }
    __syncthreads();
}
template <bool GATH>
struct MoeOrder {
    static constexpr bool GATHER = GATH;
    const LAS int* tbl; const int* list; size_t bstride;
    int G, c;
    __device__ bool next(int i, pg8::Unit& u) const {
        const int L = i * G + c; const int total = tbl[16];
        if (L >= total * 8) return false;
        const int mt = L >> 3; u.pn = L & 7; u.pm = mt; int e = 0;
#pragma unroll
        for (int j = 1; j < 16; ++j) e += (mt >= tbl[j]) ? 1 : 0;
        u.e = e; u.mi = mt - tbl[e]; return true;
    }
    __device__ __forceinline__ unsigned a_off(const pg8::Gemm& g, const pg8::Unit& u) const {
        if constexpr (GATH) return 0u; else return (unsigned)u.pm * 256u * (unsigned)g.rb; }
    __device__ __forceinline__ unsigned b_off(const pg8::Gemm& g, const pg8::Unit& u) const { return (unsigned)u.e * (unsigned)bstride + (unsigned)u.pn * 256u * (unsigned)g.rb; }
    __device__ __forceinline__ void a_voff(const pg8::Gemm& g, const pg8::Unit& u, const int (&R)[2], const int (&C)[2], unsigned (&vo)[2][2]) const {
        if constexpr (GATH) { const int cnt = tbl[17 + u.e];
#pragma unroll
            for (int h = 0; h < 2; ++h)
#pragma unroll
                for (int i = 0; i < 2; ++i) { const int idx = u.mi * 256 + h * 128 + R[i]; const int tok = (idx < cnt) ? (list[u.e * SEQ + idx] >> 1) : 0; vo[h][i] = (unsigned)(tok * g.rb + C[i] * 2); }
        } else {
#pragma unroll
            for (int h = 0; h < 2; ++h)
#pragma unroll
                for (int i = 0; i < 2; ++i) vo[h][i] = (unsigned)((h * 128 + R[i]) * g.rb + C[i] * 2);
        }
    }
};
struct EpiSwiglu {
    static constexpr bool PERM = true;
    unsigned char* H;
    __device__ __forceinline__ void operator()(const pg8::f32x4 (&acc)[2][2][4][2], const pg8::Unit& u, int wr, int wc, int fr, int fq) const {
        const int row0 = u.pm * 256 + wr * 64 + fr, col0 = u.pn * 128 + wc * 32 + 8 * fq;
#pragma unroll
        for (int ai = 0; ai < 2; ++ai)
#pragma unroll
            for (int m = 0; m < 4; ++m) { float hv[8];
#pragma unroll
                for (int n = 0; n < 2; ++n)
#pragma unroll
                    for (int i = 0; i < 4; ++i) { const float gt = acc[ai][0][m][n][i], up = acc[ai][1][m][n][i]; hv[n * 4 + i] = gt * __builtin_amdgcn_rcpf(1.f + __expf(-gt)) * up; }
                v2u w; w.x = pk4_fp8(hv[0], hv[1], hv[2], hv[3]); w.y = pk4_fp8(hv[4], hv[5], hv[6], hv[7]);
                *(v2u*)(H + (size_t)(row0 + ai * 128 + m * 16) * DEXP + col0) = w; asm volatile("" ::: "memory"); }
    }
};
struct EpiDown {
    static constexpr bool PERM = true;
    bf16* Y; const LAS int* tbl; const int* list; const float* gw;
    __device__ __forceinline__ void operator()(const pg8::f32x4 (&acc)[2][2][4][2], const pg8::Unit& u, int wr, int wc, int fr, int fq) const {
        const int cnt = tbl[17 + u.e]; const int col0 = u.pn * 256 + wc * 32 + 8 * fq;
#pragma unroll
        for (int ai = 0; ai < 2; ++ai)
#pragma unroll
            for (int m = 0; m < 4; ++m) { const int idx = u.mi * 256 + ai * 128 + wr * 64 + m * 16 + fr;
                if (idx < cnt) { const int ent = list[u.e * SEQ + idx]; const float g = gw[u.e * SEQ + idx];
                    bf16* rowp = Y + ((size_t)(ent & 1) * SEQ + (size_t)(ent >> 1)) * DM + col0;
#pragma unroll
                    for (int bj = 0; bj < 2; ++bj) { const pg8::f32x4 v0 = acc[ai][bj][m][0] * g, v1 = acc[ai][bj][m][1] * g;
                        pg8::u32x4 w; w.x = pg8::cvt_pk_bf16(v0[0], v0[1]); w.y = pg8::cvt_pk_bf16(v0[2], v0[3]); w.z = pg8::cvt_pk_bf16(v1[0], v1[1]); w.w = pg8::cvt_pk_bf16(v1[2], v1[3]);
                        *(pg8::u32x4*)(rowp + bj * 128) = w; } }
                asm volatile("" ::: "memory"); }
    }
};

template <bool OUT_F32>
__device__ __forceinline__ void p_ln2(const Args& A, int G, int layer, const bf16* x1, const bf16* ys, void* outp) {
    const int tid = fresh_tid(), lane = tid & 63, wave = tid >> 6;
    const int gw = blockIdx.x * NWAVES + wave, NGW = G * NWAVES;
    const float* gain = A.ln_gain + (size_t)(layer * 2 + 1) * DM; const float* bias = A.ln_bias + (size_t)(layer * 2 + 1) * DM;
    for (int m = gw; m < SEQ; m += NGW) {
        f32x4 v[8]; float s = 0.f;
#pragma unroll
        for (int j = 0; j < 8; ++j) {
            const v2u a = *((const v2u*)(x1 + (size_t)m * DM) + lane + 64 * j), b = *((const v2u*)(ys + (size_t)m * DM) + lane + 64 * j), c = *((const v2u*)(ys + ((size_t)SEQ + m) * DM) + lane + 64 * j);
            v[j] = (f32x4){bflo(a.x), bfhi(a.x), bflo(a.y), bfhi(a.y)} * ALPHA + (f32x4){bflo(b.x), bfhi(b.x), bflo(b.y), bfhi(b.y)} + (f32x4){bflo(c.x), bfhi(c.x), bflo(c.y), bfhi(c.y)};
            s += (v[j].x + v[j].y) + (v[j].z + v[j].w); }
        const float mean = wave_sum(s) * (1.f / DM); float s2 = 0.f;
#pragma unroll
        for (int j = 0; j < 8; ++j) { v[j] = v[j] - mean; s2 += (v[j].x * v[j].x + v[j].y * v[j].y) + (v[j].z * v[j].z + v[j].w * v[j].w); }
        const float rstd = rsqrtf(wave_sum(s2) * (1.f / DM) + LN_EPS);
#pragma unroll
        for (int j = 0; j < 8; ++j) { const f32x4 gg = *((const f32x4*)gain + lane + 64 * j), bb = *((const f32x4*)bias + lane + 64 * j); v[j] = v[j] * rstd * gg + bb;
            if constexpr (OUT_F32) *((f32x4*)((float*)outp + (size_t)m * DM) + lane + 64 * j) = v[j];
            else { v2u w; w.x = pk2(v[j].x, v[j].y); w.y = pk2(v[j].z, v[j].w); *((v2u*)((bf16*)outp + (size_t)m * DM) + lane + 64 * j) = w;
                if (L1IN_F8) *((unsigned*)(A.ws + WS_X1F8 + (size_t)m * DM) + lane + 64 * j) = pk4_fp8(v[j].x, v[j].y, v[j].z, v[j].w); } }
    }
}


constexpr int CW_TEST = 10240;
__device__ __forceinline__ void p_compare(const Args& A, int G, const bf16* a, const bf16* b, int c0, int nc) {
    const int tid = fresh_tid(); float num = 0.f, den = 0.f;
    const size_t total = (size_t)SEQ * nc;
    for (size_t i = (size_t)blockIdx.x * NTHREADS + tid; i < total; i += (size_t)G * NTHREADS) { const int m = (int)(i / nc), c = (int)(i % nc);
        const float x = bf2f(a[(size_t)m * DM + c0 + c]), y = bf2f(b[(size_t)m * DM + c0 + c]);
        if ((m & 255) < TEST_RLO || (m & 255) >= TEST_RHI) continue;
#if TEST_NANCOUNT == 2
        if (x == x) num = fmaxf(num, fabsf(x)); den = 1.f;
#elif TEST_NANCOUNT == 1
        num += (x == x && fabsf(x) < 1e4f) ? 0.f : 1.f; den += 1.f;
#else
        float d2 = (x - y) * (x - y); if (!(d2 == d2) || d2 > 1e12f) d2 = TEST_BADVAL; num += d2; den += y * y;
#endif
    }
#if TEST_NANCOUNT == 2
    for (int o = 1; o < 64; o <<= 1) num = fmaxf(num, __shfl_xor(num, o));
    if ((tid & 63) == 0) { atomicMax((unsigned*)(A.ws + WS_CTL) + CW_TEST, __float_as_uint(num)); __hip_atomic_store((float*)(A.ws + WS_CTL) + CW_TEST + 1, 1.f, RLX_AGENT); }
#else
    num = wave_sum(num); den = wave_sum(den);
    if ((tid & 63) == 0) { atomicAdd((float*)(A.ws + WS_CTL) + CW_TEST, num); atomicAdd((float*)(A.ws + WS_CTL) + CW_TEST + 1, den); }
#endif
}
__device__ __forceinline__ void p_apply_test(const Args& A, int G) {
    const float num = __hip_atomic_load((float*)(A.ws + WS_CTL) + CW_TEST, RLX_AGENT), den = __hip_atomic_load((float*)(A.ws + WS_CTL) + CW_TEST + 1, RLX_AGENT);
    const float f = 1.f + TEST_GAIN * sqrtf(num / den);
    for (size_t i = (size_t)blockIdx.x * NTHREADS + threadIdx.x; i < (size_t)SEQ * DM; i += (size_t)G * NTHREADS) A.out[i] *= f;
}

constexpr int NPHASE = 18 + (TEST_ATT ? 1 : 0);
__global__ void __launch_bounds__(NTHREADS, 2) fwd(Args A) {
    extern __shared__ __attribute__((aligned(16))) unsigned char lds[];
    LAS unsigned char* ldsl = (LAS unsigned char*)lds;
    const int tid = fresh_tid(); const int G = gridDim.x;
    for (int u = tid; u < (LDS_BYTES - LCTL_OFF) / 4; u += NTHREADS) ((LAS unsigned*)(ldsl + LCTL_OFF))[u] = 0u;
    __syncthreads();
    unsigned char* ws = A.ws;
    const int lo = A.ph_lo, hi = A.ph_hi;
    const bool fused = (hi - lo) > 1;
    XcdBarrier bar; bar.bar = (unsigned*)(ws + WS_CTL) + CW_BAR; bar.x = 0; bar.st = nullptr;
    if (fused) bar = xcd_barrier_post((unsigned*)(ws + WS_CTL) + CW_BAR, (volatile LAS unsigned*)(ldsl + LCTL_OFF));
#define IN(k) (lo <= (k) && (k) < hi)
#define SEAM(k) do { if (IN(k) && IN((k) + 1)) xcd_barrier(bar); } while (0)
    bf16* xb = (bf16*)(ws + WS_XB); bf16* hb = (bf16*)(ws + WS_H); bf16* ob = (bf16*)(ws + WS_O); bf16* yb = (bf16*)(ws + WS_Y); bf16* x1 = (bf16*)(ws + WS_X1);
    bf16* hid = (bf16*)(ws + WS_HID); bf16* ysl = (bf16*)(ws + WS_YSLOT);
    int* sel = (int*)((unsigned char*)A.out + DO_SEL);
    LAS int* mtbl = (LAS int*)(ldsl + LCTL_OFF + 256);

    if (IN(0)) { p0_prologue(A, ldsl, G);
#if DBL_PHASE == 0
        __syncthreads(); p0_prologue(A, ldsl, G);
#endif
    } SEAM(0);
#define LAYER_BACK(layer, P_OUT, WOUT, RESF32, XRES) \
    if (IN(P_OUT)) { pg8::Gemm g{ob, (const bf16*)(ws + WOUT), SEQ, DM, DM, DM}; pg8::DenseOrder S; S.init(SEQ, DM, G, (int)blockIdx.x); \
        pg8::EpiBf16 E{yb, DM}; pg8::gemm_phase<pg8::EpiBf16, pg8::DenseOrder, true, 122, 123>(ldsl, g, S, E); } \
    SEAM(P_OUT); \
    if (IN(P_OUT + 1)) { p_ln1_router<RESF32>(A, (char*)lds, G, layer, (const void*)(XRES), yb, x1); } \
    SEAM(P_OUT + 1); \
    if (IN(P_OUT + 2)) { moe_build_table(A, mtbl, layer); \
        pg8::Gemm g{(const bf16*)(ws + WS_X1F8), (const bf16*)(ws + WS_WGU + (size_t)layer * 16 * 2048 * 2048), 0, 2048, DM, DM}; \
        MoeOrder<true> S{mtbl, (const int*)(ws + WS_MLIST) + (size_t)layer * 16 * SEQ, (size_t)2048 * 2048, G, (int)blockIdx.x}; EpiSwiglu E{(unsigned char*)hid}; \
        pg8::gemm_phase<EpiSwiglu, MoeOrder<true>, true, 122, 127>(ldsl, g, S, E); \
        if (DBL_PHASE == 100 + P_OUT + 2) { __syncthreads(); pg8::gemm_phase<EpiSwiglu, MoeOrder<true>, true, 122, 127>(ldsl, g, S, E); } } \
    SEAM(P_OUT + 2); \
    if (IN(P_OUT + 3)) { moe_build_table(A, mtbl, layer); \
        pg8::Gemm g{hid, (const bf16*)(ws + WS_WDN + (size_t)layer * 16 * 2048 * 1024), 0, 2048, DEXP, DEXP}; \
        const int* mlist = (const int*)(ws + WS_MLIST) + (size_t)layer * 16 * SEQ; const float* mgw = (const float*)(ws + WS_MGW) + (size_t)layer * 16 * SEQ; \
        MoeOrder<false> S{mtbl, mlist, (size_t)2048 * 1024, G, (int)blockIdx.x}; EpiDown E{ysl, mtbl, mlist, mgw}; \
        pg8::gemm_phase<EpiDown, MoeOrder<false>, true, 122, 127>(ldsl, g, S, E); \
        if (DBL_PHASE == 100 + P_OUT + 3) { __syncthreads(); pg8::gemm_phase<EpiDown, MoeOrder<false>, true, 122, 127>(ldsl, g, S, E); } } \
    SEAM(P_OUT + 3);
    if (IN(1)) { pg8::Gemm g{xb, (const bf16*)(ws + WS_WIN0), SEQ, NQKV, DM, DM}; pg8::DenseOrder S; S.init(SEQ, NQKV, G, (int)blockIdx.x);
        pg8::EpiBf16 E{hb, NQKV}; pg8::gemm_phase<pg8::EpiBf16, pg8::DenseOrder, true, 122, 127>(ldsl, g, S, E); }
    SEAM(1);
    if (IN(2)) { p2_kmean_cumsum(A, (char*)lds, G);
#if DBL_PHASE == 2
        p2_kmean_cumsum(A, (char*)lds, G);
#endif
    } SEAM(2);
    if (IN(3)) p3_gate_cfinal(A, (char*)lds, G, sel); SEAM(3);
#if TEST_ATT
    if (IN(4)) { for (int u = blockIdx.x; u < 2048; u += G) { const int var = u >> 10, hd = (u >> 7) & 7, qb = u & 127;
            if (var == 0) naive_attn_unit<0>(A, (char*)lds, hd, qb, sel); else naive_attn_unit<1>(A, (char*)lds, hd, qb, sel); } }
#else
    if (IN(4)) { for (;;) { const int it = next_item(A, CW_Q4, (LAS int*)(ldsl + LCTL_OFF + 512)); if (it >= 512) break;
            fox_block(A, (LAS char*)ldsl, it & 7, 63 - (it >> 3), (unsigned char*)ob, DM, (it & 7) * 128); }
        moba_phase(A, (LAS char*)ldsl, G);
#if DBL_PHASE == 4
        for (int it = blockIdx.x; it < 512; it += G) { const int hd = (it & 255) >> 5, x = it & 31; fox_block(A, (LAS char*)ldsl, hd, (it < 256) ? 63 - x : x, (unsigned char*)ob, DM, hd * 128); }
#endif
#if DBL_PHASE == 41
        moba_phase(A, (LAS char*)ldsl, G);
#endif
    }
#endif
#if TEST_ATT == 4
    if (IN(4)) moba_phase(A, (LAS char*)ldsl, G);
#endif
#if TEST_ATT == 1
    if (IN(4)) { for (int u = blockIdx.x; u < 512; u += G) fox_block(A, (LAS char*)ldsl, u >> 6, u & 63, yb, DM, (u >> 6) * 128); }
#endif
    SEAM(4);
#if !TEST_ATT
    if (IN(5)) { moba_combine(A, G, (unsigned char*)ob); }
#endif
#if TEST_ATT == 1
    if (IN(5)) p_compare(A, G, yb, ob, 0, 1024);
#endif
#if TEST_ATT == 4
    if (IN(5)) moba_combine(A, G, xb);
    SEAM(5);
    if (IN(5)) p_compare(A, G, xb, ob, 1024, 1024);
#endif
    SEAM(5);
    LAYER_BACK(0, 6, WS_WOUT0, true, A.x)
    if (IN(10)) p_ln2<false>(A, G, 0, x1, ysl, (void*)xb);
    SEAM(10);
#if L1IN_F8
    if (IN(11)) { pg8::Gemm g{(const bf16*)(ws + WS_X1F8), (const bf16*)(ws + WS_WIN1), SEQ, NQKV, DM, DM}; pg8::DenseOrder S; S.init(SEQ, NQKV, G, (int)blockIdx.x);
        pg8::EpiBf16 E{hb, NQKV}; pg8::gemm_phase<pg8::EpiBf16, pg8::DenseOrder, true, 122, 127>(ldsl, g, S, E); }
#else
    if (IN(11)) { pg8::Gemm g{xb, (const bf16*)(ws + WS_WIN1), SEQ, NQKV, DM, DM * 2}; pg8::DenseOrder S; S.init(SEQ, NQKV, G, (int)blockIdx.x);
        pg8::EpiBf16 E{hb, NQKV}; pg8::gemm_phase<pg8::EpiBf16, pg8::DenseOrder>(ldsl, g, S, E);
#if DBL_PHASE == 11
        __syncthreads(); pg8::gemm_phase<pg8::EpiBf16, pg8::DenseOrder>(ldsl, g, S, E);
#endif
    }
#endif
    SEAM(11);
#if TEST_ATT
    if (IN(12)) { for (int u = blockIdx.x; u < 2048; u += G) { const int var = u >> 10, hd = (u >> 7) & 7, qb = u & 127;
            if (var == 0) naive_attn_unit<2>(A, (char*)lds, hd, qb, sel); else naive_attn_unit<3>(A, (char*)lds, hd, qb, sel); } }
#else
    if (IN(12)) { for (;;) { const int it = next_item(A, CW_Q12, (LAS int*)(ldsl + LCTL_OFF + 512)); if (it >= 512) break;
            diff_block(A, (LAS char*)ldsl, it & 7, 63 - (it >> 3), (unsigned char*)ob); }
        for (;;) { const int it = next_item(A, CW_Q12 + 64, (LAS int*)(ldsl + LCTL_OFF + 512)); if (it >= 512) break;
            sb_block(A, (LAS char*)ldsl, it & 7, 63 - (it >> 3), (unsigned char*)ob); }
#if DBL_PHASE == 12
        for (int it = blockIdx.x; it < 512; it += G) { const int hd = (it & 255) >> 5, x = it & 31; diff_block(A, (LAS char*)ldsl, hd, (it < 256) ? 63 - x : x, (unsigned char*)ob); }
#endif
#if DBL_PHASE == 121
        for (int u = blockIdx.x; u < 512; u += G) sb_block(A, (LAS char*)ldsl, u >> 6, u & 63, (unsigned char*)ob);
#endif
    }
#endif
#if TEST_ATT == 3
    if (IN(12) && blockIdx.x == 0) sb_unit_test(A, TEST_SENT);
#endif
#if TEST_ATT == 2
    if (IN(12)) { for (int u = blockIdx.x; u < 512; u += G) diff_block(A, (LAS char*)ldsl, u >> 6, u & 63, yb);
        for (int u = blockIdx.x; u < 512; u += G) sb_block(A, (LAS char*)ldsl, u >> 6, u & 63, yb); }
    SEAM(12);
#if !SB_R2PROBE
    if (IN(12)) p_compare(A, G, yb, ob, TEST_C0, TEST_NC);
#endif
#endif
    SEAM(12);
    LAYER_BACK(1, 13, WS_WOUT1, false, xb)
    if (IN(17)) p_ln2<true>(A, G, 1, x1, ysl, (void*)A.out);
#if TEST_ATT
    SEAM(17);
    if (IN(18)) p_apply_test(A, G);
#endif
#undef LAYER_BACK
#undef IN
#undef SEAM
}

#ifndef MK_FUSED
#define MK_FUSED 1
#endif
extern "C" void kernel_launch(void* const* d_in, const int* in_sizes, int n_in, void* d_out, int out_size, void* d_ws, size_t ws_size, hipStream_t stream) {
    static int grid = 0;
    if (grid == 0) {
        if (n_in != 17 || out_size != SEQ * DM || ws_size < WS_END) { fprintf(stderr, "kernel_launch: unexpected shapes (n_in %d out %d ws %zu)\n", n_in, out_size, ws_size); grid = -1; return; }
        int dev = 0, cus = 0, per_cu = 0;
        if (hipGetDevice(&dev) != hipSuccess || hipDeviceGetAttribute(&cus, hipDeviceAttributeMultiprocessorCount, dev) != hipSuccess) { grid = -1; return; }
        if (hipFuncSetAttribute((const void*)fwd, hipFuncAttributeMaxDynamicSharedMemorySize, LDS_BYTES) != hipSuccess) { fprintf(stderr, "kernel_launch: hipFuncSetAttribute failed\n"); grid = -1; return; }
        if (hipOccupancyMaxActiveBlocksPerMultiprocessor(&per_cu, (const void*)fwd, NTHREADS, LDS_BYTES) != hipSuccess || per_cu < 1) fprintf(stderr, "kernel_launch: occupancy query says %d\n", per_cu);
        (void)hipGetLastError();
        grid = cus;
    }
    if (grid < 0) return;
    (void)hipMemsetAsync((char*)d_ws + WS_CTL, 0, CTL_ZERO_BYTES, stream);
    Args a{};
    a.x = (const float*)d_in[0]; a.w_in_even = (const float*)d_in[1]; a.w_out_even = (const float*)d_in[2]; a.forget_bias = (const float*)d_in[3];
    a.w_in_odd = (const float*)d_in[4]; a.w_out_odd = (const float*)d_in[5]; a.lambda_q = (const float*)d_in[6]; a.lambda_k = (const float*)d_in[7];
    a.subln_gain = (const float*)d_in[8]; a.rel_bias = (const float*)d_in[9]; a.w_router = (const float*)d_in[10]; a.b_router = (const float*)d_in[11];
    a.w_gate = (const float*)d_in[12]; a.w_up = (const float*)d_in[13]; a.w_down = (const float*)d_in[14]; a.ln_gain = (const float*)d_in[15]; a.ln_bias = (const float*)d_in[16];
    a.out = (float*)d_out; a.ws = (unsigned char*)d_ws;
#if MK_FUSED
    a.ph_lo = 0; a.ph_hi = NPHASE;
    hipLaunchKernelGGL(fwd, dim3(grid), dim3(NTHREADS), LDS_BYTES, stream, a);
#else
    for (int p = 0; p < NPHASE; ++p) {  a.ph_lo = p; a.ph_hi = p + 1; hipLaunchKernelGGL(fwd, dim3(grid), dim3(NTHREADS), LDS_BYTES, stream, a); }
#endif
}
```

```cpp
#include <hip/hip_runtime.h>
#include <cstdio>
#include <cstdint>

namespace pg8 {
#define PG8_LAS __attribute__((address_space(3)))
typedef unsigned short bf16_t;
typedef short bf16x8 __attribute__((ext_vector_type(8)));
typedef float f32x4 __attribute__((ext_vector_type(4)));
typedef unsigned u32x4 __attribute__((ext_vector_type(4)));
constexpr int BM = 256, BK = 64, HALF = 128, HTB = HALF * BK * 2  , STAGE_BYTES = 8 * HTB, NXCD = 8, WGM = 8;

__host__ __device__ __forceinline__ int lds_byte(int r, int c) { const int st = (r >> 4) * 2 + (c >> 5), rr = r & 15, cc = c & 31, ob = rr * 64 + cc * 2; return st * 1024 + (ob ^ (((ob >> 9) & 1) << 5)); }
__host__ __device__ __forceinline__ void stage_rc(int b, int& R, int& C) { const int st = b / 1024, sb = b % 1024, swz = sb ^ (((sb >> 9) & 1) << 5); R = (st >> 1) * 16 + swz / 64; C = (st & 1) * 32 + (swz % 64) / 2; }
__host__ __device__ __forceinline__ int perm32(int rho) { const int n = rho >> 4, i = rho & 15; return 8 * (i >> 2) + 4 * n + (i & 3); }

struct Unit { int pm, pn, e, mi; };
struct Gemm { const bf16_t* A; const bf16_t* Bt; int M, N, K, rb; };

struct DenseOrder {
    static constexpr bool GATHER = false;
    int nM, nN, nwg, G, c;
    __device__ void init(int M, int N, int G_, int c_) { nM = M / BM; nN = N / BM; nwg = nM * nN; G = G_; c = c_; }
    __device__ bool next(int i, Unit& u) const {
        const long L = (long)i * G + c; if (L >= nwg) return false;
        int wgid = (int)L; { const int q = nwg / NXCD, r = nwg % NXCD, xcd = wgid % NXCD, off = wgid / NXCD; wgid = (xcd < r ? xcd * (q + 1) : r * (q + 1) + (xcd - r) * q) + off; }
        const int nig = WGM * nN, gid = wgid / nig, fm = gid * WGM, gsz = (nM - fm) < WGM ? (nM - fm) : WGM;
        u.pm = fm + ((wgid % nig) % gsz); u.pn = (wgid % nig) / gsz; u.e = 0; u.mi = 0; return true;
    }
    __device__ __forceinline__ unsigned a_off(const Gemm& g, const Unit& u) const { return (unsigned)u.pm * (unsigned)(2 * HALF) * (unsigned)g.rb; }
    __device__ __forceinline__ unsigned b_off(const Gemm& g, const Unit& u) const { return (unsigned)u.pn * (unsigned)(2 * HALF) * (unsigned)g.rb; }
    __device__ __forceinline__ void a_voff(const Gemm& g, const Unit&, const int (&R)[2], const int (&C)[2], unsigned (&vo)[2][2]) const {
#pragma unroll
        for (int h = 0; h < 2; ++h)
#pragma unroll
            for (int i = 0; i < 2; ++i) vo[h][i] = (unsigned)((h * HALF + R[i]) * g.rb + C[i] * 2);
    }
};

__device__ __forceinline__ unsigned cvt_pk_bf16(float lo, float hi) { unsigned r; asm volatile("v_cvt_pk_bf16_f32 %0, %1, %2" : "=v"(r) : "v"(lo), "v"(hi)); return r; }

struct EpiBf16 {
    static constexpr bool PERM = true;
    bf16_t* O; int ldc;
    __device__ __forceinline__ void operator()(const f32x4 (&acc)[2][2][4][2], const Unit& u, int wr, int wc, int fr, int fq) const {
        const int row0 = u.pm * BM + wr * 64 + fr; const int col0 = u.pn * BM + wc * 32 + 8 * fq;
#pragma unroll
        for (int ai = 0; ai < 2; ++ai)
#pragma unroll
            for (int m = 0; m < 4; ++m) { bf16_t* rowp = O + (size_t)(row0 + ai * HALF + m * 16) * ldc + col0;
#pragma unroll
                for (int bj = 0; bj < 2; ++bj) { const f32x4 v0 = acc[ai][bj][m][0], v1 = acc[ai][bj][m][1];
                    u32x4 w; w.x = cvt_pk_bf16(v0[0], v0[1]); w.y = cvt_pk_bf16(v0[2], v0[3]); w.z = cvt_pk_bf16(v1[0], v1[1]); w.w = cvt_pk_bf16(v1[2], v1[3]);
                    *(u32x4*)(rowp + bj * HALF) = w; }
                asm volatile("" ::: "memory"); }
    }
};

typedef int v8i_t __attribute__((ext_vector_type(8)));
typedef int v4i_t __attribute__((ext_vector_type(4)));
template <class Epi, class Sched, bool F8 = false, int SCW = 127, int SCX = 127>
__device__ __forceinline__ void gemm_phase(PG8_LAS unsigned char* lds, const Gemm g, const Sched& S, const Epi& E) {
    int tid_ = threadIdx.x; asm volatile("" : "+v"(tid_));
    const int tid = tid_, wid = __builtin_amdgcn_readfirstlane(tid >> 6), lane = tid & 63, wr = wid >> 2, wc = wid & 3, fr = lane & 15, fq = lane >> 4;
    const int RB = g.rb, nt = RB / 128;
    unsigned voffB0;
    { int R, C; stage_rc(tid * 16, R, C); const int Rb = Epi::PERM ? ((R & ~31) + perm32(R & 31)) : R; voffB0 = (unsigned)(Rb * RB + C * 2); }
#define PG8_AVOFF(unit, dst) do { int sR[2], sC[2]; int t2_ = threadIdx.x; asm volatile("" : "+v"(t2_)); stage_rc(t2_ * 16, sR[0], sC[0]); stage_rc(t2_ * 16 + 8192, sR[1], sC[1]); S.a_voff(g, unit, sR, sC, dst); } while (0)
    const unsigned kstep = (unsigned)(BK * 2);
    const unsigned hstep = (unsigned)HALF * (unsigned)RB;
    const __amdgpu_buffer_rsrc_t rsA = __builtin_amdgcn_make_buffer_rsrc((void*)g.A, 0, 0x7ffffff0, 0x00020000), rsB = __builtin_amdgcn_make_buffer_rsrc((void*)g.Bt, 0, 0x7ffffff0, 0x00020000);
    const unsigned ldsw = (unsigned)wid * 1024u;
    const int aoff = lds_byte(wr * 64 + fr, fq * (F8 ? 16 : 8)), boff = lds_byte(wc * 32 + fr, fq * (F8 ? 16 : 8));
    constexpr int KOFF = F8 ? 16 : 1024;
#define PG8_SA(b, h) (((b) * 2 + (h)) * HTB)
#define PG8_SB(b, h) ((4 + (b) * 2 + (h)) * HTB)
#define PG8_STAGE_B(bufoff, soff) do { _Pragma("unroll") for (int _i = 0; _i < 2; ++_i) \
        __builtin_amdgcn_raw_ptr_buffer_load_lds(rsB, (PG8_LAS void*)(lds + (bufoff) + ldsw + _i * 8192), 16, (int)voffB0, (int)((soff) + (unsigned)_i * 64u * (unsigned)RB), 0, 0); } while (0)
#define PG8_STAGE_A(bufoff, soff, vset, h) do { _Pragma("unroll") for (int _i = 0; _i < 2; ++_i) { \
        if constexpr (Sched::GATHER) __builtin_amdgcn_raw_ptr_buffer_load_lds(rsA, (PG8_LAS void*)(lds + (bufoff) + ldsw + _i * 8192), 16, (int)(vset)[h][_i], (int)(soff), 0, 0); \
        else __builtin_amdgcn_raw_ptr_buffer_load_lds(rsA, (PG8_LAS void*)(lds + (bufoff) + ldsw + _i * 8192), 16, (int)(vset)[0][0], (int)((soff) + (unsigned)((h) * 128 + _i * 64) * (unsigned)RB), 0, 0); } } while (0)
#define PG8_LD8(addr) __builtin_shufflevector(*(const PG8_LAS v4i_t*)(addr), *(const PG8_LAS v4i_t*)((addr) + 16), 0, 1, 2, 3, 4, 5, 6, 7)
#define PG8_LDA8(dst, b, h) do { _Pragma("unroll") for (int m = 0; m < 4; ++m) dst[m] = PG8_LD8(lds + PG8_SA(b, h) + aoff + m * 2048); } while (0)
#define PG8_LDB8(dst, b, h) do { _Pragma("unroll") for (int n = 0; n < 2; ++n) dst[n] = PG8_LD8(lds + PG8_SB(b, h) + boff + n * 2048); } while (0)
#define PG8_MMA8(ai, bj, At, Bt) do { __builtin_amdgcn_s_setprio(1); _Pragma("unroll") for (int m = 0; m < 4; ++m) _Pragma("unroll") for (int n = 0; n < 2; ++n) \
        acc[ai][bj][m][n] = __builtin_amdgcn_mfma_scale_f32_16x16x128_f8f6f4(Bt[n], At[m], acc[ai][bj][m][n], 0, 0, 0, SCW, 0, SCX); __builtin_amdgcn_s_setprio(0); } while (0)
#define PG8_LDA(dst, b, h) do { _Pragma("unroll") for (int m = 0; m < 4; ++m) _Pragma("unroll") for (int k = 0; k < 2; ++k) dst[m][k] = *(const PG8_LAS bf16x8*)(lds + PG8_SA(b, h) + aoff + m * 2048 + k * KOFF); } while (0)
#define PG8_LDB(dst, b, h) do { _Pragma("unroll") for (int n = 0; n < 2; ++n) _Pragma("unroll") for (int k = 0; k < 2; ++k) dst[n][k] = *(const PG8_LAS bf16x8*)(lds + PG8_SB(b, h) + boff + n * 2048 + k * KOFF); } while (0)
#define PG8_MMA(ai, bj, At, Bt) do { __builtin_amdgcn_s_setprio(1); _Pragma("unroll") for (int m = 0; m < 4; ++m) _Pragma("unroll") for (int n = 0; n < 2; ++n) _Pragma("unroll") for (int k = 0; k < 2; ++k) \
        acc[ai][bj][m][n] = __builtin_amdgcn_mfma_f32_16x16x32_bf16(Bt[n][k], At[m][k], acc[ai][bj][m][n], 0, 0, 0); __builtin_amdgcn_s_setprio(0); } while (0)
#define PG8_WAIT_V(n) asm volatile("s_waitcnt vmcnt(" #n ")" ::: "memory")
#define PG8_WAIT_L(n) asm volatile("s_waitcnt lgkmcnt(" #n ")" ::: "memory")
#define PG8_BAR __builtin_amdgcn_s_barrier()
#define PG8_SCHED __builtin_amdgcn_sched_barrier(0)
    Unit cur, nxt; int ui = 0;
    if (!S.next(0, cur)) return;
    f32x4 acc[2][2][4][2];
#pragma unroll
    for (int a = 0; a < 2; ++a)
#pragma unroll
        for (int b = 0; b < 2; ++b)
#pragma unroll
            for (int m = 0; m < 4; ++m)
#pragma unroll
                for (int n = 0; n < 2; ++n) acc[a][b][m][n] = (f32x4){0.f, 0.f, 0.f, 0.f};
    bf16x8 At[4][2], B0[2][2], B1[2][2];
    v8i_t At8[4], B08[2], B18[2];
    unsigned vAc[2][2], vAn[2][2];
    PG8_AVOFF(cur, vAc);
    if constexpr (Sched::GATHER) { asm volatile("s_waitcnt vmcnt(0)" ::: "memory"); asm volatile("" : "+v"(vAc[0][0]), "+v"(vAc[0][1]), "+v"(vAc[1][0]), "+v"(vAc[1][1])); }
    unsigned cA = S.a_off(g, cur), cB = S.b_off(g, cur);
    PG8_STAGE_B(PG8_SB(0, 0), cB); PG8_STAGE_B(PG8_SB(0, 1), cB + hstep); PG8_STAGE_A(PG8_SA(0, 0), cA, vAc, 0); PG8_STAGE_A(PG8_SA(0, 1), cA, vAc, 1);
    if (wr == 1) PG8_BAR;
    PG8_WAIT_V(2); PG8_BAR;
    PG8_STAGE_B(PG8_SB(1, 0), cB + kstep); PG8_STAGE_A(PG8_SA(1, 0), cA + kstep, vAc, 0); PG8_STAGE_B(PG8_SB(1, 1), cB + hstep + kstep);
    PG8_WAIT_V(6); PG8_BAR;
#pragma nounroll
    for (;;) {
        const bool has_next = S.next(ui + 1, nxt);
        if constexpr (Sched::GATHER) {
            if (has_next) { PG8_AVOFF(nxt, vAn); asm volatile("s_waitcnt vmcnt(0)" ::: "memory"); }
            else {
#pragma unroll
                for (int h = 0; h < 2; ++h)
#pragma unroll
                    for (int i = 0; i < 2; ++i) vAn[h][i] = vAc[h][i]; }
            asm volatile("" : "+v"(vAn[0][0]), "+v"(vAn[0][1]), "+v"(vAn[1][0]), "+v"(vAn[1][1]));
        } else {
#pragma unroll
            for (int h = 0; h < 2; ++h)
#pragma unroll
                for (int i = 0; i < 2; ++i) vAn[h][i] = vAc[h][i];
        }
        const unsigned nA = has_next ? S.a_off(g, nxt) : cA, nB = has_next ? S.b_off(g, nxt) : cB;
#pragma unroll 1
        for (int t = 0; t < nt; t += 2) {
            const bool last = (t == nt - 2);
            const unsigned a1 = cA + (unsigned)(t + 1) * kstep;
            const unsigned a2 = last ? nA : cA + (unsigned)(t + 2) * kstep, b2 = last ? nB : cB + (unsigned)(t + 2) * kstep;
            const unsigned a3 = a2 + kstep, b3 = b2 + kstep;
            unsigned v2[2][2];
#pragma unroll
            for (int h = 0; h < 2; ++h)
#pragma unroll
                for (int i = 0; i < 2; ++i) { if constexpr (Sched::GATHER) v2[h][i] = last ? vAn[h][i] : vAc[h][i]; else v2[h][i] = vAc[h][i]; }
            if constexpr (F8) {
            PG8_LDB8(B08, 0, 0); PG8_LDB8(B18, 0, 1); PG8_SCHED; PG8_LDA8(At8, 0, 0); PG8_STAGE_A(PG8_SA(1, 1), a1, vAc, 1);
            PG8_WAIT_V(8); PG8_WAIT_L(0); PG8_BAR; PG8_MMA8(0, 0, At8, B08); PG8_MMA8(0, 1, At8, B18); PG8_BAR; PG8_SCHED;
            PG8_LDA8(At8, 0, 1); PG8_STAGE_B(PG8_SB(0, 0), b2); PG8_STAGE_B(PG8_SB(0, 1), b2 + hstep); PG8_STAGE_A(PG8_SA(0, 0), a2, v2, 0);
            PG8_WAIT_V(8); PG8_WAIT_L(0); PG8_BAR; PG8_MMA8(1, 0, At8, B08); PG8_MMA8(1, 1, At8, B18); PG8_BAR; PG8_SCHED;
            PG8_LDB8(B08, 1, 0); PG8_LDB8(B18, 1, 1); PG8_SCHED; PG8_LDA8(At8, 1, 0); PG8_STAGE_A(PG8_SA(0, 1), a2, v2, 1);
            PG8_WAIT_V(8); PG8_WAIT_L(0); PG8_BAR; PG8_MMA8(0, 0, At8, B08); PG8_MMA8(0, 1, At8, B18); PG8_BAR; PG8_SCHED;
            PG8_LDA8(At8, 1, 1); PG8_STAGE_B(PG8_SB(1, 0), b3); PG8_STAGE_B(PG8_SB(1, 1), b3 + hstep); PG8_STAGE_A(PG8_SA(1, 0), a3, v2, 0);
            PG8_WAIT_V(8); PG8_WAIT_L(0); PG8_BAR; PG8_MMA8(1, 0, At8, B08); PG8_MMA8(1, 1, At8, B18); PG8_BAR; PG8_SCHED;
            } else {
            PG8_LDB(B0, 0, 0); PG8_LDB(B1, 0, 1); PG8_SCHED; PG8_LDA(At, 0, 0); PG8_STAGE_A(PG8_SA(1, 1), a1, vAc, 1);
            PG8_WAIT_V(8); PG8_WAIT_L(0); PG8_BAR; PG8_MMA(0, 0, At, B0); PG8_MMA(0, 1, At, B1); PG8_BAR; PG8_SCHED;
            PG8_LDA(At, 0, 1); PG8_STAGE_B(PG8_SB(0, 0), b2); PG8_STAGE_B(PG8_SB(0, 1), b2 + hstep); PG8_STAGE_A(PG8_SA(0, 0), a2, v2, 0);
            PG8_WAIT_V(8); PG8_WAIT_L(0); PG8_BAR; PG8_MMA(1, 0, At, B0); PG8_MMA(1, 1, At, B1); PG8_BAR; PG8_SCHED;
            PG8_LDB(B0, 1, 0); PG8_LDB(B1, 1, 1); PG8_SCHED; PG8_LDA(At, 1, 0); PG8_STAGE_A(PG8_SA(0, 1), a2, v2, 1);
            PG8_WAIT_V(8); PG8_WAIT_L(0); PG8_BAR; PG8_MMA(0, 0, At, B0); PG8_MMA(0, 1, At, B1); PG8_BAR; PG8_SCHED;
            PG8_LDA(At, 1, 1); PG8_STAGE_B(PG8_SB(1, 0), b3); PG8_STAGE_B(PG8_SB(1, 1), b3 + hstep); PG8_STAGE_A(PG8_SA(1, 0), a3, v2, 0);
            PG8_WAIT_V(8); PG8_WAIT_L(0); PG8_BAR; PG8_MMA(1, 0, At, B0); PG8_MMA(1, 1, At, B1); PG8_BAR; PG8_SCHED;
            }
        }
        if (wr == 0) PG8_BAR;
        { int t_ = threadIdx.x; asm volatile("" : "+v"(t_)); const int l_ = t_ & 63; E(acc, cur, wr, wc, l_ & 15, l_ >> 4); }
        if (!has_next) break;
#pragma unroll
        for (int a = 0; a < 2; ++a)
#pragma unroll
            for (int b = 0; b < 2; ++b)
#pragma unroll
                for (int m = 0; m < 4; ++m)
#pragma unroll
                    for (int n = 0; n < 2; ++n) acc[a][b][m][n] = (f32x4){0.f, 0.f, 0.f, 0.f};
        cur = nxt; cA = nA; cB = nB; ++ui;
#pragma unroll
        for (int h = 0; h < 2; ++h)
#pragma unroll
            for (int i = 0; i < 2; ++i) vAc[h][i] = vAn[h][i];
        if (wr == 1) PG8_BAR;
    }
    PG8_WAIT_V(0);
    PG8_BAR;
#undef PG8_SA
#undef PG8_SB
#undef PG8_STAGE_A
#undef PG8_STAGE_B
#undef PG8_LDA
#undef PG8_LDB
#undef PG8_MMA
#undef PG8_AVOFF
#undef PG8_MMA8
#undef PG8_LD8
#undef PG8_LDA8
#undef PG8_LDB8
#undef PG8_WAIT_V
#undef PG8_WAIT_L
#undef PG8_BAR
#undef PG8_SCHED
}
}

#ifndef L1IN_F8
#define L1IN_F8 1
#endif
#ifndef DBL_PHASE
#define DBL_PHASE -1
#endif
#ifndef TEST_ATT
#define TEST_ATT 0
#endif
#ifndef TEST_C0
#define TEST_C0 0
#define TEST_NC 2048
#endif
#ifndef TEST_RLO
#define TEST_RLO 0
#define TEST_RHI 256
#endif
#ifndef SB_TRIVIAL
#define SB_TRIVIAL 0
#endif
#ifndef SB_R2PROBE
#define SB_R2PROBE 0
#endif
#ifndef TEST_BADVAL
#define TEST_BADVAL 1e6f
#endif
#ifndef TEST_NANCOUNT
#define TEST_NANCOUNT 0
#endif
#ifndef TEST_GAIN
#define TEST_GAIN 4.0f
#endif
constexpr int SEQ = 16384, DM = 2048, NHEADS = 16, HD = 128, NEXP = 16, DEXP = 1024, NQKV = 6144, NIN0 = 6152;
constexpr float ALPHA = 1.4142135623730951f;
constexpr float LN_EPS = 1e-5f;
constexpr float SCALE128 = 0.08838834764831845f;
constexpr float SCALE64 = 0.125f;
constexpr float LAMBDA_INIT = 0.8f - 0.6f * 0.7408182206817179f;
constexpr int NWAVES = 8, NTHREADS = 512;

constexpr size_t MiB = (size_t)1 << 20;
constexpr size_t WS_CTL = 0, CTL_ZERO_BYTES = 1 * MiB;
constexpr size_t WS_KMEAN = 1 * MiB;
constexpr size_t WS_LOGF = WS_KMEAN + 262144;
constexpr size_t WS_CLOC = WS_LOGF + 524288;
constexpr size_t WS_C = WS_CLOC + 524288;
constexpr size_t WS_CTOT = WS_C + 524288;
constexpr size_t WS_LUT = WS_CTOT + 4096;
constexpr size_t WS_LAM = WS_LUT + 32768;
constexpr size_t WS_MLIST = 4 * MiB;
constexpr size_t WS_MGW = 6 * MiB;
constexpr size_t WS_WIN0 = 8 * MiB, WS_WOUT0 = 32 * MiB, WS_WIN1 = 40 * MiB, WS_WOUT1 = 64 * MiB;
constexpr size_t WS_WGU = 72 * MiB;
constexpr size_t WS_WDN = 328 * MiB;
constexpr size_t WS_XB = 456 * MiB;
constexpr size_t WS_H = 520 * MiB;
constexpr size_t WS_O = 712 * MiB;
constexpr size_t WS_Y = 776 * MiB;
constexpr size_t WS_X1 = 840 * MiB;
constexpr size_t WS_X1F8 = 904 * MiB;
constexpr size_t WS_END = 936 * MiB;
constexpr size_t WS_YSLOT = WS_H;
constexpr size_t WS_HID = WS_O;
constexpr int HID_ROWS = 36864;
constexpr size_t DO_SEL = 0;

constexpr int CW_TMO = 0;
constexpr int CW_BAR = 4096;
constexpr int CW_MOECNT = 8192;
constexpr int CW_MOBACNT = 9216;

constexpr int RING_BYTES = 147456;
constexpr int LCTL_OFF = RING_BYTES;
constexpr int LDS_BYTES = 155648;

#define GAS __attribute__((address_space(1)))
#define LAS __attribute__((address_space(3)))
typedef unsigned short bf16;
typedef unsigned v4u __attribute__((ext_vector_type(4)));
typedef unsigned v2u __attribute__((ext_vector_type(2)));
typedef float f32x4 __attribute__((ext_vector_type(4)));
typedef short bf16x8 __attribute__((ext_vector_type(8)));
typedef GAS unsigned gu32;
#define RLX_AGENT __ATOMIC_RELAXED, __HIP_MEMORY_SCOPE_AGENT
#define LDS_WAIT() asm volatile("s_waitcnt lgkmcnt(0)" ::: "memory")
__device__ __forceinline__ unsigned f2bf(float f) { unsigned u = __builtin_bit_cast(unsigned, f); return (u + 0x7fffu + ((u >> 16) & 1u)) >> 16; }
__device__ __forceinline__ unsigned pk2(float lo, float hi) { return f2bf(lo) | (f2bf(hi) << 16); }
__device__ __forceinline__ unsigned pk4_fp8(float a, float b, float c, float d) { int w = 0; w = __builtin_amdgcn_cvt_pk_fp8_f32(a, b, w, false); w = __builtin_amdgcn_cvt_pk_fp8_f32(c, d, w, true); return (unsigned)w; }
__device__ __forceinline__ float bf2f(unsigned short b) { return __builtin_bit_cast(float, (unsigned)b << 16); }
__device__ __forceinline__ float bflo(unsigned w) { return __builtin_bit_cast(float, w << 16); }
__device__ __forceinline__ float bfhi(unsigned w) { return __builtin_bit_cast(float, w & 0xffff0000u); }
__device__ __forceinline__ int fresh_tid() { int t = threadIdx.x; asm volatile("" : "+v"(t)); return t; }
__device__ __forceinline__ float wave_sum(float v) {
#define WS_DPP(x, ctrl) __builtin_bit_cast(float, __builtin_amdgcn_mov_dpp(__builtin_bit_cast(int, x), ctrl, 0xf, 0xf, true))
    v += WS_DPP(v, 0x128); v += WS_DPP(v, 0x124); v += WS_DPP(v, 0x122); v += WS_DPP(v, 0x121);
#undef WS_DPP
#define WS_RL(l) __builtin_bit_cast(float, __builtin_amdgcn_readlane(__builtin_bit_cast(int, v), l))
    const float a = WS_RL(0), b = WS_RL(16), c = WS_RL(32), d = WS_RL(48);
#undef WS_RL
    return (a + b) + (c + d);
}
__device__ __forceinline__ float log_sigmoid(float v) { return fminf(v, 0.f) - log1pf(__expf(-fabsf(v))); }

#define XB_TMO      128
#define XB_XCNT(j)  (256  + 64 * (j))
#define XB_XSUB(j)  (1280 + 64 * (j))
#define XB_XGEN(j)  (2304 + 64 * (j))
#define XB_TOP      3328
#define XB_TOPGEN   3392
#define XCD_BAR_WORDS 3456
#define XB_SPIN_CAP (1u << 22)
#ifndef XB_FLAT
#define XB_FLAT 1
#endif
__device__ __forceinline__ unsigned xb_ld(unsigned* p)              { return __hip_atomic_load(p, __ATOMIC_RELAXED, __HIP_MEMORY_SCOPE_AGENT); }
__device__ __forceinline__ unsigned xb_add(unsigned* p, unsigned v) { return __hip_atomic_fetch_add(p, v, __ATOMIC_RELAXED, __HIP_MEMORY_SCOPE_AGENT); }
__device__ __forceinline__ unsigned xb_xcc_id() { return (unsigned)__builtin_amdgcn_s_getreg((3 << 11) | 20) & 0xFu; }
#define XB_SPIN(cond, bar) do { unsigned _sp = 0; while (cond) { __builtin_amdgcn_s_sleep(1); \
    if ((++_sp & 255u) == 0u) { if (xb_ld(&(bar)[XB_TMO])) break; if (_sp > XB_SPIN_CAP) { atomicAdd(&(bar)[XB_TMO], 1u); break; } } } } while (0)
struct XcdBarrier { unsigned* bar; unsigned x; volatile LAS unsigned* st; };
__device__ __forceinline__ XcdBarrier xcd_barrier_post(unsigned* bar, volatile LAS unsigned* st) {
    XcdBarrier b; b.bar = bar; b.x = xb_xcc_id(); b.st = st;
    if (threadIdx.x == 0) (void)xb_add(&bar[XB_XCNT(b.x)], 1u);
    return b;
}
__device__ __forceinline__ void xcd_barrier_complete(unsigned* bar, unsigned x, unsigned& nloc, unsigned& nx) {
    const unsigned G = gridDim.x * gridDim.y * gridDim.z;
    unsigned sum, cnt, mine, sp = 0u;
    for (;;) {
        sum = 0u; cnt = 0u; mine = 0u;
#pragma unroll
        for (unsigned j = 0; j < 16; ++j) { const unsigned c = xb_ld(&bar[XB_XCNT(j)]); sum += c; cnt += (c > 0u) ? 1u : 0u; mine = (j == x) ? c : mine; }
        if (sum == G) break;
        __builtin_amdgcn_s_sleep(1);
        if ((++sp & 255u) == 0u) { if (xb_ld(&bar[XB_TMO])) break; if (sp > XB_SPIN_CAP) { atomicAdd(&bar[XB_TMO], 1u); break; } }
    }
    nloc = mine > 0u ? mine : 1u; nx = cnt > 0u ? cnt : 1u;
}
__device__ __forceinline__ void xcd_barrier(const XcdBarrier& b) {
    asm volatile("s_waitcnt vmcnt(0)" ::: "memory");
    __syncthreads();
    if (threadIdx.x == 0) {
        unsigned* bar = b.bar;
        __builtin_amdgcn_s_waitcnt(0);
        unsigned nloc = b.st[0], nx = b.st[1];
        if (nloc == 0u) { xcd_barrier_complete(bar, b.x, nloc, nx); b.st[0] = nloc; b.st[1] = nx; }
        const unsigned old = xb_add(&bar[XB_XSUB(b.x)], 1u);
        const unsigned gen = old / nloc;
#if XB_FLAT
        if (old + 1u == (gen + 1u) * nloc) {
            __builtin_amdgcn_fence(__ATOMIC_RELEASE, "agent");
            asm volatile("s_waitcnt vmcnt(0)" ::: "memory");
            const unsigned og = xb_add(&bar[XB_TOP], 1u);
            const unsigned tg = og / nx;
            if (og + 1u == (tg + 1u) * nx) xb_add(&bar[XB_TOPGEN], 1u);
        }
        XB_SPIN(xb_ld(&bar[XB_TOPGEN]) == gen, bar);
        __builtin_amdgcn_fence(__ATOMIC_ACQUIRE, "agent");
        asm volatile("s_waitcnt vmcnt(0)" ::: "memory");
#else
        if (old + 1u == (gen + 1u) * nloc) {
            __builtin_amdgcn_fence(__ATOMIC_RELEASE, "agent");
            asm volatile("s_waitcnt vmcnt(0)" ::: "memory");
            const unsigned og = xb_add(&bar[XB_TOP], 1u);
            const unsigned tg = og / nx;
            if (og + 1u == (tg + 1u) * nx) xb_add(&bar[XB_TOPGEN], 1u);
            else XB_SPIN(xb_ld(&bar[XB_TOPGEN]) == tg, bar);
            __builtin_amdgcn_fence(__ATOMIC_ACQUIRE, "agent");
            xb_add(&bar[XB_XGEN(b.x)], 1u);
            asm volatile("s_waitcnt vmcnt(0)" ::: "memory");
        } else {
            XB_SPIN(xb_ld(&bar[XB_XGEN(b.x)]) == gen, bar);
            __builtin_amdgcn_fence(__ATOMIC_ACQUIRE, "agent");
            asm volatile("s_waitcnt vmcnt(0)" ::: "memory");
        }
#endif
    }
    __syncthreads();
}

struct Args {
    const float* x; const float* w_in_even; const float* w_out_even; const float* forget_bias; const float* w_in_odd; const float* w_out_odd;
    const float* lambda_q; const float* lambda_k; const float* subln_gain; const float* rel_bias; const float* w_router; const float* b_router;
    const float* w_gate; const float* w_up; const float* w_down; const float* ln_gain; const float* ln_bias;
    float* out; unsigned char* ws; int ph_lo, ph_hi;
};

struct P0Tile { const float* src; unsigned char* dst; int ldw, ldk, n0, gu; };
__device__ __forceinline__ P0Tile p0_decode(const Args& A, unsigned char* ws, int it) {
    constexpr int T_IN = 8 * 48, T_OUT = 8 * 16, T_EXP = 32 * 64;
    int r = it; const float* W; unsigned char* WT; int ldw, sc0, k0, ldk, n0, gu = 0;
    if (r < T_IN) { const int kb = r / 48, nb = r % 48; n0 = nb * 128; W = A.w_in_even; ldw = NIN0; sc0 = n0 + (n0 >= 3072 ? 8 : 0); k0 = kb * 256; WT = ws + WS_WIN0; ldk = DM; }
    else if (r < T_IN + T_OUT) { r -= T_IN; const int kb = r >> 4, nb = r & 15; n0 = nb * 128; W = A.w_out_even; ldw = DM; sc0 = n0; k0 = kb * 256; WT = ws + WS_WOUT0; ldk = DM; }
    else if (r < 2 * T_IN + T_OUT) { r -= T_IN + T_OUT; const int kb = r / 48, nb = r % 48; n0 = nb * 128; W = A.w_in_odd; ldw = NQKV; sc0 = n0; k0 = kb * 256; WT = ws + WS_WIN1; ldk = DM; }
    else if (r < 2 * T_IN + 2 * T_OUT) { r -= 2 * T_IN + T_OUT; const int kb = r >> 4, nb = r & 15; n0 = nb * 128; W = A.w_out_odd; ldw = DM; sc0 = n0; k0 = kb * 256; WT = ws + WS_WOUT1; ldk = DM; }
    else if (r < 2 * T_IN + 2 * T_OUT + 2 * T_EXP) {
        r -= 2 * T_IN + 2 * T_OUT; const int isup = r >= T_EXP; if (isup) r -= T_EXP;
        const int le = r >> 6, q = r & 63, kb = q >> 3, nb = q & 7; n0 = nb * 128;
        W = (isup ? A.w_up : A.w_gate) + (size_t)le * DM * DEXP; ldw = DEXP; sc0 = n0; k0 = kb * 256; WT = ws + WS_WGU + (size_t)le * 2048 * 2048; ldk = DM; gu = 1 + isup; }
    else { r -= 2 * T_IN + 2 * T_OUT + 2 * T_EXP; const int le = r >> 6, q = r & 63, kb = q >> 4, nb = q & 15; n0 = nb * 128;
        W = A.w_down + (size_t)le * DEXP * DM; ldw = DM; sc0 = n0; k0 = kb * 256; WT = ws + WS_WDN + (size_t)le * 2048 * 1024; ldk = DEXP; }
    P0Tile p; p.src = W + (size_t)k0 * ldw + sc0; p.dst = WT + k0; p.ldw = ldw; p.ldk = ldk; p.n0 = n0; p.gu = gu;
    return p;
}
__device__ __forceinline__ void p0_prologue(const Args& A, LAS unsigned char* lds, int G) {
    const int tid = fresh_tid(), lane = tid & 63, wave = __builtin_amdgcn_readfirstlane(tid >> 6);
    const int gw = blockIdx.x * NWAVES + wave, NGW = G * NWAVES;
    unsigned char* ws = A.ws;
    constexpr int NTILES = 2 * (16 * 24) + 2 * (16 * 8) + 3 * 32 * 64;
    f32x4 vA[16], vB[16];
    const int h = lane >> 5, c = lane & 31;
    int it = blockIdx.x, buf = 0;
#define P0_ISSUE(V, T) do { _Pragma("unroll") for (int i = 0; i < 16; ++i) V[i] = __builtin_nontemporal_load((const GAS f32x4*)((T).src + (size_t)(32 * wave + 16 * h + i) * (T).ldw + 4 * c)); } while (0)
#define P0_CONVERT(V, tb) do { _Pragma("unroll") for (int j = 0; j < 4; ++j) { v4u w; \
            w.x = pk4_fp8(V[0][j] * 32.f, V[1][j] * 32.f, V[2][j] * 32.f, V[3][j] * 32.f);     w.y = pk4_fp8(V[4][j] * 32.f, V[5][j] * 32.f, V[6][j] * 32.f, V[7][j] * 32.f); \
            w.z = pk4_fp8(V[8][j] * 32.f, V[9][j] * 32.f, V[10][j] * 32.f, V[11][j] * 32.f);  w.w = pk4_fp8(V[12][j] * 32.f, V[13][j] * 32.f, V[14][j] * 32.f, V[15][j] * 32.f); \
            *(LAS v4u*)((tb) + (4 * c + j) * 256 + (((2 * wave + h) ^ (c & 15)) * 16)) = w; } } while (0)
#define P0_WRITEOUT(T, tb) do { _Pragma("unroll") for (int p = 0; p < 4; ++p) { const int n = p * 32 + (tid >> 4), ch = tid & 15, nn = (T).n0 + n; \
            const v4u d = *(const LAS v4u*)((tb) + n * 256 + ((ch ^ ((n >> 2) & 15)) * 16)); \
            const int drow = (T).gu ? ((nn >> 7) * 256 + (nn & 127) + ((T).gu == 2 ? 128 : 0)) : nn; \
            *(GAS v4u*)((T).dst + (size_t)drow * (T).ldk + 16 * ch) = d; } } while (0)
    P0Tile cur = p0_decode(A, ws, it < NTILES ? it : 0);
    if (it < NTILES) P0_ISSUE(vA, cur);
    for (; it < NTILES; it += 2 * G) {
        {   const int nit = it + G; const P0Tile nxt = p0_decode(A, ws, nit < NTILES ? nit : 0);
            if (nit < NTILES) P0_ISSUE(vB, nxt);
            LAS unsigned char* tb = lds + buf * 32768;
            P0_CONVERT(vA, tb);
            __syncthreads();
            P0_WRITEOUT(cur, tb);
            cur = nxt; buf ^= 1;
            if (nit >= NTILES) break; }
        {   const int nit = it + 2 * G; const P0Tile nxt = p0_decode(A, ws, nit < NTILES ? nit : 0);
            if (nit < NTILES) P0_ISSUE(vA, nxt);
            LAS unsigned char* tb = lds + buf * 32768;
            P0_CONVERT(vB, tb);
            __syncthreads();
            P0_WRITEOUT(cur, tb);
            cur = nxt; buf ^= 1; }
    }
#undef P0_ISSUE
#undef P0_CONVERT
#undef P0_WRITEOUT
    __syncthreads();
    LAS float* wfa = (LAS float*)lds;
    for (int idx = tid; idx < 8 * DM; idx += NTHREADS) { const int d = idx >> 3, j = idx & 7; wfa[j * DM + d] = A.w_in_even[(size_t)d * NIN0 + 3072 + j]; }
    __syncthreads();
    float* logf = (float*)(ws + WS_LOGF); bf16* xb = (bf16*)(ws + WS_XB);
    for (int m = gw; m < SEQ; m += 2 * NGW) {
        const int mB = (m + NGW < SEQ) ? m + NGW : m;
        const GAS f32x4* xr = (const GAS f32x4*)(A.x + (size_t)m * DM) + lane; const GAS f32x4* xrB = (const GAS f32x4*)(A.x + (size_t)mB * DM) + lane;
        f32x4 v[8], vB[8];
#pragma unroll
        for (int j = 0; j < 8; ++j) { v[j] = xr[64 * j]; vB[j] = xrB[64 * j]; }
        GAS unsigned* o8 = (GAS unsigned*)((unsigned char*)xb + (size_t)m * DM) + lane;
        GAS unsigned* o8B = (GAS unsigned*)((unsigned char*)xb + (size_t)mB * DM) + lane;
#pragma unroll
        for (int j = 0; j < 8; ++j) { o8[64 * j] = pk4_fp8(v[j].x, v[j].y, v[j].z, v[j].w); o8B[64 * j] = pk4_fp8(vB[j].x, vB[j].y, vB[j].z, vB[j].w); }
        float mine = 0.f, mineB = 0.f;
#pragma unroll 1
        for (int e = 0; e < 8; ++e) { float s = 0.f, sB = 0.f;
#pragma unroll
            for (int j = 0; j < 8; ++j) { const f32x4 w = *(const LAS f32x4*)(wfa + e * DM + 256 * j + 4 * lane);
                s += v[j].x * w.x + v[j].y * w.y + v[j].z * w.z + v[j].w * w.w; sB += vB[j].x * w.x + vB[j].y * w.y + vB[j].z * w.z + vB[j].w * w.w; }
            s = wave_sum(s); sB = wave_sum(sB); mine = (lane == e) ? s : mine; mineB = (lane == e) ? sB : mineB; }
        if (lane < 8) { const float fb = A.forget_bias[lane]; logf[lane * SEQ + m] = log_sigmoid(mine + fb); logf[lane * SEQ + mB] = log_sigmoid(mineB + fb); }
    }
    {
        float* lut = (float*)(ws + WS_LUT);
        for (int idx = blockIdx.x * NTHREADS + tid; idx < 8 * 1024; idx += G * NTHREADS) { const int hh = idx >> 10, d = idx & 1023;
            int b; if (d < 16) b = d; else { b = 16 + (int)(log((double)d / 16.0) / log(64.0) * 16.0 + 1e-9); b = b > 31 ? 31 : b; }
            lut[idx] = A.rel_bias[b * 8 + hh]; }
        if (tid == 0 && blockIdx.x == 0) { float s0 = 0.f, s1 = 0.f; for (int d = 0; d < 64; ++d) { s0 += A.lambda_q[d] * A.lambda_k[d]; s1 += A.lambda_q[64 + d] * A.lambda_k[64 + d]; }
            ((float*)(ws + WS_LAM))[0] = expf(s0) - expf(s1) + LAMBDA_INIT; }
    }
}

__device__ __forceinline__ void p2_kmean_cumsum(const Args& A, char* lds, int G) {
    const int tid = fresh_tid(), lane = tid & 63, wave = tid >> 6;
    const bf16* h = (const bf16*)(A.ws + WS_H);
    float* red = (float*)lds;
    for (int u = blockIdx.x; u < 1536; u += G) {
        if (u >= 1024) {
            const int v = u - 1024, hd = v >> 6, n = v & 63, c = tid & 15, g = tid >> 4; float mx = 0.f;
            for (int i = 0; i < 8; ++i) { const v4u w = *(const v4u*)(h + (size_t)(n * 256 + g + 32 * i) * NQKV + 1024 + hd * 128 + c * 8);
                float s = bflo(w.x) * bflo(w.x) + bfhi(w.x) * bfhi(w.x) + bflo(w.y) * bflo(w.y) + bfhi(w.y) * bfhi(w.y) + bflo(w.z) * bflo(w.z) + bfhi(w.z) * bfhi(w.z) + bflo(w.w) * bflo(w.w) + bfhi(w.w) * bfhi(w.w);
                s += __shfl_xor(s, 1); s += __shfl_xor(s, 2); s += __shfl_xor(s, 4); s += __shfl_xor(s, 8); mx = fmaxf(mx, s); }
            for (int o = 16; o < 64; o <<= 1) mx = fmaxf(mx, __shfl_xor(mx, o));
            if (lane == 0) atomicMax((unsigned*)(A.ws + WS_CTL) + 10496 + hd, __float_as_uint(mx));
        } else if (u < 512) {
            const int hd = u >> 6, n = u & 63, c = tid & 15, g = tid >> 4;
            float s[8] = {0, 0, 0, 0, 0, 0, 0, 0};
            for (int i = 0; i < 8; ++i) { const v4u w = *(const v4u*)(h + (size_t)(n * 256 + g + 32 * i) * NQKV + 4096 + hd * 128 + c * 8);
                s[0] += bflo(w.x); s[1] += bfhi(w.x); s[2] += bflo(w.y); s[3] += bfhi(w.y); s[4] += bflo(w.z); s[5] += bfhi(w.z); s[6] += bflo(w.w); s[7] += bfhi(w.w); }
            for (int j = 0; j < 8; ++j) red[g * 128 + c * 8 + j] = s[j];
            __syncthreads();
            if (tid < 128) { float t = 0.f; for (int gg = 0; gg < 32; ++gg) t += red[gg * 128 + tid]; ((float*)(A.ws + WS_KMEAN))[(size_t)u * 128 + tid] = t * (1.f / 256.f); }
            __syncthreads();
        } else {
            const int v = u - 512, hd = v >> 6, ch = v & 63;
            const float* lf = (const float*)(A.ws + WS_LOGF) + hd * SEQ + ch * 256;
            float x = (tid < 256) ? lf[tid] : 0.f;
            for (int o = 1; o < 64; o <<= 1) { const float y = __shfl_up(x, o); if (lane >= o) x += y; }
            if (lane == 63 && wave < 4) red[wave] = x;
            __syncthreads();
            if (tid < 256) { float pre = 0.f; for (int w = 0; w < wave; ++w) pre += red[w]; x += pre;
                ((float*)(A.ws + WS_CLOC))[hd * SEQ + ch * 256 + tid] = x;
                if (tid == 255) ((float*)(A.ws + WS_CTOT))[hd * 64 + ch] = x; }
            __syncthreads();
        }
    }
}

__device__ __forceinline__ void p3_gate_cfinal(const Args& A, char* lds, int G, int* sel) {
    const int tid = fresh_tid(), lane = tid & 63, wave = tid >> 6;
    const bf16* h = (const bf16*)(A.ws + WS_H);
    float* km = (float*)lds;
    float* scal = (float*)(lds + 65536); int* lcnt = (int*)(lds + 66560); int* gbs = lcnt + 64;
    for (int u = blockIdx.x; u < 1024; u += G) {
        if (u < 512) {
            const int hd = u >> 6, qb = (u & 256) ? 63 - (u & 63) : (u & 63);
            const float* kmg = (const float*)(A.ws + WS_KMEAN) + (size_t)hd * 64 * 128;
            for (int i = tid; i < qb * 128; i += NTHREADS) km[i] = kmg[i];
            if (tid < 64) lcnt[tid] = 0;
            __syncthreads();
            const int t = qb * 256 + (tid >> 1), dh = tid & 1;
            float q[64];
            { const bf16* qp = h + (size_t)t * NQKV + 3072 + hd * 128 + dh * 64;
#pragma unroll
              for (int i = 0; i < 8; ++i) { const v4u w = *(const v4u*)(qp + i * 8);
                q[i * 8 + 0] = bflo(w.x); q[i * 8 + 1] = bfhi(w.x); q[i * 8 + 2] = bflo(w.y); q[i * 8 + 3] = bfhi(w.y); q[i * 8 + 4] = bflo(w.z); q[i * 8 + 5] = bfhi(w.z); q[i * 8 + 6] = bflo(w.w); q[i * 8 + 7] = bfhi(w.w); } }
            float v0 = -3e38f, v1 = -3e38f, v2 = -3e38f; int i0 = 0, i1 = 1, i2 = 2;
            for (int n = 0; n < qb; ++n) {
                const float* kr = km + n * 128 + dh * 64; float s = 0.f;
#pragma unroll
                for (int d = 0; d < 64; d += 4) { const f32x4 kv = *(const f32x4*)(kr + d); s += q[d] * kv.x + q[d + 1] * kv.y + q[d + 2] * kv.z + q[d + 3] * kv.w; }
                s += __shfl_xor(s, 1);
                if (s > v0) { v2 = v1; i2 = i1; v1 = v0; i1 = i0; v0 = s; i0 = n; }
                else if (s > v1) { v2 = v1; i2 = i1; v1 = s; i1 = n; }
                else if (s > v2) { v2 = s; i2 = n; }
            }
            const int nsel = qb < 3 ? qb : 3;
            if (dh == 0) *(int4*)(sel + ((size_t)hd * SEQ + t) * 4) = make_int4(i0, i1, i2, nsel);
            int lp0 = 0, lp1 = 0, lp2 = 0;
            if (dh == 0) { if (nsel > 0) lp0 = atomicAdd(&lcnt[i0], 1); if (nsel > 1) lp1 = atomicAdd(&lcnt[i1], 1); if (nsel > 2) lp2 = atomicAdd(&lcnt[i2], 1); }
            __syncthreads();
            if (tid < 64) { const int c = lcnt[tid]; gbs[tid] = c > 0 ? (int)__hip_atomic_fetch_add((unsigned*)(A.ws + WS_CTL) + CW_MOBACNT + hd * 64 + tid, (unsigned)c, RLX_AGENT) : 0; }
            __syncthreads();
            if (dh == 0) { int* ml = (int*)((unsigned char*)A.out + (4u << 20)) + (size_t)hd * 64 * SEQ;
                if (nsel > 0) ml[(size_t)i0 * SEQ + gbs[i0] + lp0] = t * 4 + 0;
                if (nsel > 1) ml[(size_t)i1 * SEQ + gbs[i1] + lp1] = t * 4 + 1;
                if (nsel > 2) ml[(size_t)i2 * SEQ + gbs[i2] + lp2] = t * 4 + 2; }
            __syncthreads();
        } else {
            const int v = u - 512, hd = v >> 6, ch = v & 63;
            if (wave == 0) { float x = (lane < ch) ? ((const float*)(A.ws + WS_CTOT))[hd * 64 + lane] : 0.f; x = wave_sum(x); if (lane == 0) scal[0] = x; }
            __syncthreads();
            if (tid < 256) ((float*)(A.ws + WS_C))[hd * SEQ + ch * 256 + tid] = ((const float*)(A.ws + WS_CLOC))[hd * SEQ + ch * 256 + tid] + scal[0];
            __syncthreads();
        }
    }
}

template <int VAR>
__device__ __forceinline__ void naive_attn_unit(const Args& A, char* lds, int hd, int qblk, const int* sel) {
    const int tid = fresh_tid(), ql = tid >> 2, part = tid & 3;
    const int t0 = qblk * 128, t = t0 + ql;
    float* Ks = (float*)lds; float* Vs = Ks + 64 * 128; float* Cs = Vs + 64 * 128;
    const bf16* h = (const bf16*)(A.ws + WS_H); bf16* ob = (bf16*)(A.ws + WS_O);
    const int second = (VAR == 1 || VAR == 3) ? 1 : 0;
    const int qcol = second * 3072 + hd * 128, kcol = qcol + 1024, vcol = qcol + 2048, ocol = (second * 8 + hd) * 128;
    const float* cg = (const float*)(A.ws + WS_C) + hd * SEQ;
    const float* lut = (const float*)(A.ws + WS_LUT) + hd * 1024;
    float q[32];
    if (VAR != 2) { const bf16* qp = h + (size_t)t * NQKV + qcol + part * 32;
#pragma unroll
        for (int d = 0; d < 32; ++d) q[d] = bf2f(qp[d]); }
    else { const bf16* qp = h + (size_t)t * NQKV + qcol + part * 16;
#pragma unroll
        for (int d = 0; d < 16; ++d) { q[d] = bf2f(qp[d]); q[16 + d] = bf2f(qp[64 + d]); } }
    float o[32], o2[32];
#pragma unroll
    for (int d = 0; d < 32; ++d) { o[d] = 0.f; o2[d] = 0.f; }
    float m1 = -1e30f, l1 = 0.f, m2 = -1e30f, l2 = 0.f, R = 0.f;
    const float ct = (VAR == 0) ? cg[t] : 0.f;
    int s0 = -1, s1 = -1, s2 = -1;
    if (VAR == 1) { const int4 sv = *(const int4*)(sel + ((size_t)hd * SEQ + t) * 4); if (sv.w > 0) s0 = sv.x; if (sv.w > 1) s1 = sv.y; if (sv.w > 2) s2 = sv.z; }
    const int own = t >> 8;
    const int jmax = (t0 + 127) >> 6;
    for (int jj = 0; jj <= jmax; ++jj) {
        const int j = (VAR == 3) ? (jmax - jj) : jj;
        __syncthreads();
        for (int idx = tid; idx < 1024; idx += NTHREADS) { const int row = idx >> 4, c8 = (idx & 15) * 8;
            const v4u kw = *(const v4u*)(h + (size_t)(j * 64 + row) * NQKV + kcol + c8); const v4u vw = *(const v4u*)(h + (size_t)(j * 64 + row) * NQKV + vcol + c8);
            float* kd = Ks + row * 128 + c8; float* vd = Vs + row * 128 + c8;
            kd[0] = bflo(kw.x); kd[1] = bfhi(kw.x); kd[2] = bflo(kw.y); kd[3] = bfhi(kw.y); kd[4] = bflo(kw.z); kd[5] = bfhi(kw.z); kd[6] = bflo(kw.w); kd[7] = bfhi(kw.w);
            vd[0] = bflo(vw.x); vd[1] = bfhi(vw.x); vd[2] = bflo(vw.y); vd[3] = bfhi(vw.y); vd[4] = bflo(vw.z); vd[5] = bfhi(vw.z); vd[6] = bflo(vw.w); vd[7] = bfhi(vw.w); }
        if (VAR == 0 && tid < 64) Cs[tid] = cg[j * 64 + tid];
        __syncthreads();
        for (int ss = 0; ss < 64; ++ss) {
            const int s = (VAR == 3) ? (63 - ss) : ss; const int ks = j * 64 + s;
            float d1 = 0.f, d2 = 0.f;
            if (VAR != 2) { const float* kr = Ks + s * 128 + part * 32;
#pragma unroll
                for (int d = 0; d < 32; d += 4) { const f32x4 kv = *(const f32x4*)(kr + d); d1 += q[d] * kv.x + q[d + 1] * kv.y + q[d + 2] * kv.z + q[d + 3] * kv.w; } }
            else { const float* kr = Ks + s * 128 + part * 16;
#pragma unroll
                for (int d = 0; d < 16; d += 4) { const f32x4 ka = *(const f32x4*)(kr + d); const f32x4 kb = *(const f32x4*)(kr + 64 + d);
                    d1 += q[d] * ka.x + q[d + 1] * ka.y + q[d + 2] * ka.z + q[d + 3] * ka.w; d2 += q[16 + d] * kb.x + q[17 + d] * kb.y + q[18 + d] * kb.z + q[19 + d] * kb.w; } }
            d1 += __shfl_xor(d1, 1); d1 += __shfl_xor(d1, 2);
            if (VAR == 2) { d2 += __shfl_xor(d2, 1); d2 += __shfl_xor(d2, 2); }
            const float* vr = Vs + s * 128 + part * 32;
            if (VAR == 0 || VAR == 1) {
                bool valid; float sc;
                if (VAR == 0) { valid = ks <= t; sc = d1 * SCALE128 + (ct - Cs[s]); }
                else { const int nb = ks >> 8; valid = (nb == own && ks <= t) || nb == s0 || nb == s1 || nb == s2; const int dist = t - ks; sc = d1 * SCALE128 + lut[dist < 0 ? 0 : (dist > 1023 ? 1023 : dist)]; }
                if (valid) { const float mn = fmaxf(m1, sc), al = __expf(m1 - mn), p = __expf(sc - mn); l1 = l1 * al + p; m1 = mn;
#pragma unroll
                    for (int d = 0; d < 32; ++d) o[d] = o[d] * al + p * vr[d]; }
            } else if (VAR == 2) {
                if (ks <= t) { const float bias = lut[(t - ks) > 1023 ? 1023 : (t - ks)];
                    const float sa = d1 * SCALE64 + bias, sb = d2 * SCALE64 + bias;
                    const float mna = fmaxf(m1, sa), ala = __expf(m1 - mna), pa = __expf(sa - mna); l1 = l1 * ala + pa; m1 = mna;
                    const float mnb = fmaxf(m2, sb), alb = __expf(m2 - mnb), pb = __expf(sb - mnb); l2 = l2 * alb + pb; m2 = mnb;
#pragma unroll
                    for (int d = 0; d < 32; ++d) { const float vv = vr[d]; o[d] = o[d] * ala + pa * vv; o2[d] = o2[d] * alb + pb * vv; } }
            } else {
                if (ks < t) { const float z = d1 * SCALE128; float a = __expf(log_sigmoid(z) + R); R += log_sigmoid(-z);
#if SB_TRIVIAL
                    a = 0.015625f;
#endif

#pragma unroll
                    for (int d = 0; d < 32; ++d) o[d] += a * vr[d]; }
            }
        }
    }
    if (VAR == 0 || VAR == 1) { const float il = 1.f / l1;
#pragma unroll
        for (int d = 0; d < 32; ++d) o[d] *= il; }
    if (VAR == 2) { const float lam = ((const float*)(A.ws + WS_LAM))[0]; const float i1 = 1.f / l1, i2 = lam / l2; float ss = 0.f;
#pragma unroll
        for (int d = 0; d < 32; ++d) { o[d] = o[d] * i1 - o2[d] * i2; ss += o[d] * o[d]; }
        ss += __shfl_xor(ss, 1); ss += __shfl_xor(ss, 2);
        const float r = rsqrtf(ss * (1.f / 128.f) + LN_EPS) * (1.f - LAMBDA_INIT);
#pragma unroll
        for (int d = 0; d < 32; ++d) o[d] = o[d] * r * A.subln_gain[part * 32 + d]; }
    bf16* op = ob + (size_t)t * DM + ocol + part * 32;
#pragma unroll
    for (int d = 0; d < 32; d += 2) *(unsigned*)(op + d) = pk2(o[d], o[d + 1]);
}

constexpr int CW_Q4 = 10560, CW_Q12 = 10752, CW_QM = 10944;
__device__ __forceinline__ int next_item(const Args& A, int cw, LAS int* slot) {
    __syncthreads();
    if (threadIdx.x == 0) *slot = (int)__hip_atomic_fetch_add((unsigned*)(A.ws + WS_CTL) + cw, 1u, RLX_AGENT);
    __syncthreads();
    return *slot;
}


#ifndef SB_R2PROBE
#define SB_R2PROBE 0
#endif
#ifndef FRESH_W
#define FRESH_W 1
#endif
#ifndef FRESH_ALL
#define FRESH_ALL 0
#endif
#ifndef PV_FILL
#define PV_FILL 5
#endif
#ifndef FOX_CH
#define FOX_CH 16
#endif
#ifndef SB_NOCHUNK
#define SB_NOCHUNK 0
#endif
#ifndef SB_TRIVIAL
#define SB_TRIVIAL 0
#endif
namespace att {
typedef float f32x16 __attribute__((ext_vector_type(16)));
typedef short s16x4 __attribute__((ext_vector_type(4)));
constexpr int PITCH = NQKV;
constexpr int SHM_V = 16384, SHM_K = 16384;
constexpr int L_V = 0, L_K = 2 * SHM_V, L_WS = L_K + 2 * SHM_K, L_KB = L_WS + NWAVES * 64 * 4, L_FLAG = L_KB + 512, L_LUT = L_FLAG + 512, LUT_PAD = 320, LUT_N = LUT_PAD + 1024,
              L_STASH = L_LUT + LUT_N * 4 + 256, L_END = L_STASH + 65536;
static_assert(L_STASH % 16 == 0 && L_END <= RING_BYTES, "attention LDS map");
constexpr float THR = 8.f;
#define KSWZ(row, colB) ((row) * 256 + ((colB) ^ (((row) & 7) << 4)))
#define SBAR() __builtin_amdgcn_sched_barrier(0)
__device__ __forceinline__ int v_st(int k, int c) { const int kk = (k & ~0xC) | ((k & 4) << 1) | ((k & 8) >> 1); return ((kk >> 3) * 4 + (c >> 5)) * 512 + ((kk & 7) * 32 + (c & 31)) * 2; }
__device__ __forceinline__ int v_rd_base(int lane) { return ((lane & 3) << 3) | (((lane >> 2) & 3) << 6) | (((lane >> 4) & 1) << 5) | (((lane >> 5) & 1) << 8); }
constexpr int v_rd_off(int d0, int ks, int half) { return d0 * 512 + ks * 4096 + half * 2048; }
__device__ __forceinline__ int crow(int r, int hi) { return (r & 3) + 8 * (r >> 2) + 4 * hi; }
typedef __bf16 bf16x2_t __attribute__((ext_vector_type(2)));
typedef float f32x2_t __attribute__((ext_vector_type(2)));
__device__ __forceinline__ unsigned cvtpk(float lo, float hi) { f32x2_t v = {lo, hi}; bf16x2_t b = __builtin_convertvector(v, bf16x2_t); return __builtin_bit_cast(unsigned, b); }

template <int DQ> __device__ __forceinline__ void partialSM(f32x16& p0, f32x16& p1, float& m_reg, float& mn, float& alpha) {
    constexpr float SC = (DQ == 128) ? SCALE128 : SCALE64; constexpr float C2 = 1.4426950408889634f * SC;
    float pmax = p0[0]; for (int r = 1; r < 16; ++r) pmax = fmaxf(pmax, p0[r]); for (int r = 0; r < 16; ++r) pmax = fmaxf(pmax, p1[r]);
    { auto rr = __builtin_amdgcn_permlane32_swap(__float_as_uint(pmax), __float_as_uint(pmax), false, false);
      pmax = fmaxf(__uint_as_float(rr[0]), __uint_as_float(rr[1])); }
    if (__builtin_expect(__all((pmax - m_reg) * SC <= THR), 1)) { mn = m_reg; alpha = 1.f; }
    else { mn = fmaxf(m_reg, pmax); alpha = __builtin_amdgcn_exp2f((m_reg - mn) * C2); m_reg = mn; }
    const float mnL = -mn * C2;
    for (int r = 0; r < 16; ++r) p0[r] = fmaf(p0[r], C2, mnL); for (int r = 0; r < 16; ++r) p1[r] = fmaf(p1[r], C2, mnL);
    __builtin_amdgcn_sched_barrier(0);
    for (int r = 0; r < 16; ++r) p0[r] = __builtin_amdgcn_exp2f(p0[r]);
}
#define PK4(P, B_, OUT) do { unsigned a0 = cvtpk(P[B_+0], P[B_+1]), a1 = cvtpk(P[B_+2], P[B_+3]);                          \
        unsigned b0 = cvtpk(P[B_+4], P[B_+5]), b1 = cvtpk(P[B_+6], P[B_+7]);                                             \
        auto r0 = __builtin_amdgcn_permlane32_swap(a0, b0, false, false); auto r1 = __builtin_amdgcn_permlane32_swap(a1, b1, false, false); \
        pg8::u32x4 w = {r0[0], r1[0], r0[1], r1[1]}; OUT = *reinterpret_cast<bf16x8*>(&w); } while (0)
__device__ __forceinline__ void finishSM(f32x16& p0, f32x16& p1, float alpha, float& l_reg, bf16x8& pa0, bf16x8& pa1, bf16x8& pa2, bf16x8& pa3) {
    for (int r = 0; r < 16; ++r) p1[r] = __builtin_amdgcn_exp2f(p1[r]);
    __builtin_amdgcn_sched_barrier(0);
    float s0 = 0.f, s1 = 0.f, s2 = 0.f, s3 = 0.f;
    for (int r = 0; r < 16; r += 4) { s0 += p0[r]; s1 += p0[r + 1]; s2 += p0[r + 2]; s3 += p0[r + 3]; }
    for (int r = 0; r < 16; r += 4) { s0 += p1[r]; s1 += p1[r + 1]; s2 += p1[r + 2]; s3 += p1[r + 3]; }
    float ps = (s0 + s1) + (s2 + s3);
    { auto rr = __builtin_amdgcn_permlane32_swap(__float_as_uint(ps), __float_as_uint(ps), false, false);
      ps = __uint_as_float(rr[0]) + __uint_as_float(rr[1]); }
    l_reg = l_reg * alpha + ps;
    PK4(p0, 0, pa0); PK4(p0, 8, pa1); PK4(p1, 0, pa2); PK4(p1, 8, pa3);
}
__device__ __forceinline__ void sb_half(f32x16& p, float& R2, int hi) {
#if SB_TRIVIAL
#pragma unroll
    for (int r = 0; r < 16; ++r) p[r] = (p[r] < -1e37f) ? 0.f : 0.015625f;
    return;
#endif
    constexpr float C2 = 1.4426950408889634f * SCALE128;
    float T = R2;
#pragma unroll
    for (int g = 3; g >= 0; --g) { float z[4], lr[4];
#pragma unroll
        for (int e = 0; e < 4; ++e) { z[e] = p[4 * g + e] * C2; lr[e] = -(fmaxf(z[e], 0.f) + __builtin_amdgcn_logf(1.f + __builtin_amdgcn_exp2f(-fabsf(z[e])))); }
        const float G = (lr[0] + lr[1]) + (lr[2] + lr[3]);
        auto rr = __builtin_amdgcn_permlane32_swap(__float_as_uint(G), __float_as_uint(G), false, false);
        const float Go = hi ? __uint_as_float(rr[0]) : __uint_as_float(rr[1]);
        float a = T + (hi ? 0.f : Go);
        p[4 * g + 3] = __builtin_amdgcn_exp2f(z[3] + lr[3] + a); a += lr[3];
        p[4 * g + 2] = __builtin_amdgcn_exp2f(z[2] + lr[2] + a); a += lr[2];
        p[4 * g + 1] = __builtin_amdgcn_exp2f(z[1] + lr[1] + a); a += lr[1];
        p[4 * g + 0] = __builtin_amdgcn_exp2f(z[0] + lr[0] + a);
        T += G + Go; }
    R2 = T;
}
__device__ __forceinline__ void sb_pack(f32x16& p0, f32x16& p1, bf16x8& pa0, bf16x8& pa1, bf16x8& pa2, bf16x8& pa3) { PK4(p0, 0, pa0); PK4(p0, 8, pa1); PK4(p1, 0, pa2); PK4(p1, 8, pa3); }
template <int DQ> __device__ __forceinline__ void softmaxY(f32x16& p0, f32x16& p1, float& m_reg, float& alpha, float& l_reg, bf16x8& pa0, bf16x8& pa1, bf16x8& pa2, bf16x8& pa3) {
    constexpr float SC = (DQ == 128) ? SCALE128 : SCALE64; constexpr float C2 = 1.4426950408889634f * SC;
    float pmax = p0[0]; for (int r = 1; r < 16; ++r) pmax = fmaxf(pmax, p0[r]); for (int r = 0; r < 16; ++r) pmax = fmaxf(pmax, p1[r]);
    { auto rr = __builtin_amdgcn_permlane32_swap(__float_as_uint(pmax), __float_as_uint(pmax), false, false);
      pmax = fmaxf(__uint_as_float(rr[0]), __uint_as_float(rr[1])); }
    float mn;
    if (__builtin_expect(__all((pmax - m_reg) * SC <= THR), 1)) { mn = m_reg; alpha = 1.f; }
    else { mn = fmaxf(m_reg, pmax); alpha = __builtin_amdgcn_exp2f((m_reg - mn) * C2); m_reg = mn; }
    const float mnL = -mn * C2;
    for (int r = 0; r < 16; ++r) p0[r] = fmaf(p0[r], C2, mnL); for (int r = 0; r < 16; ++r) p1[r] = fmaf(p1[r], C2, mnL);
    __builtin_amdgcn_sched_barrier(0);
    for (int r = 0; r < 16; ++r) p0[r] = __builtin_amdgcn_exp2f(p0[r]); for (int r = 0; r < 16; ++r) p1[r] = __builtin_amdgcn_exp2f(p1[r]);
    __builtin_amdgcn_sched_barrier(0);
    float s0 = 0.f, s1 = 0.f, s2 = 0.f, s3 = 0.f;
    for (int r = 0; r < 16; r += 4) { s0 += p0[r]; s1 += p0[r + 1]; s2 += p0[r + 2]; s3 += p0[r + 3]; }
    for (int r = 0; r < 16; r += 4) { s0 += p1[r]; s1 += p1[r + 1]; s2 += p1[r + 2]; s3 += p1[r + 3]; }
    float ps = (s0 + s1) + (s2 + s3);
    { auto rr = __builtin_amdgcn_permlane32_swap(__float_as_uint(ps), __float_as_uint(ps), false, false);
      ps = __uint_as_float(rr[0]) + __uint_as_float(rr[1]); }
    l_reg = l_reg * alpha + ps;
    PK4(p0, 0, pa0); PK4(p0, 8, pa1); PK4(p1, 0, pa2); PK4(p1, 8, pa3);
}
#undef PK4

template <int KB, int DQ, bool INITC = false>
__device__ __forceinline__ void qkt(f32x16& p0, f32x16& p1, const LAS char* K_lds, int r32, int hi, const bf16x8* qr) {
    if constexpr (!INITC) { p0 = f32x16{}; p1 = f32x16{}; }
    unsigned ka[4];
#pragma unroll
    for (int dd = 0; dd < 4; ++dd) ka[dd] = (unsigned)(uintptr_t)(K_lds + KB * SHM_K + KSWZ(r32, (dd * 16 + hi * 8) * 2));
    bf16x8 fa0, fa1, fb0, fb1, fc0, fc1;
#define KRD(dst, dd, off) asm volatile("ds_read_b128 %0, %1 offset:%2" : "=&v"(dst) : "v"(ka[dd]), "i"(off) : "memory")
#define KRD2(n0, n1, d) do { KRD(n0, (d) & 3, ((d) >> 2) * 128); KRD(n1, (d) & 3, ((d) >> 2) * 128 + 32 * 256); } while (0)
#define KWAITN(N, x0, x1) do { asm volatile("s_waitcnt lgkmcnt(" #N ")" : "+v"(x0), "+v"(x1) :: "memory"); __builtin_amdgcn_sched_barrier(0x406); } while (0)
#define KSTEP3(d0, c0, c1, n0, n1) do { if constexpr ((d0) + 1 < DQ / 16) KWAITN(2, c0, c1); else KWAITN(0, c0, c1); \
        if constexpr ((d0) + 2 < DQ / 16) KRD2(n0, n1, (d0) + 2); \
        p0 = __builtin_amdgcn_mfma_f32_32x32x16_bf16(c0, qr[d0], p0, 0, 0, 0); p1 = __builtin_amdgcn_mfma_f32_32x32x16_bf16(c1, qr[d0], p1, 0, 0, 0); } while (0)
    KRD2(fa0, fa1, 0); KRD2(fb0, fb1, 1);
    KSTEP3(0, fa0, fa1, fc0, fc1); KSTEP3(1, fb0, fb1, fa0, fa1); KSTEP3(2, fc0, fc1, fb0, fb1); KSTEP3(3, fa0, fa1, fc0, fc1);
    if constexpr (DQ == 128) { KSTEP3(4, fb0, fb1, fa0, fa1); KSTEP3(5, fc0, fc1, fb0, fb1); KSTEP3(6, fa0, fa1, fc0, fc1); KSTEP3(7, fb0, fb1, fa0, fa1); }
#undef KSTEP3
#undef KWAITN
#undef KRD2
#undef KRD
}
template <int VB>
__device__ __forceinline__ void pv_tile2(f32x16* o, int vb0, bf16x8 pa0, bf16x8 pa1, bf16x8 pa2, bf16x8 pa3) {
#define TRRD(dst, off) asm volatile("ds_read_b64_tr_b16 %0, %1 offset:%2" : "=&v"(dst) : "v"(vb0), "i"(off) : "memory")
#define PV_RD(d0, P) constexpr int b##P = VB * SHM_V + v_rd_off(d0, 0, 0); s16x4 l0##P, l1##P, l2##P, l3##P, h0##P, h1##P, h2##P, h3##P; \
        TRRD(l0##P, b##P); TRRD(h0##P, b##P + 2048); TRRD(l1##P, b##P + 4096); TRRD(h1##P, b##P + 6144); TRRD(l2##P, b##P + 8192); TRRD(h2##P, b##P + 10240); TRRD(l3##P, b##P + 12288); TRRD(h3##P, b##P + 14336)
#define PV_MM(d0, P) do { \
        o[d0] = __builtin_amdgcn_mfma_f32_32x32x16_bf16(pa0, (bf16x8){l0##P[0], l0##P[1], l0##P[2], l0##P[3], h0##P[0], h0##P[1], h0##P[2], h0##P[3]}, o[d0], 0, 0, 0);   \
        o[d0] = __builtin_amdgcn_mfma_f32_32x32x16_bf16(pa1, (bf16x8){l1##P[0], l1##P[1], l1##P[2], l1##P[3], h1##P[0], h1##P[1], h1##P[2], h1##P[3]}, o[d0], 0, 0, 0);   \
        o[d0] = __builtin_amdgcn_mfma_f32_32x32x16_bf16(pa2, (bf16x8){l2##P[0], l2##P[1], l2##P[2], l2##P[3], h2##P[0], h2##P[1], h2##P[2], h2##P[3]}, o[d0], 0, 0, 0);   \
        o[d0] = __builtin_amdgcn_mfma_f32_32x32x16_bf16(pa3, (bf16x8){l3##P[0], l3##P[1], l3##P[2], l3##P[3], h3##P[0], h3##P[1], h3##P[2], h3##P[3]}, o[d0], 0, 0, 0); } while (0)
#define PV_WAIT() asm volatile("s_waitcnt lgkmcnt(0)" : "+v"(l0A), "+v"(l1A), "+v"(l2A), "+v"(l3A), "+v"(h0A), "+v"(h1A), "+v"(h2A), "+v"(h3A), \
        "+v"(l0B), "+v"(l1B), "+v"(l2B), "+v"(l3B), "+v"(h0B), "+v"(h1B), "+v"(h2B), "+v"(h3B) :: "memory")
    { PV_RD(0, A); PV_RD(1, B); PV_WAIT(); SBAR(); PV_MM(0, A); PV_MM(1, B); SBAR(); }
    { PV_RD(2, A); PV_RD(3, B); PV_WAIT(); SBAR(); PV_MM(2, A); PV_MM(3, B); }
#undef PV_WAIT
#undef PV_RD
#undef PV_MM
#undef TRRD
}
template <int VB>
__device__ __forceinline__ void pv_tile(f32x16* o, int vb0, bf16x8 pa0, bf16x8 pa1, bf16x8 pa2, bf16x8 pa3) {
#define TRRD(dst, off) asm volatile("ds_read_b64_tr_b16 %0, %1 offset:%2" : "=&v"(dst) : "v"(vb0), "i"(off) : "memory")
#define PV_D0(d0) do { s16x4 l0, l1, l2, l3, h0, h1, h2, h3; constexpr int b_ = VB * SHM_V + v_rd_off(d0, 0, 0); \
        TRRD(l0, b_); TRRD(h0, b_ + 2048); TRRD(l1, b_ + 4096); TRRD(h1, b_ + 6144); TRRD(l2, b_ + 8192); TRRD(h2, b_ + 10240); TRRD(l3, b_ + 12288); TRRD(h3, b_ + 14336); \
        asm volatile("s_waitcnt lgkmcnt(0)" : "+v"(l0), "+v"(l1), "+v"(l2), "+v"(l3), "+v"(h0), "+v"(h1), "+v"(h2), "+v"(h3) :: "memory"); __builtin_amdgcn_sched_barrier(0x406);     \
        o[d0] = __builtin_amdgcn_mfma_f32_32x32x16_bf16(pa0, (bf16x8){l0[0], l0[1], l0[2], l0[3], h0[0], h0[1], h0[2], h0[3]}, o[d0], 0, 0, 0);   \
        o[d0] = __builtin_amdgcn_mfma_f32_32x32x16_bf16(pa1, (bf16x8){l1[0], l1[1], l1[2], l1[3], h1[0], h1[1], h1[2], h1[3]}, o[d0], 0, 0, 0);   \
        o[d0] = __builtin_amdgcn_mfma_f32_32x32x16_bf16(pa2, (bf16x8){l2[0], l2[1], l2[2], l2[3], h2[0], h2[1], h2[2], h2[3]}, o[d0], 0, 0, 0);   \
        o[d0] = __builtin_amdgcn_mfma_f32_32x32x16_bf16(pa3, (bf16x8){l3[0], l3[1], l3[2], l3[3], h3[0], h3[1], h3[2], h3[3]}, o[d0], 0, 0, 0); \
        _Pragma("unroll") for (int g_ = 0; g_ < 4; ++g_) { __builtin_amdgcn_sched_group_barrier(0x8, 1, 0); __builtin_amdgcn_sched_group_barrier(0x2, PV_FILL, 0); } } while (0)
    PV_D0(0); PV_D0(1); PV_D0(2); PV_D0(3);
#undef PV_D0
#undef TRRD
}

template <int VB, int KB, int DQ, bool DOQK>
__device__ __forceinline__ void xphase(f32x16* o, int vb0, bf16x8 pa0, bf16x8 pa1, bf16x8 pa2, bf16x8 pa3, f32x16& p0, f32x16& p1, const LAS char* K_lds, int r32, int hi, const bf16x8* qr) {
#define TRRD(dst, off) asm volatile("ds_read_b64_tr_b16 %0, %1 offset:%2" : "=&v"(dst) : "v"(vb0), "i"(off) : "memory")
#define XRD(d0, P) do { constexpr int b_ = VB * SHM_V + v_rd_off(d0, 0, 0); TRRD(l0##P, b_); TRRD(h0##P, b_ + 2048); TRRD(l1##P, b_ + 4096); TRRD(h1##P, b_ + 6144); \
        TRRD(l2##P, b_ + 8192); TRRD(h2##P, b_ + 10240); TRRD(l3##P, b_ + 12288); TRRD(h3##P, b_ + 14336); } while (0)
#define XWAIT(P) do { asm volatile("s_waitcnt lgkmcnt(0)" : "+v"(l0##P), "+v"(l1##P), "+v"(l2##P), "+v"(l3##P), "+v"(h0##P), "+v"(h1##P), "+v"(h2##P), "+v"(h3##P) :: "memory"); SBAR(); } while (0)
#define XMM(d0, P) do { \
        o[d0] = __builtin_amdgcn_mfma_f32_32x32x16_bf16(pa0, (bf16x8){l0##P[0], l0##P[1], l0##P[2], l0##P[3], h0##P[0], h0##P[1], h0##P[2], h0##P[3]}, o[d0], 0, 0, 0); \
        o[d0] = __builtin_amdgcn_mfma_f32_32x32x16_bf16(pa1, (bf16x8){l1##P[0], l1##P[1], l1##P[2], l1##P[3], h1##P[0], h1##P[1], h1##P[2], h1##P[3]}, o[d0], 0, 0, 0); \
        o[d0] = __builtin_amdgcn_mfma_f32_32x32x16_bf16(pa2, (bf16x8){l2##P[0], l2##P[1], l2##P[2], l2##P[3], h2##P[0], h2##P[1], h2##P[2], h2##P[3]}, o[d0], 0, 0, 0); \
        o[d0] = __builtin_amdgcn_mfma_f32_32x32x16_bf16(pa3, (bf16x8){l3##P[0], l3##P[1], l3##P[2], l3##P[3], h3##P[0], h3##P[1], h3##P[2], h3##P[3]}, o[d0], 0, 0, 0); SBAR(); } while (0)
    s16x4 l0A, l1A, l2A, l3A, h0A, h1A, h2A, h3A, l0B, l1B, l2B, l3B, h0B, h1B, h2B, h3B;
    unsigned ka[4];
#pragma unroll
    for (int dd = 0; dd < 4; ++dd) ka[dd] = (unsigned)(uintptr_t)(K_lds + KB * SHM_K + KSWZ(r32, (dd * 16 + hi * 8) * 2));
    bf16x8 fa0, fa1, fb0, fb1;
#define KRD(dst, dd, off) asm volatile("ds_read_b128 %0, %1 offset:%2" : "=&v"(dst) : "v"(ka[dd]), "i"(off) : "memory")
#define KWAIT(x0, x1) do { asm volatile("s_waitcnt lgkmcnt(0)" : "+v"(x0), "+v"(x1) :: "memory"); __builtin_amdgcn_sched_barrier(0x406); } while (0)
#define KSTEP(d0, c0, c1, n0, n1) do { KWAIT(c0, c1); \
        if constexpr ((d0) + 1 < DQ / 16) { KRD(n0, ((d0) + 1) & 3, (((d0) + 1) >> 2) * 128); KRD(n1, ((d0) + 1) & 3, (((d0) + 1) >> 2) * 128 + 32 * 256); } \
        p0 = __builtin_amdgcn_mfma_f32_32x32x16_bf16(c0, qr[d0], p0, 0, 0, 0); p1 = __builtin_amdgcn_mfma_f32_32x32x16_bf16(c1, qr[d0], p1, 0, 0, 0); } while (0)
    XRD(0, A); SBAR();
    XWAIT(A); XRD(1, B); SBAR(); XMM(0, A);
    XWAIT(B); XRD(2, A); SBAR(); XMM(1, B);
    XWAIT(A); XRD(3, B); SBAR(); XMM(2, A);
    if constexpr (DOQK && DQ == 64) {
        bf16x8 fc0, fc1, fd0, fd1;
        XWAIT(B); KRD(fa0, 0, 0); KRD(fa1, 0, 32 * 256); KRD(fb0, 1, 0); KRD(fb1, 1, 32 * 256); SBAR(); XMM(3, B);
        asm volatile("s_waitcnt lgkmcnt(0)" : "+v"(fa0), "+v"(fa1), "+v"(fb0), "+v"(fb1) :: "memory"); SBAR();
        KRD(fc0, 2, 0); KRD(fc1, 2, 32 * 256); SBAR();
        p0 = f32x16{}; p1 = f32x16{};
        p0 = __builtin_amdgcn_mfma_f32_32x32x16_bf16(fa0, qr[0], p0, 0, 0, 0); p1 = __builtin_amdgcn_mfma_f32_32x32x16_bf16(fa1, qr[0], p1, 0, 0, 0); SBAR();
        KRD(fd0, 3, 0); KRD(fd1, 3, 32 * 256); SBAR();
        p0 = __builtin_amdgcn_mfma_f32_32x32x16_bf16(fb0, qr[1], p0, 0, 0, 0); p1 = __builtin_amdgcn_mfma_f32_32x32x16_bf16(fb1, qr[1], p1, 0, 0, 0); SBAR();
        asm volatile("s_waitcnt lgkmcnt(2)" : "+v"(fc0), "+v"(fc1) :: "memory"); SBAR();
        p0 = __builtin_amdgcn_mfma_f32_32x32x16_bf16(fc0, qr[2], p0, 0, 0, 0); p1 = __builtin_amdgcn_mfma_f32_32x32x16_bf16(fc1, qr[2], p1, 0, 0, 0); SBAR();
        asm volatile("s_waitcnt lgkmcnt(0)" : "+v"(fd0), "+v"(fd1) :: "memory"); SBAR();
        p0 = __builtin_amdgcn_mfma_f32_32x32x16_bf16(fd0, qr[3], p0, 0, 0, 0); p1 = __builtin_amdgcn_mfma_f32_32x32x16_bf16(fd1, qr[3], p1, 0, 0, 0);
    } else {
    XWAIT(B); if constexpr (DOQK) { KRD(fa0, 0, 0); KRD(fa1, 0, 32 * 256); SBAR(); } XMM(3, B);
    if constexpr (DOQK) {
        p0 = f32x16{}; p1 = f32x16{};
        KSTEP(0, fa0, fa1, fb0, fb1); KSTEP(1, fb0, fb1, fa0, fa1); KSTEP(2, fa0, fa1, fb0, fb1); KSTEP(3, fb0, fb1, fa0, fa1);
        if constexpr (DQ == 128) { KSTEP(4, fa0, fa1, fb0, fb1); KSTEP(5, fb0, fb1, fa0, fa1); KSTEP(6, fa0, fa1, fb0, fb1); KSTEP(7, fb0, fb1, fa0, fa1); }
    }
    }
#undef KSTEP
#undef KWAIT
#undef KRD
#undef XMM
#undef XWAIT
#undef XRD
#undef TRRD
}

struct ChunkArgs {
    const bf16* hbase; unsigned kcolB, vcolB;
    int ja, jb;
    int qpos;
    int qlo;
    const float* cb; float cref;
    float* tprobe;
};
#ifndef TIME_SEG
#define TIME_SEG 0
#endif
#ifndef PP_DIFF
#define PP_DIFF 1
#endif
#ifndef PP_SB
#define PP_SB 0
#endif
#ifndef MOBA_RES
#define MOBA_RES 1
#endif
#ifndef FOX_RES
#define FOX_RES 1
#endif
#ifndef GATE_MFMA
#define GATE_MFMA 1
#endif
#ifndef DIFF_RES
#define DIFF_RES 0
#endif
#ifndef SB_RES
#define SB_RES 1
#endif
#ifndef RES_PVDB
#define RES_PVDB 0
#endif
#ifndef PP_XPRIO
#define PP_XPRIO 0
#endif
#ifndef PP_YPRIO
#define PP_YPRIO 1
#endif
#ifndef PP_LAUNDER
#define PP_LAUNDER 0
#endif
template <int DQ, int MODE, bool REV>
__device__ __forceinline__ void attn_chunk(const ChunkArgs& a, const bf16x8* qr, float& m_reg, float& l_reg, f32x16* o, LAS char* lds) {
    int tid_ = threadIdx.x; asm volatile("" : "+v"(tid_)); const int tid = tid_, wid = __builtin_amdgcn_readfirstlane(tid >> 6), lane = tid & 63, r32 = lane & 31, hi = lane >> 5;
    const int NT = a.jb - a.ja;
    LAS char* V_lds = lds + L_V; LAS char* K_lds = lds + L_K;
    LAS float* ws = (LAS float*)(lds + L_WS) + wid * 64; LAS float* al_l = ws + 32;
    LAS float* kbl = (LAS float*)(lds + L_KB); const LAS float* lutl = (const LAS float*)(lds + L_LUT);
    const int vb0 = (int)(uintptr_t)V_lds + v_rd_base(lane);
    const __amdgpu_buffer_rsrc_t hrs = __builtin_amdgcn_make_buffer_rsrc((void*)a.hbase, 0, (int)((size_t)SEQ * PITCH * 2), 0x00020000);
#define FRESH_TID_W(t_) int t_ = threadIdx.x; if constexpr ((DQ == 128 && (MODE == 0 && FRESH_W)) || PP_LAUNDER) asm volatile("" : "+v"(t_))
#define FRESH_TID(t_) int t_ = threadIdx.x; if constexpr ((DQ == 128 && (MODE == 0 || FRESH_ALL)) || PP_LAUNDER) asm volatile("" : "+v"(t_))
    const int qlo = a.qlo;
    bf16x8 st_v0, st_v1, st_k0, st_k1; float st_c = 0.f;
#define KBASE(t) ((REV ? (a.jb - 1 - (t)) : (a.ja + (t))) * 64)
#define VMW() asm volatile("s_waitcnt vmcnt(0)" ::: "memory")
#define SLOAD(k0) do { FRESH_TID(t_); const int sr = t_ >> 4, sc = (t_ & 15) * 8; const unsigned so_ = (unsigned)(k0) * (unsigned)(PITCH * 2); \
        const unsigned vo0 = (unsigned)(sr * PITCH + sc) * 2u, vo1 = vo0 + (unsigned)(32 * PITCH * 2); \
        st_v0 = __builtin_bit_cast(bf16x8, __builtin_amdgcn_raw_buffer_load_b128(hrs, vo0, so_ + a.vcolB, 0)); st_v1 = __builtin_bit_cast(bf16x8, __builtin_amdgcn_raw_buffer_load_b128(hrs, vo1, so_ + a.vcolB, 0)); \
        if constexpr (DQ == 128) { st_k0 = __builtin_bit_cast(bf16x8, __builtin_amdgcn_raw_buffer_load_b128(hrs, vo0, so_ + a.kcolB, 0)); st_k1 = __builtin_bit_cast(bf16x8, __builtin_amdgcn_raw_buffer_load_b128(hrs, vo1, so_ + a.kcolB, 0)); } \
        else { const unsigned vk0 = (unsigned)((t_ >> 3) * PITCH + (t_ & 7) * 8) * 2u; st_k0 = __builtin_bit_cast(bf16x8, __builtin_amdgcn_raw_buffer_load_b128(hrs, vk0, so_ + a.kcolB, 0)); } \
        if constexpr (MODE == 0) { if (t_ < 64) st_c = (a.cref - a.cb[(k0) + t_]) * (1.f / SCALE128); } } while (0)
#define SWRITE_K(bf) do { FRESH_TID_W(t_); if constexpr (DQ == 128) { const int sr = t_ >> 4, sc = (t_ & 15) * 8, kws = KSWZ(sr, sc * 2); *(LAS bf16x8*)(K_lds + (bf) * SHM_K + kws) = st_k0; *(LAS bf16x8*)(K_lds + (bf) * SHM_K + kws + 32 * 256) = st_k1; } \
        else { const int sr2 = t_ >> 3, sc2 = (t_ & 7) * 8, kws2 = KSWZ(sr2, sc2 * 2); *(LAS bf16x8*)(K_lds + (bf) * SHM_K + kws2) = st_k0; } \
        if constexpr (MODE == 0) { if (t_ < 64) kbl[(bf) * 64 + t_] = st_c; } } while (0)
#define SWRITE_V(bf) do { FRESH_TID_W(t_); const int sr = t_ >> 4, sc = (t_ & 15) * 8, vst0 = v_st(sr, sc), vst1 = v_st(32 + sr, sc); *(LAS bf16x8*)(V_lds + (bf) * SHM_V + vst0) = st_v0; *(LAS bf16x8*)(V_lds + (bf) * SHM_V + vst1) = st_v1; } while (0)
#define SWRITE(bf) do { SWRITE_V(bf); SWRITE_K(bf); } while (0)
#define SCORES(P0_, P1_, t, BF) do { const int kb_ = KBASE(t); int dq; { FRESH_TID(t_); const int r32_ = t_ & 31, hi_ = (t_ >> 5) & 1; dq = ((MODE == 2) ? a.qpos : (qlo + r32_)) - 4 * hi_ - kb_; } \
        if constexpr (MODE == 1) { if (__builtin_expect(qlo - (kb_ + 63) < 790, 0)) { const LAS float* lp = lutl + (dq + LUT_PAD - 59); \
            _Pragma("unroll") for (int r = 0; r < 16; ++r) { const int c = (r & 3) + 8 * (r >> 2); P0_[r] += lp[59 - c]; P1_[r] += lp[27 - c]; } } } \
        if constexpr (MODE == 2) { if (!__all(dq - 59 >= 1023)) {   \
            _Pragma("unroll") for (int r = 0; r < 16; ++r) { const int c = (r & 3) + 8 * (r >> 2); int d0_ = dq - c, d1_ = dq - c - 32; d0_ = d0_ > 1023 ? 1023 : d0_; d1_ = d1_ > 1023 ? 1023 : d1_; \
                P0_[r] += lutl[d0_ + LUT_PAD]; P1_[r] += lutl[d1_ + LUT_PAD]; } } } \
        if ((MODE == 2 && !__all(dq - 59 >= 0)) || (MODE != 2 && __builtin_expect(kb_ + 63 >= qlo, 0))) { const float NEG = (MODE == 3) ? -3.0e4f : -__builtin_inff(); constexpr int ST = (MODE == 3) ? 1 : 0; \
            _Pragma("unroll") for (int r = 0; r < 16; ++r) { const int c = (r & 3) + 8 * (r >> 2); if (dq - c < ST) P0_[r] = NEG; if (dq - c - 32 < ST) P1_[r] = NEG; } } } while (0)
#define RESC(al) do { if (__builtin_expect(__any((al) < 1.f), 0)) { if (hi == 0) al_l[r32] = (al); asm volatile("s_waitcnt lgkmcnt(0)" ::: "memory"); \
                     for (int d_ = 0; d_ < 4; ++d_) for (int r = 0; r < 16; ++r) o[d_][r] *= al_l[crow(r, hi)]; } } while (0)
#define PARTIAL(P0_, P1_, mnX, alX) do { if constexpr (MODE == 3) { sb_half(P1_, m_reg, hi); } else { partialSM<DQ>(P0_, P1_, m_reg, mnX, alX); } } while (0)
#define FINISH(P0_, P1_, alY) do { if constexpr (MODE == 3) { sb_half(P0_, m_reg, hi); sb_pack(P0_, P1_, pa0, pa1, pa2, pa3); } else { finishSM(P0_, P1_, alY, l_reg, pa0, pa1, pa2, pa3); } } while (0)
#define RESCALE(al) do { if constexpr (MODE != 3) { RESC(al); } } while (0)
    f32x16 pA0, pA1, pB0, pB1; float mnA = 0.f, mnB = 0.f, alA = 1.f, alB = 1.f; bf16x8 pa0, pa1, pa2, pa3;
#if TIME_SEG
    unsigned long long tseg = 0, ttot = 0;
#endif
#define QKT(KB_, P0_, P1_) do { if constexpr (MODE == 0) { \
            _Pragma("unroll") for (int g = 0; g < 4; ++g) { const f32x4 b0 = *(const LAS f32x4*)(kbl + (KB_) * 64 + 8 * g + 4 * hi), b1 = *(const LAS f32x4*)(kbl + (KB_) * 64 + 32 + 8 * g + 4 * hi); \
                _Pragma("unroll") for (int e = 0; e < 4; ++e) { P0_[4 * g + e] = b0[e]; P1_[4 * g + e] = b1[e]; } } \
            qkt<KB_, DQ, true>(P0_, P1_, K_lds, r32, hi, qr); } else { qkt<KB_, DQ>(P0_, P1_, K_lds, r32, hi, qr); } } while (0)
    SLOAD(KBASE(0)); VMW(); SWRITE_K(0);
    __syncthreads();
    SWRITE_V(0); SBAR();
    if (NT > 1) SLOAD(KBASE(1));
    SBAR(); QKT(0, pA0, pA1);
    SCORES(pA0, pA1, 0, 0); PARTIAL(pA0, pA1, mnA, alA);
    if (NT > 1) { VMW(); SWRITE(1); }
    __syncthreads();
#if TIME_SEG
#define TSTAMP(k) do { if constexpr (DQ == 64) { unsigned long long t_; asm volatile("s_memtime %0\n\ts_waitcnt lgkmcnt(0)" : "=s"(t_) :: "memory"); SBAR(); \
        if (TIME_SEG == (k)) tseg -= t_; if (TIME_SEG + 1 == (k)) tseg += t_; if ((k) == 0) ttot -= t_; if ((k) == 7) ttot += t_; } } while (0)
#define TSTAMP2(seg, end) do { if constexpr (DQ == 64 && TIME_SEG == (seg)) { unsigned long long t_; asm volatile("s_memtime %0\n\ts_waitcnt lgkmcnt(0)" : "=s"(t_) :: "memory"); SBAR(); if (end) tseg += t_; else tseg -= t_; } } while (0)
#else
#define TSTAMP(k) do { } while (0)
#define TSTAMP2(seg, end) do { } while (0)
#endif
#define HALF_STEP(PX0, PX1, mnX, alX, PY0, PY1, alY, t, KB, VB, SB) do {                                 \
        TSTAMP(0); TSTAMP2(8, 0); SBAR(); QKT(KB, PX0, PX1); TSTAMP2(8, 1); TSTAMP2(9, 0);            \
        FINISH(PY0, PY1, alY); SBAR(); TSTAMP(1); TSTAMP2(9, 1);                                          \
        if ((t) + 1 < NT) { SLOAD(KBASE((t) + 1)); SBAR(); } TSTAMP(2);                                   \
        pv_tile<VB>(o, vb0, pa0, pa1, pa2, pa3); TSTAMP(3); SCORES(PX0, PX1, (t), KB); PARTIAL(PX0, PX1, mnX, alX); TSTAMP(4);  \
        __syncthreads(); TSTAMP(5);                                                                       \
        if ((t) + 1 < NT) { VMW(); SWRITE(SB); }                                                          \
        RESCALE(alX); TSTAMP(6); __syncthreads(); TSTAMP(7); } while (0)
#if TIME_SEG == 20
    unsigned long long f20a = 0; if constexpr (MODE == 0) asm volatile("s_memtime %0\n\ts_waitcnt lgkmcnt(0)" : "=s"(f20a) :: "memory");
#endif
    for (int t = 1; t + 1 < NT; t += 2) {
        HALF_STEP(pB0, pB1, mnB, alB, pA0, pA1, alA, t, 1, 0, 0);
        HALF_STEP(pA0, pA1, mnA, alA, pB0, pB1, alB, t + 1, 0, 1, 1);
    }
#if TIME_SEG == 20
    if constexpr (MODE == 0) { unsigned long long f20b; asm volatile("s_memtime %0\n\ts_waitcnt lgkmcnt(0)" : "=s"(f20b) :: "memory");
        const int nt2 = (NT - 1) & ~1; if (nt2 >= 8 && (threadIdx.x & 63) == 0) { const unsigned long long d_ = f20b - f20a, b_ = (unsigned long long)nt2 * 2000ull;
            atomicAdd(a.tprobe, (float)(d_ > b_ ? d_ - b_ : 0) * 1e-6f); atomicAdd(a.tprobe + 1, (float)nt2 * 4000.f * 1e-6f); } }
#endif
    const bool even = (NT & 1) == 0;
    if (even) { SBAR(); QKT(1, pB0, pB1); SBAR(); }
    FINISH(pA0, pA1, alA); SBAR();
    pv_tile<0>(o, vb0, pa0, pa1, pa2, pa3);
    if (even) { SCORES(pB0, pB1, NT - 1, 1); PARTIAL(pB0, pB1, mnB, alB); __syncthreads(); RESCALE(alB);
        FINISH(pB0, pB1, alB); SBAR(); pv_tile<1>(o, vb0, pa0, pa1, pa2, pa3); }
    __syncthreads();
#if TIME_SEG
    if constexpr (DQ == 64) { if ((threadIdx.x & 63) == 0) { atomicAdd((float*)(a.cb), (float)tseg * 1e-6f); atomicAdd((float*)(a.cb) + 1, (float)ttot * 1e-6f); } }
#endif
}

template <int DQ, int MODE, bool REV>
__device__ __forceinline__ void attn_chunk_pp(const ChunkArgs& a, const bf16x8* qr, float& m_reg, float& l_reg, f32x16* o, LAS char* lds) {
    int tid_ = threadIdx.x; asm volatile("" : "+v"(tid_)); const int tid = tid_, wid = __builtin_amdgcn_readfirstlane(tid >> 6), lane = tid & 63, r32 = lane & 31, hi = lane >> 5;
    const int NT = a.jb - a.ja;
    LAS char* V_lds = lds + L_V; LAS char* K_lds = lds + L_K;
    LAS float* ws = (LAS float*)(lds + L_WS) + wid * 64; LAS float* al_l = ws + 32;
    LAS float* kbl = (LAS float*)(lds + L_KB); const LAS float* lutl = (const LAS float*)(lds + L_LUT);
    const int vb0 = (int)(uintptr_t)V_lds + v_rd_base(lane);
    const __amdgpu_buffer_rsrc_t hrs = __builtin_amdgcn_make_buffer_rsrc((void*)a.hbase, 0, (int)((size_t)SEQ * PITCH * 2), 0x00020000);
    const int qlo = a.qlo;
    bf16x8 st_v0, st_v1, st_k0, st_k1; float st_c = 0.f;
    static_assert(MODE != 0, "the per-key bias table would need a ring of three here");
#define SLOAD_V(k0) do { FRESH_TID(t_); const int sr = t_ >> 4, sc = (t_ & 15) * 8; const unsigned so_ = (unsigned)(k0) * (unsigned)(PITCH * 2); \
        const unsigned vo0 = (unsigned)(sr * PITCH + sc) * 2u, vo1 = vo0 + (unsigned)(32 * PITCH * 2); \
        st_v0 = __builtin_bit_cast(bf16x8, __builtin_amdgcn_raw_buffer_load_b128(hrs, vo0, so_ + a.vcolB, 0)); st_v1 = __builtin_bit_cast(bf16x8, __builtin_amdgcn_raw_buffer_load_b128(hrs, vo1, so_ + a.vcolB, 0)); } while (0)
#define SLOAD_K(k0) do { FRESH_TID(t_); const unsigned so_ = (unsigned)(k0) * (unsigned)(PITCH * 2); \
        if constexpr (DQ == 128) { const int sr = t_ >> 4, sc = (t_ & 15) * 8; const unsigned vo0 = (unsigned)(sr * PITCH + sc) * 2u, vo1 = vo0 + (unsigned)(32 * PITCH * 2); \
            st_k0 = __builtin_bit_cast(bf16x8, __builtin_amdgcn_raw_buffer_load_b128(hrs, vo0, so_ + a.kcolB, 0)); st_k1 = __builtin_bit_cast(bf16x8, __builtin_amdgcn_raw_buffer_load_b128(hrs, vo1, so_ + a.kcolB, 0)); } \
        else { const unsigned vk0 = (unsigned)((t_ >> 3) * PITCH + (t_ & 7) * 8) * 2u; st_k0 = __builtin_bit_cast(bf16x8, __builtin_amdgcn_raw_buffer_load_b128(hrs, vk0, so_ + a.kcolB, 0)); } } while (0)
#define TCL(x) ((x) < NT ? (x) : NT - 1)
#define WGBAR() do { asm volatile("s_waitcnt lgkmcnt(0)" ::: "memory"); __builtin_amdgcn_s_barrier(); asm volatile("" ::: "memory"); } while (0)
    f32x16 p0, p1; float mn = 0.f, al = 1.f; bf16x8 pa0, pa1, pa2, pa3;
    SLOAD_K(KBASE(0)); SLOAD_V(KBASE(0)); VMW(); SWRITE_K(0); SWRITE_V(0);
    SLOAD_K(KBASE(TCL(1))); SLOAD_V(KBASE(TCL(1))); VMW(); SWRITE_K(1);
    SLOAD_K(KBASE(TCL(2)));
    WGBAR();
    qkt<0, DQ>(p0, p1, K_lds, r32, hi, qr); SBAR();
    if (wid >= 4) WGBAR();
#define YPH(t, PAR) do { __builtin_amdgcn_s_setprio(PP_YPRIO); SCORES(p0, p1, (t), PAR); if constexpr (MODE == 1) { softmaxY<DQ>(p0, p1, m_reg, al, l_reg, pa0, pa1, pa2, pa3); } else { PARTIAL(p0, p1, mn, al); FINISH(p0, p1, al); } SBAR(); RESCALE(al); __builtin_amdgcn_s_setprio(0); SBAR(); } while (0)
#define XLD(t, PAR) do { VMW(); SWRITE_K(PAR); SWRITE_V((PAR) ^ 1); SLOAD_K(KBASE(TCL((t) + 3))); SLOAD_V(KBASE(TCL((t) + 2))); SBAR(); } while (0)
#define XPH(t, PAR) do { XLD(t, PAR); __builtin_amdgcn_s_setprio(PP_XPRIO); xphase<PAR, (PAR) ^ 1, DQ, true>(o, vb0, pa0, pa1, pa2, pa3, p0, p1, K_lds, r32, hi, qr); __builtin_amdgcn_s_setprio(0); SBAR(); } while (0)
#if TIME_SEG
    unsigned long long tseg = 0, tl, tstart;
#define TNOW(t_) asm volatile("s_memtime %0\n\ts_waitcnt lgkmcnt(0)" : "=s"(t_) :: "memory")
#define TST(k) do { unsigned long long t_; TNOW(t_); SBAR(); if ((TIME_SEG % 10) == (k)) tseg += t_ - tl; tl = t_; } while (0)
    TNOW(tl); tstart = tl; unsigned long long rt0 = 0; if ((TIME_SEG % 10) == 6) asm volatile("s_memrealtime %0\n\ts_waitcnt lgkmcnt(0)" : "=s"(rt0) :: "memory");
#else
#define TST(k) do { } while (0)
#endif
    int t = 0;
    for (; t + 2 < NT; t += 2) { YPH(t, 0); TST(1); WGBAR(); TST(2); XPH(t, 0); TST(3); WGBAR(); TST(4); YPH(t + 1, 1); TST(1); WGBAR(); TST(2); XPH(t + 1, 1); TST(3); WGBAR(); TST(4); }
#if TIME_SEG
    { unsigned long long ttot = tl - tstart; if ((TIME_SEG % 10) == 5) { tseg = ttot; ttot = (unsigned long long)(NT & ~1) * 10000ull; } if ((TIME_SEG % 10) == 8) { const unsigned long long base_ = (unsigned long long)(NT & ~1) * 2400ull; tseg = ttot > base_ ? ttot - base_ : 0; ttot = (unsigned long long)(NT & ~1) * 1000ull; }
      if ((TIME_SEG % 10) == 6) { unsigned long long rt1; asm volatile("s_memrealtime %0\n\ts_waitcnt lgkmcnt(0)" : "=s"(rt1) :: "memory"); tseg = ttot; ttot = (rt1 - rt0) * 10ull; }
      if (TIME_SEG != 7 && TIME_SEG != 20 && (TIME_SEG < 10) == (wid < 4) && (threadIdx.x & 63) == 0 && NT > 8) { atomicAdd((float*)(a.cb), (float)tseg * 1e-6f); atomicAdd((float*)(a.cb) + 1, (float)ttot * 1e-6f); } }
#undef TNOW
#endif
#undef TST
    if (t + 1 < NT) { YPH(t, 0); WGBAR(); XPH(t, 0); WGBAR(); YPH(t + 1, 1); WGBAR(); pv_tile<1>(o, vb0, pa0, pa1, pa2, pa3); WGBAR(); }
    else { YPH(t, 0); WGBAR(); pv_tile<0>(o, vb0, pa0, pa1, pa2, pa3); WGBAR(); }
    if (wid < 4) WGBAR();
#undef YPH
#undef XLD
#undef XPH
#undef TCL
#undef WGBAR
#undef SLOAD_K
#undef SLOAD_V

}

constexpr int M_V = 0, M_K = 4 * SHM_V, M_WS = M_K + 4 * SHM_K, M_FLAG = M_WS + NWAVES * 64 * 4, M_LUT = M_FLAG + 512, M_PRE = M_LUT + LUT_N * 4 + 256, M_END = M_PRE + 4352;
static_assert(M_END <= 147456, "MoBA-resident LDS map must stay below the control words");
__device__ __forceinline__ void moba_stage_block(const bf16* hbase, unsigned kcolB, unsigned vcolB, int n, LAS char* lds) {
    int t_ = threadIdx.x; asm volatile("" : "+v"(t_));
    const __amdgpu_buffer_rsrc_t hrs = __builtin_amdgcn_make_buffer_rsrc((void*)hbase, 0, (int)((size_t)SEQ * PITCH * 2), 0x00020000);
    const int sr = t_ >> 4, sc = (t_ & 15) * 8; const unsigned vo0 = (unsigned)(sr * PITCH + sc) * 2u, vo1 = vo0 + (unsigned)(32 * PITCH * 2);
    const int kws = KSWZ(sr, sc * 2), vst0 = v_st(sr, sc), vst1 = v_st(32 + sr, sc);
    bf16x8 k0[4], k1[4], v0[4], v1[4];
#pragma unroll
    for (int b = 0; b < 4; ++b) { const unsigned so_ = (unsigned)((n * 4 + b) * 64) * (unsigned)(PITCH * 2);
        k0[b] = __builtin_bit_cast(bf16x8, __builtin_amdgcn_raw_buffer_load_b128(hrs, vo0, so_ + kcolB, 0)); k1[b] = __builtin_bit_cast(bf16x8, __builtin_amdgcn_raw_buffer_load_b128(hrs, vo1, so_ + kcolB, 0));
        v0[b] = __builtin_bit_cast(bf16x8, __builtin_amdgcn_raw_buffer_load_b128(hrs, vo0, so_ + vcolB, 0)); v1[b] = __builtin_bit_cast(bf16x8, __builtin_amdgcn_raw_buffer_load_b128(hrs, vo1, so_ + vcolB, 0)); }
#pragma unroll
    for (int b = 0; b < 4; ++b) {
        *(LAS bf16x8*)(lds + M_K + b * SHM_K + kws) = k0[b]; *(LAS bf16x8*)(lds + M_K + b * SHM_K + kws + 32 * 256) = k1[b];
        *(LAS bf16x8*)(lds + M_V + b * SHM_V + vst0) = v0[b]; *(LAS bf16x8*)(lds + M_V + b * SHM_V + vst1) = v1[b]; }
}
__device__ __forceinline__ void moba_tiles(const ChunkArgs& a, const bf16x8* qr, float& m_reg, float& l_reg, f32x16* o, LAS char* lds) {
    constexpr int DQ = 128, MODE = 2; constexpr bool REV = false;
    int tid_ = threadIdx.x; asm volatile("" : "+v"(tid_)); const int tid = tid_, wid = __builtin_amdgcn_readfirstlane(tid >> 6), lane = tid & 63, r32 = lane & 31, hi = lane >> 5;
    LAS char* V_lds = lds + M_V; LAS char* K_lds = lds + M_K;
    LAS float* ws = (LAS float*)(lds + M_WS) + wid * 64; LAS float* al_l = ws + 32;
    LAS float* kbl = nullptr; const LAS float* lutl = (const LAS float*)(lds + M_LUT);
    const int vb0 = (int)(uintptr_t)V_lds + v_rd_base(lane);
    const int qlo = a.qlo;
    f32x16 p0, p1; float mn = 0.f, al = 1.f; bf16x8 pa0, pa1, pa2, pa3;
#define MTILE(t) do { if (KBASE(t) <= qlo + 31) { qkt<t, DQ>(p0, p1, K_lds, r32, hi, qr); SBAR(); SCORES(p0, p1, t, 0); PARTIAL(p0, p1, mn, al); RESCALE(al); FINISH(p0, p1, al); SBAR(); pv_tile<t>(o, vb0, pa0, pa1, pa2, pa3); SBAR(); } } while (0)
    MTILE(0); MTILE(1); MTILE(2); MTILE(3);
#undef MTILE
    (void)kbl; (void)ws;
}

constexpr int M_KB = M_PRE;
template <int DQ, int MODE, bool REV>
__device__ __forceinline__ void chunk_res(const ChunkArgs& a, const bf16x8* qr, float& m_reg, float& l_reg, f32x16* o, LAS char* lds) {
    int tid_ = threadIdx.x; asm volatile("" : "+v"(tid_)); const int tid = tid_, wid = __builtin_amdgcn_readfirstlane(tid >> 6), lane = tid & 63, r32 = lane & 31, hi = lane >> 5;
    const int NT = a.jb - a.ja, NP = NT >> 1;
    LAS char* V_lds = lds + M_V; LAS char* K_lds = lds + M_K;
    LAS float* ws = (LAS float*)(lds + M_WS) + wid * 64; LAS float* al_l = ws + 32;
    LAS float* kbl = (LAS float*)(lds + M_KB); const LAS float* lutl = (const LAS float*)(lds + M_LUT);
    const int vb0 = (int)(uintptr_t)V_lds + v_rd_base(lane);
    const __amdgpu_buffer_rsrc_t hrs = __builtin_amdgcn_make_buffer_rsrc((void*)a.hbase, 0, (int)((size_t)SEQ * PITCH * 2), 0x00020000);
    const int qlo = a.qlo;
    bf16x8 sk0[2], sk1[2], sv0[2], sv1[2]; float sc_[2] = {0.f, 0.f};
#define FLOAD(p) do { int t_ = threadIdx.x; asm volatile("" : "+v"(t_)); const int sr = t_ >> 4, sc = (t_ & 15) * 8; const unsigned vo0 = (unsigned)(sr * PITCH + sc) * 2u, vo1 = vo0 + (unsigned)(32 * PITCH * 2); \
        _Pragma("unroll") for (int b = 0; b < 2; ++b) { const int k0_ = KBASE(2 * (p) + b); const unsigned so_ = (unsigned)k0_ * (unsigned)(PITCH * 2); \
            if constexpr (DQ == 128) { sk0[b] = __builtin_bit_cast(bf16x8, __builtin_amdgcn_raw_buffer_load_b128(hrs, vo0, so_ + a.kcolB, 0)); sk1[b] = __builtin_bit_cast(bf16x8, __builtin_amdgcn_raw_buffer_load_b128(hrs, vo1, so_ + a.kcolB, 0)); } \
            else { const unsigned vk0 = (unsigned)((t_ >> 3) * PITCH + (t_ & 7) * 8) * 2u; sk0[b] = __builtin_bit_cast(bf16x8, __builtin_amdgcn_raw_buffer_load_b128(hrs, vk0, so_ + a.kcolB, 0)); } \
            sv0[b] = __builtin_bit_cast(bf16x8, __builtin_amdgcn_raw_buffer_load_b128(hrs, vo0, so_ + a.vcolB, 0)); sv1[b] = __builtin_bit_cast(bf16x8, __builtin_amdgcn_raw_buffer_load_b128(hrs, vo1, so_ + a.vcolB, 0)); \
            if constexpr (MODE == 0) { if (t_ < 64) sc_[b] = (a.cref - a.cb[k0_ + t_]) * (1.f / SCALE128); } } } while (0)
#define FWRITE(g) do { int t_ = threadIdx.x; asm volatile("" : "+v"(t_)); const int sr = t_ >> 4, sc = (t_ & 15) * 8, vst0 = v_st(sr, sc), vst1 = v_st(32 + sr, sc); \
        _Pragma("unroll") for (int b = 0; b < 2; ++b) { constexpr int s_ = 2 * (g); \
            if constexpr (DQ == 128) { const int kws = KSWZ(sr, sc * 2); *(LAS bf16x8*)(K_lds + (s_ + b) * SHM_K + kws) = sk0[b]; *(LAS bf16x8*)(K_lds + (s_ + b) * SHM_K + kws + 32 * 256) = sk1[b]; } \
            else { const int sr2 = t_ >> 3, sc2 = (t_ & 7) * 8, kws2 = KSWZ(sr2, sc2 * 2); *(LAS bf16x8*)(K_lds + (s_ + b) * SHM_K + kws2) = sk0[b]; } \
            *(LAS bf16x8*)(V_lds + (s_ + b) * SHM_V + vst0) = sv0[b]; *(LAS bf16x8*)(V_lds + (s_ + b) * SHM_V + vst1) = sv1[b]; \
            if constexpr (MODE == 0) { if (t_ < 64) kbl[(s_ + b) * 64 + t_] = sc_[b]; } } } while (0)
    f32x16 p0, p1; float mn = 0.f, al = 1.f; bf16x8 pa0, pa1, pa2, pa3;
#define FTILE(t, S) do { if (KBASE(t) <= qlo + 31 - (MODE == 3 ? 1 : 0)) { QKT(S, p0, p1); SBAR(); SCORES(p0, p1, (t), S); \
        if constexpr (MODE == 1) { softmaxY<DQ>(p0, p1, m_reg, al, l_reg, pa0, pa1, pa2, pa3); SBAR(); RESCALE(al); } else { PARTIAL(p0, p1, mn, al); RESCALE(al); FINISH(p0, p1, al); } \
        SBAR(); if constexpr (RES_PVDB) xphase<S, 0, DQ, false>(o, vb0, pa0, pa1, pa2, pa3, p0, p1, K_lds, r32, hi, qr); else pv_tile<S>(o, vb0, pa0, pa1, pa2, pa3); SBAR(); } } while (0)
#define FPAIR(p, g) do { __syncthreads(); \
        if ((p) + 1 < NP) { VMW(); FWRITE((g) ^ 1); if ((p) + 2 < NP) FLOAD((p) + 2); } SBAR(); \
        FTILE(2 * (p), 2 * (g)); FTILE(2 * (p) + 1, 2 * (g) + 1); } while (0)
    FLOAD(0); VMW(); FWRITE(0); if (NP > 1) FLOAD(1);
    int p = 0;
    for (; p + 1 < NP; p += 2) { FPAIR(p, 0); FPAIR(p + 1, 1); }
    if (p < NP) FPAIR(p, 0);
    __syncthreads();
#undef FPAIR
#undef FTILE
#undef FWRITE
#undef FLOAD
    (void)lutl; (void)ws; (void)tid; (void)kbl; (void)mn;
}
__device__ __forceinline__ void fox_chunk_res(const ChunkArgs& a, const bf16x8* qr, float& m_reg, float& l_reg, f32x16* o, LAS char* lds) { chunk_res<128, 0, true>(a, qr, m_reg, l_reg, o, lds); }
#undef QKT
#undef KBASE
#undef VMW
#undef SLOAD
#undef FRESH_TID
#undef FRESH_TID_W
#undef SWRITE_K
#undef SWRITE_V
#undef SWRITE
#undef SCORES
#undef RESC
#undef PARTIAL
#undef FINISH
#undef RESCALE
#undef HALF_STEP
#undef TSTAMP
#undef TSTAMP2

template <int DQ> __device__ __forceinline__ void load_q(bf16x8* qr, const bf16* qrow, int hi) {
#pragma unroll
    for (int d0 = 0; d0 < DQ / 16; ++d0) qr[d0] = *(const bf16x8*)(qrow + d0 * 16 + hi * 8);
}
__device__ __forceinline__ void load_lut(LAS char* lds, const float* lutg, float inv_scale, int off = L_LUT) {
    LAS float* l = (LAS float*)(lds + off); const float far = lutg[1023];
    int i0 = threadIdx.x; asm volatile("" : "+v"(i0));
    for (int i = i0; i < LUT_N; i += NTHREADS) l[i] = (i < LUT_PAD) ? 0.f : (lutg[i - LUT_PAD] - far) * inv_scale;
}
template <int CTRL> __device__ __forceinline__ float quad_bcast(float v) { return __builtin_bit_cast(float, __builtin_amdgcn_mov_dpp(__builtin_bit_cast(int, v), CTRL, 0xf, 0xf, true)); }
constexpr float O8_SCALE = 16.f;
__device__ __forceinline__ void store_o(const f32x16* o, const float* rl  , unsigned char* obase, int ldo, int r32, int hi) {
#pragma unroll
    for (int r = 0; r < 16; ++r) { const int orow = crow(r, hi);
#pragma unroll
        for (int d0 = 0; d0 < 4; ++d0) { const float v = o[d0][r] * rl[r] * O8_SCALE; const float v1 = quad_bcast<0x55>(v), v2 = quad_bcast<0xAA>(v), v3 = quad_bcast<0xFF>(v);
            if ((r32 & 3) == 0) *(unsigned*)(obase + (size_t)orow * ldo + d0 * 32 + r32) = pk4_fp8(v, v1, v2, v3); } }
}
}

__device__ __forceinline__ void fox_epilogue(const att::f32x16* o, float l_reg, LAS char* lds, unsigned char* oblk, int ldo, int ws_off = att::L_WS) {
    int t_ = threadIdx.x; asm volatile("" : "+v"(t_)); const int wid = __builtin_amdgcn_readfirstlane(t_ >> 6), r32 = t_ & 31, hi = (t_ >> 5) & 1;
    LAS float* li_l = (LAS float*)(lds + ws_off) + wid * 64;
    if (hi == 0) li_l[r32] = l_reg; asm volatile("s_waitcnt lgkmcnt(0)" ::: "memory");
    float rli[16];
#pragma unroll
    for (int r = 0; r < 16; ++r) rli[r] = __builtin_amdgcn_rcpf(li_l[att::crow(r, hi)]);
    att::store_o(o, rli, oblk + (size_t)(wid * 32) * ldo, ldo, r32, hi);
    __syncthreads();
}
constexpr int CW_KMAX = 10496;
__device__ __forceinline__ void fox_block(const Args& A, LAS char* lds, int hd, int qb, unsigned char* obuf, int ldo, int ocol) {
    int tid_ = threadIdx.x; asm volatile("" : "+v"(tid_)); const int tid = tid_, wid = __builtin_amdgcn_readfirstlane(tid >> 6), lane = tid & 63, r32 = lane & 31, hi = lane >> 5;
    const bf16* h = (const bf16*)(A.ws + WS_H); const int P0 = qb * 256;
    const float* cg = (const float*)(A.ws + WS_C) + hd * SEQ;
    bf16x8 qr[8]; att::load_q<128>(qr, h + (size_t)(P0 + wid * 32 + r32) * NQKV + hd * 128, hi);
    att::ChunkArgs ca; ca.hbase = h; ca.kcolB = (unsigned)(1024 + hd * 128) * 2u; ca.vcolB = (unsigned)(2048 + hd * 128) * 2u;
    ca.qpos = P0 + wid * 32 + r32; ca.qlo = P0 + wid * 32; ca.cb = cg; ca.cref = cg[P0];
    ca.tprobe = (float*)(A.ws + WS_CTL) + 10240;
    float m_reg = -1e30f, l_reg = 0.f; att::f32x16 o[4] = {};
    LAS int* flg = (LAS int*)(lds + (FOX_RES ? att::M_FLAG : att::L_FLAG));
    int jb = P0 / 64 + 4;
    const float kmax2 = __uint_as_float(__hip_atomic_load((unsigned*)(A.ws + WS_CTL) + CW_KMAX + hd, RLX_AGENT));
    for (;;) {
        const int ja = jb > FOX_CH ? jb - FOX_CH : 0;
        ca.ja = ja; ca.jb = jb;
        const float c_low = cg[ja * 64];
#if FOX_RES
        att::fox_chunk_res(ca, qr, m_reg, l_reg, o, lds);
#else
        att::attn_chunk<128, 0, true>(ca, qr, m_reg, l_reg, o, lds);
#endif
        if (ja == 0) break;
        float qn2 = 0.f;
#pragma unroll
        for (int d0 = 0; d0 < 8; ++d0)
#pragma unroll
            for (int j = 0; j < 8; ++j) { const float v = bf2f((unsigned short)qr[d0][j]); qn2 += v * v; }
        { auto rr = __builtin_amdgcn_permlane32_swap(__float_as_uint(qn2), __float_as_uint(qn2), false, false); qn2 = __uint_as_float(rr[0]) + __uint_as_float(rr[1]); }
        const float qk_bound = sqrtf(qn2 * kmax2) * 1.001f;
        const float kb_low = (ca.cref - c_low) * (1.f / SCALE128);
        const int done = __all((qk_bound + kb_low - m_reg) * (1.4426950408889634f * SCALE128) < -152.f) ? 1 : 0;
        { int t_ = threadIdx.x; asm volatile("" : "+v"(t_)); if ((t_ & 63) == 0) flg[t_ >> 6] = done; }
        __syncthreads();
        int all = 1;
#pragma unroll
        for (int w = 0; w < NWAVES; ++w) all &= flg[w];
        __syncthreads();
        if (all) break;
        jb = ja;
    }
    fox_epilogue(o, l_reg, lds, obuf + (size_t)P0 * ldo + ocol, ldo, FOX_RES ? att::M_WS : att::L_WS);
}

template <int MP>
__device__ __forceinline__ void diff_map(const Args& A, LAS char* lds, int hd, int qb, unsigned char* obuf) {
    int tid_ = threadIdx.x; asm volatile("" : "+v"(tid_)); const int tid = tid_, wid = __builtin_amdgcn_readfirstlane(tid >> 6), lane = tid & 63, r32 = lane & 31, hi = lane >> 5;
    const bf16* h = (const bf16*)(A.ws + WS_H); const int P0 = qb * 256;
#if DIFF_RES
    unsigned short* stash = (unsigned short*)(A.ws + WS_DSTASH) + ((size_t)blockIdx.x * NWAVES + wid) * 4096 + lane;
    LAS float* li_l = (LAS float*)(lds + att::M_WS) + wid * 64;
#else
    LAS unsigned short* stash = (LAS unsigned short*)(lds + att::L_STASH) + wid * 4096 + lane;
    LAS float* li_l = (LAS float*)(lds + att::L_WS) + wid * 64;
#endif
    bf16x8 qr[4]; att::load_q<64>(qr, h + (size_t)(P0 + wid * 32 + r32) * NQKV + hd * 128 + MP * 64, hi);
    att::ChunkArgs ca; ca.hbase = h; ca.kcolB = (unsigned)(1024 + hd * 128 + MP * 64) * 2u; ca.vcolB = (unsigned)(2048 + hd * 128) * 2u;
    ca.ja = 0; ca.jb = P0 / 64 + 4; ca.qpos = P0 + wid * 32 + r32; ca.qlo = P0 + wid * 32; ca.cb = TIME_SEG ? (const float*)(A.ws + WS_CTL) + 10240 : nullptr; ca.cref = 0.f;
    float m_reg = -1e30f, l_reg = 0.f;
    att::f32x16 o[4] = {};
#if DIFF_RES
    att::chunk_res<64, 1, false>(ca, qr, m_reg, l_reg, o, lds);
#elif PP_DIFF
    att::attn_chunk_pp<64, 1, false>(ca, qr, m_reg, l_reg, o, lds);
#else
    att::attn_chunk<64, 1, false>(ca, qr, m_reg, l_reg, o, lds);
#endif
    if (hi == 0) li_l[r32] = l_reg; asm volatile("s_waitcnt lgkmcnt(0)" ::: "memory");
    if constexpr (MP == 0) {
#pragma unroll
        for (int r = 0; r < 16; ++r) { const float rl = __builtin_amdgcn_rcpf(li_l[att::crow(r, hi)]);
#pragma unroll
            for (int d0 = 0; d0 < 4; ++d0) stash[(r * 4 + d0) * 64] = (unsigned short)f2bf(o[d0][r] * rl); }
    } else {
        const float lam = ((const float*)(A.ws + WS_LAM))[0];
        unsigned char* ob = obuf + (size_t)(P0 + wid * 32) * DM + hd * 128;
#pragma unroll
        for (int r = 0; r < 16; ++r) { const float rl = lam * __builtin_amdgcn_rcpf(li_l[att::crow(r, hi)]); float v[4]; float ss = 0.f;
#pragma unroll
            for (int d0 = 0; d0 < 4; ++d0) { v[d0] = bf2f(stash[(r * 4 + d0) * 64]) - o[d0][r] * rl; ss += v[d0] * v[d0]; }
            ss += __shfl_xor(ss, 1); ss += __shfl_xor(ss, 2); ss += __shfl_xor(ss, 4); ss += __shfl_xor(ss, 8); ss += __shfl_xor(ss, 16);
            const float sc = rsqrtf(ss * (1.f / 128.f) + LN_EPS) * (1.f - LAMBDA_INIT); const int orow = att::crow(r, hi);
#pragma unroll
            for (int d0 = 0; d0 < 4; ++d0) { const float w = v[d0] * sc * A.subln_gain[d0 * 32 + r32] * att::O8_SCALE; const float w1 = att::quad_bcast<0x55>(w), w2 = att::quad_bcast<0xAA>(w), w3 = att::quad_bcast<0xFF>(w);
                if ((r32 & 3) == 0) *(unsigned*)(ob + (size_t)orow * DM + d0 * 32 + r32) = pk4_fp8(w, w1, w2, w3); } }
    }
    __syncthreads();
}
__device__ __forceinline__ void diff_block(const Args& A, LAS char* lds, int hd, int qb, unsigned char* obuf) {
    att::load_lut(lds, (const float*)(A.ws + WS_LUT) + hd * 1024, 1.f / SCALE64, DIFF_RES ? att::M_LUT : att::L_LUT);
    diff_map<0>(A, lds, hd, qb, obuf);
    diff_map<1>(A, lds, hd, qb, obuf);
}

__device__ __forceinline__ void sb_block(const Args& A, LAS char* lds, int hd, int qb, unsigned char* obuf) {
    int tid_ = threadIdx.x; asm volatile("" : "+v"(tid_)); const int tid = tid_, wid = __builtin_amdgcn_readfirstlane(tid >> 6), lane = tid & 63, r32 = lane & 31, hi = lane >> 5;
    const bf16* h = (const bf16*)(A.ws + WS_H); const int P0 = qb * 256;
    bf16x8 qr[8]; att::load_q<128>(qr, h + (size_t)(P0 + wid * 32 + r32) * NQKV + 3072 + hd * 128, hi);
    att::ChunkArgs ca; ca.hbase = h; ca.kcolB = (unsigned)(4096 + hd * 128) * 2u; ca.vcolB = (unsigned)(5120 + hd * 128) * 2u;
    ca.qpos = P0 + wid * 32 + r32; ca.qlo = P0 + wid * 32; ca.cb = nullptr; ca.cref = 0.f;
    float R2 = 0.f, l_dummy = 0.f; att::f32x16 o[4] = {};
    LAS int* flg = (LAS int*)(lds + (SB_RES ? att::M_FLAG : att::L_FLAG));
    int jb = P0 / 64 + 4;
    for (;;) {
#if SB_NOCHUNK
        const int ja = 0;
#else
        const int ja = jb > 8 ? jb - 8 : 0;
#endif
        ca.ja = ja; ca.jb = jb;
#if SB_RES
        att::chunk_res<128, 3, true>(ca, qr, R2, l_dummy, o, lds);
#elif PP_SB
        att::attn_chunk_pp<128, 3, true>(ca, qr, R2, l_dummy, o, lds);
#else
        att::attn_chunk<128, 3, true>(ca, qr, R2, l_dummy, o, lds);
#endif
        const int done = __all(R2 < -150.1f) ? 1 : 0;
        if (lane == 0) flg[wid] = done;
        __syncthreads();
        int all = 1;
#pragma unroll
        for (int w = 0; w < NWAVES; ++w) all &= flg[w];
        __syncthreads();
        if (all || ja == 0) break;
        jb = ja;
    }
#if SB_R2PROBE
    { float rm = fmaxf(R2, 0.f); for (int o_ = 1; o_ < 64; o_ <<= 1) rm = fmaxf(rm, __shfl_xor(rm, o_));
      if (lane == 0) { atomicMax((unsigned*)(A.ws + WS_CTL) + 10240, __float_as_uint(rm)); __hip_atomic_store((float*)(A.ws + WS_CTL) + 10241, 1.f, RLX_AGENT); } }
#endif
    float one[16];
#pragma unroll
    for (int r = 0; r < 16; ++r) one[r] = 1.f;
    att::store_o(o, one, obuf + (size_t)(P0 + wid * 32) * DM + (8 + hd) * 128, DM, r32, hi);
    __syncthreads();
}

__device__ __forceinline__ void sb_unit_test(const Args& A, float sentinel) {
    const int lane = threadIdx.x & 63, r32 = lane & 31, hi = lane >> 5;
    float maxerr = 0.f;
    for (int pat = 0; pat < 4; ++pat) {
        att::f32x16 p0, p1; float R2 = (pat == 3) ? -20.f : 0.f; const float R2in = R2;
        const int lim = (pat == 0) ? 64 : (pat == 1) ? (r32 * 2 + 1) : (pat == 2) ? (r32 < 16 ? 0 : 40) : 33;
#define ZRAW(k) (((k) >= lim) ? sentinel : (25.f * __sinf(0.37f * (float)(k) + 0.11f * (float)r32 + (float)pat)))
#pragma unroll
        for (int r = 0; r < 16; ++r) { p0[r] = ZRAW(att::crow(r, hi)); p1[r] = ZRAW(32 + att::crow(r, hi)); }
        att::sb_half(p1, R2, hi); att::sb_half(p0, R2, hi);
        constexpr float C2 = 1.4426950408889634f * SCALE128;
        float Rr = R2in;
        for (int k = 63; k >= 0; --k) { const float z2 = ZRAW(k) * C2; const float sp = fmaxf(z2, 0.f) + log2f(1.f + exp2f(-fabsf(z2))); const float aref = exp2f(z2 - sp + Rr); Rr -= sp;
#pragma unroll
            for (int r = 0; r < 16; ++r) { if (att::crow(r, hi) == k) maxerr = fmaxf(maxerr, fabsf(p0[r] - aref)); if (32 + att::crow(r, hi) == k) maxerr = fmaxf(maxerr, fabsf(p1[r] - aref)); }
            if (!(aref == aref)) maxerr = 1e9f; }
        maxerr = fmaxf(maxerr, fabsf(R2 - Rr) * 1e-3f);
        if (!(R2 == R2)) maxerr = 1e9f;
#pragma unroll
        for (int r = 0; r < 16; ++r) if (!(p0[r] == p0[r]) || !(p1[r] == p1[r])) maxerr = 1e9f;
#undef ZRAW
    }
    for (int o_ = 1; o_ < 64; o_ <<= 1) maxerr = fmaxf(maxerr, __shfl_xor(maxerr, o_));
    if (lane == 0) { atomicMax((unsigned*)(A.ws + WS_CTL) + 10240, __float_as_uint(maxerr)); __hip_atomic_store((float*)(A.ws + WS_CTL) + 10241, 1.f, RLX_AGENT); }
}

__device__ __forceinline__ void p3_gate_mfma(const Args& A, LAS char* lds, int G, int* sel) {
    int tid_ = threadIdx.x; asm volatile("" : "+v"(tid_)); const int tid = tid_, wid = __builtin_amdgcn_readfirstlane(tid >> 6), lane = tid & 63, r32 = lane & 31, hi = lane >> 5;
    const bf16* h = (const bf16*)(A.ws + WS_H);
    char* ldsg = (char*)lds; float* scal = (float*)(ldsg + 65536); int* lcnt = (int*)(ldsg + 66560); int* gbs = lcnt + 64;
    for (int u = blockIdx.x; u < 1024; u += G) {
        if (u < 512) {
            const int hd = u >> 6, qb = (u & 256) ? 63 - (u & 63) : (u & 63);
            const float* kmg = (const float*)(A.ws + WS_KMEAN) + (size_t)hd * 64 * 128;
            {   const int sr = tid >> 4, sc = (tid & 15) * 8, kws = KSWZ(sr, sc * 2);
#pragma unroll
                for (int half = 0; half < 2; ++half) { const float* src = kmg + (size_t)(sr + 32 * half) * 128 + sc;
                    const f32x4 a = *(const f32x4*)src, b = *(const f32x4*)(src + 4);
                    const float v[8] = {a[0], a[1], a[2], a[3], b[0], b[1], b[2], b[3]};
                    unsigned wh[4], wl[4], wm[4];
#pragma unroll
                    for (int e = 0; e < 4; ++e) {
                        const unsigned short h0 = f2bf(v[2 * e]), h1 = f2bf(v[2 * e + 1]); const float r0 = v[2 * e] - bf2f(h0), r1 = v[2 * e + 1] - bf2f(h1);
                        const unsigned short l0 = f2bf(r0), l1 = f2bf(r1); const float q0 = r0 - bf2f(l0), q1 = r1 - bf2f(l1);
                        wh[e] = (unsigned)h0 | ((unsigned)h1 << 16); wl[e] = (unsigned)l0 | ((unsigned)l1 << 16); wm[e] = (unsigned)f2bf(q0) | ((unsigned)f2bf(q1) << 16); }
                    *(LAS v4u*)(lds + att::L_K + 0 * att::SHM_K + kws + half * 32 * 256) = (v4u){wh[0], wh[1], wh[2], wh[3]};
                    *(LAS v4u*)(lds + att::L_K + 1 * att::SHM_K + kws + half * 32 * 256) = (v4u){wl[0], wl[1], wl[2], wl[3]};
                    *(LAS v4u*)(lds + att::L_V + 0 * att::SHM_K + kws + half * 32 * 256) = (v4u){wm[0], wm[1], wm[2], wm[3]}; } }
            if (tid < 64) lcnt[tid] = 0;
            const int t = qb * 256 + wid * 32 + r32;
            bf16x8 qr[8]; att::load_q<128>(qr, h + (size_t)t * NQKV + 3072 + hd * 128, hi);
            __syncthreads();
            att::f32x16 p0, p1;
            att::qkt<0, 128>(p0, p1, lds + att::L_K, r32, hi, qr); SBAR();
            att::qkt<1, 128, true>(p0, p1, lds + att::L_K, r32, hi, qr); SBAR();
            att::qkt<0, 128, true>(p0, p1, lds + att::L_V, r32, hi, qr); SBAR();
            float v0 = -3e38f, v1 = -3e38f, v2 = -3e38f; int i0 = 0, i1 = 1, i2 = 2;
#define G_INS(s_, n_) do { const float gs_ = (s_); const int gn_ = (n_); \
                if (gs_ > v0) { v2 = v1; i2 = i1; v1 = v0; i1 = i0; v0 = gs_; i0 = gn_; } else if (gs_ > v1) { v2 = v1; i2 = i1; v1 = gs_; i1 = gn_; } else if (gs_ > v2) { v2 = gs_; i2 = gn_; } } while (0)
#pragma unroll
            for (int r = 0; r < 16; ++r) { const int n = (r & 3) + 8 * (r >> 2) + 4 * hi; G_INS(n < qb ? p0[r] : -3e38f, n); }
#pragma unroll
            for (int r = 0; r < 16; ++r) { const int n = 32 + (r & 3) + 8 * (r >> 2) + 4 * hi; G_INS(n < qb ? p1[r] : -3e38f, n); }
#undef G_INS
            float ov[3]; int oi[3];
            { const float mv[3] = {v0, v1, v2}; const int mi[3] = {i0, i1, i2};
#pragma unroll
              for (int k = 0; k < 3; ++k) { auto rv = __builtin_amdgcn_permlane32_swap(__float_as_uint(mv[k]), __float_as_uint(mv[k]), false, false); auto ri = __builtin_amdgcn_permlane32_swap((unsigned)mi[k], (unsigned)mi[k], false, false);
                  ov[k] = __uint_as_float(hi ? rv[0] : rv[1]); oi[k] = (int)(hi ? ri[0] : ri[1]); } }
#define G_BEF(sa, na, sb, nb) ((sa) > (sb) || ((sa) == (sb) && (na) < (nb)))
#pragma unroll
            for (int k = 0; k < 3; ++k) { const float s = ov[k]; const int n = oi[k];
                if (s > -1e38f) {
                    if (G_BEF(s, n, v0, i0)) { v2 = v1; i2 = i1; v1 = v0; i1 = i0; v0 = s; i0 = n; } else if (G_BEF(s, n, v1, i1)) { v2 = v1; i2 = i1; v1 = s; i1 = n; } else if (G_BEF(s, n, v2, i2)) { v2 = s; i2 = n; } } }
#undef G_BEF
            const int nsel = qb < 3 ? qb : 3;
            if (hi == 0) *(int4*)(sel + ((size_t)hd * SEQ + t) * 4) = make_int4(i0, i1, i2, nsel);
            int lp0 = 0, lp1 = 0, lp2 = 0;
            if (hi == 0) { if (nsel > 0) lp0 = atomicAdd(&lcnt[i0], 1); if (nsel > 1) lp1 = atomicAdd(&lcnt[i1], 1); if (nsel > 2) lp2 = atomicAdd(&lcnt[i2], 1); }
            __syncthreads();
            if (tid < 64) { const int c = lcnt[tid]; gbs[tid] = c > 0 ? (int)__hip_atomic_fetch_add((unsigned*)(A.ws + WS_CTL) + CW_MOBACNT + hd * 64 + tid, (unsigned)c, RLX_AGENT) : 0; }
            __syncthreads();
            if (hi == 0) { int* ml = (int*)((unsigned char*)A.out + (4u << 20)) + (size_t)hd * 64 * SEQ;
                if (nsel > 0) ml[(size_t)i0 * SEQ + gbs[i0] + lp0] = t * 4 + 0;
                if (nsel > 1) ml[(size_t)i1 * SEQ + gbs[i1] + lp1] = t * 4 + 1;
                if (nsel > 2) ml[(size_t)i2 * SEQ + gbs[i2] + lp2] = t * 4 + 2; }
            __syncthreads();
        } else {
            const int v = u - 512, hd = v >> 6, ch = v & 63;
            if (wid == 0) { float x = (lane < ch) ? ((const float*)(A.ws + WS_CTOT))[hd * 64 + lane] : 0.f; x = wave_sum(x); if (lane == 0) scal[0] = x; }
            __syncthreads();
            if (tid < 256) ((float*)(A.ws + WS_C))[hd * SEQ + ch * 256 + tid] = ((const float*)(A.ws + WS_CLOC))[hd * SEQ + ch * 256 + tid] + scal[0];
            __syncthreads();
        }
    }
}

constexpr size_t DO_LSE = 2 * MiB, DO_MLIST = 4 * MiB;
__device__ __forceinline__ void moba_block(const Args& A, LAS char* lds, int hd, int n, int chunk  , int cnt) {
    int tid_ = threadIdx.x; asm volatile("" : "+v"(tid_)); const int tid = tid_, wid = __builtin_amdgcn_readfirstlane(tid >> 6), lane = tid & 63, r32 = lane & 31, hi = lane >> 5;
    const bf16* h = (const bf16*)(A.ws + WS_H);
    int t, slot, valid;
    if (chunk < 0) { t = n * 256 + wid * 32 + r32; slot = 3; valid = 1; }
    else { const int idx = chunk * 256 + wid * 32 + r32; valid = idx < cnt; const int ent = valid ? ((const int*)((const unsigned char*)A.out + DO_MLIST))[(size_t)(hd * 64 + n) * SEQ + idx] : (SEQ - 1) * 4; t = ent >> 2; slot = ent & 3; }
    bf16x8 qr[8]; att::load_q<128>(qr, h + (size_t)t * NQKV + 3072 + hd * 128, hi);
    att::ChunkArgs ca; ca.hbase = h; ca.kcolB = (unsigned)(4096 + hd * 128) * 2u; ca.vcolB = (unsigned)(5120 + hd * 128) * 2u;
    ca.ja = n * 4; ca.jb = n * 4 + 4; ca.qpos = t; ca.qlo = 0; ca.cb = nullptr; ca.cref = 0.f;
    float m_reg = -1e30f, l_reg = 0.f; att::f32x16 o[4] = {};
    att::attn_chunk<128, 2, false>(ca, qr, m_reg, l_reg, o, lds);
    LAS float* li_l = (LAS float*)(lds + att::L_WS) + wid * 64; LAS int* dst_l = (LAS int*)(li_l + 32);
    const int dst = valid ? ((hd * SEQ + t) * 4 + slot) : -1;
    if (hi == 0) { li_l[r32] = l_reg; dst_l[r32] = dst;
        if (valid) ((float*)((unsigned char*)A.out + DO_LSE))[dst] = m_reg * (1.4426950408889634f * SCALE128) + __builtin_amdgcn_logf(l_reg); }
    asm volatile("s_waitcnt lgkmcnt(0)" ::: "memory");
    bf16* part = (bf16*)(A.ws + WS_Y);
#pragma unroll
    for (int r = 0; r < 16; ++r) { const int row = att::crow(r, hi); const int d = dst_l[row]; const float rl = __builtin_amdgcn_rcpf(li_l[row]);
#pragma unroll
        for (int d0 = 0; d0 < 4; ++d0) { const float v = o[d0][r] * rl; const float vn = __shfl_xor(v, 1);
            if ((r32 & 1) == 0 && d >= 0) *(unsigned*)(part + (size_t)d * 128 + d0 * 32 + r32) = att::cvtpk(v, vn); } }
    __syncthreads();
}
__device__ __forceinline__ void moba_unit_res(const Args& A, LAS char* lds, int hd, int n, int chunk  , int cnt) {
    int tid_ = threadIdx.x; asm volatile("" : "+v"(tid_)); const int tid = tid_, wid = __builtin_amdgcn_readfirstlane(tid >> 6), lane = tid & 63, r32 = lane & 31, hi = lane >> 5;
    const bf16* h = (const bf16*)(A.ws + WS_H);
    int t, slot, valid;
    if (chunk < 0) { t = n * 256 + wid * 32 + r32; slot = 3; valid = 1; }
    else { const int idx = chunk * 256 + wid * 32 + r32; valid = idx < cnt; const int ent = valid ? ((const int*)((const unsigned char*)A.out + DO_MLIST))[(size_t)(hd * 64 + n) * SEQ + idx] : (SEQ - 1) * 4; t = ent >> 2; slot = ent & 3; }
    if (chunk >= 0 && chunk * 256 + wid * 32 >= cnt) return;
    bf16x8 qr[8]; att::load_q<128>(qr, h + (size_t)t * NQKV + 3072 + hd * 128, hi);
    att::ChunkArgs ca; ca.hbase = h; ca.kcolB = 0; ca.vcolB = 0; ca.ja = n * 4; ca.jb = n * 4 + 4; ca.qpos = t; ca.qlo = (chunk < 0) ? n * 256 + wid * 32 : (1 << 29); ca.cb = nullptr; ca.cref = 0.f; ca.tprobe = nullptr;
    float m_reg = -1e30f, l_reg = 0.f; att::f32x16 o[4] = {};
    att::moba_tiles(ca, qr, m_reg, l_reg, o, lds);
    LAS float* li_l = (LAS float*)(lds + att::M_WS) + wid * 64; LAS int* dst_l = (LAS int*)(li_l + 32);
    const int dst = valid ? ((hd * SEQ + t) * 4 + slot) : -1;
    if (hi == 0) { li_l[r32] = l_reg; dst_l[r32] = dst;
        if (valid) ((float*)((unsigned char*)A.out + DO_LSE))[dst] = m_reg * (1.4426950408889634f * SCALE128) + __builtin_amdgcn_logf(l_reg); }
    asm volatile("s_waitcnt lgkmcnt(0)" ::: "memory");
    bf16* part = (bf16*)(A.ws + WS_Y);
#pragma unroll
    for (int r = 0; r < 16; ++r) { const int row = att::crow(r, hi); const int d = dst_l[row]; const float rl = __builtin_amdgcn_rcpf(li_l[row]);
#pragma unroll
        for (int d0 = 0; d0 < 4; ++d0) { const float v = o[d0][r] * rl; const float vn = __shfl_xor(v, 1);
            if ((r32 & 1) == 0 && d >= 0) *(unsigned*)(part + (size_t)d * 128 + d0 * 32 + r32) = att::cvtpk(v, vn); } }
    asm volatile("s_waitcnt lgkmcnt(0)" ::: "memory");
}
__device__ __forceinline__ void moba_phase_res(const Args& A, LAS char* lds, int G) {
    int curhd = -1;
    for (;;) {
        const int g = next_item(A, CW_QM, (LAS int*)(lds + att::M_FLAG + 64)); if (g >= 512) break;
        const int n = g >> 3, hd = g & 7;
        const int cnt = (int)__hip_atomic_load((unsigned*)(A.ws + WS_CTL) + CW_MOBACNT + hd * 64 + n, RLX_AGENT);
        if (hd != curhd) { att::load_lut(lds, (const float*)(A.ws + WS_LUT) + hd * 1024, 1.f / SCALE128, att::M_LUT); curhd = hd; }
        att::moba_stage_block((const bf16*)(A.ws + WS_H), (unsigned)(4096 + hd * 128) * 2u, (unsigned)(5120 + hd * 128) * 2u, n, lds);
        __syncthreads();
        const int nch = (cnt + 255) >> 8;
        for (int c = -1; c < nch; ++c) moba_unit_res(A, lds, hd, n, c, cnt);
    }
}
__device__ __forceinline__ void moba_phase(const Args& A, LAS char* lds, int G) {
    const int tid = fresh_tid();
    LAS int* pre = (LAS int*)(lds + att::L_STASH);
    LAS int* cnts = pre + 520;
    if (tid < 512) { const int c = (int)__hip_atomic_load((unsigned*)(A.ws + WS_CTL) + CW_MOBACNT + tid, RLX_AGENT); cnts[tid] = c; pre[tid] = (c + 255) >> 8; }
    __syncthreads();
    if (tid == 0) { int acc = 0; for (int i = 0; i < 512; ++i) { const int v = pre[i]; pre[i] = acc; acc += v; } pre[512] = acc; }
    __syncthreads();
    const int total = 512 + pre[512];
    int curhd = -1;
    for (;;) {
        const int u = next_item(A, CW_QM, (LAS int*)(lds + att::L_FLAG + 64)); if (u >= total) break;
        int hn, chunk;
        if (u < 512) { hn = u; chunk = -1; }
        else { const int g = u - 512; int lo = 0, hi_ = 511;
            while (lo < hi_) { const int mid = (lo + hi_ + 1) >> 1; if (pre[mid] <= g) lo = mid; else hi_ = mid - 1; }
            hn = lo; chunk = g - pre[hn]; }
        const int hd = hn >> 6, n = hn & 63;
        if (hd != curhd) { att::load_lut(lds, (const float*)(A.ws + WS_LUT) + hd * 1024, 1.f / SCALE128); curhd = hd; }
        moba_block(A, lds, hd, n, chunk, cnts[hn]);
    }
}
__device__ __forceinline__ void moba_combine(const Args& A, int G, unsigned char* obuf) {
    const int tid = fresh_tid();
    const float* lse = (const float*)((const unsigned char*)A.out + DO_LSE); const bf16* part = (const bf16*)(A.ws + WS_Y);
    for (int i = blockIdx.x * NTHREADS + tid; i < 8 * SEQ * 16; i += G * NTHREADS) { const int it = i >> 4, c8 = (i & 15) * 8; const int hd = it >> 14, t = it & (SEQ - 1);
        const int own = t >> 8, nsel = own < 3 ? own : 3; const size_t base = ((size_t)hd * SEQ + t) * 4;
        const f32x4 lv = *(const f32x4*)(lse + base);
        v4u pw[4];
#pragma unroll
        for (int j = 0; j < 4; ++j) pw[j] = *(const v4u*)(part + (base + j) * 128 + c8);
        float l[4] = {lv.x, lv.y, lv.z, lv.w}; float mx = l[3];
#pragma unroll
        for (int j = 0; j < 3; ++j) { l[j] = (j < nsel) ? l[j] : -3e38f; mx = fmaxf(mx, l[j]); }
        float w[4], ws_ = 0.f;
#pragma unroll
        for (int j = 0; j < 4; ++j) { w[j] = (j == 3 || j < nsel) ? __builtin_amdgcn_exp2f(l[j] - mx) : 0.f; ws_ += w[j]; }
        const float inv = 1.f / ws_; float a[8] = {0, 0, 0, 0, 0, 0, 0, 0};
#pragma unroll
        for (int j = 0; j < 4; ++j) { const float wj = w[j] * inv; const bool on = (j == 3 || j < nsel);
            a[0] += on ? wj * bflo(pw[j].x) : 0.f; a[1] += on ? wj * bfhi(pw[j].x) : 0.f; a[2] += on ? wj * bflo(pw[j].y) : 0.f; a[3] += on ? wj * bfhi(pw[j].y) : 0.f;
            a[4] += on ? wj * bflo(pw[j].z) : 0.f; a[5] += on ? wj * bfhi(pw[j].z) : 0.f; a[6] += on ? wj * bflo(pw[j].w) : 0.f; a[7] += on ? wj * bfhi(pw[j].w) : 0.f; }
        v2u o; o.x = pk4_fp8(a[0] * att::O8_SCALE, a[1] * att::O8_SCALE, a[2] * att::O8_SCALE, a[3] * att::O8_SCALE); o.y = pk4_fp8(a[4] * att::O8_SCALE, a[5] * att::O8_SCALE, a[6] * att::O8_SCALE, a[7] * att::O8_SCALE);
        *(v2u*)(obuf + (size_t)t * DM + (8 + hd) * 128 + c8) = o; }
}


template <bool RES_F32>
__device__ __forceinline__ void p_ln1_router(const Args& A, char* lds, int G, int layer, const void* xres, const bf16* y, bf16* x1) {
    const int tid = fresh_tid(), lane = tid & 63, wave = tid >> 6;
    constexpr int WP = DM + 4;
    float* wT = (float*)lds; int* rinfo = (int*)(lds + 131584); int* lcnt = (int*)(lds + 139776); int* gbase = lcnt + 16;
    for (int idx = tid; idx < 16 * DM; idx += NTHREADS) { const int d = idx >> 4, e = idx & 15; wT[e * WP + d] = A.w_router[idx]; }
    if (tid < 16) lcnt[tid] = 0;
    __syncthreads();
    const int rows_per = (SEQ + G - 1) / G; const int row0 = blockIdx.x * rows_per; int nrows = SEQ - row0; nrows = nrows < 0 ? 0 : (nrows > rows_per ? rows_per : nrows);
    const float* gain = A.ln_gain + (size_t)(layer * 2 + 0) * DM; const float* bias = A.ln_bias + (size_t)(layer * 2 + 0) * DM;
    auto ln_row = [&](int m, f32x4 (&v)[8]) __attribute__((always_inline)) {
        float s = 0.f; int lane = tid & 63; asm volatile("" : "+v"(lane));
#pragma unroll
        for (int j = 0; j < 8; ++j) {
            f32x4 xr;
            if constexpr (RES_F32) xr = *((const f32x4*)((const float*)xres + (size_t)m * DM) + lane + 64 * j);
            else { const v2u w = *((const v2u*)((const bf16*)xres + (size_t)m * DM) + lane + 64 * j); xr = (f32x4){bflo(w.x), bfhi(w.x), bflo(w.y), bfhi(w.y)}; }
            const v2u yw = *((const v2u*)(y + (size_t)m * DM) + lane + 64 * j);
            v[j] = xr * ALPHA + (f32x4){bflo(yw.x), bfhi(yw.x), bflo(yw.y), bfhi(yw.y)};
            s += (v[j].x + v[j].y) + (v[j].z + v[j].w); }
        const float mean = wave_sum(s) * (1.f / DM); float s2 = 0.f;
#pragma unroll
        for (int j = 0; j < 8; ++j) { v[j] = v[j] - mean; s2 += (v[j].x * v[j].x + v[j].y * v[j].y) + (v[j].z * v[j].z + v[j].w * v[j].w); }
        const float rstd = rsqrtf(wave_sum(s2) * (1.f / DM) + LN_EPS);
#pragma unroll
        for (int j = 0; j < 8; ++j) { const f32x4 gg = *((const f32x4*)gain + lane + 64 * j), bb = *((const f32x4*)bias + lane + 64 * j); v[j] = v[j] * rstd * gg + bb;
            v2u w; w.x = pk2(v[j].x, v[j].y); w.y = pk2(v[j].z, v[j].w); *((v2u*)(x1 + (size_t)m * DM) + lane + 64 * j) = w;
            *((unsigned*)(A.ws + WS_X1F8 + (size_t)m * DM) + lane + 64 * j) = pk4_fp8(v[j].x, v[j].y, v[j].z, v[j].w); }
    };
    auto route_row = [&](int r, const float (&lg)[16]) __attribute__((always_inline)) {
        int gs = 0; float gbest = fmaxf(fmaxf(lg[0], lg[1]), fmaxf(lg[2], lg[3]));
#pragma unroll
        for (int g = 1; g < 4; ++g) { const float gm = fmaxf(fmaxf(lg[4 * g], lg[4 * g + 1]), fmaxf(lg[4 * g + 2], lg[4 * g + 3])); if (gm > gbest) { gbest = gm; gs = g; } }
        float c0 = 0.f, c1 = 0.f, c2 = 0.f, c3 = 0.f;
#pragma unroll
        for (int g = 0; g < 4; ++g) if (gs == g) { c0 = lg[4 * g]; c1 = lg[4 * g + 1]; c2 = lg[4 * g + 2]; c3 = lg[4 * g + 3]; }
        float b0 = c0; int k0 = 0; if (c1 > b0) { b0 = c1; k0 = 1; } if (c2 > b0) { b0 = c2; k0 = 2; } if (c3 > b0) { b0 = c3; k0 = 3; }
        float b1 = -3e38f; int k1 = 0;
        if (k0 != 0 && c0 > b1) { b1 = c0; k1 = 0; } if (k0 != 1 && c1 > b1) { b1 = c1; k1 = 1; } if (k0 != 2 && c2 > b1) { b1 = c2; k1 = 2; } if (k0 != 3 && c3 > b1) { b1 = c3; k1 = 3; }
        const float ex = __expf(b1 - b0); const float w0 = 1.f / (1.f + ex), w1 = ex / (1.f + ex);
        if (lane == 0) { const int e0 = gs * 4 + k0, e1 = gs * 4 + k1; const int p0 = atomicAdd(&lcnt[e0], 1), p1 = atomicAdd(&lcnt[e1], 1);
            int* ri = rinfo + r * 8; ri[0] = e0; ri[1] = e1; ri[2] = __builtin_bit_cast(int, w0); ri[3] = __builtin_bit_cast(int, w1); ri[4] = p0; ri[5] = p1; }
    };
    for (int r = wave; r < nrows; r += 2 * NWAVES) {
        const int rB = r + NWAVES; const bool hasB = rB < nrows;
        f32x4 vA[8], vB[8];
        ln_row(row0 + r, vA); __builtin_amdgcn_sched_barrier(0);
        if (hasB) ln_row(row0 + rB, vB); else {
#pragma unroll
            for (int j = 0; j < 8; ++j) vB[j] = vA[j]; }
        __builtin_amdgcn_sched_barrier(0);
        float lgA[16], lgB[16];
#pragma unroll
        for (int e = 0; e < 16; ++e) { float a = 0.f, b = 0.f;
#pragma unroll
            for (int j = 0; j < 8; ++j) { const f32x4 w = *(const f32x4*)(wT + e * WP + 256 * j + 4 * lane);
                a += vA[j].x * w.x + vA[j].y * w.y + vA[j].z * w.z + vA[j].w * w.w; b += vB[j].x * w.x + vB[j].y * w.y + vB[j].z * w.z + vB[j].w * w.w; }
            const float be = A.b_router[e]; lgA[e] = wave_sum(a) + be; lgB[e] = wave_sum(b) + be; }
        route_row(r, lgA);
        if (hasB) route_row(rB, lgB);
    }
    __syncthreads();
    if (tid < 16) gbase[tid] = (int)__hip_atomic_fetch_add((unsigned*)(A.ws + WS_CTL) + CW_MOECNT + layer * 64 + tid, (unsigned)lcnt[tid], RLX_AGENT);
    __syncthreads();
    int* mlist = (int*)(A.ws + WS_MLIST) + (size_t)layer * 16 * SEQ; float* mgw = (float*)(A.ws + WS_MGW) + (size_t)layer * 16 * SEQ;
    if (tid < nrows) { const int* ri = rinfo + tid * 8; const int m = row0 + tid;
        const int e0 = ri[0], e1 = ri[1]; const int q0 = gbase[e0] + ri[4], q1 = gbase[e1] + ri[5];
        mlist[e0 * SEQ + q0] = m * 2 + 0; mgw[e0 * SEQ + q0] = __builtin_bit_cast(float, ri[2]);
        mlist[e1 * SEQ + q1] = m * 2 + 1; mgw[e1 * SEQ + q1] = __builtin_bit_cast(float, ri[3]); }
    __syncthreads();
}

struct MoeTable { const LAS int* t; };
__device__ __forceinline__ void moe_build_table(const Args& A, LAS int* tbl, int layer) {
    if (threadIdx.x == 0) { int acc = 0;
        for (int e = 0; e < 16; ++e) { const int c = (int)__hip_atomic_load((unsigned*)(A.ws + WS_CTL) + CW_MOECNT + layer * 64 + e, RLX_AGENT); tbl[e] = acc; tbl[17 + e] = c; acc += (c + 255) >> 8; }
        tbl[16] = acc; tbl[33] = acc; }
    __syncthreads();
}
template <bool GATH>
struct MoeOrder {
    static constexpr bool GATHER = GATH;
    const LAS int* tbl; const int* list; size_t bstride;
    int G, c;
    __device__ bool next(int i, pg8::Unit& u) const {
        const int L = i * G + c; const int total = tbl[16];
        if (L >= total * 8) return false;
        const int mt = L >> 3; u.pn = L & 7; u.pm = mt; int e = 0;
#pragma unroll
        for (int j = 1; j < 16; ++j) e += (mt >= tbl[j]) ? 1 : 0;
        u.e = e; u.mi = mt - tbl[e]; return true;
    }
    __device__ __forceinline__ unsigned a_off(const pg8::Gemm& g, const pg8::Unit& u) const {
        if constexpr (GATH) return 0u; else return (unsigned)u.pm * 256u * (unsigned)g.rb; }
    __device__ __forceinline__ unsigned b_off(const pg8::Gemm& g, const pg8::Unit& u) const { return (unsigned)u.e * (unsigned)bstride + (unsigned)u.pn * 256u * (unsigned)g.rb; }
    __device__ __forceinline__ void a_voff(const pg8::Gemm& g, const pg8::Unit& u, const int (&R)[2], const int (&C)[2], unsigned (&vo)[2][2]) const {
        if constexpr (GATH) { const int cnt = tbl[17 + u.e];
#pragma unroll
            for (int h = 0; h < 2; ++h)
#pragma unroll
                for (int i = 0; i < 2; ++i) { const int idx = u.mi * 256 + h * 128 + R[i]; const int tok = (idx < cnt) ? (list[u.e * SEQ + idx] >> 1) : 0; vo[h][i] = (unsigned)(tok * g.rb + C[i] * 2); }
        } else {
#pragma unroll
            for (int h = 0; h < 2; ++h)
#pragma unroll
                for (int i = 0; i < 2; ++i) vo[h][i] = (unsigned)((h * 128 + R[i]) * g.rb + C[i] * 2);
        }
    }
};
struct EpiSwiglu {
    static constexpr bool PERM = true;
    unsigned char* H;
    __device__ __forceinline__ void operator()(const pg8::f32x4 (&acc)[2][2][4][2], const pg8::Unit& u, int wr, int wc, int fr, int fq) const {
        const int row0 = u.pm * 256 + wr * 64 + fr, col0 = u.pn * 128 + wc * 32 + 8 * fq;
#pragma unroll
        for (int ai = 0; ai < 2; ++ai)
#pragma unroll
            for (int m = 0; m < 4; ++m) { float hv[8];
#pragma unroll
                for (int n = 0; n < 2; ++n)
#pragma unroll
                    for (int i = 0; i < 4; ++i) { const float gt = acc[ai][0][m][n][i], up = acc[ai][1][m][n][i]; hv[n * 4 + i] = gt * __builtin_amdgcn_rcpf(1.f + __expf(-gt)) * up; }
                v2u w; w.x = pk4_fp8(hv[0], hv[1], hv[2], hv[3]); w.y = pk4_fp8(hv[4], hv[5], hv[6], hv[7]);
                *(v2u*)(H + (size_t)(row0 + ai * 128 + m * 16) * DEXP + col0) = w; asm volatile("" ::: "memory"); }
    }
};
struct EpiDown {
    static constexpr bool PERM = true;
    bf16* Y; const LAS int* tbl; const int* list; const float* gw;
    __device__ __forceinline__ void operator()(const pg8::f32x4 (&acc)[2][2][4][2], const pg8::Unit& u, int wr, int wc, int fr, int fq) const {
        const int cnt = tbl[17 + u.e]; const int col0 = u.pn * 256 + wc * 32 + 8 * fq;
#pragma unroll
        for (int ai = 0; ai < 2; ++ai)
#pragma unroll
            for (int m = 0; m < 4; ++m) { const int idx = u.mi * 256 + ai * 128 + wr * 64 + m * 16 + fr;
                if (idx < cnt) { const int ent = list[u.e * SEQ + idx]; const float g = gw[u.e * SEQ + idx];
                    bf16* rowp = Y + ((size_t)(ent & 1) * SEQ + (size_t)(ent >> 1)) * DM + col0;
#pragma unroll
                    for (int bj = 0; bj < 2; ++bj) { const pg8::f32x4 v0 = acc[ai][bj][m][0] * g, v1 = acc[ai][bj][m][1] * g;
                        pg8::u32x4 w; w.x = pg8::cvt_pk_bf16(v0[0], v0[1]); w.y = pg8::cvt_pk_bf16(v0[2], v0[3]); w.z = pg8::cvt_pk_bf16(v1[0], v1[1]); w.w = pg8::cvt_pk_bf16(v1[2], v1[3]);
                        *(pg8::u32x4*)(rowp + bj * 128) = w; } }
                asm volatile("" ::: "memory"); }
    }
};

template <bool OUT_F32>
__device__ __forceinline__ void p_ln2(const Args& A, int G, int layer, const bf16* x1, const bf16* ys, void* outp) {
    const int tid = fresh_tid(), lane = tid & 63, wave = tid >> 6;
    const int gw = blockIdx.x * NWAVES + wave, NGW = G * NWAVES;
    const float* gain = A.ln_gain + (size_t)(layer * 2 + 1) * DM; const float* bias = A.ln_bias + (size_t)(layer * 2 + 1) * DM;
    for (int m = gw; m < SEQ; m += NGW) {
        f32x4 v[8]; float s = 0.f;
#pragma unroll
        for (int j = 0; j < 8; ++j) {
            const v2u a = *((const v2u*)(x1 + (size_t)m * DM) + lane + 64 * j), b = *((const v2u*)(ys + (size_t)m * DM) + lane + 64 * j), c = *((const v2u*)(ys + ((size_t)SEQ + m) * DM) + lane + 64 * j);
            v[j] = (f32x4){bflo(a.x), bfhi(a.x), bflo(a.y), bfhi(a.y)} * ALPHA + (f32x4){bflo(b.x), bfhi(b.x), bflo(b.y), bfhi(b.y)} + (f32x4){bflo(c.x), bfhi(c.x), bflo(c.y), bfhi(c.y)};
            s += (v[j].x + v[j].y) + (v[j].z + v[j].w); }
        const float mean = wave_sum(s) * (1.f / DM); float s2 = 0.f;
#pragma unroll
        for (int j = 0; j < 8; ++j) { v[j] = v[j] - mean; s2 += (v[j].x * v[j].x + v[j].y * v[j].y) + (v[j].z * v[j].z + v[j].w * v[j].w); }
        const float rstd = rsqrtf(wave_sum(s2) * (1.f / DM) + LN_EPS);
#pragma unroll
        for (int j = 0; j < 8; ++j) { const f32x4 gg = *((const f32x4*)gain + lane + 64 * j), bb = *((const f32x4*)bias + lane + 64 * j); v[j] = v[j] * rstd * gg + bb;
            if constexpr (OUT_F32) *((f32x4*)((float*)outp + (size_t)m * DM) + lane + 64 * j) = v[j];
            else { v2u w; w.x = pk2(v[j].x, v[j].y); w.y = pk2(v[j].z, v[j].w); *((v2u*)((bf16*)outp + (size_t)m * DM) + lane + 64 * j) = w;
                if (L1IN_F8) *((unsigned*)(A.ws + WS_X1F8 + (size_t)m * DM) + lane + 64 * j) = pk4_fp8(v[j].x, v[j].y, v[j].z, v[j].w); } }
    }
}


constexpr int CW_TEST = 10240;
__device__ __forceinline__ void p_compare(const Args& A, int G, const bf16* a, const bf16* b, int c0, int nc) {
    const int tid = fresh_tid(); float num = 0.f, den = 0.f;
    const size_t total = (size_t)SEQ * nc;
    for (size_t i = (size_t)blockIdx.x * NTHREADS + tid; i < total; i += (size_t)G * NTHREADS) { const int m = (int)(i / nc), c = (int)(i % nc);
        const float x = bf2f(a[(size_t)m * DM + c0 + c]), y = bf2f(b[(size_t)m * DM + c0 + c]);
        if ((m & 255) < TEST_RLO || (m & 255) >= TEST_RHI) continue;
#if TEST_NANCOUNT == 2
        if (x == x) num = fmaxf(num, fabsf(x)); den = 1.f;
#elif TEST_NANCOUNT == 1
        num += (x == x && fabsf(x) < 1e4f) ? 0.f : 1.f; den += 1.f;
#else
        float d2 = (x - y) * (x - y); if (!(d2 == d2) || d2 > 1e12f) d2 = TEST_BADVAL; num += d2; den += y * y;
#endif
    }
#if TEST_NANCOUNT == 2
    for (int o = 1; o < 64; o <<= 1) num = fmaxf(num, __shfl_xor(num, o));
    if ((tid & 63) == 0) { atomicMax((unsigned*)(A.ws + WS_CTL) + CW_TEST, __float_as_uint(num)); __hip_atomic_store((float*)(A.ws + WS_CTL) + CW_TEST + 1, 1.f, RLX_AGENT); }
#else
    num = wave_sum(num); den = wave_sum(den);
    if ((tid & 63) == 0) { atomicAdd((float*)(A.ws + WS_CTL) + CW_TEST, num); atomicAdd((float*)(A.ws + WS_CTL) + CW_TEST + 1, den); }
#endif
}
__device__ __forceinline__ void p_apply_test(const Args& A, int G) {
    const float num = __hip_atomic_load((float*)(A.ws + WS_CTL) + CW_TEST, RLX_AGENT), den = __hip_atomic_load((float*)(A.ws + WS_CTL) + CW_TEST + 1, RLX_AGENT);
#if TIME_SEG == 20
    const float f = 1.f + TEST_GAIN * sqrtf(floorf(num / den * 50.f + 0.5f) * 0.02f);
#else
    const float f = 1.f + TEST_GAIN * sqrtf(num / den);
#endif
    for (size_t i = (size_t)blockIdx.x * NTHREADS + threadIdx.x; i < (size_t)SEQ * DM; i += (size_t)G * NTHREADS) A.out[i] *= f;
}

constexpr int NPHASE = 18 + ((TEST_ATT || TIME_SEG) ? 1 : 0);
__global__ void __launch_bounds__(NTHREADS, 2) fwd(Args A) {
    extern __shared__ __attribute__((aligned(16))) unsigned char lds[];
    LAS unsigned char* ldsl = (LAS unsigned char*)lds;
    const int tid = fresh_tid(); const int G = gridDim.x;
    for (int u = tid; u < (LDS_BYTES - LCTL_OFF) / 4; u += NTHREADS) ((LAS unsigned*)(ldsl + LCTL_OFF))[u] = 0u;
    __syncthreads();
    unsigned char* ws = A.ws;
    const int lo = A.ph_lo, hi = A.ph_hi;
#if TIME_SEG == 7
    unsigned long long kt0; asm volatile("s_memtime %0\n\ts_waitcnt lgkmcnt(0)" : "=s"(kt0) :: "memory");
#endif
    const bool fused = (hi - lo) > 1;
    XcdBarrier bar; bar.bar = (unsigned*)(ws + WS_CTL) + CW_BAR; bar.x = 0; bar.st = nullptr;
    if (fused) bar = xcd_barrier_post((unsigned*)(ws + WS_CTL) + CW_BAR, (volatile LAS unsigned*)(ldsl + LCTL_OFF));
#define IN(k) (lo <= (k) && (k) < hi)
#define SEAM(k) do { if (IN(k) && IN((k) + 1)) xcd_barrier(bar); } while (0)
    bf16* xb = (bf16*)(ws + WS_XB); bf16* hb = (bf16*)(ws + WS_H); bf16* ob = (bf16*)(ws + WS_O); bf16* yb = (bf16*)(ws + WS_Y); bf16* x1 = (bf16*)(ws + WS_X1);
    bf16* hid = (bf16*)(ws + WS_HID); bf16* ysl = (bf16*)(ws + WS_YSLOT);
    int* sel = (int*)((unsigned char*)A.out + DO_SEL);
    LAS int* mtbl = (LAS int*)(ldsl + LCTL_OFF + 256);

    if (IN(0)) { p0_prologue(A, ldsl, G);
#if DBL_PHASE == 0
        __syncthreads(); p0_prologue(A, ldsl, G);
#endif
    } SEAM(0);
#define LAYER_BACK(layer, P_OUT, WOUT, RESF32, XRES) \
    if (IN(P_OUT)) { pg8::Gemm g{ob, (const bf16*)(ws + WOUT), SEQ, DM, DM, DM}; pg8::DenseOrder S; S.init(SEQ, DM, G, (int)blockIdx.x); \
        pg8::EpiBf16 E{yb, DM}; pg8::gemm_phase<pg8::EpiBf16, pg8::DenseOrder, true, 122, 123>(ldsl, g, S, E); } \
    SEAM(P_OUT); \
    if (IN(P_OUT + 1)) { p_ln1_router<RESF32>(A, (char*)lds, G, layer, (const void*)(XRES), yb, x1); } \
    SEAM(P_OUT + 1); \
    if (IN(P_OUT + 2)) { moe_build_table(A, mtbl, layer); \
        pg8::Gemm g{(const bf16*)(ws + WS_X1F8), (const bf16*)(ws + WS_WGU + (size_t)layer * 16 * 2048 * 2048), 0, 2048, DM, DM}; \
        MoeOrder<true> S{mtbl, (const int*)(ws + WS_MLIST) + (size_t)layer * 16 * SEQ, (size_t)2048 * 2048, G, (int)blockIdx.x}; EpiSwiglu E{(unsigned char*)hid}; \
        pg8::gemm_phase<EpiSwiglu, MoeOrder<true>, true, 122, 127>(ldsl, g, S, E); \
        if (DBL_PHASE == 100 + P_OUT + 2) { __syncthreads(); pg8::gemm_phase<EpiSwiglu, MoeOrder<true>, true, 122, 127>(ldsl, g, S, E); } } \
    SEAM(P_OUT + 2); \
    if (IN(P_OUT + 3)) { moe_build_table(A, mtbl, layer); \
        pg8::Gemm g{hid, (const bf16*)(ws + WS_WDN + (size_t)layer * 16 * 2048 * 1024), 0, 2048, DEXP, DEXP}; \
        const int* mlist = (const int*)(ws + WS_MLIST) + (size_t)layer * 16 * SEQ; const float* mgw = (const float*)(ws + WS_MGW) + (size_t)layer * 16 * SEQ; \
        MoeOrder<false> S{mtbl, mlist, (size_t)2048 * 1024, G, (int)blockIdx.x}; EpiDown E{ysl, mtbl, mlist, mgw}; \
        pg8::gemm_phase<EpiDown, MoeOrder<false>, true, 122, 127>(ldsl, g, S, E); \
        if (DBL_PHASE == 100 + P_OUT + 3) { __syncthreads(); pg8::gemm_phase<EpiDown, MoeOrder<false>, true, 122, 127>(ldsl, g, S, E); } } \
    SEAM(P_OUT + 3);
    if (IN(1)) { pg8::Gemm g{xb, (const bf16*)(ws + WS_WIN0), SEQ, NQKV, DM, DM}; pg8::DenseOrder S; S.init(SEQ, NQKV, G, (int)blockIdx.x);
        pg8::EpiBf16 E{hb, NQKV}; pg8::gemm_phase<pg8::EpiBf16, pg8::DenseOrder, true, 122, 127>(ldsl, g, S, E); }
    SEAM(1);
    if (IN(2)) { p2_kmean_cumsum(A, (char*)lds, G);
#if DBL_PHASE == 2
        p2_kmean_cumsum(A, (char*)lds, G);
#endif
    } SEAM(2);
#if GATE_MFMA
    if (IN(3)) p3_gate_mfma(A, (LAS char*)ldsl, G, sel); SEAM(3);
#else
    if (IN(3)) p3_gate_cfinal(A, (char*)lds, G, sel); SEAM(3);
#endif
#if TEST_ATT
    if (IN(4)) { for (int u = blockIdx.x; u < 2048; u += G) { const int var = u >> 10, hd = (u >> 7) & 7, qb = u & 127;
            if (var == 0) naive_attn_unit<0>(A, (char*)lds, hd, qb, sel); else naive_attn_unit<1>(A, (char*)lds, hd, qb, sel); } }
#else
    if (IN(4)) { for (;;) { const int it = next_item(A, CW_Q4, (LAS int*)(ldsl + LCTL_OFF + 512)); if (it >= 512) break;
            fox_block(A, (LAS char*)ldsl, it & 7, 63 - (it >> 3), (unsigned char*)ob, DM, (it & 7) * 128); }
#if MOBA_RES
        moba_phase_res(A, (LAS char*)ldsl, G);
#else
        moba_phase(A, (LAS char*)ldsl, G);
#endif
#if DBL_PHASE == 4
        for (int it = blockIdx.x; it < 512; it += G) { const int hd = (it & 255) >> 5, x = it & 31; fox_block(A, (LAS char*)ldsl, hd, (it < 256) ? 63 - x : x, (unsigned char*)ob, DM, hd * 128); }
#endif
#if DBL_PHASE == 41
        moba_phase(A, (LAS char*)ldsl, G);
#endif
    }
#endif
#if TEST_ATT == 4
    if (IN(4)) moba_phase(A, (LAS char*)ldsl, G);
#endif
#if TEST_ATT == 1
    if (IN(4)) { for (int u = blockIdx.x; u < 512; u += G) fox_block(A, (LAS char*)ldsl, u >> 6, u & 63, yb, DM, (u >> 6) * 128); }
#endif
    SEAM(4);
#if !TEST_ATT
    if (IN(5)) { moba_combine(A, G, (unsigned char*)ob); }
#endif
#if TEST_ATT == 1
    if (IN(5)) p_compare(A, G, yb, ob, 0, 1024);
#endif
#if TEST_ATT == 4
    if (IN(5)) moba_combine(A, G, xb);
    SEAM(5);
    if (IN(5)) p_compare(A, G, xb, ob, 1024, 1024);
#endif
    SEAM(5);
    LAYER_BACK(0, 6, WS_WOUT0, true, A.x)
    if (IN(10)) p_ln2<false>(A, G, 0, x1, ysl, (void*)xb);
    SEAM(10);
#if L1IN_F8
    if (IN(11)) { pg8::Gemm g{(const bf16*)(ws + WS_X1F8), (const bf16*)(ws + WS_WIN1), SEQ, NQKV, DM, DM}; pg8::DenseOrder S; S.init(SEQ, NQKV, G, (int)blockIdx.x);
        pg8::EpiBf16 E{hb, NQKV}; pg8::gemm_phase<pg8::EpiBf16, pg8::DenseOrder, true, 122, 127>(ldsl, g, S, E); }
#else
    if (IN(11)) { pg8::Gemm g{xb, (const bf16*)(ws + WS_WIN1), SEQ, NQKV, DM, DM * 2}; pg8::DenseOrder S; S.init(SEQ, NQKV, G, (int)blockIdx.x);
        pg8::EpiBf16 E{hb, NQKV}; pg8::gemm_phase<pg8::EpiBf16, pg8::DenseOrder>(ldsl, g, S, E);
#if DBL_PHASE == 11
        __syncthreads(); pg8::gemm_phase<pg8::EpiBf16, pg8::DenseOrder>(ldsl, g, S, E);
#endif
    }
#endif
    SEAM(11);
#if TEST_ATT
    if (IN(12)) { for (int u = blockIdx.x; u < 2048; u += G) { const int var = u >> 10, hd = (u >> 7) & 7, qb = u & 127;
            if (var == 0) naive_attn_unit<2>(A, (char*)lds, hd, qb, sel); else naive_attn_unit<3>(A, (char*)lds, hd, qb, sel); } }
#else
#if DBL_PHASE == 12
    if (IN(12)) { for (int it_ = blockIdx.x; it_ < 1536; it_ += G) { const int it = it_ & 511, hd = (it & 255) >> 5, x = it & 31; diff_block(A, (LAS char*)ldsl, hd, (it < 256) ? 63 - x : x, (unsigned char*)ob); }
#else
    if (IN(12)) { for (;;) { const int it = next_item(A, CW_Q12, (LAS int*)(ldsl + LCTL_OFF + 512)); if (it >= 512) break;
            diff_block(A, (LAS char*)ldsl, it & 7, 63 - (it >> 3), (unsigned char*)ob); }
#endif
        for (;;) { const int it = next_item(A, CW_Q12 + 64, (LAS int*)(ldsl + LCTL_OFF + 512)); if (it >= 512) break;
            sb_block(A, (LAS char*)ldsl, it & 7, 63 - (it >> 3), (unsigned char*)ob); }
#if DBL_PHASE == 121
        for (int u = blockIdx.x; u < 512; u += G) sb_block(A, (LAS char*)ldsl, u >> 6, u & 63, (unsigned char*)ob);
#endif
    }
#endif
#if TEST_ATT == 3
    if (IN(12) && blockIdx.x == 0) sb_unit_test(A, TEST_SENT);
#endif
#if TEST_ATT == 2
    if (IN(12)) { for (int u = blockIdx.x; u < 512; u += G) diff_block(A, (LAS char*)ldsl, u >> 6, u & 63, yb);
        for (int u = blockIdx.x; u < 512; u += G) sb_block(A, (LAS char*)ldsl, u >> 6, u & 63, yb); }
    SEAM(12);
#if !SB_R2PROBE
    if (IN(12)) p_compare(A, G, yb, ob, TEST_C0, TEST_NC);
#endif
#endif
    SEAM(12);
#ifdef EXTRA_BARRIERS
    if (IN(12) && IN(13)) { for (int i_ = 0; i_ < EXTRA_BARRIERS; ++i_) xcd_barrier(bar); }
#endif
    LAYER_BACK(1, 13, WS_WOUT1, false, xb)
    if (IN(17)) p_ln2<true>(A, G, 1, x1, ysl, (void*)A.out);
#if TIME_SEG == 7
    if (blockIdx.x == 0 && threadIdx.x == 0) { unsigned long long kt1; asm volatile("s_memtime %0\n\ts_waitcnt lgkmcnt(0)" : "=s"(kt1) :: "memory");
        const float ghz = (float)(kt1 - kt0) / 3.42e6f; atomicAdd((float*)(A.ws + WS_CTL) + CW_TEST, floorf(ghz * 5.f + 0.5f) * 0.2f); atomicAdd((float*)(A.ws + WS_CTL) + CW_TEST + 1, 10.f); }
#endif
#if TEST_ATT || TIME_SEG
    SEAM(17);
    if (IN(18)) p_apply_test(A, G);
#endif
#undef LAYER_BACK
#undef IN
#undef SEAM
}

#ifndef MK_FUSED
#define MK_FUSED 1
#endif
extern "C" void kernel_launch(void* const* d_in, const int* in_sizes, int n_in, void* d_out, int out_size, void* d_ws, size_t ws_size, hipStream_t stream) {
    static int grid = 0;
    if (grid == 0) {
        if (n_in != 17 || out_size != SEQ * DM || ws_size < WS_END) { fprintf(stderr, "kernel_launch: unexpected shapes (n_in %d out %d ws %zu)\n", n_in, out_size, ws_size); grid = -1; return; }
        int dev = 0, cus = 0, per_cu = 0;
        if (hipGetDevice(&dev) != hipSuccess || hipDeviceGetAttribute(&cus, hipDeviceAttributeMultiprocessorCount, dev) != hipSuccess) { grid = -1; return; }
        if (hipFuncSetAttribute((const void*)fwd, hipFuncAttributeMaxDynamicSharedMemorySize, LDS_BYTES) != hipSuccess) { fprintf(stderr, "kernel_launch: hipFuncSetAttribute failed\n"); grid = -1; return; }
        if (hipOccupancyMaxActiveBlocksPerMultiprocessor(&per_cu, (const void*)fwd, NTHREADS, LDS_BYTES) != hipSuccess || per_cu < 1) fprintf(stderr, "kernel_launch: occupancy query says %d\n", per_cu);
        (void)hipGetLastError();
        grid = cus;
    }
    if (grid < 0) return;
    (void)hipMemsetAsync((char*)d_ws + WS_CTL, 0, CTL_ZERO_BYTES, stream);
    Args a{};
    a.x = (const float*)d_in[0]; a.w_in_even = (const float*)d_in[1]; a.w_out_even = (const float*)d_in[2]; a.forget_bias = (const float*)d_in[3];
    a.w_in_odd = (const float*)d_in[4]; a.w_out_odd = (const float*)d_in[5]; a.lambda_q = (const float*)d_in[6]; a.lambda_k = (const float*)d_in[7];
    a.subln_gain = (const float*)d_in[8]; a.rel_bias = (const float*)d_in[9]; a.w_router = (const float*)d_in[10]; a.b_router = (const float*)d_in[11];
    a.w_gate = (const float*)d_in[12]; a.w_up = (const float*)d_in[13]; a.w_down = (const float*)d_in[14]; a.ln_gain = (const float*)d_in[15]; a.ln_bias = (const float*)d_in[16];
    a.out = (float*)d_out; a.ws = (unsigned char*)d_ws;
#if MK_FUSED
    a.ph_lo = 0; a.ph_hi = NPHASE;
    hipLaunchKernelGGL(fwd, dim3(grid), dim3(NTHREADS), LDS_BYTES, stream, a);
#else
    for (int p = 0; p < NPHASE; ++p) {  a.ph_lo = p; a.ph_hi = p + 1; hipLaunchKernelGGL(fwd, dim3(grid), dim3(NTHREADS), LDS_BYTES, stream, a); }
#endif
}
```

```cpp
#include <hip/hip_runtime.h>
#include <cstdio>
#include <cstdint>

namespace pg8 {
#define PG8_LAS __attribute__((address_space(3)))
typedef unsigned short bf16_t;
typedef short bf16x8 __attribute__((ext_vector_type(8)));
typedef float f32x4 __attribute__((ext_vector_type(4)));
typedef unsigned u32x4 __attribute__((ext_vector_type(4)));
constexpr int BM = 256, BK = 64, HALF = 128, HTB = HALF * BK * 2  , STAGE_BYTES = 8 * HTB, NXCD = 8, WGM = 8;

__host__ __device__ __forceinline__ int lds_byte(int r, int c) { const int st = (r >> 4) * 2 + (c >> 5), rr = r & 15, cc = c & 31, ob = rr * 64 + cc * 2; return st * 1024 + (ob ^ (((ob >> 9) & 1) << 5)); }
__host__ __device__ __forceinline__ void stage_rc(int b, int& R, int& C) { const int st = b / 1024, sb = b % 1024, swz = sb ^ (((sb >> 9) & 1) << 5); R = (st >> 1) * 16 + swz / 64; C = (st & 1) * 32 + (swz % 64) / 2; }
__host__ __device__ __forceinline__ int perm32(int rho) { const int n = rho >> 4, i = rho & 15; return 8 * (i >> 2) + 4 * n + (i & 3); }

struct Unit { int pm, pn, e, mi; };
struct Gemm { const bf16_t* A; const bf16_t* Bt; int M, N, K, rb; };

struct DenseOrder {
    static constexpr bool GATHER = false;
    int nM, nN, nwg, G, c;
    __device__ void init(int M, int N, int G_, int c_) { nM = M / BM; nN = N / BM; nwg = nM * nN; G = G_; c = c_; }
    __device__ bool next(int i, Unit& u) const {
        const long L = (long)i * G + c; if (L >= nwg) return false;
        int wgid = (int)L; { const int q = nwg / NXCD, r = nwg % NXCD, xcd = wgid % NXCD, off = wgid / NXCD; wgid = (xcd < r ? xcd * (q + 1) : r * (q + 1) + (xcd - r) * q) + off; }
        const int nig = WGM * nN, gid = wgid / nig, fm = gid * WGM, gsz = (nM - fm) < WGM ? (nM - fm) : WGM;
        u.pm = fm + ((wgid % nig) % gsz); u.pn = (wgid % nig) / gsz; u.e = 0; u.mi = 0; return true;
    }
    __device__ __forceinline__ unsigned a_off(const Gemm& g, const Unit& u) const { return (unsigned)u.pm * (unsigned)(2 * HALF) * (unsigned)g.rb; }
    __device__ __forceinline__ unsigned b_off(const Gemm& g, const Unit& u) const { return (unsigned)u.pn * (unsigned)(2 * HALF) * (unsigned)g.rb; }
    __device__ __forceinline__ void a_voff(const Gemm& g, const Unit&, const int (&R)[2], const int (&C)[2], unsigned (&vo)[2][2]) const {
#pragma unroll
        for (int h = 0; h < 2; ++h)
#pragma unroll
            for (int i = 0; i < 2; ++i) vo[h][i] = (unsigned)((h * HALF + R[i]) * g.rb + C[i] * 2);
    }
};

__device__ __forceinline__ unsigned cvt_pk_bf16(float lo, float hi) { unsigned r; asm volatile("v_cvt_pk_bf16_f32 %0, %1, %2" : "=v"(r) : "v"(lo), "v"(hi)); return r; }

struct EpiBf16 {
    static constexpr bool PERM = true;
    bf16_t* O; int ldc;
    __device__ __forceinline__ void operator()(const f32x4 (&acc)[2][2][4][2], const Unit& u, int wr, int wc, int fr, int fq) const {
        const int row0 = u.pm * BM + wr * 64 + fr; const int col0 = u.pn * BM + wc * 32 + 8 * fq;
#pragma unroll
        for (int ai = 0; ai < 2; ++ai)
#pragma unroll
            for (int m = 0; m < 4; ++m) { bf16_t* rowp = O + (size_t)(row0 + ai * HALF + m * 16) * ldc + col0;
#pragma unroll
                for (int bj = 0; bj < 2; ++bj) { const f32x4 v0 = acc[ai][bj][m][0], v1 = acc[ai][bj][m][1];
                    u32x4 w; w.x = cvt_pk_bf16(v0[0], v0[1]); w.y = cvt_pk_bf16(v0[2], v0[3]); w.z = cvt_pk_bf16(v1[0], v1[1]); w.w = cvt_pk_bf16(v1[2], v1[3]);
                    *(u32x4*)(rowp + bj * HALF) = w; }
                asm volatile("" ::: "memory"); }
    }
};

typedef int v8i_t __attribute__((ext_vector_type(8)));
typedef int v4i_t __attribute__((ext_vector_type(4)));
template <class Epi, class Sched, bool F8 = false, int SCW = 127, int SCX = 127>
__device__ __forceinline__ void gemm_phase(PG8_LAS unsigned char* lds, const Gemm g, const Sched& S, const Epi& E) {
    int tid_ = threadIdx.x; asm volatile("" : "+v"(tid_));
    const int tid = tid_, wid = __builtin_amdgcn_readfirstlane(tid >> 6), lane = tid & 63, wr = wid >> 2, wc = wid & 3, fr = lane & 15, fq = lane >> 4;
    const int RB = g.rb, nt = RB / 128;
    unsigned voffB0;
    { int R, C; stage_rc(tid * 16, R, C); const int Rb = Epi::PERM ? ((R & ~31) + perm32(R & 31)) : R; voffB0 = (unsigned)(Rb * RB + C * 2); }
#define PG8_AVOFF(unit, dst) do { int sR[2], sC[2]; int t2_ = threadIdx.x; asm volatile("" : "+v"(t2_)); stage_rc(t2_ * 16, sR[0], sC[0]); stage_rc(t2_ * 16 + 8192, sR[1], sC[1]); S.a_voff(g, unit, sR, sC, dst); } while (0)
    const unsigned kstep = (unsigned)(BK * 2);
    const unsigned hstep = (unsigned)HALF * (unsigned)RB;
    const __amdgpu_buffer_rsrc_t rsA = __builtin_amdgcn_make_buffer_rsrc((void*)g.A, 0, 0x7ffffff0, 0x00020000), rsB = __builtin_amdgcn_make_buffer_rsrc((void*)g.Bt, 0, 0x7ffffff0, 0x00020000);
    const unsigned ldsw = (unsigned)wid * 1024u;
    const int aoff = lds_byte(wr * 64 + fr, fq * (F8 ? 16 : 8)), boff = lds_byte(wc * 32 + fr, fq * (F8 ? 16 : 8));
    constexpr int KOFF = F8 ? 16 : 1024;
#define PG8_SA(b, h) (((b) * 2 + (h)) * HTB)
#define PG8_SB(b, h) ((4 + (b) * 2 + (h)) * HTB)
#define PG8_STAGE_B(bufoff, soff) do { _Pragma("unroll") for (int _i = 0; _i < 2; ++_i) \
        __builtin_amdgcn_raw_ptr_buffer_load_lds(rsB, (PG8_LAS void*)(lds + (bufoff) + ldsw + _i * 8192), 16, (int)voffB0, (int)((soff) + (unsigned)_i * 64u * (unsigned)RB), 0, 0); } while (0)
#define PG8_STAGE_A(bufoff, soff, vset, h) do { _Pragma("unroll") for (int _i = 0; _i < 2; ++_i) { \
        if constexpr (Sched::GATHER) __builtin_amdgcn_raw_ptr_buffer_load_lds(rsA, (PG8_LAS void*)(lds + (bufoff) + ldsw + _i * 8192), 16, (int)(vset)[h][_i], (int)(soff), 0, 0); \
        else __builtin_amdgcn_raw_ptr_buffer_load_lds(rsA, (PG8_LAS void*)(lds + (bufoff) + ldsw + _i * 8192), 16, (int)(vset)[0][0], (int)((soff) + (unsigned)((h) * 128 + _i * 64) * (unsigned)RB), 0, 0); } } while (0)
#define PG8_LD8(addr) __builtin_shufflevector(*(const PG8_LAS v4i_t*)(addr), *(const PG8_LAS v4i_t*)((addr) + 16), 0, 1, 2, 3, 4, 5, 6, 7)
#define PG8_LDA8(dst, b, h) do { _Pragma("unroll") for (int m = 0; m < 4; ++m) dst[m] = PG8_LD8(lds + PG8_SA(b, h) + aoff + m * 2048); } while (0)
#define PG8_LDB8(dst, b, h) do { _Pragma("unroll") for (int n = 0; n < 2; ++n) dst[n] = PG8_LD8(lds + PG8_SB(b, h) + boff + n * 2048); } while (0)
#define PG8_MMA8(ai, bj, At, Bt) do { __builtin_amdgcn_s_setprio(1); _Pragma("unroll") for (int m = 0; m < 4; ++m) _Pragma("unroll") for (int n = 0; n < 2; ++n) \
        acc[ai][bj][m][n] = __builtin_amdgcn_mfma_scale_f32_16x16x128_f8f6f4(Bt[n], At[m], acc[ai][bj][m][n], 0, 0, 0, SCW, 0, SCX); __builtin_amdgcn_s_setprio(0); } while (0)
#define PG8_LDA(dst, b, h) do { _Pragma("unroll") for (int m = 0; m < 4; ++m) _Pragma("unroll") for (int k = 0; k < 2; ++k) dst[m][k] = *(const PG8_LAS bf16x8*)(lds + PG8_SA(b, h) + aoff + m * 2048 + k * KOFF); } while (0)
#define PG8_LDB(dst, b, h) do { _Pragma("unroll") for (int n = 0; n < 2; ++n) _Pragma("unroll") for (int k = 0; k < 2; ++k) dst[n][k] = *(const PG8_LAS bf16x8*)(lds + PG8_SB(b, h) + boff + n * 2048 + k * KOFF); } while (0)
#define PG8_MMA(ai, bj, At, Bt) do { __builtin_amdgcn_s_setprio(1); _Pragma("unroll") for (int m = 0; m < 4; ++m) _Pragma("unroll") for (int n = 0; n < 2; ++n) _Pragma("unroll") for (int k = 0; k < 2; ++k) \
        acc[ai][bj][m][n] = __builtin_amdgcn_mfma_f32_16x16x32_bf16(Bt[n][k], At[m][k], acc[ai][bj][m][n], 0, 0, 0); __builtin_amdgcn_s_setprio(0); } while (0)
#define PG8_WAIT_V(n) asm volatile("s_waitcnt vmcnt(" #n ")" ::: "memory")
#define PG8_WAIT_L(n) asm volatile("s_waitcnt lgkmcnt(" #n ")" ::: "memory")
#define PG8_BAR __builtin_amdgcn_s_barrier()
#define PG8_SCHED __builtin_amdgcn_sched_barrier(0)
    Unit cur, nxt; int ui = 0;
    if (!S.next(0, cur)) return;
    f32x4 acc[2][2][4][2];
#pragma unroll
    for (int a = 0; a < 2; ++a)
#pragma unroll
        for (int b = 0; b < 2; ++b)
#pragma unroll
            for (int m = 0; m < 4; ++m)
#pragma unroll
                for (int n = 0; n < 2; ++n) acc[a][b][m][n] = (f32x4){0.f, 0.f, 0.f, 0.f};
    bf16x8 At[4][2], B0[2][2], B1[2][2];
    v8i_t At8[4], B08[2], B18[2];
    unsigned vAc[2][2], vAn[2][2];
    PG8_AVOFF(cur, vAc);
    if constexpr (Sched::GATHER) { asm volatile("s_waitcnt vmcnt(0)" ::: "memory"); asm volatile("" : "+v"(vAc[0][0]), "+v"(vAc[0][1]), "+v"(vAc[1][0]), "+v"(vAc[1][1])); }
    unsigned cA = S.a_off(g, cur), cB = S.b_off(g, cur);
    PG8_STAGE_B(PG8_SB(0, 0), cB); PG8_STAGE_B(PG8_SB(0, 1), cB + hstep); PG8_STAGE_A(PG8_SA(0, 0), cA, vAc, 0); PG8_STAGE_A(PG8_SA(0, 1), cA, vAc, 1);
    if (wr == 1) PG8_BAR;
    PG8_WAIT_V(2); PG8_BAR;
    PG8_STAGE_B(PG8_SB(1, 0), cB + kstep); PG8_STAGE_A(PG8_SA(1, 0), cA + kstep, vAc, 0); PG8_STAGE_B(PG8_SB(1, 1), cB + hstep + kstep);
    PG8_WAIT_V(6); PG8_BAR;
#pragma nounroll
    for (;;) {
        const bool has_next = S.next(ui + 1, nxt);
        if constexpr (Sched::GATHER) {
            if (has_next) { PG8_AVOFF(nxt, vAn); asm volatile("s_waitcnt vmcnt(0)" ::: "memory"); }
            else {
#pragma unroll
                for (int h = 0; h < 2; ++h)
#pragma unroll
                    for (int i = 0; i < 2; ++i) vAn[h][i] = vAc[h][i]; }
            asm volatile("" : "+v"(vAn[0][0]), "+v"(vAn[0][1]), "+v"(vAn[1][0]), "+v"(vAn[1][1]));
        } else {
#pragma unroll
            for (int h = 0; h < 2; ++h)
#pragma unroll
                for (int i = 0; i < 2; ++i) vAn[h][i] = vAc[h][i];
        }
        const unsigned nA = has_next ? S.a_off(g, nxt) : cA, nB = has_next ? S.b_off(g, nxt) : cB;
#pragma unroll 1
        for (int t = 0; t < nt; t += 2) {
            const bool last = (t == nt - 2);
            const unsigned a1 = cA + (unsigned)(t + 1) * kstep;
            const unsigned a2 = last ? nA : cA + (unsigned)(t + 2) * kstep, b2 = last ? nB : cB + (unsigned)(t + 2) * kstep;
            const unsigned a3 = a2 + kstep, b3 = b2 + kstep;
            unsigned v2[2][2];
#pragma unroll
            for (int h = 0; h < 2; ++h)
#pragma unroll
                for (int i = 0; i < 2; ++i) { if constexpr (Sched::GATHER) v2[h][i] = last ? vAn[h][i] : vAc[h][i]; else v2[h][i] = vAc[h][i]; }
            if constexpr (F8) {
            PG8_LDB8(B08, 0, 0); PG8_LDB8(B18, 0, 1); PG8_SCHED; PG8_LDA8(At8, 0, 0); PG8_STAGE_A(PG8_SA(1, 1), a1, vAc, 1);
            PG8_WAIT_V(8); PG8_WAIT_L(0); PG8_BAR; PG8_MMA8(0, 0, At8, B08); PG8_MMA8(0, 1, At8, B18); PG8_BAR; PG8_SCHED;
            PG8_LDA8(At8, 0, 1); PG8_STAGE_B(PG8_SB(0, 0), b2); PG8_STAGE_B(PG8_SB(0, 1), b2 + hstep); PG8_STAGE_A(PG8_SA(0, 0), a2, v2, 0);
            PG8_WAIT_V(8); PG8_WAIT_L(0); PG8_BAR; PG8_MMA8(1, 0, At8, B08); PG8_MMA8(1, 1, At8, B18); PG8_BAR; PG8_SCHED;
            PG8_LDB8(B08, 1, 0); PG8_LDB8(B18, 1, 1); PG8_SCHED; PG8_LDA8(At8, 1, 0); PG8_STAGE_A(PG8_SA(0, 1), a2, v2, 1);
            PG8_WAIT_V(8); PG8_WAIT_L(0); PG8_BAR; PG8_MMA8(0, 0, At8, B08); PG8_MMA8(0, 1, At8, B18); PG8_BAR; PG8_SCHED;
            PG8_LDA8(At8, 1, 1); PG8_STAGE_B(PG8_SB(1, 0), b3); PG8_STAGE_B(PG8_SB(1, 1), b3 + hstep); PG8_STAGE_A(PG8_SA(1, 0), a3, v2, 0);
            PG8_WAIT_V(8); PG8_WAIT_L(0); PG8_BAR; PG8_MMA8(1, 0, At8, B08); PG8_MMA8(1, 1, At8, B18); PG8_BAR; PG8_SCHED;
            } else {
            PG8_LDB(B0, 0, 0); PG8_LDB(B1, 0, 1); PG8_SCHED; PG8_LDA(At, 0, 0); PG8_STAGE_A(PG8_SA(1, 1), a1, vAc, 1);
            PG8_WAIT_V(8); PG8_WAIT_L(0); PG8_BAR; PG8_MMA(0, 0, At, B0); PG8_MMA(0, 1, At, B1); PG8_BAR; PG8_SCHED;
            PG8_LDA(At, 0, 1); PG8_STAGE_B(PG8_SB(0, 0), b2); PG8_STAGE_B(PG8_SB(0, 1), b2 + hstep); PG8_STAGE_A(PG8_SA(0, 0), a2, v2, 0);
            PG8_WAIT_V(8); PG8_WAIT_L(0); PG8_BAR; PG8_MMA(1, 0, At, B0); PG8_MMA(1, 1, At, B1); PG8_BAR; PG8_SCHED;
            PG8_LDB(B0, 1, 0); PG8_LDB(B1, 1, 1); PG8_SCHED; PG8_LDA(At, 1, 0); PG8_STAGE_A(PG8_SA(0, 1), a2, v2, 1);
            PG8_WAIT_V(8); PG8_WAIT_L(0); PG8_BAR; PG8_MMA(0, 0, At, B0); PG8_MMA(0, 1, At, B1); PG8_BAR; PG8_SCHED;
            PG8_LDA(At, 1, 1); PG8_STAGE_B(PG8_SB(1, 0), b3); PG8_STAGE_B(PG8_SB(1, 1), b3 + hstep); PG8_STAGE_A(PG8_SA(1, 0), a3, v2, 0);
            PG8_WAIT_V(8); PG8_WAIT_L(0); PG8_BAR; PG8_MMA(1, 0, At, B0); PG8_MMA(1, 1, At, B1); PG8_BAR; PG8_SCHED;
            }
        }
        if (wr == 0) PG8_BAR;
        { int t_ = threadIdx.x; asm volatile("" : "+v"(t_)); const int l_ = t_ & 63; E(acc, cur, wr, wc, l_ & 15, l_ >> 4); }
        if (!has_next) break;
#pragma unroll
        for (int a = 0; a < 2; ++a)
#pragma unroll
            for (int b = 0; b < 2; ++b)
#pragma unroll
                for (int m = 0; m < 4; ++m)
#pragma unroll
                    for (int n = 0; n < 2; ++n) acc[a][b][m][n] = (f32x4){0.f, 0.f, 0.f, 0.f};
        cur = nxt; cA = nA; cB = nB; ++ui;
#pragma unroll
        for (int h = 0; h < 2; ++h)
#pragma unroll
            for (int i = 0; i < 2; ++i) vAc[h][i] = vAn[h][i];
        if (wr == 1) PG8_BAR;
    }
    PG8_WAIT_V(0);
    PG8_BAR;
#undef PG8_SA
#undef PG8_SB
#undef PG8_STAGE_A
#undef PG8_STAGE_B
#undef PG8_LDA
#undef PG8_LDB
#undef PG8_MMA
#undef PG8_AVOFF
#undef PG8_MMA8
#undef PG8_LD8
#undef PG8_LDA8
#undef PG8_LDB8
#undef PG8_WAIT_V
#undef PG8_WAIT_L
#undef PG8_BAR
#undef PG8_SCHED
}
}

#ifndef L1IN_F8
#define L1IN_F8 1
#endif
#ifndef DBL_PHASE
#define DBL_PHASE -1
#endif
#ifndef TEST_ATT
#define TEST_ATT 0
#endif
#ifndef TEST_C0
#define TEST_C0 0
#define TEST_NC 2048
#endif
#ifndef TEST_RLO
#define TEST_RLO 0
#define TEST_RHI 256
#endif
#ifndef SB_TRIVIAL
#define SB_TRIVIAL 0
#endif
#ifndef SB_R2PROBE
#define SB_R2PROBE 0
#endif
#ifndef TEST_BADVAL
#define TEST_BADVAL 1e6f
#endif
#ifndef TEST_NANCOUNT
#define TEST_NANCOUNT 0
#endif
#ifndef TEST_GAIN
#define TEST_GAIN 4.0f
#endif
constexpr int SEQ = 16384, DM = 2048, NHEADS = 16, HD = 128, NEXP = 16, DEXP = 1024, NQKV = 6144, NIN0 = 6152;
constexpr float ALPHA = 1.4142135623730951f;
constexpr float LN_EPS = 1e-5f;
constexpr float SCALE128 = 0.08838834764831845f;
constexpr float SCALE64 = 0.125f;
constexpr float LAMBDA_INIT = 0.8f - 0.6f * 0.7408182206817179f;
constexpr int NWAVES = 8, NTHREADS = 512;

constexpr size_t MiB = (size_t)1 << 20;
constexpr size_t WS_CTL = 0, CTL_ZERO_BYTES = 1 * MiB;
constexpr size_t WS_KMEAN = 1 * MiB;
constexpr size_t WS_LOGF = WS_KMEAN + 262144;
constexpr size_t WS_CLOC = WS_LOGF + 524288;
constexpr size_t WS_C = WS_CLOC + 524288;
constexpr size_t WS_CTOT = WS_C + 524288;
constexpr size_t WS_LUT = WS_CTOT + 4096;
constexpr size_t WS_LAM = WS_LUT + 32768;
constexpr size_t WS_MLIST = 4 * MiB;
constexpr size_t WS_MGW = 6 * MiB;
constexpr size_t WS_WIN0 = 8 * MiB, WS_WOUT0 = 32 * MiB, WS_WIN1 = 40 * MiB, WS_WOUT1 = 64 * MiB;
constexpr size_t WS_WGU = 72 * MiB;
constexpr size_t WS_WDN = 328 * MiB;
constexpr size_t WS_XB = 456 * MiB;
constexpr size_t WS_H = 520 * MiB;
constexpr size_t WS_O = 712 * MiB;
constexpr size_t WS_Y = 776 * MiB;
constexpr size_t WS_X1 = 840 * MiB;
constexpr size_t WS_X1F8 = 904 * MiB;
constexpr size_t WS_END = 936 * MiB;
constexpr size_t WS_YSLOT = WS_H;
constexpr size_t WS_HID = WS_O;
constexpr int HID_ROWS = 36864;
constexpr size_t DO_SEL = 0;

constexpr int CW_TMO = 0;
constexpr int CW_BAR = 4096;
constexpr int CW_MOECNT = 8192;
constexpr int CW_MOBACNT = 9216;

constexpr int RING_BYTES = 147456;
constexpr int LCTL_OFF = RING_BYTES;
constexpr int LDS_BYTES = 155648;

#define GAS __attribute__((address_space(1)))
#define LAS __attribute__((address_space(3)))
typedef unsigned short bf16;
typedef unsigned v4u __attribute__((ext_vector_type(4)));
typedef unsigned v2u __attribute__((ext_vector_type(2)));
typedef float f32x4 __attribute__((ext_vector_type(4)));
typedef short bf16x8 __attribute__((ext_vector_type(8)));
typedef GAS unsigned gu32;
#define RLX_AGENT __ATOMIC_RELAXED, __HIP_MEMORY_SCOPE_AGENT
#define LDS_WAIT() asm volatile("s_waitcnt lgkmcnt(0)" ::: "memory")
__device__ __forceinline__ unsigned f2bf(float f) { unsigned u = __builtin_bit_cast(unsigned, f); return (u + 0x7fffu + ((u >> 16) & 1u)) >> 16; }
__device__ __forceinline__ unsigned pk2(float lo, float hi) { return f2bf(lo) | (f2bf(hi) << 16); }
__device__ __forceinline__ unsigned pk4_fp8(float a, float b, float c, float d) { int w = 0; w = __builtin_amdgcn_cvt_pk_fp8_f32(a, b, w, false); w = __builtin_amdgcn_cvt_pk_fp8_f32(c, d, w, true); return (unsigned)w; }
__device__ __forceinline__ float bf2f(unsigned short b) { return __builtin_bit_cast(float, (unsigned)b << 16); }
__device__ __forceinline__ float bflo(unsigned w) { return __builtin_bit_cast(float, w << 16); }
__device__ __forceinline__ float bfhi(unsigned w) { return __builtin_bit_cast(float, w & 0xffff0000u); }
__device__ __forceinline__ int fresh_tid() { int t = threadIdx.x; asm volatile("" : "+v"(t)); return t; }
__device__ __forceinline__ float wave_sum(float v) {
#define WS_DPP(x, ctrl) __builtin_bit_cast(float, __builtin_amdgcn_mov_dpp(__builtin_bit_cast(int, x), ctrl, 0xf, 0xf, true))
    v += WS_DPP(v, 0x128); v += WS_DPP(v, 0x124); v += WS_DPP(v, 0x122); v += WS_DPP(v, 0x121);
#undef WS_DPP
#define WS_RL(l) __builtin_bit_cast(float, __builtin_amdgcn_readlane(__builtin_bit_cast(int, v), l))
    const float a = WS_RL(0), b = WS_RL(16), c = WS_RL(32), d = WS_RL(48);
#undef WS_RL
    return (a + b) + (c + d);
}
__device__ __forceinline__ float log_sigmoid(float v) { return fminf(v, 0.f) - log1pf(__expf(-fabsf(v))); }

#define XB_TMO      128
#define XB_XCNT(j)  (256  + 64 * (j))
#define XB_XSUB(j)  (1280 + 64 * (j))
#define XB_XGEN(j)  (2304 + 64 * (j))
#define XB_TOP      3328
#define XB_TOPGEN   3392
#define XCD_BAR_WORDS 3456
#define XB_SPIN_CAP (1u << 22)
#ifndef XB_FLAT
#define XB_FLAT 1
#endif
__device__ __forceinline__ unsigned xb_ld(unsigned* p)              { return __hip_atomic_load(p, __ATOMIC_RELAXED, __HIP_MEMORY_SCOPE_AGENT); }
__device__ __forceinline__ unsigned xb_add(unsigned* p, unsigned v) { return __hip_atomic_fetch_add(p, v, __ATOMIC_RELAXED, __HIP_MEMORY_SCOPE_AGENT); }
__device__ __forceinline__ unsigned xb_xcc_id() { return (unsigned)__builtin_amdgcn_s_getreg((3 << 11) | 20) & 0xFu; }
#define XB_SPIN(cond, bar) do { unsigned _sp = 0; while (cond) { __builtin_amdgcn_s_sleep(1); \
    if ((++_sp & 255u) == 0u) { if (xb_ld(&(bar)[XB_TMO])) break; if (_sp > XB_SPIN_CAP) { atomicAdd(&(bar)[XB_TMO], 1u); break; } } } } while (0)
struct XcdBarrier { unsigned* bar; unsigned x; volatile LAS unsigned* st; };
__device__ __forceinline__ XcdBarrier xcd_barrier_post(unsigned* bar, volatile LAS unsigned* st) {
    XcdBarrier b; b.bar = bar; b.x = xb_xcc_id(); b.st = st;
    if (threadIdx.x == 0) (void)xb_add(&bar[XB_XCNT(b.x)], 1u);
    return b;
}
__device__ __forceinline__ void xcd_barrier_complete(unsigned* bar, unsigned x, unsigned& nloc, unsigned& nx) {
    const unsigned G = gridDim.x * gridDim.y * gridDim.z;
    unsigned sum, cnt, mine, sp = 0u;
    for (;;) {
        sum = 0u; cnt = 0u; mine = 0u;
#pragma unroll
        for (unsigned j = 0; j < 16; ++j) { const unsigned c = xb_ld(&bar[XB_XCNT(j)]); sum += c; cnt += (c > 0u) ? 1u : 0u; mine = (j == x) ? c : mine; }
        if (sum == G) break;
        __builtin_amdgcn_s_sleep(1);
        if ((++sp & 255u) == 0u) { if (xb_ld(&bar[XB_TMO])) break; if (sp > XB_SPIN_CAP) { atomicAdd(&bar[XB_TMO], 1u); break; } }
    }
    nloc = mine > 0u ? mine : 1u; nx = cnt > 0u ? cnt : 1u;
}
__device__ __forceinline__ void xcd_barrier(const XcdBarrier& b) {
    asm volatile("s_waitcnt vmcnt(0)" ::: "memory");
    __syncthreads();
    if (threadIdx.x == 0) {
        unsigned* bar = b.bar;
        __builtin_amdgcn_s_waitcnt(0);
        unsigned nloc = b.st[0], nx = b.st[1];
        if (nloc == 0u) { xcd_barrier_complete(bar, b.x, nloc, nx); b.st[0] = nloc; b.st[1] = nx; }
        const unsigned old = xb_add(&bar[XB_XSUB(b.x)], 1u);
        const unsigned gen = old / nloc;
#if XB_FLAT
        if (old + 1u == (gen + 1u) * nloc) {
            __builtin_amdgcn_fence(__ATOMIC_RELEASE, "agent");
            asm volatile("s_waitcnt vmcnt(0)" ::: "memory");
            const unsigned og = xb_add(&bar[XB_TOP], 1u);
            const unsigned tg = og / nx;
            if (og + 1u == (tg + 1u) * nx) xb_add(&bar[XB_TOPGEN], 1u);
        }
        XB_SPIN(xb_ld(&bar[XB_TOPGEN]) == gen, bar);
        __builtin_amdgcn_fence(__ATOMIC_ACQUIRE, "agent");
        asm volatile("s_waitcnt vmcnt(0)" ::: "memory");
#else
        if (old + 1u == (gen + 1u) * nloc) {
            __builtin_amdgcn_fence(__ATOMIC_RELEASE, "agent");
            asm volatile("s_waitcnt vmcnt(0)" ::: "memory");
            const unsigned og = xb_add(&bar[XB_TOP], 1u);
            const unsigned tg = og / nx;
            if (og + 1u == (tg + 1u) * nx) xb_add(&bar[XB_TOPGEN], 1u);
            else XB_SPIN(xb_ld(&bar[XB_TOPGEN]) == tg, bar);
            __builtin_amdgcn_fence(__ATOMIC_ACQUIRE, "agent");
            xb_add(&bar[XB_XGEN(b.x)], 1u);
            asm volatile("s_waitcnt vmcnt(0)" ::: "memory");
        } else {
            XB_SPIN(xb_ld(&bar[XB_XGEN(b.x)]) == gen, bar);
            __builtin_amdgcn_fence(__ATOMIC_ACQUIRE, "agent");
            asm volatile("s_waitcnt vmcnt(0)" ::: "memory");
        }
#endif
    }
    __syncthreads();
}

struct Args {
    const float* x; const float* w_in_even; const float* w_out_even; const float* forget_bias; const float* w_in_odd; const float* w_out_odd;
    const float* lambda_q; const float* lambda_k; const float* subln_gain; const float* rel_bias; const float* w_router; const float* b_router;
    const float* w_gate; const float* w_up; const float* w_down; const float* ln_gain; const float* ln_bias;
    float* out; unsigned char* ws; int ph_lo, ph_hi;
};

struct P0Tile { const float* src; unsigned char* dst; int ldw, ldk, n0, gu; };
__device__ __forceinline__ P0Tile p0_decode(const Args& A, unsigned char* ws, int it) {
    constexpr int T_IN = 8 * 48, T_OUT = 8 * 16, T_EXP = 32 * 64;
    int r = it; const float* W; unsigned char* WT; int ldw, sc0, k0, ldk, n0, gu = 0;
    if (r < T_IN) { const int kb = r / 48, nb = r % 48; n0 = nb * 128; W = A.w_in_even; ldw = NIN0; sc0 = n0 + (n0 >= 3072 ? 8 : 0); k0 = kb * 256; WT = ws + WS_WIN0; ldk = DM; }
    else if (r < T_IN + T_OUT) { r -= T_IN; const int kb = r >> 4, nb = r & 15; n0 = nb * 128; W = A.w_out_even; ldw = DM; sc0 = n0; k0 = kb * 256; WT = ws + WS_WOUT0; ldk = DM; }
    else if (r < 2 * T_IN + T_OUT) { r -= T_IN + T_OUT; const int kb = r / 48, nb = r % 48; n0 = nb * 128; W = A.w_in_odd; ldw = NQKV; sc0 = n0; k0 = kb * 256; WT = ws + WS_WIN1; ldk = DM; }
    else if (r < 2 * T_IN + 2 * T_OUT) { r -= 2 * T_IN + T_OUT; const int kb = r >> 4, nb = r & 15; n0 = nb * 128; W = A.w_out_odd; ldw = DM; sc0 = n0; k0 = kb * 256; WT = ws + WS_WOUT1; ldk = DM; }
    else if (r < 2 * T_IN + 2 * T_OUT + 2 * T_EXP) {
        r -= 2 * T_IN + 2 * T_OUT; const int isup = r >= T_EXP; if (isup) r -= T_EXP;
        const int le = r >> 6, q = r & 63, kb = q >> 3, nb = q & 7; n0 = nb * 128;
        W = (isup ? A.w_up : A.w_gate) + (size_t)le * DM * DEXP; ldw = DEXP; sc0 = n0; k0 = kb * 256; WT = ws + WS_WGU + (size_t)le * 2048 * 2048; ldk = DM; gu = 1 + isup; }
    else { r -= 2 * T_IN + 2 * T_OUT + 2 * T_EXP; const int le = r >> 6, q = r & 63, kb = q >> 4, nb = q & 15; n0 = nb * 128;
        W = A.w_down + (size_t)le * DEXP * DM; ldw = DM; sc0 = n0; k0 = kb * 256; WT = ws + WS_WDN + (size_t)le * 2048 * 1024; ldk = DEXP; }
    P0Tile p; p.src = W + (size_t)k0 * ldw + sc0; p.dst = WT + k0; p.ldw = ldw; p.ldk = ldk; p.n0 = n0; p.gu = gu;
    return p;
}
__device__ __forceinline__ void p0_prologue(const Args& A, LAS unsigned char* lds, int G) {
    const int tid = fresh_tid(), lane = tid & 63, wave = __builtin_amdgcn_readfirstlane(tid >> 6);
    const int gw = blockIdx.x * NWAVES + wave, NGW = G * NWAVES;
    unsigned char* ws = A.ws;
    constexpr int NTILES = 2 * (16 * 24) + 2 * (16 * 8) + 3 * 32 * 64;
    f32x4 vA[16], vB[16];
    const int h = lane >> 5, c = lane & 31;
    int it = blockIdx.x, buf = 0;
#define P0_ISSUE(V, T) do { _Pragma("unroll") for (int i = 0; i < 16; ++i) V[i] = __builtin_nontemporal_load((const GAS f32x4*)((T).src + (size_t)(32 * wave + 16 * h + i) * (T).ldw + 4 * c)); } while (0)
#define P0_CONVERT(V, tb) do { _Pragma("unroll") for (int j = 0; j < 4; ++j) { v4u w; \
            w.x = pk4_fp8(V[0][j] * 32.f, V[1][j] * 32.f, V[2][j] * 32.f, V[3][j] * 32.f);     w.y = pk4_fp8(V[4][j] * 32.f, V[5][j] * 32.f, V[6][j] * 32.f, V[7][j] * 32.f); \
            w.z = pk4_fp8(V[8][j] * 32.f, V[9][j] * 32.f, V[10][j] * 32.f, V[11][j] * 32.f);  w.w = pk4_fp8(V[12][j] * 32.f, V[13][j] * 32.f, V[14][j] * 32.f, V[15][j] * 32.f); \
            *(LAS v4u*)((tb) + (4 * c + j) * 256 + (((2 * wave + h) ^ (c & 15)) * 16)) = w; } } while (0)
#define P0_WRITEOUT(T, tb) do { _Pragma("unroll") for (int p = 0; p < 4; ++p) { const int n = p * 32 + (tid >> 4), ch = tid & 15, nn = (T).n0 + n; \
            const v4u d = *(const LAS v4u*)((tb) + n * 256 + ((ch ^ ((n >> 2) & 15)) * 16)); \
            const int drow = (T).gu ? ((nn >> 7) * 256 + (nn & 127) + ((T).gu == 2 ? 128 : 0)) : nn; \
            *(GAS v4u*)((T).dst + (size_t)drow * (T).ldk + 16 * ch) = d; } } while (0)
    P0Tile cur = p0_decode(A, ws, it < NTILES ? it : 0);
    if (it < NTILES) P0_ISSUE(vA, cur);
    for (; it < NTILES; it += 2 * G) {
        {   const int nit = it + G; const P0Tile nxt = p0_decode(A, ws, nit < NTILES ? nit : 0);
            if (nit < NTILES) P0_ISSUE(vB, nxt);
            LAS unsigned char* tb = lds + buf * 32768;
            P0_CONVERT(vA, tb);
            __syncthreads();
            P0_WRITEOUT(cur, tb);
            cur = nxt; buf ^= 1;
            if (nit >= NTILES) break; }
        {   const int nit = it + 2 * G; const P0Tile nxt = p0_decode(A, ws, nit < NTILES ? nit : 0);
            if (nit < NTILES) P0_ISSUE(vA, nxt);
            LAS unsigned char* tb = lds + buf * 32768;
            P0_CONVERT(vB, tb);
            __syncthreads();
            P0_WRITEOUT(cur, tb);
            cur = nxt; buf ^= 1; }
    }
#undef P0_ISSUE
#undef P0_CONVERT
#undef P0_WRITEOUT
    __syncthreads();
    LAS float* wfa = (LAS float*)lds;
    for (int idx = tid; idx < 8 * DM; idx += NTHREADS) { const int d = idx >> 3, j = idx & 7; wfa[j * DM + d] = A.w_in_even[(size_t)d * NIN0 + 3072 + j]; }
    __syncthreads();
    float* logf = (float*)(ws + WS_LOGF); bf16* xb = (bf16*)(ws + WS_XB);
    for (int m = gw; m < SEQ; m += 2 * NGW) {
        const int mB = (m + NGW < SEQ) ? m + NGW : m;
        const GAS f32x4* xr = (const GAS f32x4*)(A.x + (size_t)m * DM) + lane; const GAS f32x4* xrB = (const GAS f32x4*)(A.x + (size_t)mB * DM) + lane;
        f32x4 v[8], vB[8];
#pragma unroll
        for (int j = 0; j < 8; ++j) { v[j] = xr[64 * j]; vB[j] = xrB[64 * j]; }
        GAS unsigned* o8 = (GAS unsigned*)((unsigned char*)xb + (size_t)m * DM) + lane;
        GAS unsigned* o8B = (GAS unsigned*)((unsigned char*)xb + (size_t)mB * DM) + lane;
#pragma unroll
        for (int j = 0; j < 8; ++j) { o8[64 * j] = pk4_fp8(v[j].x, v[j].y, v[j].z, v[j].w); o8B[64 * j] = pk4_fp8(vB[j].x, vB[j].y, vB[j].z, vB[j].w); }
        float mine = 0.f, mineB = 0.f;
#pragma unroll 1
        for (int e = 0; e < 8; ++e) { float s = 0.f, sB = 0.f;
#pragma unroll
            for (int j = 0; j < 8; ++j) { const f32x4 w = *(const LAS f32x4*)(wfa + e * DM + 256 * j + 4 * lane);
                s += v[j].x * w.x + v[j].y * w.y + v[j].z * w.z + v[j].w * w.w; sB += vB[j].x * w.x + vB[j].y * w.y + vB[j].z * w.z + vB[j].w * w.w; }
            s = wave_sum(s); sB = wave_sum(sB); mine = (lane == e) ? s : mine; mineB = (lane == e) ? sB : mineB; }
        if (lane < 8) { const float fb = A.forget_bias[lane]; logf[lane * SEQ + m] = log_sigmoid(mine + fb); logf[lane * SEQ + mB] = log_sigmoid(mineB + fb); }
    }
    {
        float* lut = (float*)(ws + WS_LUT);
        for (int idx = blockIdx.x * NTHREADS + tid; idx < 8 * 1024; idx += G * NTHREADS) { const int hh = idx >> 10, d = idx & 1023;
            int b; if (d < 16) b = d; else { b = 16 + (int)(log((double)d / 16.0) / log(64.0) * 16.0 + 1e-9); b = b > 31 ? 31 : b; }
            lut[idx] = A.rel_bias[b * 8 + hh]; }
        if (tid == 0 && blockIdx.x == 0) { float s0 = 0.f, s1 = 0.f; for (int d = 0; d < 64; ++d) { s0 += A.lambda_q[d] * A.lambda_k[d]; s1 += A.lambda_q[64 + d] * A.lambda_k[64 + d]; }
            ((float*)(ws + WS_LAM))[0] = expf(s0) - expf(s1) + LAMBDA_INIT; }
    }
}

__device__ __forceinline__ void p2_kmean_cumsum(const Args& A, char* lds, int G) {
    const int tid = fresh_tid(), lane = tid & 63, wave = tid >> 6;
    const bf16* h = (const bf16*)(A.ws + WS_H);
    float* red = (float*)lds;
    for (int u = blockIdx.x; u < 1536; u += G) {
        if (u >= 1024) {
            const int v = u - 1024, hd = v >> 6, n = v & 63, c = tid & 15, g = tid >> 4; float mx = 0.f;
            for (int i = 0; i < 8; ++i) { const v4u w = *(const v4u*)(h + (size_t)(n * 256 + g + 32 * i) * NQKV + 1024 + hd * 128 + c * 8);
                float s = bflo(w.x) * bflo(w.x) + bfhi(w.x) * bfhi(w.x) + bflo(w.y) * bflo(w.y) + bfhi(w.y) * bfhi(w.y) + bflo(w.z) * bflo(w.z) + bfhi(w.z) * bfhi(w.z) + bflo(w.w) * bflo(w.w) + bfhi(w.w) * bfhi(w.w);
                s += __shfl_xor(s, 1); s += __shfl_xor(s, 2); s += __shfl_xor(s, 4); s += __shfl_xor(s, 8); mx = fmaxf(mx, s); }
            for (int o = 16; o < 64; o <<= 1) mx = fmaxf(mx, __shfl_xor(mx, o));
            if (lane == 0) atomicMax((unsigned*)(A.ws + WS_CTL) + 10496 + hd, __float_as_uint(mx));
        } else if (u < 512) {
            const int hd = u >> 6, n = u & 63, c = tid & 15, g = tid >> 4;
            float s[8] = {0, 0, 0, 0, 0, 0, 0, 0};
            for (int i = 0; i < 8; ++i) { const v4u w = *(const v4u*)(h + (size_t)(n * 256 + g + 32 * i) * NQKV + 4096 + hd * 128 + c * 8);
                s[0] += bflo(w.x); s[1] += bfhi(w.x); s[2] += bflo(w.y); s[3] += bfhi(w.y); s[4] += bflo(w.z); s[5] += bfhi(w.z); s[6] += bflo(w.w); s[7] += bfhi(w.w); }
            for (int j = 0; j < 8; ++j) red[g * 128 + c * 8 + j] = s[j];
            __syncthreads();
            if (tid < 128) { float t = 0.f; for (int gg = 0; gg < 32; ++gg) t += red[gg * 128 + tid]; ((float*)(A.ws + WS_KMEAN))[(size_t)u * 128 + tid] = t * (1.f / 256.f); }
            __syncthreads();
        } else {
            const int v = u - 512, hd = v >> 6, ch = v & 63;
            const float* lf = (const float*)(A.ws + WS_LOGF) + hd * SEQ + ch * 256;
            float x = (tid < 256) ? lf[tid] : 0.f;
            for (int o = 1; o < 64; o <<= 1) { const float y = __shfl_up(x, o); if (lane >= o) x += y; }
            if (lane == 63 && wave < 4) red[wave] = x;
            __syncthreads();
            if (tid < 256) { float pre = 0.f; for (int w = 0; w < wave; ++w) pre += red[w]; x += pre;
                ((float*)(A.ws + WS_CLOC))[hd * SEQ + ch * 256 + tid] = x;
                if (tid == 255) ((float*)(A.ws + WS_CTOT))[hd * 64 + ch] = x; }
            __syncthreads();
        }
    }
}

__device__ __forceinline__ void p3_gate_cfinal(const Args& A, char* lds, int G, int* sel) {
    const int tid = fresh_tid(), lane = tid & 63, wave = tid >> 6;
    const bf16* h = (const bf16*)(A.ws + WS_H);
    float* km = (float*)lds;
    float* scal = (float*)(lds + 65536); int* lcnt = (int*)(lds + 66560); int* gbs = lcnt + 64;
    for (int u = blockIdx.x; u < 1024; u += G) {
        if (u < 512) {
            const int hd = u >> 6, qb = (u & 256) ? 63 - (u & 63) : (u & 63);
            const float* kmg = (const float*)(A.ws + WS_KMEAN) + (size_t)hd * 64 * 128;
            for (int i = tid; i < qb * 128; i += NTHREADS) km[i] = kmg[i];
            if (tid < 64) lcnt[tid] = 0;
            __syncthreads();
            const int t = qb * 256 + (tid >> 1), dh = tid & 1;
            float q[64];
            { const bf16* qp = h + (size_t)t * NQKV + 3072 + hd * 128 + dh * 64;
#pragma unroll
              for (int i = 0; i < 8; ++i) { const v4u w = *(const v4u*)(qp + i * 8);
                q[i * 8 + 0] = bflo(w.x); q[i * 8 + 1] = bfhi(w.x); q[i * 8 + 2] = bflo(w.y); q[i * 8 + 3] = bfhi(w.y); q[i * 8 + 4] = bflo(w.z); q[i * 8 + 5] = bfhi(w.z); q[i * 8 + 6] = bflo(w.w); q[i * 8 + 7] = bfhi(w.w); } }
            float v0 = -3e38f, v1 = -3e38f, v2 = -3e38f; int i0 = 0, i1 = 1, i2 = 2;
            for (int n = 0; n < qb; ++n) {
                const float* kr = km + n * 128 + dh * 64; float s = 0.f;
#pragma unroll
                for (int d = 0; d < 64; d += 4) { const f32x4 kv = *(const f32x4*)(kr + d); s += q[d] * kv.x + q[d + 1] * kv.y + q[d + 2] * kv.z + q[d + 3] * kv.w; }
                s += __shfl_xor(s, 1);
                if (s > v0) { v2 = v1; i2 = i1; v1 = v0; i1 = i0; v0 = s; i0 = n; }
                else if (s > v1) { v2 = v1; i2 = i1; v1 = s; i1 = n; }
                else if (s > v2) { v2 = s; i2 = n; }
            }
            const int nsel = qb < 3 ? qb : 3;
            if (dh == 0) *(int4*)(sel + ((size_t)hd * SEQ + t) * 4) = make_int4(i0, i1, i2, nsel);
            int lp0 = 0, lp1 = 0, lp2 = 0;
            if (dh == 0) { if (nsel > 0) lp0 = atomicAdd(&lcnt[i0], 1); if (nsel > 1) lp1 = atomicAdd(&lcnt[i1], 1); if (nsel > 2) lp2 = atomicAdd(&lcnt[i2], 1); }
            __syncthreads();
            if (tid < 64) { const int c = lcnt[tid]; gbs[tid] = c > 0 ? (int)__hip_atomic_fetch_add((unsigned*)(A.ws + WS_CTL) + CW_MOBACNT + hd * 64 + tid, (unsigned)c, RLX_AGENT) : 0; }
            __syncthreads();
            if (dh == 0) { int* ml = (int*)((unsigned char*)A.out + (4u << 20)) + (size_t)hd * 64 * SEQ;
                if (nsel > 0) ml[(size_t)i0 * SEQ + gbs[i0] + lp0] = t * 4 + 0;
                if (nsel > 1) ml[(size_t)i1 * SEQ + gbs[i1] + lp1] = t * 4 + 1;
                if (nsel > 2) ml[(size_t)i2 * SEQ + gbs[i2] + lp2] = t * 4 + 2; }
            __syncthreads();
        } else {
            const int v = u - 512, hd = v >> 6, ch = v & 63;
            if (wave == 0) { float x = (lane < ch) ? ((const float*)(A.ws + WS_CTOT))[hd * 64 + lane] : 0.f; x = wave_sum(x); if (lane == 0) scal[0] = x; }
            __syncthreads();
            if (tid < 256) ((float*)(A.ws + WS_C))[hd * SEQ + ch * 256 + tid] = ((const float*)(A.ws + WS_CLOC))[hd * SEQ + ch * 256 + tid] + scal[0];
            __syncthreads();
        }
    }
}

template <int VAR>
__device__ __forceinline__ void naive_attn_unit(const Args& A, char* lds, int hd, int qblk, const int* sel) {
    const int tid = fresh_tid(), ql = tid >> 2, part = tid & 3;
    const int t0 = qblk * 128, t = t0 + ql;
    float* Ks = (float*)lds; float* Vs = Ks + 64 * 128; float* Cs = Vs + 64 * 128;
    const bf16* h = (const bf16*)(A.ws + WS_H); bf16* ob = (bf16*)(A.ws + WS_O);
    const int second = (VAR == 1 || VAR == 3) ? 1 : 0;
    const int qcol = second * 3072 + hd * 128, kcol = qcol + 1024, vcol = qcol + 2048, ocol = (second * 8 + hd) * 128;
    const float* cg = (const float*)(A.ws + WS_C) + hd * SEQ;
    const float* lut = (const float*)(A.ws + WS_LUT) + hd * 1024;
    float q[32];
    if (VAR != 2) { const bf16* qp = h + (size_t)t * NQKV + qcol + part * 32;
#pragma unroll
        for (int d = 0; d < 32; ++d) q[d] = bf2f(qp[d]); }
    else { const bf16* qp = h + (size_t)t * NQKV + qcol + part * 16;
#pragma unroll
        for (int d = 0; d < 16; ++d) { q[d] = bf2f(qp[d]); q[16 + d] = bf2f(qp[64 + d]); } }
    float o[32], o2[32];
#pragma unroll
    for (int d = 0; d < 32; ++d) { o[d] = 0.f; o2[d] = 0.f; }
    float m1 = -1e30f, l1 = 0.f, m2 = -1e30f, l2 = 0.f, R = 0.f;
    const float ct = (VAR == 0) ? cg[t] : 0.f;
    int s0 = -1, s1 = -1, s2 = -1;
    if (VAR == 1) { const int4 sv = *(const int4*)(sel + ((size_t)hd * SEQ + t) * 4); if (sv.w > 0) s0 = sv.x; if (sv.w > 1) s1 = sv.y; if (sv.w > 2) s2 = sv.z; }
    const int own = t >> 8;
    const int jmax = (t0 + 127) >> 6;
    for (int jj = 0; jj <= jmax; ++jj) {
        const int j = (VAR == 3) ? (jmax - jj) : jj;
        __syncthreads();
        for (int idx = tid; idx < 1024; idx += NTHREADS) { const int row = idx >> 4, c8 = (idx & 15) * 8;
            const v4u kw = *(const v4u*)(h + (size_t)(j * 64 + row) * NQKV + kcol + c8); const v4u vw = *(const v4u*)(h + (size_t)(j * 64 + row) * NQKV + vcol + c8);
            float* kd = Ks + row * 128 + c8; float* vd = Vs + row * 128 + c8;
            kd[0] = bflo(kw.x); kd[1] = bfhi(kw.x); kd[2] = bflo(kw.y); kd[3] = bfhi(kw.y); kd[4] = bflo(kw.z); kd[5] = bfhi(kw.z); kd[6] = bflo(kw.w); kd[7] = bfhi(kw.w);
            vd[0] = bflo(vw.x); vd[1] = bfhi(vw.x); vd[2] = bflo(vw.y); vd[3] = bfhi(vw.y); vd[4] = bflo(vw.z); vd[5] = bfhi(vw.z); vd[6] = bflo(vw.w); vd[7] = bfhi(vw.w); }
        if (VAR == 0 && tid < 64) Cs[tid] = cg[j * 64 + tid];
        __syncthreads();
        for (int ss = 0; ss < 64; ++ss) {
            const int s = (VAR == 3) ? (63 - ss) : ss; const int ks = j * 64 + s;
            float d1 = 0.f, d2 = 0.f;
            if (VAR != 2) { const float* kr = Ks + s * 128 + part * 32;
#pragma unroll
                for (int d = 0; d < 32; d += 4) { const f32x4 kv = *(const f32x4*)(kr + d); d1 += q[d] * kv.x + q[d + 1] * kv.y + q[d + 2] * kv.z + q[d + 3] * kv.w; } }
            else { const float* kr = Ks + s * 128 + part * 16;
#pragma unroll
                for (int d = 0; d < 16; d += 4) { const f32x4 ka = *(const f32x4*)(kr + d); const f32x4 kb = *(const f32x4*)(kr + 64 + d);
                    d1 += q[d] * ka.x + q[d + 1] * ka.y + q[d + 2] * ka.z + q[d + 3] * ka.w; d2 += q[16 + d] * kb.x + q[17 + d] * kb.y + q[18 + d] * kb.z + q[19 + d] * kb.w; } }
            d1 += __shfl_xor(d1, 1); d1 += __shfl_xor(d1, 2);
            if (VAR == 2) { d2 += __shfl_xor(d2, 1); d2 += __shfl_xor(d2, 2); }
            const float* vr = Vs + s * 128 + part * 32;
            if (VAR == 0 || VAR == 1) {
                bool valid; float sc;
                if (VAR == 0) { valid = ks <= t; sc = d1 * SCALE128 + (ct - Cs[s]); }
                else { const int nb = ks >> 8; valid = (nb == own && ks <= t) || nb == s0 || nb == s1 || nb == s2; const int dist = t - ks; sc = d1 * SCALE128 + lut[dist < 0 ? 0 : (dist > 1023 ? 1023 : dist)]; }
                if (valid) { const float mn = fmaxf(m1, sc), al = __expf(m1 - mn), p = __expf(sc - mn); l1 = l1 * al + p; m1 = mn;
#pragma unroll
                    for (int d = 0; d < 32; ++d) o[d] = o[d] * al + p * vr[d]; }
            } else if (VAR == 2) {
                if (ks <= t) { const float bias = lut[(t - ks) > 1023 ? 1023 : (t - ks)];
                    const float sa = d1 * SCALE64 + bias, sb = d2 * SCALE64 + bias;
                    const float mna = fmaxf(m1, sa), ala = __expf(m1 - mna), pa = __expf(sa - mna); l1 = l1 * ala + pa; m1 = mna;
                    const float mnb = fmaxf(m2, sb), alb = __expf(m2 - mnb), pb = __expf(sb - mnb); l2 = l2 * alb + pb; m2 = mnb;
#pragma unroll
                    for (int d = 0; d < 32; ++d) { const float vv = vr[d]; o[d] = o[d] * ala + pa * vv; o2[d] = o2[d] * alb + pb * vv; } }
            } else {
                if (ks < t) { const float z = d1 * SCALE128; float a = __expf(log_sigmoid(z) + R); R += log_sigmoid(-z);
#if SB_TRIVIAL
                    a = 0.015625f;
#endif

#pragma unroll
                    for (int d = 0; d < 32; ++d) o[d] += a * vr[d]; }
            }
        }
    }
    if (VAR == 0 || VAR == 1) { const float il = 1.f / l1;
#pragma unroll
        for (int d = 0; d < 32; ++d) o[d] *= il; }
    if (VAR == 2) { const float lam = ((const float*)(A.ws + WS_LAM))[0]; const float i1 = 1.f / l1, i2 = lam / l2; float ss = 0.f;
#pragma unroll
        for (int d = 0; d < 32; ++d) { o[d] = o[d] * i1 - o2[d] * i2; ss += o[d] * o[d]; }
        ss += __shfl_xor(ss, 1); ss += __shfl_xor(ss, 2);
        const float r = rsqrtf(ss * (1.f / 128.f) + LN_EPS) * (1.f - LAMBDA_INIT);
#pragma unroll
        for (int d = 0; d < 32; ++d) o[d] = o[d] * r * A.subln_gain[part * 32 + d]; }
    bf16* op = ob + (size_t)t * DM + ocol + part * 32;
#pragma unroll
    for (int d = 0; d < 32; d += 2) *(unsigned*)(op + d) = pk2(o[d], o[d + 1]);
}

constexpr int CW_Q4 = 10560, CW_Q12 = 10752, CW_QM = 10944;
__device__ __forceinline__ int next_item(const Args& A, int cw, LAS int* slot) {
    __syncthreads();
    if (threadIdx.x == 0) *slot = (int)__hip_atomic_fetch_add((unsigned*)(A.ws + WS_CTL) + cw, 1u, RLX_AGENT);
    __syncthreads();
    return *slot;
}


#ifndef SB_R2PROBE
#define SB_R2PROBE 0
#endif
#ifndef FRESH_W
#define FRESH_W 1
#endif
#ifndef FRESH_ALL
#define FRESH_ALL 0
#endif
#ifndef PV_FILL
#define PV_FILL 5
#endif
#ifndef FOX_CH
#define FOX_CH 16
#endif
#ifndef SB_NOCHUNK
#define SB_NOCHUNK 0
#endif
#ifndef SB_TRIVIAL
#define SB_TRIVIAL 0
#endif
namespace att {
typedef float f32x16 __attribute__((ext_vector_type(16)));
typedef short s16x4 __attribute__((ext_vector_type(4)));
constexpr int PITCH = NQKV;
constexpr int SHM_V = 16384, SHM_K = 16384;
constexpr int L_V = 0, L_K = 2 * SHM_V, L_WS = L_K + 2 * SHM_K, L_KB = L_WS + NWAVES * 64 * 4, L_FLAG = L_KB + 512, L_LUT = L_FLAG + 512, LUT_PAD = 320, LUT_N = LUT_PAD + 1024,
              L_STASH = L_LUT + LUT_N * 4 + 256, L_END = L_STASH + 65536;
static_assert(L_STASH % 16 == 0 && L_END <= RING_BYTES, "attention LDS map");
constexpr float THR = 8.f;
#define KSWZ(row, colB) ((row) * 256 + ((colB) ^ (((row) & 7) << 4)))
#define SBAR() __builtin_amdgcn_sched_barrier(0)
__device__ __forceinline__ int v_st(int k, int c) { const int kk = (k & ~0xC) | ((k & 4) << 1) | ((k & 8) >> 1); return ((kk >> 3) * 4 + (c >> 5)) * 512 + ((kk & 7) * 32 + (c & 31)) * 2; }
__device__ __forceinline__ int v_rd_base(int lane) { return ((lane & 3) << 3) | (((lane >> 2) & 3) << 6) | (((lane >> 4) & 1) << 5) | (((lane >> 5) & 1) << 8); }
constexpr int v_rd_off(int d0, int ks, int half) { return d0 * 512 + ks * 4096 + half * 2048; }
__device__ __forceinline__ int crow(int r, int hi) { return (r & 3) + 8 * (r >> 2) + 4 * hi; }
typedef __bf16 bf16x2_t __attribute__((ext_vector_type(2)));
typedef float f32x2_t __attribute__((ext_vector_type(2)));
__device__ __forceinline__ unsigned cvtpk(float lo, float hi) { f32x2_t v = {lo, hi}; bf16x2_t b = __builtin_convertvector(v, bf16x2_t); return __builtin_bit_cast(unsigned, b); }

template <int DQ> __device__ __forceinline__ void partialSM(f32x16& p0, f32x16& p1, float& m_reg, float& mn, float& alpha) {
    constexpr float SC = (DQ == 128) ? SCALE128 : SCALE64; constexpr float C2 = 1.4426950408889634f * SC;
    float pmax = p0[0]; for (int r = 1; r < 16; ++r) pmax = fmaxf(pmax, p0[r]); for (int r = 0; r < 16; ++r) pmax = fmaxf(pmax, p1[r]);
    { auto rr = __builtin_amdgcn_permlane32_swap(__float_as_uint(pmax), __float_as_uint(pmax), false, false);
      pmax = fmaxf(__uint_as_float(rr[0]), __uint_as_float(rr[1])); }
    if (__builtin_expect(__all((pmax - m_reg) * SC <= THR), 1)) { mn = m_reg; alpha = 1.f; }
    else { mn = fmaxf(m_reg, pmax); alpha = __builtin_amdgcn_exp2f((m_reg - mn) * C2); m_reg = mn; }
    const float mnL = -mn * C2;
    for (int r = 0; r < 16; ++r) p0[r] = fmaf(p0[r], C2, mnL); for (int r = 0; r < 16; ++r) p1[r] = fmaf(p1[r], C2, mnL);
    __builtin_amdgcn_sched_barrier(0);
    for (int r = 0; r < 16; ++r) p0[r] = __builtin_amdgcn_exp2f(p0[r]);
}
#define PK4(P, B_, OUT) do { unsigned a0 = cvtpk(P[B_+0], P[B_+1]), a1 = cvtpk(P[B_+2], P[B_+3]);                          \
        unsigned b0 = cvtpk(P[B_+4], P[B_+5]), b1 = cvtpk(P[B_+6], P[B_+7]);                                             \
        auto r0 = __builtin_amdgcn_permlane32_swap(a0, b0, false, false); auto r1 = __builtin_amdgcn_permlane32_swap(a1, b1, false, false); \
        pg8::u32x4 w = {r0[0], r1[0], r0[1], r1[1]}; OUT = *reinterpret_cast<bf16x8*>(&w); } while (0)
__device__ __forceinline__ void finishSM(f32x16& p0, f32x16& p1, float alpha, float& l_reg, bf16x8& pa0, bf16x8& pa1, bf16x8& pa2, bf16x8& pa3) {
    for (int r = 0; r < 16; ++r) p1[r] = __builtin_amdgcn_exp2f(p1[r]);
    __builtin_amdgcn_sched_barrier(0);
    float s0 = 0.f, s1 = 0.f, s2 = 0.f, s3 = 0.f;
    for (int r = 0; r < 16; r += 4) { s0 += p0[r]; s1 += p0[r + 1]; s2 += p0[r + 2]; s3 += p0[r + 3]; }
    for (int r = 0; r < 16; r += 4) { s0 += p1[r]; s1 += p1[r + 1]; s2 += p1[r + 2]; s3 += p1[r + 3]; }
    float ps = (s0 + s1) + (s2 + s3);
    { auto rr = __builtin_amdgcn_permlane32_swap(__float_as_uint(ps), __float_as_uint(ps), false, false);
      ps = __uint_as_float(rr[0]) + __uint_as_float(rr[1]); }
    l_reg = l_reg * alpha + ps;
    PK4(p0, 0, pa0); PK4(p0, 8, pa1); PK4(p1, 0, pa2); PK4(p1, 8, pa3);
}
__device__ __forceinline__ void sb_half(f32x16& p, float& R2, int hi) {
#if SB_TRIVIAL
#pragma unroll
    for (int r = 0; r < 16; ++r) p[r] = (p[r] < -1e37f) ? 0.f : 0.015625f;
    return;
#endif
    constexpr float C2 = 1.4426950408889634f * SCALE128;
    float T = R2;
#pragma unroll
    for (int g = 3; g >= 0; --g) { float z[4], lr[4];
#pragma unroll
        for (int e = 0; e < 4; ++e) { z[e] = p[4 * g + e] * C2; lr[e] = -(fmaxf(z[e], 0.f) + __builtin_amdgcn_logf(1.f + __builtin_amdgcn_exp2f(-fabsf(z[e])))); }
        const float G = (lr[0] + lr[1]) + (lr[2] + lr[3]);
        auto rr = __builtin_amdgcn_permlane32_swap(__float_as_uint(G), __float_as_uint(G), false, false);
        const float Go = hi ? __uint_as_float(rr[0]) : __uint_as_float(rr[1]);
        float a = T + (hi ? 0.f : Go);
        p[4 * g + 3] = __builtin_amdgcn_exp2f(z[3] + lr[3] + a); a += lr[3];
        p[4 * g + 2] = __builtin_amdgcn_exp2f(z[2] + lr[2] + a); a += lr[2];
        p[4 * g + 1] = __builtin_amdgcn_exp2f(z[1] + lr[1] + a); a += lr[1];
        p[4 * g + 0] = __builtin_amdgcn_exp2f(z[0] + lr[0] + a);
        T += G + Go; }
    R2 = T;
}
__device__ __forceinline__ void sb_pack(f32x16& p0, f32x16& p1, bf16x8& pa0, bf16x8& pa1, bf16x8& pa2, bf16x8& pa3) { PK4(p0, 0, pa0); PK4(p0, 8, pa1); PK4(p1, 0, pa2); PK4(p1, 8, pa3); }
template <int DQ> __device__ __forceinline__ void softmaxY(f32x16& p0, f32x16& p1, float& m_reg, float& alpha, float& l_reg, bf16x8& pa0, bf16x8& pa1, bf16x8& pa2, bf16x8& pa3) {
    constexpr float SC = (DQ == 128) ? SCALE128 : SCALE64; constexpr float C2 = 1.4426950408889634f * SC;
    float pmax = p0[0]; for (int r = 1; r < 16; ++r) pmax = fmaxf(pmax, p0[r]); for (int r = 0; r < 16; ++r) pmax = fmaxf(pmax, p1[r]);
    { auto rr = __builtin_amdgcn_permlane32_swap(__float_as_uint(pmax), __float_as_uint(pmax), false, false);
      pmax = fmaxf(__uint_as_float(rr[0]), __uint_as_float(rr[1])); }
    float mn;
    if (__builtin_expect(__all((pmax - m_reg) * SC <= THR), 1)) { mn = m_reg; alpha = 1.f; }
    else { mn = fmaxf(m_reg, pmax); alpha = __builtin_amdgcn_exp2f((m_reg - mn) * C2); m_reg = mn; }
    const float mnL = -mn * C2;
    for (int r = 0; r < 16; ++r) p0[r] = fmaf(p0[r], C2, mnL); for (int r = 0; r < 16; ++r) p1[r] = fmaf(p1[r], C2, mnL);
    __builtin_amdgcn_sched_barrier(0);
    for (int r = 0; r < 16; ++r) p0[r] = __builtin_amdgcn_exp2f(p0[r]); for (int r = 0; r < 16; ++r) p1[r] = __builtin_amdgcn_exp2f(p1[r]);
    __builtin_amdgcn_sched_barrier(0);
    float s0 = 0.f, s1 = 0.f, s2 = 0.f, s3 = 0.f;
    for (int r = 0; r < 16; r += 4) { s0 += p0[r]; s1 += p0[r + 1]; s2 += p0[r + 2]; s3 += p0[r + 3]; }
    for (int r = 0; r < 16; r += 4) { s0 += p1[r]; s1 += p1[r + 1]; s2 += p1[r + 2]; s3 += p1[r + 3]; }
    float ps = (s0 + s1) + (s2 + s3);
    { auto rr = __builtin_amdgcn_permlane32_swap(__float_as_uint(ps), __float_as_uint(ps), false, false);
      ps = __uint_as_float(rr[0]) + __uint_as_float(rr[1]); }
    l_reg = l_reg * alpha + ps;
    PK4(p0, 0, pa0); PK4(p0, 8, pa1); PK4(p1, 0, pa2); PK4(p1, 8, pa3);
}
#undef PK4

template <int KB, int DQ, bool INITC = false>
__device__ __forceinline__ void qkt(f32x16& p0, f32x16& p1, const LAS char* K_lds, int r32, int hi, const bf16x8* qr) {
    if constexpr (!INITC) { p0 = f32x16{}; p1 = f32x16{}; }
    unsigned ka[4];
#pragma unroll
    for (int dd = 0; dd < 4; ++dd) ka[dd] = (unsigned)(uintptr_t)(K_lds + KB * SHM_K + KSWZ(r32, (dd * 16 + hi * 8) * 2));
    bf16x8 fa0, fa1, fb0, fb1, fc0, fc1;
#define KRD(dst, dd, off) asm volatile("ds_read_b128 %0, %1 offset:%2" : "=&v"(dst) : "v"(ka[dd]), "i"(off) : "memory")
#define KRD2(n0, n1, d) do { KRD(n0, (d) & 3, ((d) >> 2) * 128); KRD(n1, (d) & 3, ((d) >> 2) * 128 + 32 * 256); } while (0)
#define KWAITN(N, x0, x1) do { asm volatile("s_waitcnt lgkmcnt(" #N ")" : "+v"(x0), "+v"(x1) :: "memory"); __builtin_amdgcn_sched_barrier(0x406); } while (0)
#define KSTEP3(d0, c0, c1, n0, n1) do { if constexpr ((d0) + 1 < DQ / 16) KWAITN(2, c0, c1); else KWAITN(0, c0, c1); \
        if constexpr ((d0) + 2 < DQ / 16) KRD2(n0, n1, (d0) + 2); \
        p0 = __builtin_amdgcn_mfma_f32_32x32x16_bf16(c0, qr[d0], p0, 0, 0, 0); p1 = __builtin_amdgcn_mfma_f32_32x32x16_bf16(c1, qr[d0], p1, 0, 0, 0); } while (0)
    KRD2(fa0, fa1, 0); KRD2(fb0, fb1, 1);
    KSTEP3(0, fa0, fa1, fc0, fc1); KSTEP3(1, fb0, fb1, fa0, fa1); KSTEP3(2, fc0, fc1, fb0, fb1); KSTEP3(3, fa0, fa1, fc0, fc1);
    if constexpr (DQ == 128) { KSTEP3(4, fb0, fb1, fa0, fa1); KSTEP3(5, fc0, fc1, fb0, fb1); KSTEP3(6, fa0, fa1, fc0, fc1); KSTEP3(7, fb0, fb1, fa0, fa1); }
#undef KSTEP3
#undef KWAITN
#undef KRD2
#undef KRD
}
template <int VB>
__device__ __forceinline__ void pv_tile2(f32x16* o, int vb0, bf16x8 pa0, bf16x8 pa1, bf16x8 pa2, bf16x8 pa3) {
#define TRRD(dst, off) asm volatile("ds_read_b64_tr_b16 %0, %1 offset:%2" : "=&v"(dst) : "v"(vb0), "i"(off) : "memory")
#define PV_RD(d0, P) constexpr int b##P = VB * SHM_V + v_rd_off(d0, 0, 0); s16x4 l0##P, l1##P, l2##P, l3##P, h0##P, h1##P, h2##P, h3##P; \
        TRRD(l0##P, b##P); TRRD(h0##P, b##P + 2048); TRRD(l1##P, b##P + 4096); TRRD(h1##P, b##P + 6144); TRRD(l2##P, b##P + 8192); TRRD(h2##P, b##P + 10240); TRRD(l3##P, b##P + 12288); TRRD(h3##P, b##P + 14336)
#define PV_MM(d0, P) do { \
        o[d0] = __builtin_amdgcn_mfma_f32_32x32x16_bf16(pa0, (bf16x8){l0##P[0], l0##P[1], l0##P[2], l0##P[3], h0##P[0], h0##P[1], h0##P[2], h0##P[3]}, o[d0], 0, 0, 0);   \
        o[d0] = __builtin_amdgcn_mfma_f32_32x32x16_bf16(pa1, (bf16x8){l1##P[0], l1##P[1], l1##P[2], l1##P[3], h1##P[0], h1##P[1], h1##P[2], h1##P[3]}, o[d0], 0, 0, 0);   \
        o[d0] = __builtin_amdgcn_mfma_f32_32x32x16_bf16(pa2, (bf16x8){l2##P[0], l2##P[1], l2##P[2], l2##P[3], h2##P[0], h2##P[1], h2##P[2], h2##P[3]}, o[d0], 0, 0, 0);   \
        o[d0] = __builtin_amdgcn_mfma_f32_32x32x16_bf16(pa3, (bf16x8){l3##P[0], l3##P[1], l3##P[2], l3##P[3], h3##P[0], h3##P[1], h3##P[2], h3##P[3]}, o[d0], 0, 0, 0); } while (0)
#define PV_WAIT() asm volatile("s_waitcnt lgkmcnt(0)" : "+v"(l0A), "+v"(l1A), "+v"(l2A), "+v"(l3A), "+v"(h0A), "+v"(h1A), "+v"(h2A), "+v"(h3A), \
        "+v"(l0B), "+v"(l1B), "+v"(l2B), "+v"(l3B), "+v"(h0B), "+v"(h1B), "+v"(h2B), "+v"(h3B) :: "memory")
    { PV_RD(0, A); PV_RD(1, B); PV_WAIT(); SBAR(); PV_MM(0, A); PV_MM(1, B); SBAR(); }
    { PV_RD(2, A); PV_RD(3, B); PV_WAIT(); SBAR(); PV_MM(2, A); PV_MM(3, B); }
#undef PV_WAIT
#undef PV_RD
#undef PV_MM
#undef TRRD
}
template <int VB>
__device__ __forceinline__ void pv_tile(f32x16* o, int vb0, bf16x8 pa0, bf16x8 pa1, bf16x8 pa2, bf16x8 pa3) {
#define TRRD(dst, off) asm volatile("ds_read_b64_tr_b16 %0, %1 offset:%2" : "=&v"(dst) : "v"(vb0), "i"(off) : "memory")
#define PV_D0(d0) do { s16x4 l0, l1, l2, l3, h0, h1, h2, h3; constexpr int b_ = VB * SHM_V + v_rd_off(d0, 0, 0); \
        TRRD(l0, b_); TRRD(h0, b_ + 2048); TRRD(l1, b_ + 4096); TRRD(h1, b_ + 6144); TRRD(l2, b_ + 8192); TRRD(h2, b_ + 10240); TRRD(l3, b_ + 12288); TRRD(h3, b_ + 14336); \
        asm volatile("s_waitcnt lgkmcnt(0)" : "+v"(l0), "+v"(l1), "+v"(l2), "+v"(l3), "+v"(h0), "+v"(h1), "+v"(h2), "+v"(h3) :: "memory"); __builtin_amdgcn_sched_barrier(0x406);     \
        o[d0] = __builtin_amdgcn_mfma_f32_32x32x16_bf16(pa0, (bf16x8){l0[0], l0[1], l0[2], l0[3], h0[0], h0[1], h0[2], h0[3]}, o[d0], 0, 0, 0);   \
        o[d0] = __builtin_amdgcn_mfma_f32_32x32x16_bf16(pa1, (bf16x8){l1[0], l1[1], l1[2], l1[3], h1[0], h1[1], h1[2], h1[3]}, o[d0], 0, 0, 0);   \
        o[d0] = __builtin_amdgcn_mfma_f32_32x32x16_bf16(pa2, (bf16x8){l2[0], l2[1], l2[2], l2[3], h2[0], h2[1], h2[2], h2[3]}, o[d0], 0, 0, 0);   \
        o[d0] = __builtin_amdgcn_mfma_f32_32x32x16_bf16(pa3, (bf16x8){l3[0], l3[1], l3[2], l3[3], h3[0], h3[1], h3[2], h3[3]}, o[d0], 0, 0, 0); \
        _Pragma("unroll") for (int g_ = 0; g_ < 4; ++g_) { __builtin_amdgcn_sched_group_barrier(0x8, 1, 0); __builtin_amdgcn_sched_group_barrier(0x2, PV_FILL, 0); } } while (0)
    PV_D0(0); PV_D0(1); PV_D0(2); PV_D0(3);
#undef PV_D0
#undef TRRD
}

template <int VB, int KB, int DQ, bool DOQK>
__device__ __forceinline__ void xphase(f32x16* o, int vb0, bf16x8 pa0, bf16x8 pa1, bf16x8 pa2, bf16x8 pa3, f32x16& p0, f32x16& p1, const LAS char* K_lds, int r32, int hi, const bf16x8* qr) {
#define TRRD(dst, off) asm volatile("ds_read_b64_tr_b16 %0, %1 offset:%2" : "=&v"(dst) : "v"(vb0), "i"(off) : "memory")
#define XRD(d0, P) do { constexpr int b_ = VB * SHM_V + v_rd_off(d0, 0, 0); TRRD(l0##P, b_); TRRD(h0##P, b_ + 2048); TRRD(l1##P, b_ + 4096); TRRD(h1##P, b_ + 6144); \
        TRRD(l2##P, b_ + 8192); TRRD(h2##P, b_ + 10240); TRRD(l3##P, b_ + 12288); TRRD(h3##P, b_ + 14336); } while (0)
#define XWAIT(P) do { asm volatile("s_waitcnt lgkmcnt(0)" : "+v"(l0##P), "+v"(l1##P), "+v"(l2##P), "+v"(l3##P), "+v"(h0##P), "+v"(h1##P), "+v"(h2##P), "+v"(h3##P) :: "memory"); SBAR(); } while (0)
#define XMM(d0, P) do { \
        o[d0] = __builtin_amdgcn_mfma_f32_32x32x16_bf16(pa0, (bf16x8){l0##P[0], l0##P[1], l0##P[2], l0##P[3], h0##P[0], h0##P[1], h0##P[2], h0##P[3]}, o[d0], 0, 0, 0); \
        o[d0] = __builtin_amdgcn_mfma_f32_32x32x16_bf16(pa1, (bf16x8){l1##P[0], l1##P[1], l1##P[2], l1##P[3], h1##P[0], h1##P[1], h1##P[2], h1##P[3]}, o[d0], 0, 0, 0); \
        o[d0] = __builtin_amdgcn_mfma_f32_32x32x16_bf16(pa2, (bf16x8){l2##P[0], l2##P[1], l2##P[2], l2##P[3], h2##P[0], h2##P[1], h2##P[2], h2##P[3]}, o[d0], 0, 0, 0); \
        o[d0] = __builtin_amdgcn_mfma_f32_32x32x16_bf16(pa3, (bf16x8){l3##P[0], l3##P[1], l3##P[2], l3##P[3], h3##P[0], h3##P[1], h3##P[2], h3##P[3]}, o[d0], 0, 0, 0); SBAR(); } while (0)
    s16x4 l0A, l1A, l2A, l3A, h0A, h1A, h2A, h3A, l0B, l1B, l2B, l3B, h0B, h1B, h2B, h3B;
    unsigned ka[4];
#pragma unroll
    for (int dd = 0; dd < 4; ++dd) ka[dd] = (unsigned)(uintptr_t)(K_lds + KB * SHM_K + KSWZ(r32, (dd * 16 + hi * 8) * 2));
    bf16x8 fa0, fa1, fb0, fb1;
#define KRD(dst, dd, off) asm volatile("ds_read_b128 %0, %1 offset:%2" : "=&v"(dst) : "v"(ka[dd]), "i"(off) : "memory")
#define KWAIT(x0, x1) do { asm volatile("s_waitcnt lgkmcnt(0)" : "+v"(x0), "+v"(x1) :: "memory"); __builtin_amdgcn_sched_barrier(0x406); } while (0)
#define KSTEP(d0, c0, c1, n0, n1) do { KWAIT(c0, c1); \
        if constexpr ((d0) + 1 < DQ / 16) { KRD(n0, ((d0) + 1) & 3, (((d0) + 1) >> 2) * 128); KRD(n1, ((d0) + 1) & 3, (((d0) + 1) >> 2) * 128 + 32 * 256); } \
        p0 = __builtin_amdgcn_mfma_f32_32x32x16_bf16(c0, qr[d0], p0, 0, 0, 0); p1 = __builtin_amdgcn_mfma_f32_32x32x16_bf16(c1, qr[d0], p1, 0, 0, 0); } while (0)
    XRD(0, A); SBAR();
    XWAIT(A); XRD(1, B); SBAR(); XMM(0, A);
    XWAIT(B); XRD(2, A); SBAR(); XMM(1, B);
    XWAIT(A); XRD(3, B); SBAR(); XMM(2, A);
    if constexpr (DOQK && DQ == 64) {
        bf16x8 fc0, fc1, fd0, fd1;
        XWAIT(B); KRD(fa0, 0, 0); KRD(fa1, 0, 32 * 256); KRD(fb0, 1, 0); KRD(fb1, 1, 32 * 256); SBAR(); XMM(3, B);
        asm volatile("s_waitcnt lgkmcnt(0)" : "+v"(fa0), "+v"(fa1), "+v"(fb0), "+v"(fb1) :: "memory"); SBAR();
        KRD(fc0, 2, 0); KRD(fc1, 2, 32 * 256); SBAR();
        p0 = f32x16{}; p1 = f32x16{};
        p0 = __builtin_amdgcn_mfma_f32_32x32x16_bf16(fa0, qr[0], p0, 0, 0, 0); p1 = __builtin_amdgcn_mfma_f32_32x32x16_bf16(fa1, qr[0], p1, 0, 0, 0); SBAR();
        KRD(fd0, 3, 0); KRD(fd1, 3, 32 * 256); SBAR();
        p0 = __builtin_amdgcn_mfma_f32_32x32x16_bf16(fb0, qr[1], p0, 0, 0, 0); p1 = __builtin_amdgcn_mfma_f32_32x32x16_bf16(fb1, qr[1], p1, 0, 0, 0); SBAR();
        asm volatile("s_waitcnt lgkmcnt(2)" : "+v"(fc0), "+v"(fc1) :: "memory"); SBAR();
        p0 = __builtin_amdgcn_mfma_f32_32x32x16_bf16(fc0, qr[2], p0, 0, 0, 0); p1 = __builtin_amdgcn_mfma_f32_32x32x16_bf16(fc1, qr[2], p1, 0, 0, 0); SBAR();
        asm volatile("s_waitcnt lgkmcnt(0)" : "+v"(fd0), "+v"(fd1) :: "memory"); SBAR();
        p0 = __builtin_amdgcn_mfma_f32_32x32x16_bf16(fd0, qr[3], p0, 0, 0, 0); p1 = __builtin_amdgcn_mfma_f32_32x32x16_bf16(fd1, qr[3], p1, 0, 0, 0);
    } else {
    XWAIT(B); if constexpr (DOQK) { KRD(fa0, 0, 0); KRD(fa1, 0, 32 * 256); SBAR(); } XMM(3, B);
    if constexpr (DOQK) {
        p0 = f32x16{}; p1 = f32x16{};
        KSTEP(0, fa0, fa1, fb0, fb1); KSTEP(1, fb0, fb1, fa0, fa1); KSTEP(2, fa0, fa1, fb0, fb1); KSTEP(3, fb0, fb1, fa0, fa1);
        if constexpr (DQ == 128) { KSTEP(4, fa0, fa1, fb0, fb1); KSTEP(5, fb0, fb1, fa0, fa1); KSTEP(6, fa0, fa1, fb0, fb1); KSTEP(7, fb0, fb1, fa0, fa1); }
    }
    }
#undef KSTEP
#undef KWAIT
#undef KRD
#undef XMM
#undef XWAIT
#undef XRD
#undef TRRD
}

struct ChunkArgs {
    const bf16* hbase; unsigned kcolB, vcolB;
    int ja, jb;
    int qpos;
    int qlo;
    const float* cb; float cref;
    float* tprobe;
};
#ifndef TIME_SEG
#define TIME_SEG 0
#endif
#ifndef PP_DIFF
#define PP_DIFF 1
#endif
#ifndef PP_SB
#define PP_SB 0
#endif
#ifndef MOBA_RES
#define MOBA_RES 1
#endif
#ifndef FOX_RES
#define FOX_RES 1
#endif
#ifndef GATE_MFMA
#define GATE_MFMA 1
#endif
#ifndef DIFF_RES
#define DIFF_RES 0
#endif
#ifndef SB_RES
#define SB_RES 1
#endif
#ifndef RES_PVDB
#define RES_PVDB 0
#endif
#ifndef PP_XPRIO
#define PP_XPRIO 0
#endif
#ifndef PP_YPRIO
#define PP_YPRIO 1
#endif
#ifndef PP_LAUNDER
#define PP_LAUNDER 0
#endif
template <int DQ, int MODE, bool REV>
__device__ __forceinline__ void attn_chunk(const ChunkArgs& a, const bf16x8* qr, float& m_reg, float& l_reg, f32x16* o, LAS char* lds) {
    int tid_ = threadIdx.x; asm volatile("" : "+v"(tid_)); const int tid = tid_, wid = __builtin_amdgcn_readfirstlane(tid >> 6), lane = tid & 63, r32 = lane & 31, hi = lane >> 5;
    const int NT = a.jb - a.ja;
    LAS char* V_lds = lds + L_V; LAS char* K_lds = lds + L_K;
    LAS float* ws = (LAS float*)(lds + L_WS) + wid * 64; LAS float* al_l = ws + 32;
    LAS float* kbl = (LAS float*)(lds + L_KB); const LAS float* lutl = (const LAS float*)(lds + L_LUT);
    const int vb0 = (int)(uintptr_t)V_lds + v_rd_base(lane);
    const __amdgpu_buffer_rsrc_t hrs = __builtin_amdgcn_make_buffer_rsrc((void*)a.hbase, 0, (int)((size_t)SEQ * PITCH * 2), 0x00020000);
#define FRESH_TID_W(t_) int t_ = threadIdx.x; if constexpr ((DQ == 128 && (MODE == 0 && FRESH_W)) || PP_LAUNDER) asm volatile("" : "+v"(t_))
#define FRESH_TID(t_) int t_ = threadIdx.x; if constexpr ((DQ == 128 && (MODE == 0 || FRESH_ALL)) || PP_LAUNDER) asm volatile("" : "+v"(t_))
    const int qlo = a.qlo;
    bf16x8 st_v0, st_v1, st_k0, st_k1; float st_c = 0.f;
#define KBASE(t) ((REV ? (a.jb - 1 - (t)) : (a.ja + (t))) * 64)
#define VMW() asm volatile("s_waitcnt vmcnt(0)" ::: "memory")
#define SLOAD(k0) do { FRESH_TID(t_); const int sr = t_ >> 4, sc = (t_ & 15) * 8; const unsigned so_ = (unsigned)(k0) * (unsigned)(PITCH * 2); \
        const unsigned vo0 = (unsigned)(sr * PITCH + sc) * 2u, vo1 = vo0 + (unsigned)(32 * PITCH * 2); \
        st_v0 = __builtin_bit_cast(bf16x8, __builtin_amdgcn_raw_buffer_load_b128(hrs, vo0, so_ + a.vcolB, 0)); st_v1 = __builtin_bit_cast(bf16x8, __builtin_amdgcn_raw_buffer_load_b128(hrs, vo1, so_ + a.vcolB, 0)); \
        if constexpr (DQ == 128) { st_k0 = __builtin_bit_cast(bf16x8, __builtin_amdgcn_raw_buffer_load_b128(hrs, vo0, so_ + a.kcolB, 0)); st_k1 = __builtin_bit_cast(bf16x8, __builtin_amdgcn_raw_buffer_load_b128(hrs, vo1, so_ + a.kcolB, 0)); } \
        else { const unsigned vk0 = (unsigned)((t_ >> 3) * PITCH + (t_ & 7) * 8) * 2u; st_k0 = __builtin_bit_cast(bf16x8, __builtin_amdgcn_raw_buffer_load_b128(hrs, vk0, so_ + a.kcolB, 0)); } \
        if constexpr (MODE == 0) { if (t_ < 64) st_c = (a.cref - a.cb[(k0) + t_]) * (1.f / SCALE128); } } while (0)
#define SWRITE_K(bf) do { FRESH_TID_W(t_); if constexpr (DQ == 128) { const int sr = t_ >> 4, sc = (t_ & 15) * 8, kws = KSWZ(sr, sc * 2); *(LAS bf16x8*)(K_lds + (bf) * SHM_K + kws) = st_k0; *(LAS bf16x8*)(K_lds + (bf) * SHM_K + kws + 32 * 256) = st_k1; } \
        else { const int sr2 = t_ >> 3, sc2 = (t_ & 7) * 8, kws2 = KSWZ(sr2, sc2 * 2); *(LAS bf16x8*)(K_lds + (bf) * SHM_K + kws2) = st_k0; } \
        if constexpr (MODE == 0) { if (t_ < 64) kbl[(bf) * 64 + t_] = st_c; } } while (0)
#define SWRITE_V(bf) do { FRESH_TID_W(t_); const int sr = t_ >> 4, sc = (t_ & 15) * 8, vst0 = v_st(sr, sc), vst1 = v_st(32 + sr, sc); *(LAS bf16x8*)(V_lds + (bf) * SHM_V + vst0) = st_v0; *(LAS bf16x8*)(V_lds + (bf) * SHM_V + vst1) = st_v1; } while (0)
#define SWRITE(bf) do { SWRITE_V(bf); SWRITE_K(bf); } while (0)
#define SCORES(P0_, P1_, t, BF) do { const int kb_ = KBASE(t); int dq; { FRESH_TID(t_); const int r32_ = t_ & 31, hi_ = (t_ >> 5) & 1; dq = ((MODE == 2) ? a.qpos : (qlo + r32_)) - 4 * hi_ - kb_; } \
        if constexpr (MODE == 1) { if (__builtin_expect(qlo - (kb_ + 63) < 790, 0)) { const LAS float* lp = lutl + (dq + LUT_PAD - 59); \
            _Pragma("unroll") for (int r = 0; r < 16; ++r) { const int c = (r & 3) + 8 * (r >> 2); P0_[r] += lp[59 - c]; P1_[r] += lp[27 - c]; } } } \
        if constexpr (MODE == 2) { if (!__all(dq - 59 >= 1023)) {   \
            _Pragma("unroll") for (int r = 0; r < 16; ++r) { const int c = (r & 3) + 8 * (r >> 2); int d0_ = dq - c, d1_ = dq - c - 32; d0_ = d0_ > 1023 ? 1023 : d0_; d1_ = d1_ > 1023 ? 1023 : d1_; \
                P0_[r] += lutl[d0_ + LUT_PAD]; P1_[r] += lutl[d1_ + LUT_PAD]; } } } \
        if ((MODE == 2 && !__all(dq - 59 >= 0)) || (MODE != 2 && __builtin_expect(kb_ + 63 >= qlo, 0))) { const float NEG = (MODE == 3) ? -3.0e4f : -__builtin_inff(); constexpr int ST = (MODE == 3) ? 1 : 0; \
            _Pragma("unroll") for (int r = 0; r < 16; ++r) { const int c = (r & 3) + 8 * (r >> 2); if (dq - c < ST) P0_[r] = NEG; if (dq - c - 32 < ST) P1_[r] = NEG; } } } while (0)
#define RESC(al) do { if (__builtin_expect(__any((al) < 1.f), 0)) { if (hi == 0) al_l[r32] = (al); asm volatile("s_waitcnt lgkmcnt(0)" ::: "memory"); \
                     for (int d_ = 0; d_ < 4; ++d_) for (int r = 0; r < 16; ++r) o[d_][r] *= al_l[crow(r, hi)]; } } while (0)
#define PARTIAL(P0_, P1_, mnX, alX) do { if constexpr (MODE == 3) { sb_half(P1_, m_reg, hi); } else { partialSM<DQ>(P0_, P1_, m_reg, mnX, alX); } } while (0)
#define FINISH(P0_, P1_, alY) do { if constexpr (MODE == 3) { sb_half(P0_, m_reg, hi); sb_pack(P0_, P1_, pa0, pa1, pa2, pa3); } else { finishSM(P0_, P1_, alY, l_reg, pa0, pa1, pa2, pa3); } } while (0)
#define RESCALE(al) do { if constexpr (MODE != 3) { RESC(al); } } while (0)
    f32x16 pA0, pA1, pB0, pB1; float mnA = 0.f, mnB = 0.f, alA = 1.f, alB = 1.f; bf16x8 pa0, pa1, pa2, pa3;
#if TIME_SEG
    unsigned long long tseg = 0, ttot = 0;
#endif
#define QKT(KB_, P0_, P1_) do { if constexpr (MODE == 0) { \
            _Pragma("unroll") for (int g = 0; g < 4; ++g) { const f32x4 b0 = *(const LAS f32x4*)(kbl + (KB_) * 64 + 8 * g + 4 * hi), b1 = *(const LAS f32x4*)(kbl + (KB_) * 64 + 32 + 8 * g + 4 * hi); \
                _Pragma("unroll") for (int e = 0; e < 4; ++e) { P0_[4 * g + e] = b0[e]; P1_[4 * g + e] = b1[e]; } } \
            qkt<KB_, DQ, true>(P0_, P1_, K_lds, r32, hi, qr); } else { qkt<KB_, DQ>(P0_, P1_, K_lds, r32, hi, qr); } } while (0)
    SLOAD(KBASE(0)); VMW(); SWRITE_K(0);
    __syncthreads();
    SWRITE_V(0); SBAR();
    if (NT > 1) SLOAD(KBASE(1));
    SBAR(); QKT(0, pA0, pA1);
    SCORES(pA0, pA1, 0, 0); PARTIAL(pA0, pA1, mnA, alA);
    if (NT > 1) { VMW(); SWRITE(1); }
    __syncthreads();
#if TIME_SEG
#define TSTAMP(k) do { if constexpr (DQ == 64) { unsigned long long t_; asm volatile("s_memtime %0\n\ts_waitcnt lgkmcnt(0)" : "=s"(t_) :: "memory"); SBAR(); \
        if (TIME_SEG == (k)) tseg -= t_; if (TIME_SEG + 1 == (k)) tseg += t_; if ((k) == 0) ttot -= t_; if ((k) == 7) ttot += t_; } } while (0)
#define TSTAMP2(seg, end) do { if constexpr (DQ == 64 && TIME_SEG == (seg)) { unsigned long long t_; asm volatile("s_memtime %0\n\ts_waitcnt lgkmcnt(0)" : "=s"(t_) :: "memory"); SBAR(); if (end) tseg += t_; else tseg -= t_; } } while (0)
#else
#define TSTAMP(k) do { } while (0)
#define TSTAMP2(seg, end) do { } while (0)
#endif
#define HALF_STEP(PX0, PX1, mnX, alX, PY0, PY1, alY, t, KB, VB, SB) do {                                 \
        TSTAMP(0); TSTAMP2(8, 0); SBAR(); QKT(KB, PX0, PX1); TSTAMP2(8, 1); TSTAMP2(9, 0);            \
        FINISH(PY0, PY1, alY); SBAR(); TSTAMP(1); TSTAMP2(9, 1);                                          \
        if ((t) + 1 < NT) { SLOAD(KBASE((t) + 1)); SBAR(); } TSTAMP(2);                                   \
        pv_tile<VB>(o, vb0, pa0, pa1, pa2, pa3); TSTAMP(3); SCORES(PX0, PX1, (t), KB); PARTIAL(PX0, PX1, mnX, alX); TSTAMP(4);  \
        __syncthreads(); TSTAMP(5);                                                                       \
        if ((t) + 1 < NT) { VMW(); SWRITE(SB); }                                                          \
        RESCALE(alX); TSTAMP(6); __syncthreads(); TSTAMP(7); } while (0)
#if TIME_SEG == 20
    unsigned long long f20a = 0; if constexpr (MODE == 0) asm volatile("s_memtime %0\n\ts_waitcnt lgkmcnt(0)" : "=s"(f20a) :: "memory");
#endif
    for (int t = 1; t + 1 < NT; t += 2) {
        HALF_STEP(pB0, pB1, mnB, alB, pA0, pA1, alA, t, 1, 0, 0);
        HALF_STEP(pA0, pA1, mnA, alA, pB0, pB1, alB, t + 1, 0, 1, 1);
    }
#if TIME_SEG == 20
    if constexpr (MODE == 0) { unsigned long long f20b; asm volatile("s_memtime %0\n\ts_waitcnt lgkmcnt(0)" : "=s"(f20b) :: "memory");
        const int nt2 = (NT - 1) & ~1; if (nt2 >= 8 && (threadIdx.x & 63) == 0) { const unsigned long long d_ = f20b - f20a, b_ = (unsigned long long)nt2 * 2000ull;
            atomicAdd(a.tprobe, (float)(d_ > b_ ? d_ - b_ : 0) * 1e-6f); atomicAdd(a.tprobe + 1, (float)nt2 * 4000.f * 1e-6f); } }
#endif
    const bool even = (NT & 1) == 0;
    if (even) { SBAR(); QKT(1, pB0, pB1); SBAR(); }
    FINISH(pA0, pA1, alA); SBAR();
    pv_tile<0>(o, vb0, pa0, pa1, pa2, pa3);
    if (even) { SCORES(pB0, pB1, NT - 1, 1); PARTIAL(pB0, pB1, mnB, alB); __syncthreads(); RESCALE(alB);
        FINISH(pB0, pB1, alB); SBAR(); pv_tile<1>(o, vb0, pa0, pa1, pa2, pa3); }
    __syncthreads();
#if TIME_SEG
    if constexpr (DQ == 64) { if ((threadIdx.x & 63) == 0) { atomicAdd((float*)(a.cb), (float)tseg * 1e-6f); atomicAdd((float*)(a.cb) + 1, (float)ttot * 1e-6f); } }
#endif
}

template <int DQ, int MODE, bool REV>
__device__ __forceinline__ void attn_chunk_pp(const ChunkArgs& a, const bf16x8* qr, float& m_reg, float& l_reg, f32x16* o, LAS char* lds) {
    int tid_ = threadIdx.x; asm volatile("" : "+v"(tid_)); const int tid = tid_, wid = __builtin_amdgcn_readfirstlane(tid >> 6), lane = tid & 63, r32 = lane & 31, hi = lane >> 5;
    const int NT = a.jb - a.ja;
    LAS char* V_lds = lds + L_V; LAS char* K_lds = lds + L_K;
    LAS float* ws = (LAS float*)(lds + L_WS) + wid * 64; LAS float* al_l = ws + 32;
    LAS float* kbl = (LAS float*)(lds + L_KB); const LAS float* lutl = (const LAS float*)(lds + L_LUT);
    const int vb0 = (int)(uintptr_t)V_lds + v_rd_base(lane);
    const __amdgpu_buffer_rsrc_t hrs = __builtin_amdgcn_make_buffer_rsrc((void*)a.hbase, 0, (int)((size_t)SEQ * PITCH * 2), 0x00020000);
    const int qlo = a.qlo;
    bf16x8 st_v0, st_v1, st_k0, st_k1; float st_c = 0.f;
    static_assert(MODE != 0, "the per-key bias table would need a ring of three here");
#define SLOAD_V(k0) do { FRESH_TID(t_); const int sr = t_ >> 4, sc = (t_ & 15) * 8; const unsigned so_ = (unsigned)(k0) * (unsigned)(PITCH * 2); \
        const unsigned vo0 = (unsigned)(sr * PITCH + sc) * 2u, vo1 = vo0 + (unsigned)(32 * PITCH * 2); \
        st_v0 = __builtin_bit_cast(bf16x8, __builtin_amdgcn_raw_buffer_load_b128(hrs, vo0, so_ + a.vcolB, 0)); st_v1 = __builtin_bit_cast(bf16x8, __builtin_amdgcn_raw_buffer_load_b128(hrs, vo1, so_ + a.vcolB, 0)); } while (0)
#define SLOAD_K(k0) do { FRESH_TID(t_); const unsigned so_ = (unsigned)(k0) * (unsigned)(PITCH * 2); \
        if constexpr (DQ == 128) { const int sr = t_ >> 4, sc = (t_ & 15) * 8; const unsigned vo0 = (unsigned)(sr * PITCH + sc) * 2u, vo1 = vo0 + (unsigned)(32 * PITCH * 2); \
            st_k0 = __builtin_bit_cast(bf16x8, __builtin_amdgcn_raw_buffer_load_b128(hrs, vo0, so_ + a.kcolB, 0)); st_k1 = __builtin_bit_cast(bf16x8, __builtin_amdgcn_raw_buffer_load_b128(hrs, vo1, so_ + a.kcolB, 0)); } \
        else { const unsigned vk0 = (unsigned)((t_ >> 3) * PITCH + (t_ & 7) * 8) * 2u; st_k0 = __builtin_bit_cast(bf16x8, __builtin_amdgcn_raw_buffer_load_b128(hrs, vk0, so_ + a.kcolB, 0)); } } while (0)
#define TCL(x) ((x) < NT ? (x) : NT - 1)
#define WGBAR() do { asm volatile("s_waitcnt lgkmcnt(0)" ::: "memory"); __builtin_amdgcn_s_barrier(); asm volatile("" ::: "memory"); } while (0)
    f32x16 p0, p1; float mn = 0.f, al = 1.f; bf16x8 pa0, pa1, pa2, pa3;
    SLOAD_K(KBASE(0)); SLOAD_V(KBASE(0)); VMW(); SWRITE_K(0); SWRITE_V(0);
    SLOAD_K(KBASE(TCL(1))); SLOAD_V(KBASE(TCL(1))); VMW(); SWRITE_K(1);
    SLOAD_K(KBASE(TCL(2)));
    WGBAR();
    qkt<0, DQ>(p0, p1, K_lds, r32, hi, qr); SBAR();
    if (wid >= 4) WGBAR();
#define YPH(t, PAR) do { __builtin_amdgcn_s_setprio(PP_YPRIO); SCORES(p0, p1, (t), PAR); if constexpr (MODE == 1) { softmaxY<DQ>(p0, p1, m_reg, al, l_reg, pa0, pa1, pa2, pa3); } else { PARTIAL(p0, p1, mn, al); FINISH(p0, p1, al); } SBAR(); RESCALE(al); __builtin_amdgcn_s_setprio(0); SBAR(); } while (0)
#define XLD(t, PAR) do { VMW(); SWRITE_K(PAR); SWRITE_V((PAR) ^ 1); SLOAD_K(KBASE(TCL((t) + 3))); SLOAD_V(KBASE(TCL((t) + 2))); SBAR(); } while (0)
#define XPH(t, PAR) do { XLD(t, PAR); __builtin_amdgcn_s_setprio(PP_XPRIO); xphase<PAR, (PAR) ^ 1, DQ, true>(o, vb0, pa0, pa1, pa2, pa3, p0, p1, K_lds, r32, hi, qr); __builtin_amdgcn_s_setprio(0); SBAR(); } while (0)
#if TIME_SEG
    unsigned long long tseg = 0, tl, tstart;
#define TNOW(t_) asm volatile("s_memtime %0\n\ts_waitcnt lgkmcnt(0)" : "=s"(t_) :: "memory")
#define TST(k) do { unsigned long long t_; TNOW(t_); SBAR(); if ((TIME_SEG % 10) == (k)) tseg += t_ - tl; tl = t_; } while (0)
    TNOW(tl); tstart = tl; unsigned long long rt0 = 0; if ((TIME_SEG % 10) == 6) asm volatile("s_memrealtime %0\n\ts_waitcnt lgkmcnt(0)" : "=s"(rt0) :: "memory");
#else
#define TST(k) do { } while (0)
#endif
    int t = 0;
    for (; t + 2 < NT; t += 2) { YPH(t, 0); TST(1); WGBAR(); TST(2); XPH(t, 0); TST(3); WGBAR(); TST(4); YPH(t + 1, 1); TST(1); WGBAR(); TST(2); XPH(t + 1, 1); TST(3); WGBAR(); TST(4); }
#if TIME_SEG
    { unsigned long long ttot = tl - tstart; if ((TIME_SEG % 10) == 5) { tseg = ttot; ttot = (unsigned long long)(NT & ~1) * 10000ull; } if ((TIME_SEG % 10) == 8) { const unsigned long long base_ = (unsigned long long)(NT & ~1) * 2400ull; tseg = ttot > base_ ? ttot - base_ : 0; ttot = (unsigned long long)(NT & ~1) * 1000ull; }
      if ((TIME_SEG % 10) == 6) { unsigned long long rt1; asm volatile("s_memrealtime %0\n\ts_waitcnt lgkmcnt(0)" : "=s"(rt1) :: "memory"); tseg = ttot; ttot = (rt1 - rt0) * 10ull; }
      if (TIME_SEG != 7 && TIME_SEG != 20 && (TIME_SEG < 10) == (wid < 4) && (threadIdx.x & 63) == 0 && NT > 8) { atomicAdd((float*)(a.cb), (float)tseg * 1e-6f); atomicAdd((float*)(a.cb) + 1, (float)ttot * 1e-6f); } }
#undef TNOW
#endif
#undef TST
    if (t + 1 < NT) { YPH(t, 0); WGBAR(); XPH(t, 0); WGBAR(); YPH(t + 1, 1); WGBAR(); pv_tile<1>(o, vb0, pa0, pa1, pa2, pa3); WGBAR(); }
    else { YPH(t, 0); WGBAR(); pv_tile<0>(o, vb0, pa0, pa1, pa2, pa3); WGBAR(); }
    if (wid < 4) WGBAR();
#undef YPH
#undef XLD
#undef XPH
#undef TCL
#undef WGBAR
#undef SLOAD_K
#undef SLOAD_V

}

constexpr int M_V = 0, M_K = 4 * SHM_V, M_WS = M_K + 4 * SHM_K, M_FLAG = M_WS + NWAVES * 64 * 4, M_LUT = M_FLAG + 512, M_PRE = M_LUT + LUT_N * 4 + 256, M_END = M_PRE + 4352;
static_assert(M_END <= 147456, "MoBA-resident LDS map must stay below the control words");
__device__ __forceinline__ void moba_stage_block(const bf16* hbase, unsigned kcolB, unsigned vcolB, int n, LAS char* lds) {
    int t_ = threadIdx.x; asm volatile("" : "+v"(t_));
    const __amdgpu_buffer_rsrc_t hrs = __builtin_amdgcn_make_buffer_rsrc((void*)hbase, 0, (int)((size_t)SEQ * PITCH * 2), 0x00020000);
    const int sr = t_ >> 4, sc = (t_ & 15) * 8; const unsigned vo0 = (unsigned)(sr * PITCH + sc) * 2u, vo1 = vo0 + (unsigned)(32 * PITCH * 2);
    const int kws = KSWZ(sr, sc * 2), vst0 = v_st(sr, sc), vst1 = v_st(32 + sr, sc);
    bf16x8 k0[4], k1[4], v0[4], v1[4];
#pragma unroll
    for (int b = 0; b < 4; ++b) { const unsigned so_ = (unsigned)((n * 4 + b) * 64) * (unsigned)(PITCH * 2);
        k0[b] = __builtin_bit_cast(bf16x8, __builtin_amdgcn_raw_buffer_load_b128(hrs, vo0, so_ + kcolB, 0)); k1[b] = __builtin_bit_cast(bf16x8, __builtin_amdgcn_raw_buffer_load_b128(hrs, vo1, so_ + kcolB, 0));
        v0[b] = __builtin_bit_cast(bf16x8, __builtin_amdgcn_raw_buffer_load_b128(hrs, vo0, so_ + vcolB, 0)); v1[b] = __builtin_bit_cast(bf16x8, __builtin_amdgcn_raw_buffer_load_b128(hrs, vo1, so_ + vcolB, 0)); }
#pragma unroll
    for (int b = 0; b < 4; ++b) {
        *(LAS bf16x8*)(lds + M_K + b * SHM_K + kws) = k0[b]; *(LAS bf16x8*)(lds + M_K + b * SHM_K + kws + 32 * 256) = k1[b];
        *(LAS bf16x8*)(lds + M_V + b * SHM_V + vst0) = v0[b]; *(LAS bf16x8*)(lds + M_V + b * SHM_V + vst1) = v1[b]; }
}
__device__ __forceinline__ void moba_tiles(const ChunkArgs& a, const bf16x8* qr, float& m_reg, float& l_reg, f32x16* o, LAS char* lds) {
    constexpr int DQ = 128, MODE = 2; constexpr bool REV = false;
    int tid_ = threadIdx.x; asm volatile("" : "+v"(tid_)); const int tid = tid_, wid = __builtin_amdgcn_readfirstlane(tid >> 6), lane = tid & 63, r32 = lane & 31, hi = lane >> 5;
    LAS char* V_lds = lds + M_V; LAS char* K_lds = lds + M_K;
    LAS float* ws = (LAS float*)(lds + M_WS) + wid * 64; LAS float* al_l = ws + 32;
    LAS float* kbl = nullptr; const LAS float* lutl = (const LAS float*)(lds + M_LUT);
    const int vb0 = (int)(uintptr_t)V_lds + v_rd_base(lane);
    const int qlo = a.qlo;
    f32x16 p0, p1; float mn = 0.f, al = 1.f; bf16x8 pa0, pa1, pa2, pa3;
#define MTILE(t) do { if (KBASE(t) <= qlo + 31) { qkt<t, DQ>(p0, p1, K_lds, r32, hi, qr); SBAR(); SCORES(p0, p1, t, 0); PARTIAL(p0, p1, mn, al); RESCALE(al); FINISH(p0, p1, al); SBAR(); pv_tile<t>(o, vb0, pa0, pa1, pa2, pa3); SBAR(); } } while (0)
    MTILE(0); MTILE(1); MTILE(2); MTILE(3);
#undef MTILE
    (void)kbl; (void)ws;
}

constexpr int M_KB = M_PRE;
template <int DQ, int MODE, bool REV>
__device__ __forceinline__ void chunk_res(const ChunkArgs& a, const bf16x8* qr, float& m_reg, float& l_reg, f32x16* o, LAS char* lds) {
    int tid_ = threadIdx.x; asm volatile("" : "+v"(tid_)); const int tid = tid_, wid = __builtin_amdgcn_readfirstlane(tid >> 6), lane = tid & 63, r32 = lane & 31, hi = lane >> 5;
    const int NT = a.jb - a.ja, NP = NT >> 1;
    LAS char* V_lds = lds + M_V; LAS char* K_lds = lds + M_K;
    LAS float* ws = (LAS float*)(lds + M_WS) + wid * 64; LAS float* al_l = ws + 32;
    LAS float* kbl = (LAS float*)(lds + M_KB); const LAS float* lutl = (const LAS float*)(lds + M_LUT);
    const int vb0 = (int)(uintptr_t)V_lds + v_rd_base(lane);
    const __amdgpu_buffer_rsrc_t hrs = __builtin_amdgcn_make_buffer_rsrc((void*)a.hbase, 0, (int)((size_t)SEQ * PITCH * 2), 0x00020000);
    const int qlo = a.qlo;
    bf16x8 sk0[2], sk1[2], sv0[2], sv1[2]; float sc_[2] = {0.f, 0.f};
#define FLOAD(p) do { int t_ = threadIdx.x; asm volatile("" : "+v"(t_)); const int sr = t_ >> 4, sc = (t_ & 15) * 8; const unsigned vo0 = (unsigned)(sr * PITCH + sc) * 2u, vo1 = vo0 + (unsigned)(32 * PITCH * 2); \
        _Pragma("unroll") for (int b = 0; b < 2; ++b) { const int k0_ = KBASE(2 * (p) + b); const unsigned so_ = (unsigned)k0_ * (unsigned)(PITCH * 2); \
            if constexpr (DQ == 128) { sk0[b] = __builtin_bit_cast(bf16x8, __builtin_amdgcn_raw_buffer_load_b128(hrs, vo0, so_ + a.kcolB, 0)); sk1[b] = __builtin_bit_cast(bf16x8, __builtin_amdgcn_raw_buffer_load_b128(hrs, vo1, so_ + a.kcolB, 0)); } \
            else { const unsigned vk0 = (unsigned)((t_ >> 3) * PITCH + (t_ & 7) * 8) * 2u; sk0[b] = __builtin_bit_cast(bf16x8, __builtin_amdgcn_raw_buffer_load_b128(hrs, vk0, so_ + a.kcolB, 0)); } \
            sv0[b] = __builtin_bit_cast(bf16x8, __builtin_amdgcn_raw_buffer_load_b128(hrs, vo0, so_ + a.vcolB, 0)); sv1[b] = __builtin_bit_cast(bf16x8, __builtin_amdgcn_raw_buffer_load_b128(hrs, vo1, so_ + a.vcolB, 0)); \
            if constexpr (MODE == 0) { if (t_ < 64) sc_[b] = (a.cref - a.cb[k0_ + t_]) * (1.f / SCALE128); } } } while (0)
#define FWRITE(g) do { int t_ = threadIdx.x; asm volatile("" : "+v"(t_)); const int sr = t_ >> 4, sc = (t_ & 15) * 8, vst0 = v_st(sr, sc), vst1 = v_st(32 + sr, sc); \
        _Pragma("unroll") for (int b = 0; b < 2; ++b) { constexpr int s_ = 2 * (g); \
            if constexpr (DQ == 128) { const int kws = KSWZ(sr, sc * 2); *(LAS bf16x8*)(K_lds + (s_ + b) * SHM_K + kws) = sk0[b]; *(LAS bf16x8*)(K_lds + (s_ + b) * SHM_K + kws + 32 * 256) = sk1[b]; } \
            else { const int sr2 = t_ >> 3, sc2 = (t_ & 7) * 8, kws2 = KSWZ(sr2, sc2 * 2); *(LAS bf16x8*)(K_lds + (s_ + b) * SHM_K + kws2) = sk0[b]; } \
            *(LAS bf16x8*)(V_lds + (s_ + b) * SHM_V + vst0) = sv0[b]; *(LAS bf16x8*)(V_lds + (s_ + b) * SHM_V + vst1) = sv1[b]; \
            if constexpr (MODE == 0) { if (t_ < 64) kbl[(s_ + b) * 64 + t_] = sc_[b]; } } } while (0)
    f32x16 p0, p1; float mn = 0.f, al = 1.f; bf16x8 pa0, pa1, pa2, pa3;
#define FTILE(t, S) do { if (KBASE(t) <= qlo + 31 - (MODE == 3 ? 1 : 0)) { QKT(S, p0, p1); SBAR(); SCORES(p0, p1, (t), S); \
        if constexpr (MODE == 1) { softmaxY<DQ>(p0, p1, m_reg, al, l_reg, pa0, pa1, pa2, pa3); SBAR(); RESCALE(al); } else { PARTIAL(p0, p1, mn, al); RESCALE(al); FINISH(p0, p1, al); } \
        SBAR(); if constexpr (RES_PVDB) xphase<S, 0, DQ, false>(o, vb0, pa0, pa1, pa2, pa3, p0, p1, K_lds, r32, hi, qr); else pv_tile<S>(o, vb0, pa0, pa1, pa2, pa3); SBAR(); } } while (0)
#define FPAIR(p, g) do { __syncthreads(); \
        if ((p) + 1 < NP) { VMW(); FWRITE((g) ^ 1); if ((p) + 2 < NP) FLOAD((p) + 2); } SBAR(); \
        FTILE(2 * (p), 2 * (g)); FTILE(2 * (p) + 1, 2 * (g) + 1); } while (0)
    FLOAD(0); VMW(); FWRITE(0); if (NP > 1) FLOAD(1);
    int p = 0;
    for (; p + 1 < NP; p += 2) { FPAIR(p, 0); FPAIR(p + 1, 1); }
    if (p < NP) FPAIR(p, 0);
    __syncthreads();
#undef FPAIR
#undef FTILE
#undef FWRITE
#undef FLOAD
    (void)lutl; (void)ws; (void)tid; (void)kbl; (void)mn;
}
__device__ __forceinline__ void fox_chunk_res(const ChunkArgs& a, const bf16x8* qr, float& m_reg, float& l_reg, f32x16* o, LAS char* lds) { chunk_res<128, 0, true>(a, qr, m_reg, l_reg, o, lds); }
#undef QKT
#undef KBASE
#undef VMW
#undef SLOAD
#undef FRESH_TID
#undef FRESH_TID_W
#undef SWRITE_K
#undef SWRITE_V
#undef SWRITE
#undef SCORES
#undef RESC
#undef PARTIAL
#undef FINISH
#undef RESCALE
#undef HALF_STEP
#undef TSTAMP
#undef TSTAMP2

template <int DQ> __device__ __forceinline__ void load_q(bf16x8* qr, const bf16* qrow, int hi) {
#pragma unroll
    for (int d0 = 0; d0 < DQ / 16; ++d0) qr[d0] = *(const bf16x8*)(qrow + d0 * 16 + hi * 8);
}
__device__ __forceinline__ void load_lut(LAS char* lds, const float* lutg, float inv_scale, int off = L_LUT) {
    LAS float* l = (LAS float*)(lds + off); const float far = lutg[1023];
    int i0 = threadIdx.x; asm volatile("" : "+v"(i0));
    for (int i = i0; i < LUT_N; i += NTHREADS) l[i] = (i < LUT_PAD) ? 0.f : (lutg[i - LUT_PAD] - far) * inv_scale;
}
template <int CTRL> __device__ __forceinline__ float quad_bcast(float v) { return __builtin_bit_cast(float, __builtin_amdgcn_mov_dpp(__builtin_bit_cast(int, v), CTRL, 0xf, 0xf, true)); }
constexpr float O8_SCALE = 16.f;
__device__ __forceinline__ void store_o(const f32x16* o, const float* rl  , unsigned char* obase, int ldo, int r32, int hi) {
#pragma unroll
    for (int r = 0; r < 16; ++r) { const int orow = crow(r, hi);
#pragma unroll
        for (int d0 = 0; d0 < 4; ++d0) { const float v = o[d0][r] * rl[r] * O8_SCALE; const float v1 = quad_bcast<0x55>(v), v2 = quad_bcast<0xAA>(v), v3 = quad_bcast<0xFF>(v);
            if ((r32 & 3) == 0) *(unsigned*)(obase + (size_t)orow * ldo + d0 * 32 + r32) = pk4_fp8(v, v1, v2, v3); } }
}
}

__device__ __forceinline__ void fox_epilogue(const att::f32x16* o, float l_reg, LAS char* lds, unsigned char* oblk, int ldo, int ws_off = att::L_WS) {
    int t_ = threadIdx.x; asm volatile("" : "+v"(t_)); const int wid = __builtin_amdgcn_readfirstlane(t_ >> 6), r32 = t_ & 31, hi = (t_ >> 5) & 1;
    LAS float* li_l = (LAS float*)(lds + ws_off) + wid * 64;
    if (hi == 0) li_l[r32] = l_reg; asm volatile("s_waitcnt lgkmcnt(0)" ::: "memory");
    float rli[16];
#pragma unroll
    for (int r = 0; r < 16; ++r) rli[r] = __builtin_amdgcn_rcpf(li_l[att::crow(r, hi)]);
    att::store_o(o, rli, oblk + (size_t)(wid * 32) * ldo, ldo, r32, hi);
    __syncthreads();
}
constexpr int CW_KMAX = 10496;
__device__ __forceinline__ void fox_block(const Args& A, LAS char* lds, int hd, int qb, unsigned char* obuf, int ldo, int ocol) {
    int tid_ = threadIdx.x; asm volatile("" : "+v"(tid_)); const int tid = tid_, wid = __builtin_amdgcn_readfirstlane(tid >> 6), lane = tid & 63, r32 = lane & 31, hi = lane >> 5;
    const bf16* h = (const bf16*)(A.ws + WS_H); const int P0 = qb * 256;
    const float* cg = (const float*)(A.ws + WS_C) + hd * SEQ;
    bf16x8 qr[8]; att::load_q<128>(qr, h + (size_t)(P0 + wid * 32 + r32) * NQKV + hd * 128, hi);
    att::ChunkArgs ca; ca.hbase = h; ca.kcolB = (unsigned)(1024 + hd * 128) * 2u; ca.vcolB = (unsigned)(2048 + hd * 128) * 2u;
    ca.qpos = P0 + wid * 32 + r32; ca.qlo = P0 + wid * 32; ca.cb = cg; ca.cref = cg[P0];
    ca.tprobe = (float*)(A.ws + WS_CTL) + 10240;
    float m_reg = -1e30f, l_reg = 0.f; att::f32x16 o[4] = {};
    LAS int* flg = (LAS int*)(lds + (FOX_RES ? att::M_FLAG : att::L_FLAG));
    int jb = P0 / 64 + 4;
    for (;;) {
        const int ja = jb > FOX_CH ? jb - FOX_CH : 0;
        ca.ja = ja; ca.jb = jb;
#if FOX_RES
        att::fox_chunk_res(ca, qr, m_reg, l_reg, o, lds);
#else
        att::attn_chunk<128, 0, true>(ca, qr, m_reg, l_reg, o, lds);
#endif
        if (ja == 0) break;
        float qn2 = 0.f;
#pragma unroll
        for (int d0 = 0; d0 < 8; ++d0)
#pragma unroll
            for (int j = 0; j < 8; ++j) { const float v = bf2f((unsigned short)qr[d0][j]); qn2 += v * v; }
        { auto rr = __builtin_amdgcn_permlane32_swap(__float_as_uint(qn2), __float_as_uint(qn2), false, false); qn2 = __uint_as_float(rr[0]) + __uint_as_float(rr[1]); }
        const float kmax2 = __uint_as_float(__hip_atomic_load((unsigned*)(A.ws + WS_CTL) + CW_KMAX + hd, RLX_AGENT));
        const float qk_bound = sqrtf(qn2 * kmax2) * 1.001f;
        const float kb_low = (ca.cref - cg[ja * 64]) * (1.f / SCALE128);
        const int done = __all((qk_bound + kb_low - m_reg) * (1.4426950408889634f * SCALE128) < -152.f) ? 1 : 0;
        { int t_ = threadIdx.x; asm volatile("" : "+v"(t_)); if ((t_ & 63) == 0) flg[t_ >> 6] = done; }
        __syncthreads();
        int all = 1;
#pragma unroll
        for (int w = 0; w < NWAVES; ++w) all &= flg[w];
        __syncthreads();
        if (all) break;
        jb = ja;
    }
    fox_epilogue(o, l_reg, lds, obuf + (size_t)P0 * ldo + ocol, ldo, FOX_RES ? att::M_WS : att::L_WS);
}

template <int MP>
__device__ __forceinline__ void diff_map(const Args& A, LAS char* lds, int hd, int qb, unsigned char* obuf) {
    int tid_ = threadIdx.x; asm volatile("" : "+v"(tid_)); const int tid = tid_, wid = __builtin_amdgcn_readfirstlane(tid >> 6), lane = tid & 63, r32 = lane & 31, hi = lane >> 5;
    const bf16* h = (const bf16*)(A.ws + WS_H); const int P0 = qb * 256;
#if DIFF_RES
    unsigned short* stash = (unsigned short*)(A.ws + WS_DSTASH) + ((size_t)blockIdx.x * NWAVES + wid) * 4096 + lane;
    LAS float* li_l = (LAS float*)(lds + att::M_WS) + wid * 64;
#else
    LAS unsigned short* stash = (LAS unsigned short*)(lds + att::L_STASH) + wid * 4096 + lane;
    LAS float* li_l = (LAS float*)(lds + att::L_WS) + wid * 64;
#endif
    bf16x8 qr[4]; att::load_q<64>(qr, h + (size_t)(P0 + wid * 32 + r32) * NQKV + hd * 128 + MP * 64, hi);
    att::ChunkArgs ca; ca.hbase = h; ca.kcolB = (unsigned)(1024 + hd * 128 + MP * 64) * 2u; ca.vcolB = (unsigned)(2048 + hd * 128) * 2u;
    ca.ja = 0; ca.jb = P0 / 64 + 4; ca.qpos = P0 + wid * 32 + r32; ca.qlo = P0 + wid * 32; ca.cb = TIME_SEG ? (const float*)(A.ws + WS_CTL) + 10240 : nullptr; ca.cref = 0.f;
    float m_reg = -1e30f, l_reg = 0.f;
    att::f32x16 o[4] = {};
#if DIFF_RES
    att::chunk_res<64, 1, false>(ca, qr, m_reg, l_reg, o, lds);
#elif PP_DIFF
    att::attn_chunk_pp<64, 1, false>(ca, qr, m_reg, l_reg, o, lds);
#else
    att::attn_chunk<64, 1, false>(ca, qr, m_reg, l_reg, o, lds);
#endif
    if (hi == 0) li_l[r32] = l_reg; asm volatile("s_waitcnt lgkmcnt(0)" ::: "memory");
    if constexpr (MP == 0) {
#pragma unroll
        for (int r = 0; r < 16; ++r) { const float rl = __builtin_amdgcn_rcpf(li_l[att::crow(r, hi)]);
#pragma unroll
            for (int d0 = 0; d0 < 4; ++d0) stash[(r * 4 + d0) * 64] = (unsigned short)f2bf(o[d0][r] * rl); }
    } else {
        const float lam = ((const float*)(A.ws + WS_LAM))[0];
        unsigned char* ob = obuf + (size_t)(P0 + wid * 32) * DM + hd * 128;
#pragma unroll
        for (int r = 0; r < 16; ++r) { const float rl = lam * __builtin_amdgcn_rcpf(li_l[att::crow(r, hi)]); float v[4]; float ss = 0.f;
#pragma unroll
            for (int d0 = 0; d0 < 4; ++d0) { v[d0] = bf2f(stash[(r * 4 + d0) * 64]) - o[d0][r] * rl; ss += v[d0] * v[d0]; }
            ss += __shfl_xor(ss, 1); ss += __shfl_xor(ss, 2); ss += __shfl_xor(ss, 4); ss += __shfl_xor(ss, 8); ss += __shfl_xor(ss, 16);
            const float sc = rsqrtf(ss * (1.f / 128.f) + LN_EPS) * (1.f - LAMBDA_INIT); const int orow = att::crow(r, hi);
#pragma unroll
            for (int d0 = 0; d0 < 4; ++d0) { const float w = v[d0] * sc * A.subln_gain[d0 * 32 + r32] * att::O8_SCALE; const float w1 = att::quad_bcast<0x55>(w), w2 = att::quad_bcast<0xAA>(w), w3 = att::quad_bcast<0xFF>(w);
                if ((r32 & 3) == 0) *(unsigned*)(ob + (size_t)orow * DM + d0 * 32 + r32) = pk4_fp8(w, w1, w2, w3); } }
    }
    __syncthreads();
}
__device__ __forceinline__ void diff_block(const Args& A, LAS char* lds, int hd, int qb, unsigned char* obuf) {
    att::load_lut(lds, (const float*)(A.ws + WS_LUT) + hd * 1024, 1.f / SCALE64, DIFF_RES ? att::M_LUT : att::L_LUT);
    diff_map<0>(A, lds, hd, qb, obuf);
    diff_map<1>(A, lds, hd, qb, obuf);
}

__device__ __forceinline__ void sb_block(const Args& A, LAS char* lds, int hd, int qb, unsigned char* obuf) {
    int tid_ = threadIdx.x; asm volatile("" : "+v"(tid_)); const int tid = tid_, wid = __builtin_amdgcn_readfirstlane(tid >> 6), lane = tid & 63, r32 = lane & 31, hi = lane >> 5;
    const bf16* h = (const bf16*)(A.ws + WS_H); const int P0 = qb * 256;
    bf16x8 qr[8]; att::load_q<128>(qr, h + (size_t)(P0 + wid * 32 + r32) * NQKV + 3072 + hd * 128, hi);
    att::ChunkArgs ca; ca.hbase = h; ca.kcolB = (unsigned)(4096 + hd * 128) * 2u; ca.vcolB = (unsigned)(5120 + hd * 128) * 2u;
    ca.qpos = P0 + wid * 32 + r32; ca.qlo = P0 + wid * 32; ca.cb = nullptr; ca.cref = 0.f;
    float R2 = 0.f, l_dummy = 0.f; att::f32x16 o[4] = {};
    LAS int* flg = (LAS int*)(lds + (SB_RES ? att::M_FLAG : att::L_FLAG));
    int jb = P0 / 64 + 4;
    for (;;) {
#if SB_NOCHUNK
        const int ja = 0;
#else
        const int ja = jb > 8 ? jb - 8 : 0;
#endif
        ca.ja = ja; ca.jb = jb;
#if SB_RES
        att::chunk_res<128, 3, true>(ca, qr, R2, l_dummy, o, lds);
#elif PP_SB
        att::attn_chunk_pp<128, 3, true>(ca, qr, R2, l_dummy, o, lds);
#else
        att::attn_chunk<128, 3, true>(ca, qr, R2, l_dummy, o, lds);
#endif
        const int done = __all(R2 < -150.1f) ? 1 : 0;
        if (lane == 0) flg[wid] = done;
        __syncthreads();
        int all = 1;
#pragma unroll
        for (int w = 0; w < NWAVES; ++w) all &= flg[w];
        __syncthreads();
        if (all || ja == 0) break;
        jb = ja;
    }
#if SB_R2PROBE
    { float rm = fmaxf(R2, 0.f); for (int o_ = 1; o_ < 64; o_ <<= 1) rm = fmaxf(rm, __shfl_xor(rm, o_));
      if (lane == 0) { atomicMax((unsigned*)(A.ws + WS_CTL) + 10240, __float_as_uint(rm)); __hip_atomic_store((float*)(A.ws + WS_CTL) + 10241, 1.f, RLX_AGENT); } }
#endif
    float one[16];
#pragma unroll
    for (int r = 0; r < 16; ++r) one[r] = 1.f;
    att::store_o(o, one, obuf + (size_t)(P0 + wid * 32) * DM + (8 + hd) * 128, DM, r32, hi);
    __syncthreads();
}

__device__ __forceinline__ void sb_unit_test(const Args& A, float sentinel) {
    const int lane = threadIdx.x & 63, r32 = lane & 31, hi = lane >> 5;
    float maxerr = 0.f;
    for (int pat = 0; pat < 4; ++pat) {
        att::f32x16 p0, p1; float R2 = (pat == 3) ? -20.f : 0.f; const float R2in = R2;
        const int lim = (pat == 0) ? 64 : (pat == 1) ? (r32 * 2 + 1) : (pat == 2) ? (r32 < 16 ? 0 : 40) : 33;
#define ZRAW(k) (((k) >= lim) ? sentinel : (25.f * __sinf(0.37f * (float)(k) + 0.11f * (float)r32 + (float)pat)))
#pragma unroll
        for (int r = 0; r < 16; ++r) { p0[r] = ZRAW(att::crow(r, hi)); p1[r] = ZRAW(32 + att::crow(r, hi)); }
        att::sb_half(p1, R2, hi); att::sb_half(p0, R2, hi);
        constexpr float C2 = 1.4426950408889634f * SCALE128;
        float Rr = R2in;
        for (int k = 63; k >= 0; --k) { const float z2 = ZRAW(k) * C2; const float sp = fmaxf(z2, 0.f) + log2f(1.f + exp2f(-fabsf(z2))); const float aref = exp2f(z2 - sp + Rr); Rr -= sp;
#pragma unroll
            for (int r = 0; r < 16; ++r) { if (att::crow(r, hi) == k) maxerr = fmaxf(maxerr, fabsf(p0[r] - aref)); if (32 + att::crow(r, hi) == k) maxerr = fmaxf(maxerr, fabsf(p1[r] - aref)); }
            if (!(aref == aref)) maxerr = 1e9f; }
        maxerr = fmaxf(maxerr, fabsf(R2 - Rr) * 1e-3f);
        if (!(R2 == R2)) maxerr = 1e9f;
#pragma unroll
        for (int r = 0; r < 16; ++r) if (!(p0[r] == p0[r]) || !(p1[r] == p1[r])) maxerr = 1e9f;
#undef ZRAW
    }
    for (int o_ = 1; o_ < 64; o_ <<= 1) maxerr = fmaxf(maxerr, __shfl_xor(maxerr, o_));
    if (lane == 0) { atomicMax((unsigned*)(A.ws + WS_CTL) + 10240, __float_as_uint(maxerr)); __hip_atomic_store((float*)(A.ws + WS_CTL) + 10241, 1.f, RLX_AGENT); }
}

__device__ __forceinline__ void p3_gate_mfma(const Args& A, LAS char* lds, int G, int* sel) {
    int tid_ = threadIdx.x; asm volatile("" : "+v"(tid_)); const int tid = tid_, wid = __builtin_amdgcn_readfirstlane(tid >> 6), lane = tid & 63, r32 = lane & 31, hi = lane >> 5;
    const bf16* h = (const bf16*)(A.ws + WS_H);
    char* ldsg = (char*)lds; float* scal = (float*)(ldsg + 65536); int* lcnt = (int*)(ldsg + 66560); int* gbs = lcnt + 64;
    for (int u = blockIdx.x; u < 1024; u += G) {
        if (u < 512) {
            const int hd = u >> 6, qb = (u & 256) ? 63 - (u & 63) : (u & 63);
            const float* kmg = (const float*)(A.ws + WS_KMEAN) + (size_t)hd * 64 * 128;
            {   const int sr = tid >> 4, sc = (tid & 15) * 8, kws = KSWZ(sr, sc * 2);
#pragma unroll
                for (int half = 0; half < 2; ++half) { const float* src = kmg + (size_t)(sr + 32 * half) * 128 + sc;
                    const f32x4 a = *(const f32x4*)src, b = *(const f32x4*)(src + 4);
                    const float v[8] = {a[0], a[1], a[2], a[3], b[0], b[1], b[2], b[3]};
                    unsigned wh[4], wl[4], wm[4];
#pragma unroll
                    for (int e = 0; e < 4; ++e) {
                        const unsigned short h0 = f2bf(v[2 * e]), h1 = f2bf(v[2 * e + 1]); const float r0 = v[2 * e] - bf2f(h0), r1 = v[2 * e + 1] - bf2f(h1);
                        const unsigned short l0 = f2bf(r0), l1 = f2bf(r1); const float q0 = r0 - bf2f(l0), q1 = r1 - bf2f(l1);
                        wh[e] = (unsigned)h0 | ((unsigned)h1 << 16); wl[e] = (unsigned)l0 | ((unsigned)l1 << 16); wm[e] = (unsigned)f2bf(q0) | ((unsigned)f2bf(q1) << 16); }
                    *(LAS v4u*)(lds + att::L_K + 0 * att::SHM_K + kws + half * 32 * 256) = (v4u){wh[0], wh[1], wh[2], wh[3]};
                    *(LAS v4u*)(lds + att::L_K + 1 * att::SHM_K + kws + half * 32 * 256) = (v4u){wl[0], wl[1], wl[2], wl[3]};
                    *(LAS v4u*)(lds + att::L_V + 0 * att::SHM_K + kws + half * 32 * 256) = (v4u){wm[0], wm[1], wm[2], wm[3]}; } }
            if (tid < 64) lcnt[tid] = 0;
            const int t = qb * 256 + wid * 32 + r32;
            bf16x8 qr[8]; att::load_q<128>(qr, h + (size_t)t * NQKV + 3072 + hd * 128, hi);
            __syncthreads();
            att::f32x16 p0, p1;
            att::qkt<0, 128>(p0, p1, lds + att::L_K, r32, hi, qr); SBAR();
            att::qkt<1, 128, true>(p0, p1, lds + att::L_K, r32, hi, qr); SBAR();
            att::qkt<0, 128, true>(p0, p1, lds + att::L_V, r32, hi, qr); SBAR();
            float v0 = -3e38f, v1 = -3e38f, v2 = -3e38f; int i0 = 0, i1 = 1, i2 = 2;
#define G_INS(s_, n_) do { const float gs_ = (s_); const int gn_ = (n_); \
                if (gs_ > v0) { v2 = v1; i2 = i1; v1 = v0; i1 = i0; v0 = gs_; i0 = gn_; } else if (gs_ > v1) { v2 = v1; i2 = i1; v1 = gs_; i1 = gn_; } else if (gs_ > v2) { v2 = gs_; i2 = gn_; } } while (0)
#pragma unroll
            for (int r = 0; r < 16; ++r) { const int n = (r & 3) + 8 * (r >> 2) + 4 * hi; G_INS(n < qb ? p0[r] : -3e38f, n); }
#pragma unroll
            for (int r = 0; r < 16; ++r) { const int n = 32 + (r & 3) + 8 * (r >> 2) + 4 * hi; G_INS(n < qb ? p1[r] : -3e38f, n); }
#undef G_INS
            float ov[3]; int oi[3];
            { const float mv[3] = {v0, v1, v2}; const int mi[3] = {i0, i1, i2};
#pragma unroll
              for (int k = 0; k < 3; ++k) { auto rv = __builtin_amdgcn_permlane32_swap(__float_as_uint(mv[k]), __float_as_uint(mv[k]), false, false); auto ri = __builtin_amdgcn_permlane32_swap((unsigned)mi[k], (unsigned)mi[k], false, false);
                  ov[k] = __uint_as_float(hi ? rv[0] : rv[1]); oi[k] = (int)(hi ? ri[0] : ri[1]); } }
#define G_BEF(sa, na, sb, nb) ((sa) > (sb) || ((sa) == (sb) && (na) < (nb)))
#pragma unroll
            for (int k = 0; k < 3; ++k) { const float s = ov[k]; const int n = oi[k];
                if (s > -1e38f) {
                    if (G_BEF(s, n, v0, i0)) { v2 = v1; i2 = i1; v1 = v0; i1 = i0; v0 = s; i0 = n; } else if (G_BEF(s, n, v1, i1)) { v2 = v1; i2 = i1; v1 = s; i1 = n; } else if (G_BEF(s, n, v2, i2)) { v2 = s; i2 = n; } } }
#undef G_BEF
            const int nsel = qb < 3 ? qb : 3;
            if (hi == 0) *(int4*)(sel + ((size_t)hd * SEQ + t) * 4) = make_int4(i0, i1, i2, nsel);
            int lp0 = 0, lp1 = 0, lp2 = 0;
            if (hi == 0) { if (nsel > 0) lp0 = atomicAdd(&lcnt[i0], 1); if (nsel > 1) lp1 = atomicAdd(&lcnt[i1], 1); if (nsel > 2) lp2 = atomicAdd(&lcnt[i2], 1); }
            __syncthreads();
            if (tid < 64) { const int c = lcnt[tid]; gbs[tid] = c > 0 ? (int)__hip_atomic_fetch_add((unsigned*)(A.ws + WS_CTL) + CW_MOBACNT + hd * 64 + tid, (unsigned)c, RLX_AGENT) : 0; }
            __syncthreads();
            if (hi == 0) { int* ml = (int*)((unsigned char*)A.out + (4u << 20)) + (size_t)hd * 64 * SEQ;
                if (nsel > 0) ml[(size_t)i0 * SEQ + gbs[i0] + lp0] = t * 4 + 0;
                if (nsel > 1) ml[(size_t)i1 * SEQ + gbs[i1] + lp1] = t * 4 + 1;
                if (nsel > 2) ml[(size_t)i2 * SEQ + gbs[i2] + lp2] = t * 4 + 2; }
            __syncthreads();
        } else {
            const int v = u - 512, hd = v >> 6, ch = v & 63;
            if (wid == 0) { float x = (lane < ch) ? ((const float*)(A.ws + WS_CTOT))[hd * 64 + lane] : 0.f; x = wave_sum(x); if (lane == 0) scal[0] = x; }
            __syncthreads();
            if (tid < 256) ((float*)(A.ws + WS_C))[hd * SEQ + ch * 256 + tid] = ((const float*)(A.ws + WS_CLOC))[hd * SEQ + ch * 256 + tid] + scal[0];
            __syncthreads();
        }
    }
}

constexpr size_t DO_LSE = 2 * MiB, DO_MLIST = 4 * MiB;
__device__ __forceinline__ void moba_block(const Args& A, LAS char* lds, int hd, int n, int chunk  , int cnt) {
    int tid_ = threadIdx.x; asm volatile("" : "+v"(tid_)); const int tid = tid_, wid = __builtin_amdgcn_readfirstlane(tid >> 6), lane = tid & 63, r32 = lane & 31, hi = lane >> 5;
    const bf16* h = (const bf16*)(A.ws + WS_H);
    int t, slot, valid;
    if (chunk < 0) { t = n * 256 + wid * 32 + r32; slot = 3; valid = 1; }
    else { const int idx = chunk * 256 + wid * 32 + r32; valid = idx < cnt; const int ent = valid ? ((const int*)((const unsigned char*)A.out + DO_MLIST))[(size_t)(hd * 64 + n) * SEQ + idx] : (SEQ - 1) * 4; t = ent >> 2; slot = ent & 3; }
    bf16x8 qr[8]; att::load_q<128>(qr, h + (size_t)t * NQKV + 3072 + hd * 128, hi);
    att::ChunkArgs ca; ca.hbase = h; ca.kcolB = (unsigned)(4096 + hd * 128) * 2u; ca.vcolB = (unsigned)(5120 + hd * 128) * 2u;
    ca.ja = n * 4; ca.jb = n * 4 + 4; ca.qpos = t; ca.qlo = 0; ca.cb = nullptr; ca.cref = 0.f;
    float m_reg = -1e30f, l_reg = 0.f; att::f32x16 o[4] = {};
    att::attn_chunk<128, 2, false>(ca, qr, m_reg, l_reg, o, lds);
    LAS float* li_l = (LAS float*)(lds + att::L_WS) + wid * 64; LAS int* dst_l = (LAS int*)(li_l + 32);
    const int dst = valid ? ((hd * SEQ + t) * 4 + slot) : -1;
    if (hi == 0) { li_l[r32] = l_reg; dst_l[r32] = dst;
        if (valid) ((float*)((unsigned char*)A.out + DO_LSE))[dst] = m_reg * (1.4426950408889634f * SCALE128) + __builtin_amdgcn_logf(l_reg); }
    asm volatile("s_waitcnt lgkmcnt(0)" ::: "memory");
    bf16* part = (bf16*)(A.ws + WS_Y);
#pragma unroll
    for (int r = 0; r < 16; ++r) { const int row = att::crow(r, hi); const int d = dst_l[row]; const float rl = __builtin_amdgcn_rcpf(li_l[row]);
#pragma unroll
        for (int d0 = 0; d0 < 4; ++d0) { const float v = o[d0][r] * rl; const float vn = __shfl_xor(v, 1);
            if ((r32 & 1) == 0 && d >= 0) *(unsigned*)(part + (size_t)d * 128 + d0 * 32 + r32) = att::cvtpk(v, vn); } }
    __syncthreads();
}
__device__ __forceinline__ void moba_unit_res(const Args& A, LAS char* lds, int hd, int n, int chunk  , int cnt) {
    int tid_ = threadIdx.x; asm volatile("" : "+v"(tid_)); const int tid = tid_, wid = __builtin_amdgcn_readfirstlane(tid >> 6), lane = tid & 63, r32 = lane & 31, hi = lane >> 5;
    const bf16* h = (const bf16*)(A.ws + WS_H);
    int t, slot, valid;
    if (chunk < 0) { t = n * 256 + wid * 32 + r32; slot = 3; valid = 1; }
    else { const int idx = chunk * 256 + wid * 32 + r32; valid = idx < cnt; const int ent = valid ? ((const int*)((const unsigned char*)A.out + DO_MLIST))[(size_t)(hd * 64 + n) * SEQ + idx] : (SEQ - 1) * 4; t = ent >> 2; slot = ent & 3; }
    if (chunk >= 0 && chunk * 256 + wid * 32 >= cnt) return;
    bf16x8 qr[8]; att::load_q<128>(qr, h + (size_t)t * NQKV + 3072 + hd * 128, hi);
    att::ChunkArgs ca; ca.hbase = h; ca.kcolB = 0; ca.vcolB = 0; ca.ja = n * 4; ca.jb = n * 4 + 4; ca.qpos = t; ca.qlo = (chunk < 0) ? n * 256 + wid * 32 : (1 << 29); ca.cb = nullptr; ca.cref = 0.f; ca.tprobe = nullptr;
    float m_reg = -1e30f, l_reg = 0.f; att::f32x16 o[4] = {};
    att::moba_tiles(ca, qr, m_reg, l_reg, o, lds);
    LAS float* li_l = (LAS float*)(lds + att::M_WS) + wid * 64; LAS int* dst_l = (LAS int*)(li_l + 32);
    const int dst = valid ? ((hd * SEQ + t) * 4 + slot) : -1;
    if (hi == 0) { li_l[r32] = l_reg; dst_l[r32] = dst;
        if (valid) ((float*)((unsigned char*)A.out + DO_LSE))[dst] = m_reg * (1.4426950408889634f * SCALE128) + __builtin_amdgcn_logf(l_reg); }
    asm volatile("s_waitcnt lgkmcnt(0)" ::: "memory");
    bf16* part = (bf16*)(A.ws + WS_Y);
#pragma unroll
    for (int r = 0; r < 16; ++r) { const int row = att::crow(r, hi); const int d = dst_l[row]; const float rl = __builtin_amdgcn_rcpf(li_l[row]);
#pragma unroll
        for (int d0 = 0; d0 < 4; ++d0) { const float v = o[d0][r] * rl; const float vn = __shfl_xor(v, 1);
            if ((r32 & 1) == 0 && d >= 0) *(unsigned*)(part + (size_t)d * 128 + d0 * 32 + r32) = att::cvtpk(v, vn); } }
    asm volatile("s_waitcnt lgkmcnt(0)" ::: "memory");
}
__device__ __forceinline__ void moba_phase_res(const Args& A, LAS char* lds, int G) {
    int curhd = -1;
    for (;;) {
        const int g = next_item(A, CW_QM, (LAS int*)(lds + att::M_FLAG + 64)); if (g >= 512) break;
        const int n = g >> 3, hd = g & 7;
        const int cnt = (int)__hip_atomic_load((unsigned*)(A.ws + WS_CTL) + CW_MOBACNT + hd * 64 + n, RLX_AGENT);
        if (hd != curhd) { att::load_lut(lds, (const float*)(A.ws + WS_LUT) + hd * 1024, 1.f / SCALE128, att::M_LUT); curhd = hd; }
        att::moba_stage_block((const bf16*)(A.ws + WS_H), (unsigned)(4096 + hd * 128) * 2u, (unsigned)(5120 + hd * 128) * 2u, n, lds);
        __syncthreads();
        const int nch = (cnt + 255) >> 8;
        for (int c = -1; c < nch; ++c) moba_unit_res(A, lds, hd, n, c, cnt);
    }
}
__device__ __forceinline__ void moba_phase(const Args& A, LAS char* lds, int G) {
    const int tid = fresh_tid();
    LAS int* pre = (LAS int*)(lds + att::L_STASH);
    LAS int* cnts = pre + 520;
    if (tid < 512) { const int c = (int)__hip_atomic_load((unsigned*)(A.ws + WS_CTL) + CW_MOBACNT + tid, RLX_AGENT); cnts[tid] = c; pre[tid] = (c + 255) >> 8; }
    __syncthreads();
    if (tid == 0) { int acc = 0; for (int i = 0; i < 512; ++i) { const int v = pre[i]; pre[i] = acc; acc += v; } pre[512] = acc; }
    __syncthreads();
    const int total = 512 + pre[512];
    int curhd = -1;
    for (;;) {
        const int u = next_item(A, CW_QM, (LAS int*)(lds + att::L_FLAG + 64)); if (u >= total) break;
        int hn, chunk;
        if (u < 512) { hn = u; chunk = -1; }
        else { const int g = u - 512; int lo = 0, hi_ = 511;
            while (lo < hi_) { const int mid = (lo + hi_ + 1) >> 1; if (pre[mid] <= g) lo = mid; else hi_ = mid - 1; }
            hn = lo; chunk = g - pre[hn]; }
        const int hd = hn >> 6, n = hn & 63;
        if (hd != curhd) { att::load_lut(lds, (const float*)(A.ws + WS_LUT) + hd * 1024, 1.f / SCALE128); curhd = hd; }
        moba_block(A, lds, hd, n, chunk, cnts[hn]);
    }
}
__device__ __forceinline__ void moba_combine(const Args& A, int G, unsigned char* obuf) {
    const int tid = fresh_tid();
    const float* lse = (const float*)((const unsigned char*)A.out + DO_LSE); const bf16* part = (const bf16*)(A.ws + WS_Y);
    for (int i = blockIdx.x * NTHREADS + tid; i < 8 * SEQ * 16; i += G * NTHREADS) { const int it = i >> 4, c8 = (i & 15) * 8; const int hd = it >> 14, t = it & (SEQ - 1);
        const int own = t >> 8, nsel = own < 3 ? own : 3; const size_t base = ((size_t)hd * SEQ + t) * 4;
        const f32x4 lv = *(const f32x4*)(lse + base);
        v4u pw[4];
#pragma unroll
        for (int j = 0; j < 4; ++j) pw[j] = *(const v4u*)(part + (base + j) * 128 + c8);
        float l[4] = {lv.x, lv.y, lv.z, lv.w}; float mx = l[3];
#pragma unroll
        for (int j = 0; j < 3; ++j) { l[j] = (j < nsel) ? l[j] : -3e38f; mx = fmaxf(mx, l[j]); }
        float w[4], ws_ = 0.f;
#pragma unroll
        for (int j = 0; j < 4; ++j) { w[j] = (j == 3 || j < nsel) ? __builtin_amdgcn_exp2f(l[j] - mx) : 0.f; ws_ += w[j]; }
        const float inv = 1.f / ws_; float a[8] = {0, 0, 0, 0, 0, 0, 0, 0};
#pragma unroll
        for (int j = 0; j < 4; ++j) { const float wj = w[j] * inv; const bool on = (j == 3 || j < nsel);
            a[0] += on ? wj * bflo(pw[j].x) : 0.f; a[1] += on ? wj * bfhi(pw[j].x) : 0.f; a[2] += on ? wj * bflo(pw[j].y) : 0.f; a[3] += on ? wj * bfhi(pw[j].y) : 0.f;
            a[4] += on ? wj * bflo(pw[j].z) : 0.f; a[5] += on ? wj * bfhi(pw[j].z) : 0.f; a[6] += on ? wj * bflo(pw[j].w) : 0.f; a[7] += on ? wj * bfhi(pw[j].w) : 0.f; }
        v2u o; o.x = pk4_fp8(a[0] * att::O8_SCALE, a[1] * att::O8_SCALE, a[2] * att::O8_SCALE, a[3] * att::O8_SCALE); o.y = pk4_fp8(a[4] * att::O8_SCALE, a[5] * att::O8_SCALE, a[6] * att::O8_SCALE, a[7] * att::O8_SCALE);
        *(v2u*)(obuf + (size_t)t * DM + (8 + hd) * 128 + c8) = o; }
}


template <bool RES_F32>
__device__ __forceinline__ void p_ln1_router(const Args& A, char* lds, int G, int layer, const void* xres, const bf16* y, bf16* x1) {
    const int tid = fresh_tid(), lane = tid & 63, wave = tid >> 6;
    constexpr int WP = DM + 4;
    float* wT = (float*)lds; int* rinfo = (int*)(lds + 131584); int* lcnt = (int*)(lds + 139776); int* gbase = lcnt + 16;
    for (int idx = tid; idx < 16 * DM; idx += NTHREADS) { const int d = idx >> 4, e = idx & 15; wT[e * WP + d] = A.w_router[idx]; }
    if (tid < 16) lcnt[tid] = 0;
    __syncthreads();
    const int rows_per = (SEQ + G - 1) / G; const int row0 = blockIdx.x * rows_per; int nrows = SEQ - row0; nrows = nrows < 0 ? 0 : (nrows > rows_per ? rows_per : nrows);
    const float* gain = A.ln_gain + (size_t)(layer * 2 + 0) * DM; const float* bias = A.ln_bias + (size_t)(layer * 2 + 0) * DM;
    auto ln_row = [&](int m, f32x4 (&v)[8]) __attribute__((always_inline)) {
        float s = 0.f; int lane = tid & 63; asm volatile("" : "+v"(lane));
#pragma unroll
        for (int j = 0; j < 8; ++j) {
            f32x4 xr;
            if constexpr (RES_F32) xr = *((const f32x4*)((const float*)xres + (size_t)m * DM) + lane + 64 * j);
            else { const v2u w = *((const v2u*)((const bf16*)xres + (size_t)m * DM) + lane + 64 * j); xr = (f32x4){bflo(w.x), bfhi(w.x), bflo(w.y), bfhi(w.y)}; }
            const v2u yw = *((const v2u*)(y + (size_t)m * DM) + lane + 64 * j);
            v[j] = xr * ALPHA + (f32x4){bflo(yw.x), bfhi(yw.x), bflo(yw.y), bfhi(yw.y)};
            s += (v[j].x + v[j].y) + (v[j].z + v[j].w); }
        const float mean = wave_sum(s) * (1.f / DM); float s2 = 0.f;
#pragma unroll
        for (int j = 0; j < 8; ++j) { v[j] = v[j] - mean; s2 += (v[j].x * v[j].x + v[j].y * v[j].y) + (v[j].z * v[j].z + v[j].w * v[j].w); }
        const float rstd = rsqrtf(wave_sum(s2) * (1.f / DM) + LN_EPS);
#pragma unroll
        for (int j = 0; j < 8; ++j) { const f32x4 gg = *((const f32x4*)gain + lane + 64 * j), bb = *((const f32x4*)bias + lane + 64 * j); v[j] = v[j] * rstd * gg + bb;
            v2u w; w.x = pk2(v[j].x, v[j].y); w.y = pk2(v[j].z, v[j].w); *((v2u*)(x1 + (size_t)m * DM) + lane + 64 * j) = w;
            *((unsigned*)(A.ws + WS_X1F8 + (size_t)m * DM) + lane + 64 * j) = pk4_fp8(v[j].x, v[j].y, v[j].z, v[j].w); }
    };
    auto route_row = [&](int r, const float (&lg)[16]) __attribute__((always_inline)) {
        int gs = 0; float gbest = fmaxf(fmaxf(lg[0], lg[1]), fmaxf(lg[2], lg[3]));
#pragma unroll
        for (int g = 1; g < 4; ++g) { const float gm = fmaxf(fmaxf(lg[4 * g], lg[4 * g + 1]), fmaxf(lg[4 * g + 2], lg[4 * g + 3])); if (gm > gbest) { gbest = gm; gs = g; } }
        float c0 = 0.f, c1 = 0.f, c2 = 0.f, c3 = 0.f;
#pragma unroll
        for (int g = 0; g < 4; ++g) if (gs == g) { c0 = lg[4 * g]; c1 = lg[4 * g + 1]; c2 = lg[4 * g + 2]; c3 = lg[4 * g + 3]; }
        float b0 = c0; int k0 = 0; if (c1 > b0) { b0 = c1; k0 = 1; } if (c2 > b0) { b0 = c2; k0 = 2; } if (c3 > b0) { b0 = c3; k0 = 3; }
        float b1 = -3e38f; int k1 = 0;
        if (k0 != 0 && c0 > b1) { b1 = c0; k1 = 0; } if (k0 != 1 && c1 > b1) { b1 = c1; k1 = 1; } if (k0 != 2 && c2 > b1) { b1 = c2; k1 = 2; } if (k0 != 3 && c3 > b1) { b1 = c3; k1 = 3; }
        const float ex = __expf(b1 - b0); const float w0 = 1.f / (1.f + ex), w1 = ex / (1.f + ex);
        if (lane == 0) { const int e0 = gs * 4 + k0, e1 = gs * 4 + k1; const int p0 = atomicAdd(&lcnt[e0], 1), p1 = atomicAdd(&lcnt[e1], 1);
            int* ri = rinfo + r * 8; ri[0] = e0; ri[1] = e1; ri[2] = __builtin_bit_cast(int, w0); ri[3] = __builtin_bit_cast(int, w1); ri[4] = p0; ri[5] = p1; }
    };
    for (int r = wave; r < nrows; r += 2 * NWAVES) {
        const int rB = r + NWAVES; const bool hasB = rB < nrows;
        f32x4 vA[8], vB[8];
        ln_row(row0 + r, vA); __builtin_amdgcn_sched_barrier(0);
        if (hasB) ln_row(row0 + rB, vB); else {
#pragma unroll
            for (int j = 0; j < 8; ++j) vB[j] = vA[j]; }
        __builtin_amdgcn_sched_barrier(0);
        float lgA[16], lgB[16];
#pragma unroll
        for (int e = 0; e < 16; ++e) { float a = 0.f, b = 0.f;
#pragma unroll
            for (int j = 0; j < 8; ++j) { const f32x4 w = *(const f32x4*)(wT + e * WP + 256 * j + 4 * lane);
                a += vA[j].x * w.x + vA[j].y * w.y + vA[j].z * w.z + vA[j].w * w.w; b += vB[j].x * w.x + vB[j].y * w.y + vB[j].z * w.z + vB[j].w * w.w; }
            const float be = A.b_router[e]; lgA[e] = wave_sum(a) + be; lgB[e] = wave_sum(b) + be; }
        route_row(r, lgA);
        if (hasB) route_row(rB, lgB);
    }
    __syncthreads();
    if (tid < 16) gbase[tid] = (int)__hip_atomic_fetch_add((unsigned*)(A.ws + WS_CTL) + CW_MOECNT + layer * 64 + tid, (unsigned)lcnt[tid], RLX_AGENT);
    __syncthreads();
    int* mlist = (int*)(A.ws + WS_MLIST) + (size_t)layer * 16 * SEQ; float* mgw = (float*)(A.ws + WS_MGW) + (size_t)layer * 16 * SEQ;
    if (tid < nrows) { const int* ri = rinfo + tid * 8; const int m = row0 + tid;
        const int e0 = ri[0], e1 = ri[1]; const int q0 = gbase[e0] + ri[4], q1 = gbase[e1] + ri[5];
        mlist[e0 * SEQ + q0] = m * 2 + 0; mgw[e0 * SEQ + q0] = __builtin_bit_cast(float, ri[2]);
        mlist[e1 * SEQ + q1] = m * 2 + 1; mgw[e1 * SEQ + q1] = __builtin_bit_cast(float, ri[3]); }
    __syncthreads();
}

struct MoeTable { const LAS int* t; };
__device__ __forceinline__ void moe_build_table(const Args& A, LAS int* tbl, int layer) {
    if (threadIdx.x == 0) { int acc = 0;
        for (int e = 0; e < 16; ++e) { const int c = (int)__hip_atomic_load((unsigned*)(A.ws + WS_CTL) + CW_MOECNT + layer * 64 + e, RLX_AGENT); tbl[e] = acc; tbl[17 + e] = c; acc += (c + 255) >> 8; }
        tbl[16] = acc; tbl[33] = acc; }
    __syncthreads();
}
template <bool GATH>
struct MoeOrder {
    static constexpr bool GATHER = GATH;
    const LAS int* tbl; const int* list; size_t bstride;
    int G, c;
    __device__ bool next(int i, pg8::Unit& u) const {
        const int L = i * G + c; const int total = tbl[16];
        if (L >= total * 8) return false;
        const int mt = L >> 3; u.pn = L & 7; u.pm = mt; int e = 0;
#pragma unroll
        for (int j = 1; j < 16; ++j) e += (mt >= tbl[j]) ? 1 : 0;
        u.e = e; u.mi = mt - tbl[e]; return true;
    }
    __device__ __forceinline__ unsigned a_off(const pg8::Gemm& g, const pg8::Unit& u) const {
        if constexpr (GATH) return 0u; else return (unsigned)u.pm * 256u * (unsigned)g.rb; }
    __device__ __forceinline__ unsigned b_off(const pg8::Gemm& g, const pg8::Unit& u) const { return (unsigned)u.e * (unsigned)bstride + (unsigned)u.pn * 256u * (unsigned)g.rb; }
    __device__ __forceinline__ void a_voff(const pg8::Gemm& g, const pg8::Unit& u, const int (&R)[2], const int (&C)[2], unsigned (&vo)[2][2]) const {
        if constexpr (GATH) { const int cnt = tbl[17 + u.e];
#pragma unroll
            for (int h = 0; h < 2; ++h)
#pragma unroll
                for (int i = 0; i < 2; ++i) { const int idx = u.mi * 256 + h * 128 + R[i]; const int tok = (idx < cnt) ? (list[u.e * SEQ + idx] >> 1) : 0; vo[h][i] = (unsigned)(tok * g.rb + C[i] * 2); }
        } else {
#pragma unroll
            for (int h = 0; h < 2; ++h)
#pragma unroll
                for (int i = 0; i < 2; ++i) vo[h][i] = (unsigned)((h * 128 + R[i]) * g.rb + C[i] * 2);
        }
    }
};
struct EpiSwiglu {
    static constexpr bool PERM = true;
    unsigned char* H;
    __device__ __forceinline__ void operator()(const pg8::f32x4 (&acc)[2][2][4][2], const pg8::Unit& u, int wr, int wc, int fr, int fq) const {
        const int row0 = u.pm * 256 + wr * 64 + fr, col0 = u.pn * 128 + wc * 32 + 8 * fq;
#pragma unroll
        for (int ai = 0; ai < 2; ++ai)
#pragma unroll
            for (int m = 0; m < 4; ++m) { float hv[8];
#pragma unroll
                for (int n = 0; n < 2; ++n)
#pragma unroll
                    for (int i = 0; i < 4; ++i) { const float gt = acc[ai][0][m][n][i], up = acc[ai][1][m][n][i]; hv[n * 4 + i] = gt * __builtin_amdgcn_rcpf(1.f + __expf(-gt)) * up; }
                v2u w; w.x = pk4_fp8(hv[0], hv[1], hv[2], hv[3]); w.y = pk4_fp8(hv[4], hv[5], hv[6], hv[7]);
                *(v2u*)(H + (size_t)(row0 + ai * 128 + m * 16) * DEXP + col0) = w; asm volatile("" ::: "memory"); }
    }
};
struct EpiDown {
    static constexpr bool PERM = true;
    bf16* Y; const LAS int* tbl; const int* list; const float* gw;
    __device__ __forceinline__ void operator()(const pg8::f32x4 (&acc)[2][2][4][2], const pg8::Unit& u, int wr, int wc, int fr, int fq) const {
        const int cnt = tbl[17 + u.e]; const int col0 = u.pn * 256 + wc * 32 + 8 * fq;
#pragma unroll
        for (int ai = 0; ai < 2; ++ai)
#pragma unroll
            for (int m = 0; m < 4; ++m) { const int idx = u.mi * 256 + ai * 128 + wr * 64 + m * 16 + fr;
                if (idx < cnt) { const int ent = list[u.e * SEQ + idx]; const float g = gw[u.e * SEQ + idx];
                    bf16* rowp = Y + ((size_t)(ent & 1) * SEQ + (size_t)(ent >> 1)) * DM + col0;
#pragma unroll
                    for (int bj = 0; bj < 2; ++bj) { const pg8::f32x4 v0 = acc[ai][bj][m][0] * g, v1 = acc[ai][bj][m][1] * g;
                        pg8::u32x4 w; w.x = pg8::cvt_pk_bf16(v0[0], v0[1]); w.y = pg8::cvt_pk_bf16(v0[2], v0[3]); w.z = pg8::cvt_pk_bf16(v1[0], v1[1]); w.w = pg8::cvt_pk_bf16(v1[2], v1[3]);
                        *(pg8::u32x4*)(rowp + bj * 128) = w; } }
                asm volatile("" ::: "memory"); }
    }
};

template <bool OUT_F32>
__device__ __forceinline__ void p_ln2(const Args& A, int G, int layer, const bf16* x1, const bf16* ys, void* outp) {
    const int tid = fresh_tid(), lane = tid & 63, wave = tid >> 6;
    const int gw = blockIdx.x * NWAVES + wave, NGW = G * NWAVES;
    const float* gain = A.ln_gain + (size_t)(layer * 2 + 1) * DM; const float* bias = A.ln_bias + (size_t)(layer * 2 + 1) * DM;
    for (int m = gw; m < SEQ; m += NGW) {
        float v[4][8]; float s = 0.f;
#pragma unroll
        for (int j = 0; j < 4; ++j) {
            const v4u a = *((const v4u*)(x1 + (size_t)m * DM) + lane + 64 * j), b = *((const v4u*)(ys + (size_t)m * DM) + lane + 64 * j), c = *((const v4u*)(ys + ((size_t)SEQ + m) * DM) + lane + 64 * j);
            const unsigned aw[4] = {a.x, a.y, a.z, a.w}, bw[4] = {b.x, b.y, b.z, b.w}, cw[4] = {c.x, c.y, c.z, c.w};
#pragma unroll
            for (int e = 0; e < 4; ++e) { v[j][2 * e] = bflo(aw[e]) * ALPHA + bflo(bw[e]) + bflo(cw[e]); v[j][2 * e + 1] = bfhi(aw[e]) * ALPHA + bfhi(bw[e]) + bfhi(cw[e]); }
#pragma unroll
            for (int e = 0; e < 8; e += 4) s += (v[j][e] + v[j][e + 1]) + (v[j][e + 2] + v[j][e + 3]); }
        const float mean = wave_sum(s) * (1.f / DM); float s2 = 0.f;
#pragma unroll
        for (int j = 0; j < 4; ++j)
#pragma unroll
            for (int e = 0; e < 8; e += 4) { v[j][e] -= mean; v[j][e + 1] -= mean; v[j][e + 2] -= mean; v[j][e + 3] -= mean;
                s2 += (v[j][e] * v[j][e] + v[j][e + 1] * v[j][e + 1]) + (v[j][e + 2] * v[j][e + 2] + v[j][e + 3] * v[j][e + 3]); }
        const float rstd = rsqrtf(wave_sum(s2) * (1.f / DM) + LN_EPS);
#pragma unroll
        for (int j = 0; j < 4; ++j) {
            const f32x4 g0 = *((const f32x4*)gain + 2 * lane + 128 * j), g1 = *((const f32x4*)gain + 2 * lane + 128 * j + 1), b0 = *((const f32x4*)bias + 2 * lane + 128 * j), b1 = *((const f32x4*)bias + 2 * lane + 128 * j + 1);
            const f32x4 o0 = (f32x4){v[j][0], v[j][1], v[j][2], v[j][3]} * rstd * g0 + b0, o1 = (f32x4){v[j][4], v[j][5], v[j][6], v[j][7]} * rstd * g1 + b1;
            if constexpr (OUT_F32) { f32x4* op = (f32x4*)((float*)outp + (size_t)m * DM) + 2 * lane + 128 * j; op[0] = o0; op[1] = o1; }
            else { v4u w; w.x = pk2(o0.x, o0.y); w.y = pk2(o0.z, o0.w); w.z = pk2(o1.x, o1.y); w.w = pk2(o1.z, o1.w); *((v4u*)((bf16*)outp + (size_t)m * DM) + lane + 64 * j) = w;
                if (L1IN_F8) { v2u f; f.x = pk4_fp8(o0.x, o0.y, o0.z, o0.w); f.y = pk4_fp8(o1.x, o1.y, o1.z, o1.w); *((v2u*)(A.ws + WS_X1F8 + (size_t)m * DM) + lane + 64 * j) = f; } } }
    }
}


constexpr int CW_TEST = 10240;
__device__ __forceinline__ void p_compare(const Args& A, int G, const bf16* a, const bf16* b, int c0, int nc) {
    const int tid = fresh_tid(); float num = 0.f, den = 0.f;
    const size_t total = (size_t)SEQ * nc;
    for (size_t i = (size_t)blockIdx.x * NTHREADS + tid; i < total; i += (size_t)G * NTHREADS) { const int m = (int)(i / nc), c = (int)(i % nc);
        const float x = bf2f(a[(size_t)m * DM + c0 + c]), y = bf2f(b[(size_t)m * DM + c0 + c]);
        if ((m & 255) < TEST_RLO || (m & 255) >= TEST_RHI) continue;
#if TEST_NANCOUNT == 2
        if (x == x) num = fmaxf(num, fabsf(x)); den = 1.f;
#elif TEST_NANCOUNT == 1
        num += (x == x && fabsf(x) < 1e4f) ? 0.f : 1.f; den += 1.f;
#else
        float d2 = (x - y) * (x - y); if (!(d2 == d2) || d2 > 1e12f) d2 = TEST_BADVAL; num += d2; den += y * y;
#endif
    }
#if TEST_NANCOUNT == 2
    for (int o = 1; o < 64; o <<= 1) num = fmaxf(num, __shfl_xor(num, o));
    if ((tid & 63) == 0) { atomicMax((unsigned*)(A.ws + WS_CTL) + CW_TEST, __float_as_uint(num)); __hip_atomic_store((float*)(A.ws + WS_CTL) + CW_TEST + 1, 1.f, RLX_AGENT); }
#else
    num = wave_sum(num); den = wave_sum(den);
    if ((tid & 63) == 0) { atomicAdd((float*)(A.ws + WS_CTL) + CW_TEST, num); atomicAdd((float*)(A.ws + WS_CTL) + CW_TEST + 1, den); }
#endif
}
__device__ __forceinline__ void p_apply_test(const Args& A, int G) {
    const float num = __hip_atomic_load((float*)(A.ws + WS_CTL) + CW_TEST, RLX_AGENT), den = __hip_atomic_load((float*)(A.ws + WS_CTL) + CW_TEST + 1, RLX_AGENT);
#if TIME_SEG == 20
    const float f = 1.f + TEST_GAIN * sqrtf(floorf(num / den * 50.f + 0.5f) * 0.02f);
#else
    const float f = 1.f + TEST_GAIN * sqrtf(num / den);
#endif
    for (size_t i = (size_t)blockIdx.x * NTHREADS + threadIdx.x; i < (size_t)SEQ * DM; i += (size_t)G * NTHREADS) A.out[i] *= f;
}

constexpr int NPHASE = 18 + ((TEST_ATT || TIME_SEG) ? 1 : 0);
__global__ void __launch_bounds__(NTHREADS, 2) fwd(Args A) {
    extern __shared__ __attribute__((aligned(16))) unsigned char lds[];
    LAS unsigned char* ldsl = (LAS unsigned char*)lds;
    const int tid = fresh_tid(); const int G = gridDim.x;
    for (int u = tid; u < (LDS_BYTES - LCTL_OFF) / 4; u += NTHREADS) ((LAS unsigned*)(ldsl + LCTL_OFF))[u] = 0u;
    __syncthreads();
    unsigned char* ws = A.ws;
    const int lo = A.ph_lo, hi = A.ph_hi;
#if TIME_SEG == 7
    unsigned long long kt0; asm volatile("s_memtime %0\n\ts_waitcnt lgkmcnt(0)" : "=s"(kt0) :: "memory");
#endif
    const bool fused = (hi - lo) > 1;
    XcdBarrier bar; bar.bar = (unsigned*)(ws + WS_CTL) + CW_BAR; bar.x = 0; bar.st = nullptr;
    if (fused) bar = xcd_barrier_post((unsigned*)(ws + WS_CTL) + CW_BAR, (volatile LAS unsigned*)(ldsl + LCTL_OFF));
#define IN(k) (lo <= (k) && (k) < hi)
#define SEAM(k) do { if (IN(k) && IN((k) + 1)) xcd_barrier(bar); } while (0)
    bf16* xb = (bf16*)(ws + WS_XB); bf16* hb = (bf16*)(ws + WS_H); bf16* ob = (bf16*)(ws + WS_O); bf16* yb = (bf16*)(ws + WS_Y); bf16* x1 = (bf16*)(ws + WS_X1);
    bf16* hid = (bf16*)(ws + WS_HID); bf16* ysl = (bf16*)(ws + WS_YSLOT);
    int* sel = (int*)((unsigned char*)A.out + DO_SEL);
    LAS int* mtbl = (LAS int*)(ldsl + LCTL_OFF + 256);

    if (IN(0)) { p0_prologue(A, ldsl, G);
#if DBL_PHASE == 0
        __syncthreads(); p0_prologue(A, ldsl, G);
#endif
    } SEAM(0);
#define LAYER_BACK(layer, P_OUT, WOUT, RESF32, XRES) \
    if (IN(P_OUT)) { pg8::Gemm g{ob, (const bf16*)(ws + WOUT), SEQ, DM, DM, DM}; pg8::DenseOrder S; S.init(SEQ, DM, G, (int)blockIdx.x); \
        pg8::EpiBf16 E{yb, DM}; pg8::gemm_phase<pg8::EpiBf16, pg8::DenseOrder, true, 122, 123>(ldsl, g, S, E); } \
    SEAM(P_OUT); \
    if (IN(P_OUT + 1)) { p_ln1_router<RESF32>(A, (char*)lds, G, layer, (const void*)(XRES), yb, x1); } \
    SEAM(P_OUT + 1); \
    if (IN(P_OUT + 2)) { moe_build_table(A, mtbl, layer); \
        pg8::Gemm g{(const bf16*)(ws + WS_X1F8), (const bf16*)(ws + WS_WGU + (size_t)layer * 16 * 2048 * 2048), 0, 2048, DM, DM}; \
        MoeOrder<true> S{mtbl, (const int*)(ws + WS_MLIST) + (size_t)layer * 16 * SEQ, (size_t)2048 * 2048, G, (int)blockIdx.x}; EpiSwiglu E{(unsigned char*)hid}; \
        pg8::gemm_phase<EpiSwiglu, MoeOrder<true>, true, 122, 127>(ldsl, g, S, E); \
        if (DBL_PHASE == 100 + P_OUT + 2) { __syncthreads(); pg8::gemm_phase<EpiSwiglu, MoeOrder<true>, true, 122, 127>(ldsl, g, S, E); } } \
    SEAM(P_OUT + 2); \
    if (IN(P_OUT + 3)) { moe_build_table(A, mtbl, layer); \
        pg8::Gemm g{hid, (const bf16*)(ws + WS_WDN + (size_t)layer * 16 * 2048 * 1024), 0, 2048, DEXP, DEXP}; \
        const int* mlist = (const int*)(ws + WS_MLIST) + (size_t)layer * 16 * SEQ; const float* mgw = (const float*)(ws + WS_MGW) + (size_t)layer * 16 * SEQ; \
        MoeOrder<false> S{mtbl, mlist, (size_t)2048 * 1024, G, (int)blockIdx.x}; EpiDown E{ysl, mtbl, mlist, mgw}; \
        pg8::gemm_phase<EpiDown, MoeOrder<false>, true, 122, 127>(ldsl, g, S, E); \
        if (DBL_PHASE == 100 + P_OUT + 3) { __syncthreads(); pg8::gemm_phase<EpiDown, MoeOrder<false>, true, 122, 127>(ldsl, g, S, E); } } \
    SEAM(P_OUT + 3);
    if (IN(1)) { pg8::Gemm g{xb, (const bf16*)(ws + WS_WIN0), SEQ, NQKV, DM, DM}; pg8::DenseOrder S; S.init(SEQ, NQKV, G, (int)blockIdx.x);
        pg8::EpiBf16 E{hb, NQKV}; pg8::gemm_phase<pg8::EpiBf16, pg8::DenseOrder, true, 122, 127>(ldsl, g, S, E); }
    SEAM(1);
    if (IN(2)) { p2_kmean_cumsum(A, (char*)lds, G);
#if DBL_PHASE == 2
        p2_kmean_cumsum(A, (char*)lds, G);
#endif
    } SEAM(2);
#if GATE_MFMA
    if (IN(3)) p3_gate_mfma(A, (LAS char*)ldsl, G, sel); SEAM(3);
#else
    if (IN(3)) p3_gate_cfinal(A, (char*)lds, G, sel); SEAM(3);
#endif
#if TEST_ATT
    if (IN(4)) { for (int u = blockIdx.x; u < 2048; u += G) { const int var = u >> 10, hd = (u >> 7) & 7, qb = u & 127;
            if (var == 0) naive_attn_unit<0>(A, (char*)lds, hd, qb, sel); else naive_attn_unit<1>(A, (char*)lds, hd, qb, sel); } }
#else
    if (IN(4)) { for (;;) { const int it = next_item(A, CW_Q4, (LAS int*)(ldsl + LCTL_OFF + 512)); if (it >= 512) break;
            fox_block(A, (LAS char*)ldsl, it & 7, 63 - (it >> 3), (unsigned char*)ob, DM, (it & 7) * 128); }
#if MOBA_RES
        moba_phase_res(A, (LAS char*)ldsl, G);
#else
        moba_phase(A, (LAS char*)ldsl, G);
#endif
#if DBL_PHASE == 4
        for (int it = blockIdx.x; it < 512; it += G) { const int hd = (it & 255) >> 5, x = it & 31; fox_block(A, (LAS char*)ldsl, hd, (it < 256) ? 63 - x : x, (unsigned char*)ob, DM, hd * 128); }
#endif
#if DBL_PHASE == 41
        moba_phase(A, (LAS char*)ldsl, G);
#endif
    }
#endif
#if TEST_ATT == 4
    if (IN(4)) moba_phase(A, (LAS char*)ldsl, G);
#endif
#if TEST_ATT == 1
    if (IN(4)) { for (int u = blockIdx.x; u < 512; u += G) fox_block(A, (LAS char*)ldsl, u >> 6, u & 63, yb, DM, (u >> 6) * 128); }
#endif
    SEAM(4);
#if !TEST_ATT
    if (IN(5)) { moba_combine(A, G, (unsigned char*)ob); }
#endif
#if TEST_ATT == 1
    if (IN(5)) p_compare(A, G, yb, ob, 0, 1024);
#endif
#if TEST_ATT == 4
    if (IN(5)) moba_combine(A, G, xb);
    SEAM(5);
    if (IN(5)) p_compare(A, G, xb, ob, 1024, 1024);
#endif
    SEAM(5);
    LAYER_BACK(0, 6, WS_WOUT0, true, A.x)
    if (IN(10)) p_ln2<false>(A, G, 0, x1, ysl, (void*)xb);
    SEAM(10);
#if L1IN_F8
    if (IN(11)) { pg8::Gemm g{(const bf16*)(ws + WS_X1F8), (const bf16*)(ws + WS_WIN1), SEQ, NQKV, DM, DM}; pg8::DenseOrder S; S.init(SEQ, NQKV, G, (int)blockIdx.x);
        pg8::EpiBf16 E{hb, NQKV}; pg8::gemm_phase<pg8::EpiBf16, pg8::DenseOrder, true, 122, 127>(ldsl, g, S, E); }
#else
    if (IN(11)) { pg8::Gemm g{xb, (const bf16*)(ws + WS_WIN1), SEQ, NQKV, DM, DM * 2}; pg8::DenseOrder S; S.init(SEQ, NQKV, G, (int)blockIdx.x);
        pg8::EpiBf16 E{hb, NQKV}; pg8::gemm_phase<pg8::EpiBf16, pg8::DenseOrder>(ldsl, g, S, E);
#if DBL_PHASE == 11
        __syncthreads(); pg8::gemm_phase<pg8::EpiBf16, pg8::DenseOrder>(ldsl, g, S, E);
#endif
    }
#endif
    SEAM(11);
#if TEST_ATT
    if (IN(12)) { for (int u = blockIdx.x; u < 2048; u += G) { const int var = u >> 10, hd = (u >> 7) & 7, qb = u & 127;
            if (var == 0) naive_attn_unit<2>(A, (char*)lds, hd, qb, sel); else naive_attn_unit<3>(A, (char*)lds, hd, qb, sel); } }
#else
#if DBL_PHASE == 12
    if (IN(12)) { for (int it_ = blockIdx.x; it_ < 1536; it_ += G) { const int it = it_ & 511, hd = (it & 255) >> 5, x = it & 31; diff_block(A, (LAS char*)ldsl, hd, (it < 256) ? 63 - x : x, (unsigned char*)ob); }
#else
    if (IN(12)) { for (;;) { const int it = next_item(A, CW_Q12, (LAS int*)(ldsl + LCTL_OFF + 512)); if (it >= 512) break;
            diff_block(A, (LAS char*)ldsl, it & 7, 63 - (it >> 3), (unsigned char*)ob); }
#endif
        for (;;) { const int it = next_item(A, CW_Q12 + 64, (LAS int*)(ldsl + LCTL_OFF + 512)); if (it >= 512) break;
            sb_block(A, (LAS char*)ldsl, it & 7, 63 - (it >> 3), (unsigned char*)ob); }
#if DBL_PHASE == 121
        for (int u = blockIdx.x; u < 512; u += G) sb_block(A, (LAS char*)ldsl, u >> 6, u & 63, (unsigned char*)ob);
#endif
    }
#endif
#if TEST_ATT == 3
    if (IN(12) && blockIdx.x == 0) sb_unit_test(A, TEST_SENT);
#endif
#if TEST_ATT == 2
    if (IN(12)) { for (int u = blockIdx.x; u < 512; u += G) diff_block(A, (LAS char*)ldsl, u >> 6, u & 63, yb);
        for (int u = blockIdx.x; u < 512; u += G) sb_block(A, (LAS char*)ldsl, u >> 6, u & 63, yb); }
    SEAM(12);
#if !SB_R2PROBE
    if (IN(12)) p_compare(A, G, yb, ob, TEST_C0, TEST_NC);
#endif
#endif
    SEAM(12);
#ifdef EXTRA_BARRIERS
    if (IN(12) && IN(13)) { for (int i_ = 0; i_ < EXTRA_BARRIERS; ++i_) xcd_barrier(bar); }
#endif
    LAYER_BACK(1, 13, WS_WOUT1, false, xb)
    if (IN(17)) p_ln2<true>(A, G, 1, x1, ysl, (void*)A.out);
#if TIME_SEG == 7
    if (blockIdx.x == 0 && threadIdx.x == 0) { unsigned long long kt1; asm volatile("s_memtime %0\n\ts_waitcnt lgkmcnt(0)" : "=s"(kt1) :: "memory");
        const float ghz = (float)(kt1 - kt0) / 3.42e6f; atomicAdd((float*)(A.ws + WS_CTL) + CW_TEST, floorf(ghz * 5.f + 0.5f) * 0.2f); atomicAdd((float*)(A.ws + WS_CTL) + CW_TEST + 1, 10.f); }
#endif
#if TEST_ATT || TIME_SEG
    SEAM(17);
    if (IN(18)) p_apply_test(A, G);
#endif
#undef LAYER_BACK
#undef IN
#undef SEAM
}

#ifndef MK_FUSED
#define MK_FUSED 1
#endif
extern "C" void kernel_launch(void* const* d_in, const int* in_sizes, int n_in, void* d_out, int out_size, void* d_ws, size_t ws_size, hipStream_t stream) {
    static int grid = 0;
    if (grid == 0) {
        if (n_in != 17 || out_size != SEQ * DM || ws_size < WS_END) { fprintf(stderr, "kernel_launch: unexpected shapes (n_in %d out %d ws %zu)\n", n_in, out_size, ws_size); grid = -1; return; }
        int dev = 0, cus = 0, per_cu = 0;
        if (hipGetDevice(&dev) != hipSuccess || hipDeviceGetAttribute(&cus, hipDeviceAttributeMultiprocessorCount, dev) != hipSuccess) { grid = -1; return; }
        if (hipFuncSetAttribute((const void*)fwd, hipFuncAttributeMaxDynamicSharedMemorySize, LDS_BYTES) != hipSuccess) { fprintf(stderr, "kernel_launch: hipFuncSetAttribute failed\n"); grid = -1; return; }
        if (hipOccupancyMaxActiveBlocksPerMultiprocessor(&per_cu, (const void*)fwd, NTHREADS, LDS_BYTES) != hipSuccess || per_cu < 1) fprintf(stderr, "kernel_launch: occupancy query says %d\n", per_cu);
        (void)hipGetLastError();
        grid = cus;
    }
    if (grid < 0) return;
    (void)hipMemsetAsync((char*)d_ws + WS_CTL, 0, CTL_ZERO_BYTES, stream);
    Args a{};
    a.x = (const float*)d_in[0]; a.w_in_even = (const float*)d_in[1]; a.w_out_even = (const float*)d_in[2]; a.forget_bias = (const float*)d_in[3];
    a.w_in_odd = (const float*)d_in[4]; a.w_out_odd = (const float*)d_in[5]; a.lambda_q = (const float*)d_in[6]; a.lambda_k = (const float*)d_in[7];
    a.subln_gain = (const float*)d_in[8]; a.rel_bias = (const float*)d_in[9]; a.w_router = (const float*)d_in[10]; a.b_router = (const float*)d_in[11];
    a.w_gate = (const float*)d_in[12]; a.w_up = (const float*)d_in[13]; a.w_down = (const float*)d_in[14]; a.ln_gain = (const float*)d_in[15]; a.ln_bias = (const float*)d_in[16];
    a.out = (float*)d_out; a.ws = (unsigned char*)d_ws;
#if MK_FUSED
    a.ph_lo = 0; a.ph_hi = NPHASE;
    hipLaunchKernelGGL(fwd, dim3(grid), dim3(NTHREADS), LDS_BYTES, stream, a);
#else
    for (int p = 0; p < NPHASE; ++p) {  a.ph_lo = p; a.ph_hi = p + 1; hipLaunchKernelGGL(fwd, dim3(grid), dim3(NTHREADS), LDS_BYTES, stream, a); }
#endif
}
```

```cpp
#include <hip/hip_runtime.h>
#include <cstdio>
#include <cstdint>

namespace pg8 {
#define PG8_LAS __attribute__((address_space(3)))
typedef unsigned short bf16_t;
typedef short bf16x8 __attribute__((ext_vector_type(8)));
typedef float f32x4 __attribute__((ext_vector_type(4)));
typedef unsigned u32x4 __attribute__((ext_vector_type(4)));
constexpr int BM = 256, BK = 64, HALF = 128, HTB = HALF * BK * 2  , STAGE_BYTES = 8 * HTB, NXCD = 8, WGM = 8;

__host__ __device__ __forceinline__ int lds_byte(int r, int c) { const int st = (r >> 4) * 2 + (c >> 5), rr = r & 15, cc = c & 31, ob = rr * 64 + cc * 2; return st * 1024 + (ob ^ (((ob >> 9) & 1) << 5)); }
__host__ __device__ __forceinline__ void stage_rc(int b, int& R, int& C) { const int st = b / 1024, sb = b % 1024, swz = sb ^ (((sb >> 9) & 1) << 5); R = (st >> 1) * 16 + swz / 64; C = (st & 1) * 32 + (swz % 64) / 2; }
__host__ __device__ __forceinline__ int perm32(int rho) { const int n = rho >> 4, i = rho & 15; return 8 * (i >> 2) + 4 * n + (i & 3); }

struct Unit { int pm, pn, e, mi; };
struct Gemm { const bf16_t* A; const bf16_t* Bt; int M, N, K, rb; };

struct DenseOrder {
    static constexpr bool GATHER = false;
    int nM, nN, nwg, G, c;
    __device__ void init(int M, int N, int G_, int c_) { nM = M / BM; nN = N / BM; nwg = nM * nN; G = G_; c = c_; }
    __device__ bool next(int i, Unit& u) const {
        const long L = (long)i * G + c; if (L >= nwg) return false;
        int wgid = (int)L; { const int q = nwg / NXCD, r = nwg % NXCD, xcd = wgid % NXCD, off = wgid / NXCD; wgid = (xcd < r ? xcd * (q + 1) : r * (q + 1) + (xcd - r) * q) + off; }
        const int nig = WGM * nN, gid = wgid / nig, fm = gid * WGM, gsz = (nM - fm) < WGM ? (nM - fm) : WGM;
        u.pm = fm + ((wgid % nig) % gsz); u.pn = (wgid % nig) / gsz; u.e = 0; u.mi = 0; return true;
    }
    __device__ __forceinline__ unsigned a_off(const Gemm& g, const Unit& u) const { return (unsigned)u.pm * (unsigned)(2 * HALF) * (unsigned)g.rb; }
    __device__ __forceinline__ unsigned b_off(const Gemm& g, const Unit& u) const { return (unsigned)u.pn * (unsigned)(2 * HALF) * (unsigned)g.rb; }
    __device__ __forceinline__ void a_voff(const Gemm& g, const Unit&, const int (&R)[2], const int (&C)[2], unsigned (&vo)[2][2]) const {
#pragma unroll
        for (int h = 0; h < 2; ++h)
#pragma unroll
            for (int i = 0; i < 2; ++i) vo[h][i] = (unsigned)((h * HALF + R[i]) * g.rb + C[i] * 2);
    }
};

__device__ __forceinline__ unsigned cvt_pk_bf16(float lo, float hi) { unsigned r; asm volatile("v_cvt_pk_bf16_f32 %0, %1, %2" : "=v"(r) : "v"(lo), "v"(hi)); return r; }

struct EpiBf16 {
    static constexpr bool PERM = true;
    bf16_t* O; int ldc;
    __device__ __forceinline__ void operator()(const f32x4 (&acc)[2][2][4][2], const Unit& u, int wr, int wc, int fr, int fq) const {
        const int row0 = u.pm * BM + wr * 64 + fr; const int col0 = u.pn * BM + wc * 32 + 8 * fq;
#pragma unroll
        for (int ai = 0; ai < 2; ++ai)
#pragma unroll
            for (int m = 0; m < 4; ++m) { bf16_t* rowp = O + (size_t)(row0 + ai * HALF + m * 16) * ldc + col0;
#pragma unroll
                for (int bj = 0; bj < 2; ++bj) { const f32x4 v0 = acc[ai][bj][m][0], v1 = acc[ai][bj][m][1];
                    u32x4 w; w.x = cvt_pk_bf16(v0[0], v0[1]); w.y = cvt_pk_bf16(v0[2], v0[3]); w.z = cvt_pk_bf16(v1[0], v1[1]); w.w = cvt_pk_bf16(v1[2], v1[3]);
                    *(u32x4*)(rowp + bj * HALF) = w; }
                asm volatile("" ::: "memory"); }
    }
};

typedef int v8i_t __attribute__((ext_vector_type(8)));
typedef int v4i_t __attribute__((ext_vector_type(4)));
template <class Epi, class Sched, bool F8 = false, int SCW = 127, int SCX = 127>
__device__ __forceinline__ void gemm_phase(PG8_LAS unsigned char* lds, const Gemm g, const Sched& S, const Epi& E) {
    int tid_ = threadIdx.x; asm volatile("" : "+v"(tid_));
    const int tid = tid_, wid = __builtin_amdgcn_readfirstlane(tid >> 6), lane = tid & 63, wr = wid >> 2, wc = wid & 3, fr = lane & 15, fq = lane >> 4;
    const int RB = g.rb, nt = RB / 128;
    unsigned voffB0;
    { int R, C; stage_rc(tid * 16, R, C); const int Rb = Epi::PERM ? ((R & ~31) + perm32(R & 31)) : R; voffB0 = (unsigned)(Rb * RB + C * 2); }
#define PG8_AVOFF(unit, dst) do { int sR[2], sC[2]; int t2_ = threadIdx.x; asm volatile("" : "+v"(t2_)); stage_rc(t2_ * 16, sR[0], sC[0]); stage_rc(t2_ * 16 + 8192, sR[1], sC[1]); S.a_voff(g, unit, sR, sC, dst); } while (0)
    const unsigned kstep = (unsigned)(BK * 2);
    const unsigned hstep = (unsigned)HALF * (unsigned)RB;
    const __amdgpu_buffer_rsrc_t rsA = __builtin_amdgcn_make_buffer_rsrc((void*)g.A, 0, 0x7ffffff0, 0x00020000), rsB = __builtin_amdgcn_make_buffer_rsrc((void*)g.Bt, 0, 0x7ffffff0, 0x00020000);
    const unsigned ldsw = (unsigned)wid * 1024u;
    const int aoff = lds_byte(wr * 64 + fr, fq * (F8 ? 16 : 8)), boff = lds_byte(wc * 32 + fr, fq * (F8 ? 16 : 8));
    constexpr int KOFF = F8 ? 16 : 1024;
#define PG8_SA(b, h) (((b) * 2 + (h)) * HTB)
#define PG8_SB(b, h) ((4 + (b) * 2 + (h)) * HTB)
#define PG8_STAGE_B(bufoff, soff) do { _Pragma("unroll") for (int _i = 0; _i < 2; ++_i) \
        __builtin_amdgcn_raw_ptr_buffer_load_lds(rsB, (PG8_LAS void*)(lds + (bufoff) + ldsw + _i * 8192), 16, (int)voffB0, (int)((soff) + (unsigned)_i * 64u * (unsigned)RB), 0, 0); } while (0)
#define PG8_STAGE_A(bufoff, soff, vset, h) do { _Pragma("unroll") for (int _i = 0; _i < 2; ++_i) { \
        if constexpr (Sched::GATHER) __builtin_amdgcn_raw_ptr_buffer_load_lds(rsA, (PG8_LAS void*)(lds + (bufoff) + ldsw + _i * 8192), 16, (int)(vset)[h][_i], (int)(soff), 0, 0); \
        else __builtin_amdgcn_raw_ptr_buffer_load_lds(rsA, (PG8_LAS void*)(lds + (bufoff) + ldsw + _i * 8192), 16, (int)(vset)[0][0], (int)((soff) + (unsigned)((h) * 128 + _i * 64) * (unsigned)RB), 0, 0); } } while (0)
#define PG8_LD8(addr) __builtin_shufflevector(*(const PG8_LAS v4i_t*)(addr), *(const PG8_LAS v4i_t*)((addr) + 16), 0, 1, 2, 3, 4, 5, 6, 7)
#define PG8_LDA8(dst, b, h) do { _Pragma("unroll") for (int m = 0; m < 4; ++m) dst[m] = PG8_LD8(lds + PG8_SA(b, h) + aoff + m * 2048); } while (0)
#define PG8_LDB8(dst, b, h) do { _Pragma("unroll") for (int n = 0; n < 2; ++n) dst[n] = PG8_LD8(lds + PG8_SB(b, h) + boff + n * 2048); } while (0)
#define PG8_MMA8(ai, bj, At, Bt) do { __builtin_amdgcn_s_setprio(1); _Pragma("unroll") for (int m = 0; m < 4; ++m) _Pragma("unroll") for (int n = 0; n < 2; ++n) \
        acc[ai][bj][m][n] = __builtin_amdgcn_mfma_scale_f32_16x16x128_f8f6f4(Bt[n], At[m], acc[ai][bj][m][n], 0, 0, 0, SCW, 0, SCX); __builtin_amdgcn_s_setprio(0); } while (0)
#define PG8_LDA(dst, b, h) do { _Pragma("unroll") for (int m = 0; m < 4; ++m) _Pragma("unroll") for (int k = 0; k < 2; ++k) dst[m][k] = *(const PG8_LAS bf16x8*)(lds + PG8_SA(b, h) + aoff + m * 2048 + k * KOFF); } while (0)
#define PG8_LDB(dst, b, h) do { _Pragma("unroll") for (int n = 0; n < 2; ++n) _Pragma("unroll") for (int k = 0; k < 2; ++k) dst[n][k] = *(const PG8_LAS bf16x8*)(lds + PG8_SB(b, h) + boff + n * 2048 + k * KOFF); } while (0)
#define PG8_MMA(ai, bj, At, Bt) do { __builtin_amdgcn_s_setprio(1); _Pragma("unroll") for (int m = 0; m < 4; ++m) _Pragma("unroll") for (int n = 0; n < 2; ++n) _Pragma("unroll") for (int k = 0; k < 2; ++k) \
        acc[ai][bj][m][n] = __builtin_amdgcn_mfma_f32_16x16x32_bf16(Bt[n][k], At[m][k], acc[ai][bj][m][n], 0, 0, 0); __builtin_amdgcn_s_setprio(0); } while (0)
#define PG8_WAIT_V(n) asm volatile("s_waitcnt vmcnt(" #n ")" ::: "memory")
#define PG8_WAIT_L(n) asm volatile("s_waitcnt lgkmcnt(" #n ")" ::: "memory")
#define PG8_BAR __builtin_amdgcn_s_barrier()
#define PG8_SCHED __builtin_amdgcn_sched_barrier(0)
    Unit cur, nxt; int ui = 0;
    if (!S.next(0, cur)) return;
    f32x4 acc[2][2][4][2];
#pragma unroll
    for (int a = 0; a < 2; ++a)
#pragma unroll
        for (int b = 0; b < 2; ++b)
#pragma unroll
            for (int m = 0; m < 4; ++m)
#pragma unroll
                for (int n = 0; n < 2; ++n) acc[a][b][m][n] = (f32x4){0.f, 0.f, 0.f, 0.f};
    bf16x8 At[4][2], B0[2][2], B1[2][2];
    v8i_t At8[4], B08[2], B18[2];
    unsigned vAc[2][2], vAn[2][2];
    PG8_AVOFF(cur, vAc);
    if constexpr (Sched::GATHER) { asm volatile("s_waitcnt vmcnt(0)" ::: "memory"); asm volatile("" : "+v"(vAc[0][0]), "+v"(vAc[0][1]), "+v"(vAc[1][0]), "+v"(vAc[1][1])); }
    unsigned cA = S.a_off(g, cur), cB = S.b_off(g, cur);
    PG8_STAGE_B(PG8_SB(0, 0), cB); PG8_STAGE_B(PG8_SB(0, 1), cB + hstep); PG8_STAGE_A(PG8_SA(0, 0), cA, vAc, 0); PG8_STAGE_A(PG8_SA(0, 1), cA, vAc, 1);
    if (wr == 1) PG8_BAR;
    PG8_WAIT_V(2); PG8_BAR;
    PG8_STAGE_B(PG8_SB(1, 0), cB + kstep); PG8_STAGE_A(PG8_SA(1, 0), cA + kstep, vAc, 0); PG8_STAGE_B(PG8_SB(1, 1), cB + hstep + kstep);
    PG8_WAIT_V(6); PG8_BAR;
#pragma nounroll
    for (;;) {
        const bool has_next = S.next(ui + 1, nxt);
        if constexpr (Sched::GATHER) {
            if (has_next) { PG8_AVOFF(nxt, vAn); asm volatile("s_waitcnt vmcnt(0)" ::: "memory"); }
            else {
#pragma unroll
                for (int h = 0; h < 2; ++h)
#pragma unroll
                    for (int i = 0; i < 2; ++i) vAn[h][i] = vAc[h][i]; }
            asm volatile("" : "+v"(vAn[0][0]), "+v"(vAn[0][1]), "+v"(vAn[1][0]), "+v"(vAn[1][1]));
        } else {
#pragma unroll
            for (int h = 0; h < 2; ++h)
#pragma unroll
                for (int i = 0; i < 2; ++i) vAn[h][i] = vAc[h][i];
        }
        const unsigned nA = has_next ? S.a_off(g, nxt) : cA, nB = has_next ? S.b_off(g, nxt) : cB;
#pragma unroll 1
        for (int t = 0; t < nt; t += 2) {
            const bool last = (t == nt - 2);
            const unsigned a1 = cA + (unsigned)(t + 1) * kstep;
            const unsigned a2 = last ? nA : cA + (unsigned)(t + 2) * kstep, b2 = last ? nB : cB + (unsigned)(t + 2) * kstep;
            const unsigned a3 = a2 + kstep, b3 = b2 + kstep;
            unsigned v2[2][2];
#pragma unroll
            for (int h = 0; h < 2; ++h)
#pragma unroll
                for (int i = 0; i < 2; ++i) { if constexpr (Sched::GATHER) v2[h][i] = last ? vAn[h][i] : vAc[h][i]; else v2[h][i] = vAc[h][i]; }
            if constexpr (F8) {
            PG8_LDB8(B08, 0, 0); PG8_LDB8(B18, 0, 1); PG8_SCHED; PG8_LDA8(At8, 0, 0); PG8_STAGE_A(PG8_SA(1, 1), a1, vAc, 1);
            PG8_WAIT_V(8); PG8_WAIT_L(0); PG8_BAR; PG8_MMA8(0, 0, At8, B08); PG8_MMA8(0, 1, At8, B18); PG8_BAR; PG8_SCHED;
            PG8_LDA8(At8, 0, 1); PG8_STAGE_B(PG8_SB(0, 0), b2); PG8_STAGE_B(PG8_SB(0, 1), b2 + hstep); PG8_STAGE_A(PG8_SA(0, 0), a2, v2, 0);
            PG8_WAIT_V(8); PG8_WAIT_L(0); PG8_BAR; PG8_MMA8(1, 0, At8, B08); PG8_MMA8(1, 1, At8, B18); PG8_BAR; PG8_SCHED;
            PG8_LDB8(B08, 1, 0); PG8_LDB8(B18, 1, 1); PG8_SCHED; PG8_LDA8(At8, 1, 0); PG8_STAGE_A(PG8_SA(0, 1), a2, v2, 1);
            PG8_WAIT_V(8); PG8_WAIT_L(0); PG8_BAR; PG8_MMA8(0, 0, At8, B08); PG8_MMA8(0, 1, At8, B18); PG8_BAR; PG8_SCHED;
            PG8_LDA8(At8, 1, 1); PG8_STAGE_B(PG8_SB(1, 0), b3); PG8_STAGE_B(PG8_SB(1, 1), b3 + hstep); PG8_STAGE_A(PG8_SA(1, 0), a3, v2, 0);
            PG8_WAIT_V(8); PG8_WAIT_L(0); PG8_BAR; PG8_MMA8(1, 0, At8, B08); PG8_MMA8(1, 1, At8, B18); PG8_BAR; PG8_SCHED;
            } else {
            PG8_LDB(B0, 0, 0); PG8_LDB(B1, 0, 1); PG8_SCHED; PG8_LDA(At, 0, 0); PG8_STAGE_A(PG8_SA(1, 1), a1, vAc, 1);
            PG8_WAIT_V(8); PG8_WAIT_L(0); PG8_BAR; PG8_MMA(0, 0, At, B0); PG8_MMA(0, 1, At, B1); PG8_BAR; PG8_SCHED;
            PG8_LDA(At, 0, 1); PG8_STAGE_B(PG8_SB(0, 0), b2); PG8_STAGE_B(PG8_SB(0, 1), b2 + hstep); PG8_STAGE_A(PG8_SA(0, 0), a2, v2, 0);
            PG8_WAIT_V(8); PG8_WAIT_L(0); PG8_BAR; PG8_MMA(1, 0, At, B0); PG8_MMA(1, 1, At, B1); PG8_BAR; PG8_SCHED;
            PG8_LDB(B0, 1, 0); PG8_LDB(B1, 1, 1); PG8_SCHED; PG8_LDA(At, 1, 0); PG8_STAGE_A(PG8_SA(0, 1), a2, v2, 1);
            PG8_WAIT_V(8); PG8_WAIT_L(0); PG8_BAR; PG8_MMA(0, 0, At, B0); PG8_MMA(0, 1, At, B1); PG8_BAR; PG8_SCHED;
            PG8_LDA(At, 1, 1); PG8_STAGE_B(PG8_SB(1, 0), b3); PG8_STAGE_B(PG8_SB(1, 1), b3 + hstep); PG8_STAGE_A(PG8_SA(1, 0), a3, v2, 0);
            PG8_WAIT_V(8); PG8_WAIT_L(0); PG8_BAR; PG8_MMA(1, 0, At, B0); PG8_MMA(1, 1, At, B1); PG8_BAR; PG8_SCHED;
            }
        }
        if (wr == 0) PG8_BAR;
        { int t_ = threadIdx.x; asm volatile("" : "+v"(t_)); const int l_ = t_ & 63; E(acc, cur, wr, wc, l_ & 15, l_ >> 4); }
        if (!has_next) break;
#pragma unroll
        for (int a = 0; a < 2; ++a)
#pragma unroll
            for (int b = 0; b < 2; ++b)
#pragma unroll
                for (int m = 0; m < 4; ++m)
#pragma unroll
                    for (int n = 0; n < 2; ++n) acc[a][b][m][n] = (f32x4){0.f, 0.f, 0.f, 0.f};
        cur = nxt; cA = nA; cB = nB; ++ui;
#pragma unroll
        for (int h = 0; h < 2; ++h)
#pragma unroll
            for (int i = 0; i < 2; ++i) vAc[h][i] = vAn[h][i];
        if (wr == 1) PG8_BAR;
    }
    PG8_WAIT_V(0);
    PG8_BAR;
#undef PG8_SA
#undef PG8_SB
#undef PG8_STAGE_A
#undef PG8_STAGE_B
#undef PG8_LDA
#undef PG8_LDB
#undef PG8_MMA
#undef PG8_AVOFF
#undef PG8_MMA8
#undef PG8_LD8
#undef PG8_LDA8
#undef PG8_LDB8
#undef PG8_WAIT_V
#undef PG8_WAIT_L
#undef PG8_BAR
#undef PG8_SCHED
}
}

#ifndef L1IN_F8
#define L1IN_F8 1
#endif
#ifndef DBL_PHASE
#define DBL_PHASE -1
#endif
#ifndef TEST_ATT
#define TEST_ATT 0
#endif
#ifndef TEST_C0
#define TEST_C0 0
#define TEST_NC 2048
#endif
#ifndef TEST_RLO
#define TEST_RLO 0
#define TEST_RHI 256
#endif
#ifndef SB_TRIVIAL
#define SB_TRIVIAL 0
#endif
#ifndef SB_R2PROBE
#define SB_R2PROBE 0
#endif
#ifndef TEST_BADVAL
#define TEST_BADVAL 1e6f
#endif
#ifndef TEST_NANCOUNT
#define TEST_NANCOUNT 0
#endif
#ifndef TEST_GAIN
#define TEST_GAIN 4.0f
#endif
constexpr int SEQ = 16384, DM = 2048, NHEADS = 16, HD = 128, NEXP = 16, DEXP = 1024, NQKV = 6144, NIN0 = 6152;
constexpr float ALPHA = 1.4142135623730951f;
constexpr float LN_EPS = 1e-5f;
constexpr float SCALE128 = 0.08838834764831845f;
constexpr float SCALE64 = 0.125f;
constexpr float LAMBDA_INIT = 0.8f - 0.6f * 0.7408182206817179f;
constexpr int NWAVES = 8, NTHREADS = 512;

constexpr size_t MiB = (size_t)1 << 20;
constexpr size_t WS_CTL = 0, CTL_ZERO_BYTES = 1 * MiB;
constexpr size_t WS_KMEAN = 1 * MiB;
constexpr size_t WS_LOGF = WS_KMEAN + 262144;
constexpr size_t WS_CLOC = WS_LOGF + 524288;
constexpr size_t WS_C = WS_CLOC + 524288;
constexpr size_t WS_CTOT = WS_C + 524288;
constexpr size_t WS_LUT = WS_CTOT + 4096;
constexpr size_t WS_LAM = WS_LUT + 32768;
constexpr size_t WS_MLIST = 4 * MiB;
constexpr size_t WS_MGW = 6 * MiB;
constexpr size_t WS_WIN0 = 8 * MiB, WS_WOUT0 = 32 * MiB, WS_WIN1 = 40 * MiB, WS_WOUT1 = 64 * MiB;
constexpr size_t WS_WGU = 72 * MiB;
constexpr size_t WS_WDN = 328 * MiB;
constexpr size_t WS_XB = 456 * MiB;
constexpr size_t WS_H = 520 * MiB;
constexpr size_t WS_O = 712 * MiB;
constexpr size_t WS_Y = 776 * MiB;
constexpr size_t WS_X1 = 840 * MiB;
constexpr size_t WS_X1F8 = 904 * MiB;
constexpr size_t WS_END = 936 * MiB;
constexpr size_t WS_YSLOT = WS_H;
constexpr size_t WS_HID = WS_O;
constexpr int HID_ROWS = 36864;
constexpr size_t DO_SEL = 0;

constexpr int CW_TMO = 0;
constexpr int CW_BAR = 4096;
constexpr int CW_MOECNT = 8192;
constexpr int CW_MOBACNT = 9216;

constexpr int RING_BYTES = 147456;
constexpr int LCTL_OFF = RING_BYTES;
constexpr int LDS_BYTES = 155648;

#define GAS __attribute__((address_space(1)))
#define LAS __attribute__((address_space(3)))
typedef unsigned short bf16;
typedef unsigned v4u __attribute__((ext_vector_type(4)));
typedef unsigned v2u __attribute__((ext_vector_type(2)));
typedef float f32x4 __attribute__((ext_vector_type(4)));
typedef short bf16x8 __attribute__((ext_vector_type(8)));
typedef GAS unsigned gu32;
#define RLX_AGENT __ATOMIC_RELAXED, __HIP_MEMORY_SCOPE_AGENT
#define LDS_WAIT() asm volatile("s_waitcnt lgkmcnt(0)" ::: "memory")
__device__ __forceinline__ unsigned f2bf(float f) { unsigned u = __builtin_bit_cast(unsigned, f); return (u + 0x7fffu + ((u >> 16) & 1u)) >> 16; }
__device__ __forceinline__ unsigned pk2(float lo, float hi) { return f2bf(lo) | (f2bf(hi) << 16); }
__device__ __forceinline__ unsigned pk4_fp8(float a, float b, float c, float d) { int w = 0; w = __builtin_amdgcn_cvt_pk_fp8_f32(a, b, w, false); w = __builtin_amdgcn_cvt_pk_fp8_f32(c, d, w, true); return (unsigned)w; }
__device__ __forceinline__ float bf2f(unsigned short b) { return __builtin_bit_cast(float, (unsigned)b << 16); }
__device__ __forceinline__ float bflo(unsigned w) { return __builtin_bit_cast(float, w << 16); }
__device__ __forceinline__ float bfhi(unsigned w) { return __builtin_bit_cast(float, w & 0xffff0000u); }
__device__ __forceinline__ int fresh_tid() { int t = threadIdx.x; asm volatile("" : "+v"(t)); return t; }
__device__ __forceinline__ float wave_sum(float v) {
#define WS_DPP(x, ctrl) __builtin_bit_cast(float, __builtin_amdgcn_mov_dpp(__builtin_bit_cast(int, x), ctrl, 0xf, 0xf, true))
    v += WS_DPP(v, 0x128); v += WS_DPP(v, 0x124); v += WS_DPP(v, 0x122); v += WS_DPP(v, 0x121);
#undef WS_DPP
#define WS_RL(l) __builtin_bit_cast(float, __builtin_amdgcn_readlane(__builtin_bit_cast(int, v), l))
    const float a = WS_RL(0), b = WS_RL(16), c = WS_RL(32), d = WS_RL(48);
#undef WS_RL
    return (a + b) + (c + d);
}
__device__ __forceinline__ float log_sigmoid(float v) { return fminf(v, 0.f) - log1pf(__expf(-fabsf(v))); }

#define XB_TMO      128
#define XB_XCNT(j)  (256  + 64 * (j))
#define XB_XSUB(j)  (1280 + 64 * (j))
#define XB_XGEN(j)  (2304 + 64 * (j))
#define XB_TOP      3328
#define XB_TOPGEN   3392
#define XCD_BAR_WORDS 3456
#define XB_SPIN_CAP (1u << 22)
#ifndef XB_FLAT
#define XB_FLAT 1
#endif
__device__ __forceinline__ unsigned xb_ld(unsigned* p)              { return __hip_atomic_load(p, __ATOMIC_RELAXED, __HIP_MEMORY_SCOPE_AGENT); }
__device__ __forceinline__ unsigned xb_add(unsigned* p, unsigned v) { return __hip_atomic_fetch_add(p, v, __ATOMIC_RELAXED, __HIP_MEMORY_SCOPE_AGENT); }
__device__ __forceinline__ unsigned xb_xcc_id() { return (unsigned)__builtin_amdgcn_s_getreg((3 << 11) | 20) & 0xFu; }
#define XB_SPIN(cond, bar) do { unsigned _sp = 0; while (cond) { __builtin_amdgcn_s_sleep(1); \
    if ((++_sp & 255u) == 0u) { if (xb_ld(&(bar)[XB_TMO])) break; if (_sp > XB_SPIN_CAP) { atomicAdd(&(bar)[XB_TMO], 1u); break; } } } } while (0)
struct XcdBarrier { unsigned* bar; unsigned x; volatile LAS unsigned* st; };
__device__ __forceinline__ XcdBarrier xcd_barrier_post(unsigned* bar, volatile LAS unsigned* st) {
    XcdBarrier b; b.bar = bar; b.x = xb_xcc_id(); b.st = st;
    if (threadIdx.x == 0) (void)xb_add(&bar[XB_XCNT(b.x)], 1u);
    return b;
}
__device__ __forceinline__ void xcd_barrier_complete(unsigned* bar, unsigned x, unsigned& nloc, unsigned& nx) {
    const unsigned G = gridDim.x * gridDim.y * gridDim.z;
    unsigned sum, cnt, mine, sp = 0u;
    for (;;) {
        sum = 0u; cnt = 0u; mine = 0u;
#pragma unroll
        for (unsigned j = 0; j < 16; ++j) { const unsigned c = xb_ld(&bar[XB_XCNT(j)]); sum += c; cnt += (c > 0u) ? 1u : 0u; mine = (j == x) ? c : mine; }
        if (sum == G) break;
        __builtin_amdgcn_s_sleep(1);
        if ((++sp & 255u) == 0u) { if (xb_ld(&bar[XB_TMO])) break; if (sp > XB_SPIN_CAP) { atomicAdd(&bar[XB_TMO], 1u); break; } }
    }
    nloc = mine > 0u ? mine : 1u; nx = cnt > 0u ? cnt : 1u;
}
__device__ __forceinline__ void xcd_barrier(const XcdBarrier& b) {
    asm volatile("s_waitcnt vmcnt(0)" ::: "memory");
    __syncthreads();
    if (threadIdx.x == 0) {
        unsigned* bar = b.bar;
        __builtin_amdgcn_s_waitcnt(0);
        unsigned nloc = b.st[0], nx = b.st[1];
        if (nloc == 0u) { xcd_barrier_complete(bar, b.x, nloc, nx); b.st[0] = nloc; b.st[1] = nx; }
        const unsigned old = xb_add(&bar[XB_XSUB(b.x)], 1u);
        const unsigned gen = old / nloc;
#if XB_FLAT
        if (old + 1u == (gen + 1u) * nloc) {
            __builtin_amdgcn_fence(__ATOMIC_RELEASE, "agent");
            asm volatile("s_waitcnt vmcnt(0)" ::: "memory");
            const unsigned og = xb_add(&bar[XB_TOP], 1u);
            const unsigned tg = og / nx;
            if (og + 1u == (tg + 1u) * nx) xb_add(&bar[XB_TOPGEN], 1u);
        }
        XB_SPIN(xb_ld(&bar[XB_TOPGEN]) == gen, bar);
        __builtin_amdgcn_fence(__ATOMIC_ACQUIRE, "agent");
        asm volatile("s_waitcnt vmcnt(0)" ::: "memory");
#else
        if (old + 1u == (gen + 1u) * nloc) {
            __builtin_amdgcn_fence(__ATOMIC_RELEASE, "agent");
            asm volatile("s_waitcnt vmcnt(0)" ::: "memory");
            const unsigned og = xb_add(&bar[XB_TOP], 1u);
            const unsigned tg = og / nx;
            if (og + 1u == (tg + 1u) * nx) xb_add(&bar[XB_TOPGEN], 1u);
            else XB_SPIN(xb_ld(&bar[XB_TOPGEN]) == tg, bar);
            __builtin_amdgcn_fence(__ATOMIC_ACQUIRE, "agent");
            xb_add(&bar[XB_XGEN(b.x)], 1u);
            asm volatile("s_waitcnt vmcnt(0)" ::: "memory");
        } else {
            XB_SPIN(xb_ld(&bar[XB_XGEN(b.x)]) == gen, bar);
            __builtin_amdgcn_fence(__ATOMIC_ACQUIRE, "agent");
            asm volatile("s_waitcnt vmcnt(0)" ::: "memory");
        }
#endif
    }
    __syncthreads();
}

struct Args {
    const float* x; const float* w_in_even; const float* w_out_even; const float* forget_bias; const float* w_in_odd; const float* w_out_odd;
    const float* lambda_q; const float* lambda_k; const float* subln_gain; const float* rel_bias; const float* w_router; const float* b_router;
    const float* w_gate; const float* w_up; const float* w_down; const float* ln_gain; const float* ln_bias;
    float* out; unsigned char* ws; int ph_lo, ph_hi;
};

struct P0Tile { const float* src; unsigned char* dst; int ldw, ldk, n0, gu; };
__device__ __forceinline__ P0Tile p0_decode(const Args& A, unsigned char* ws, int it) {
    constexpr int T_IN = 8 * 48, T_OUT = 8 * 16, T_EXP = 32 * 64;
    int r = it; const float* W; unsigned char* WT; int ldw, sc0, k0, ldk, n0, gu = 0;
    if (r < T_IN) { const int kb = r / 48, nb = r % 48; n0 = nb * 128; W = A.w_in_even; ldw = NIN0; sc0 = n0 + (n0 >= 3072 ? 8 : 0); k0 = kb * 256; WT = ws + WS_WIN0; ldk = DM; }
    else if (r < T_IN + T_OUT) { r -= T_IN; const int kb = r >> 4, nb = r & 15; n0 = nb * 128; W = A.w_out_even; ldw = DM; sc0 = n0; k0 = kb * 256; WT = ws + WS_WOUT0; ldk = DM; }
    else if (r < 2 * T_IN + T_OUT) { r -= T_IN + T_OUT; const int kb = r / 48, nb = r % 48; n0 = nb * 128; W = A.w_in_odd; ldw = NQKV; sc0 = n0; k0 = kb * 256; WT = ws + WS_WIN1; ldk = DM; }
    else if (r < 2 * T_IN + 2 * T_OUT) { r -= 2 * T_IN + T_OUT; const int kb = r >> 4, nb = r & 15; n0 = nb * 128; W = A.w_out_odd; ldw = DM; sc0 = n0; k0 = kb * 256; WT = ws + WS_WOUT1; ldk = DM; }
    else if (r < 2 * T_IN + 2 * T_OUT + 2 * T_EXP) {
        r -= 2 * T_IN + 2 * T_OUT; const int isup = r >= T_EXP; if (isup) r -= T_EXP;
        const int le = r >> 6, q = r & 63, kb = q >> 3, nb = q & 7; n0 = nb * 128;
        W = (isup ? A.w_up : A.w_gate) + (size_t)le * DM * DEXP; ldw = DEXP; sc0 = n0; k0 = kb * 256; WT = ws + WS_WGU + (size_t)le * 2048 * 2048; ldk = DM; gu = 1 + isup; }
    else { r -= 2 * T_IN + 2 * T_OUT + 2 * T_EXP; const int le = r >> 6, q = r & 63, kb = q >> 4, nb = q & 15; n0 = nb * 128;
        W = A.w_down + (size_t)le * DEXP * DM; ldw = DM; sc0 = n0; k0 = kb * 256; WT = ws + WS_WDN + (size_t)le * 2048 * 1024; ldk = DEXP; }
    P0Tile p; p.src = W + (size_t)k0 * ldw + sc0; p.dst = WT + k0; p.ldw = ldw; p.ldk = ldk; p.n0 = n0; p.gu = gu;
    return p;
}
__device__ __forceinline__ void p0_prologue(const Args& A, LAS unsigned char* lds, int G) {
    const int tid = fresh_tid(), lane = tid & 63, wave = __builtin_amdgcn_readfirstlane(tid >> 6);
    const int gw = blockIdx.x * NWAVES + wave, NGW = G * NWAVES;
    unsigned char* ws = A.ws;
    constexpr int NTILES = 2 * (16 * 24) + 2 * (16 * 8) + 3 * 32 * 64;
    f32x4 vA[16], vB[16];
    const int h = lane >> 5, c = lane & 31;
    int it = blockIdx.x, buf = 0;
#define P0_ISSUE(V, T) do { _Pragma("unroll") for (int i = 0; i < 16; ++i) V[i] = __builtin_nontemporal_load((const GAS f32x4*)((T).src + (size_t)(32 * wave + 16 * h + i) * (T).ldw + 4 * c)); } while (0)
#define P0_CONVERT(V, tb) do { _Pragma("unroll") for (int j = 0; j < 4; ++j) { v4u w; \
            w.x = pk4_fp8(V[0][j] * 32.f, V[1][j] * 32.f, V[2][j] * 32.f, V[3][j] * 32.f);     w.y = pk4_fp8(V[4][j] * 32.f, V[5][j] * 32.f, V[6][j] * 32.f, V[7][j] * 32.f); \
            w.z = pk4_fp8(V[8][j] * 32.f, V[9][j] * 32.f, V[10][j] * 32.f, V[11][j] * 32.f);  w.w = pk4_fp8(V[12][j] * 32.f, V[13][j] * 32.f, V[14][j] * 32.f, V[15][j] * 32.f); \
            *(LAS v4u*)((tb) + (4 * c + j) * 256 + (((2 * wave + h) ^ (c & 15)) * 16)) = w; } } while (0)
#define P0_WRITEOUT(T, tb) do { _Pragma("unroll") for (int p = 0; p < 4; ++p) { const int n = p * 32 + (tid >> 4), ch = tid & 15, nn = (T).n0 + n; \
            const v4u d = *(const LAS v4u*)((tb) + n * 256 + ((ch ^ ((n >> 2) & 15)) * 16)); \
            const int drow = (T).gu ? ((nn >> 7) * 256 + (nn & 127) + ((T).gu == 2 ? 128 : 0)) : nn; \
            *(GAS v4u*)((T).dst + (size_t)drow * (T).ldk + 16 * ch) = d; } } while (0)
    P0Tile cur = p0_decode(A, ws, it < NTILES ? it : 0);
    if (it < NTILES) P0_ISSUE(vA, cur);
    for (; it < NTILES; it += 2 * G) {
        {   const int nit = it + G; const P0Tile nxt = p0_decode(A, ws, nit < NTILES ? nit : 0);
            if (nit < NTILES) P0_ISSUE(vB, nxt);
            LAS unsigned char* tb = lds + buf * 32768;
            P0_CONVERT(vA, tb);
            __syncthreads();
            P0_WRITEOUT(cur, tb);
            cur = nxt; buf ^= 1;
            if (nit >= NTILES) break; }
        {   const int nit = it + 2 * G; const P0Tile nxt = p0_decode(A, ws, nit < NTILES ? nit : 0);
            if (nit < NTILES) P0_ISSUE(vA, nxt);
            LAS unsigned char* tb = lds + buf * 32768;
            P0_CONVERT(vB, tb);
            __syncthreads();
            P0_WRITEOUT(cur, tb);
            cur = nxt; buf ^= 1; }
    }
#undef P0_ISSUE
#undef P0_CONVERT
#undef P0_WRITEOUT
    __syncthreads();
    LAS float* wfa = (LAS float*)lds;
    for (int idx = tid; idx < 8 * DM; idx += NTHREADS) { const int d = idx >> 3, j = idx & 7; wfa[j * DM + d] = A.w_in_even[(size_t)d * NIN0 + 3072 + j]; }
    __syncthreads();
    float* logf = (float*)(ws + WS_LOGF); bf16* xb = (bf16*)(ws + WS_XB);
    for (int m = gw; m < SEQ; m += 2 * NGW) {
        const int mB = (m + NGW < SEQ) ? m + NGW : m;
        const GAS f32x4* xr = (const GAS f32x4*)(A.x + (size_t)m * DM) + lane; const GAS f32x4* xrB = (const GAS f32x4*)(A.x + (size_t)mB * DM) + lane;
        f32x4 v[8], vB[8];
#pragma unroll
        for (int j = 0; j < 8; ++j) { v[j] = xr[64 * j]; vB[j] = xrB[64 * j]; }
        GAS unsigned* o8 = (GAS unsigned*)((unsigned char*)xb + (size_t)m * DM) + lane;
        GAS unsigned* o8B = (GAS unsigned*)((unsigned char*)xb + (size_t)mB * DM) + lane;
#pragma unroll
        for (int j = 0; j < 8; ++j) { o8[64 * j] = pk4_fp8(v[j].x, v[j].y, v[j].z, v[j].w); o8B[64 * j] = pk4_fp8(vB[j].x, vB[j].y, vB[j].z, vB[j].w); }
        float mine = 0.f, mineB = 0.f;
#pragma unroll 1
        for (int e = 0; e < 8; ++e) { float s = 0.f, sB = 0.f;
#pragma unroll
            for (int j = 0; j < 8; ++j) { const f32x4 w = *(const LAS f32x4*)(wfa + e * DM + 256 * j + 4 * lane);
                s += v[j].x * w.x + v[j].y * w.y + v[j].z * w.z + v[j].w * w.w; sB += vB[j].x * w.x + vB[j].y * w.y + vB[j].z * w.z + vB[j].w * w.w; }
            s = wave_sum(s); sB = wave_sum(sB); mine = (lane == e) ? s : mine; mineB = (lane == e) ? sB : mineB; }
        if (lane < 8) { const float fb = A.forget_bias[lane]; logf[lane * SEQ + m] = log_sigmoid(mine + fb); logf[lane * SEQ + mB] = log_sigmoid(mineB + fb); }
    }
    {
        float* lut = (float*)(ws + WS_LUT);
        for (int idx = blockIdx.x * NTHREADS + tid; idx < 8 * 1024; idx += G * NTHREADS) { const int hh = idx >> 10, d = idx & 1023;
            int b; if (d < 16) b = d; else { b = 16 + (int)(log((double)d / 16.0) / log(64.0) * 16.0 + 1e-9); b = b > 31 ? 31 : b; }
            lut[idx] = A.rel_bias[b * 8 + hh]; }
        if (tid == 0 && blockIdx.x == 0) { float s0 = 0.f, s1 = 0.f; for (int d = 0; d < 64; ++d) { s0 += A.lambda_q[d] * A.lambda_k[d]; s1 += A.lambda_q[64 + d] * A.lambda_k[64 + d]; }
            ((float*)(ws + WS_LAM))[0] = expf(s0) - expf(s1) + LAMBDA_INIT; }
    }
}

__device__ __forceinline__ void p2_kmean_cumsum(const Args& A, char* lds, int G) {
    const int tid = fresh_tid(), lane = tid & 63, wave = tid >> 6;
    const bf16* h = (const bf16*)(A.ws + WS_H);
    float* red = (float*)lds;
    for (int u = blockIdx.x; u < 1536; u += G) {
        if (u >= 1024) {
            const int v = u - 1024, hd = v >> 6, n = v & 63, c = tid & 15, g = tid >> 4; float mx = 0.f;
            for (int i = 0; i < 8; ++i) { const v4u w = *(const v4u*)(h + (size_t)(n * 256 + g + 32 * i) * NQKV + 1024 + hd * 128 + c * 8);
                float s = bflo(w.x) * bflo(w.x) + bfhi(w.x) * bfhi(w.x) + bflo(w.y) * bflo(w.y) + bfhi(w.y) * bfhi(w.y) + bflo(w.z) * bflo(w.z) + bfhi(w.z) * bfhi(w.z) + bflo(w.w) * bflo(w.w) + bfhi(w.w) * bfhi(w.w);
                s += __shfl_xor(s, 1); s += __shfl_xor(s, 2); s += __shfl_xor(s, 4); s += __shfl_xor(s, 8); mx = fmaxf(mx, s); }
            for (int o = 16; o < 64; o <<= 1) mx = fmaxf(mx, __shfl_xor(mx, o));
            if (lane == 0) atomicMax((unsigned*)(A.ws + WS_CTL) + 10496 + hd, __float_as_uint(mx));
        } else if (u < 512) {
            const int hd = u >> 6, n = u & 63, c = tid & 15, g = tid >> 4;
            float s[8] = {0, 0, 0, 0, 0, 0, 0, 0};
            for (int i = 0; i < 8; ++i) { const v4u w = *(const v4u*)(h + (size_t)(n * 256 + g + 32 * i) * NQKV + 4096 + hd * 128 + c * 8);
                s[0] += bflo(w.x); s[1] += bfhi(w.x); s[2] += bflo(w.y); s[3] += bfhi(w.y); s[4] += bflo(w.z); s[5] += bfhi(w.z); s[6] += bflo(w.w); s[7] += bfhi(w.w); }
            for (int j = 0; j < 8; ++j) red[g * 128 + c * 8 + j] = s[j];
            __syncthreads();
            if (tid < 128) { float t = 0.f; for (int gg = 0; gg < 32; ++gg) t += red[gg * 128 + tid]; ((float*)(A.ws + WS_KMEAN))[(size_t)u * 128 + tid] = t * (1.f / 256.f); }
            __syncthreads();
        } else {
            const int v = u - 512, hd = v >> 6, ch = v & 63;
            const float* lf = (const float*)(A.ws + WS_LOGF) + hd * SEQ + ch * 256;
            float x = (tid < 256) ? lf[tid] : 0.f;
            for (int o = 1; o < 64; o <<= 1) { const float y = __shfl_up(x, o); if (lane >= o) x += y; }
            if (lane == 63 && wave < 4) red[wave] = x;
            __syncthreads();
            if (tid < 256) { float pre = 0.f; for (int w = 0; w < wave; ++w) pre += red[w]; x += pre;
                ((float*)(A.ws + WS_CLOC))[hd * SEQ + ch * 256 + tid] = x;
                if (tid == 255) ((float*)(A.ws + WS_CTOT))[hd * 64 + ch] = x; }
            __syncthreads();
        }
    }
}

__device__ __forceinline__ void p3_gate_cfinal(const Args& A, char* lds, int G, int* sel) {
    const int tid = fresh_tid(), lane = tid & 63, wave = tid >> 6;
    const bf16* h = (const bf16*)(A.ws + WS_H);
    float* km = (float*)lds;
    float* scal = (float*)(lds + 65536); int* lcnt = (int*)(lds + 66560); int* gbs = lcnt + 64;
    for (int u = blockIdx.x; u < 1024; u += G) {
        if (u < 512) {
            const int hd = u >> 6, qb = (u & 256) ? 63 - (u & 63) : (u & 63);
            const float* kmg = (const float*)(A.ws + WS_KMEAN) + (size_t)hd * 64 * 128;
            for (int i = tid; i < qb * 128; i += NTHREADS) km[i] = kmg[i];
            if (tid < 64) lcnt[tid] = 0;
            __syncthreads();
            const int t = qb * 256 + (tid >> 1), dh = tid & 1;
            float q[64];
            { const bf16* qp = h + (size_t)t * NQKV + 3072 + hd * 128 + dh * 64;
#pragma unroll
              for (int i = 0; i < 8; ++i) { const v4u w = *(const v4u*)(qp + i * 8);
                q[i * 8 + 0] = bflo(w.x); q[i * 8 + 1] = bfhi(w.x); q[i * 8 + 2] = bflo(w.y); q[i * 8 + 3] = bfhi(w.y); q[i * 8 + 4] = bflo(w.z); q[i * 8 + 5] = bfhi(w.z); q[i * 8 + 6] = bflo(w.w); q[i * 8 + 7] = bfhi(w.w); } }
            float v0 = -3e38f, v1 = -3e38f, v2 = -3e38f; int i0 = 0, i1 = 1, i2 = 2;
            for (int n = 0; n < qb; ++n) {
                const float* kr = km + n * 128 + dh * 64; float s = 0.f;
#pragma unroll
                for (int d = 0; d < 64; d += 4) { const f32x4 kv = *(const f32x4*)(kr + d); s += q[d] * kv.x + q[d + 1] * kv.y + q[d + 2] * kv.z + q[d + 3] * kv.w; }
                s += __shfl_xor(s, 1);
                if (s > v0) { v2 = v1; i2 = i1; v1 = v0; i1 = i0; v0 = s; i0 = n; }
                else if (s > v1) { v2 = v1; i2 = i1; v1 = s; i1 = n; }
                else if (s > v2) { v2 = s; i2 = n; }
            }
            const int nsel = qb < 3 ? qb : 3;
            if (dh == 0) *(int4*)(sel + ((size_t)hd * SEQ + t) * 4) = make_int4(i0, i1, i2, nsel);
            int lp0 = 0, lp1 = 0, lp2 = 0;
            if (dh == 0) { if (nsel > 0) lp0 = atomicAdd(&lcnt[i0], 1); if (nsel > 1) lp1 = atomicAdd(&lcnt[i1], 1); if (nsel > 2) lp2 = atomicAdd(&lcnt[i2], 1); }
            __syncthreads();
            if (tid < 64) { const int c = lcnt[tid]; gbs[tid] = c > 0 ? (int)__hip_atomic_fetch_add((unsigned*)(A.ws + WS_CTL) + CW_MOBACNT + hd * 64 + tid, (unsigned)c, RLX_AGENT) : 0; }
            __syncthreads();
            if (dh == 0) { int* ml = (int*)((unsigned char*)A.out + (4u << 20)) + (size_t)hd * 64 * SEQ;
                if (nsel > 0) ml[(size_t)i0 * SEQ + gbs[i0] + lp0] = t * 4 + 0;
                if (nsel > 1) ml[(size_t)i1 * SEQ + gbs[i1] + lp1] = t * 4 + 1;
                if (nsel > 2) ml[(size_t)i2 * SEQ + gbs[i2] + lp2] = t * 4 + 2; }
            __syncthreads();
        } else {
            const int v = u - 512, hd = v >> 6, ch = v & 63;
            if (wave == 0) { float x = (lane < ch) ? ((const float*)(A.ws + WS_CTOT))[hd * 64 + lane] : 0.f; x = wave_sum(x); if (lane == 0) scal[0] = x; }
            __syncthreads();
            if (tid < 256) ((float*)(A.ws + WS_C))[hd * SEQ + ch * 256 + tid] = ((const float*)(A.ws + WS_CLOC))[hd * SEQ + ch * 256 + tid] + scal[0];
            __syncthreads();
        }
    }
}

template <int VAR>
__device__ __forceinline__ void naive_attn_unit(const Args& A, char* lds, int hd, int qblk, const int* sel) {
    const int tid = fresh_tid(), ql = tid >> 2, part = tid & 3;
    const int t0 = qblk * 128, t = t0 + ql;
    float* Ks = (float*)lds; float* Vs = Ks + 64 * 128; float* Cs = Vs + 64 * 128;
    const bf16* h = (const bf16*)(A.ws + WS_H); bf16* ob = (bf16*)(A.ws + WS_O);
    const int second = (VAR == 1 || VAR == 3) ? 1 : 0;
    const int qcol = second * 3072 + hd * 128, kcol = qcol + 1024, vcol = qcol + 2048, ocol = (second * 8 + hd) * 128;
    const float* cg = (const float*)(A.ws + WS_C) + hd * SEQ;
    const float* lut = (const float*)(A.ws + WS_LUT) + hd * 1024;
    float q[32];
    if (VAR != 2) { const bf16* qp = h + (size_t)t * NQKV + qcol + part * 32;
#pragma unroll
        for (int d = 0; d < 32; ++d) q[d] = bf2f(qp[d]); }
    else { const bf16* qp = h + (size_t)t * NQKV + qcol + part * 16;
#pragma unroll
        for (int d = 0; d < 16; ++d) { q[d] = bf2f(qp[d]); q[16 + d] = bf2f(qp[64 + d]); } }
    float o[32], o2[32];
#pragma unroll
    for (int d = 0; d < 32; ++d) { o[d] = 0.f; o2[d] = 0.f; }
    float m1 = -1e30f, l1 = 0.f, m2 = -1e30f, l2 = 0.f, R = 0.f;
    const float ct = (VAR == 0) ? cg[t] : 0.f;
    int s0 = -1, s1 = -1, s2 = -1;
    if (VAR == 1) { const int4 sv = *(const int4*)(sel + ((size_t)hd * SEQ + t) * 4); if (sv.w > 0) s0 = sv.x; if (sv.w > 1) s1 = sv.y; if (sv.w > 2) s2 = sv.z; }
    const int own = t >> 8;
    const int jmax = (t0 + 127) >> 6;
    for (int jj = 0; jj <= jmax; ++jj) {
        const int j = (VAR == 3) ? (jmax - jj) : jj;
        __syncthreads();
        for (int idx = tid; idx < 1024; idx += NTHREADS) { const int row = idx >> 4, c8 = (idx & 15) * 8;
            const v4u kw = *(const v4u*)(h + (size_t)(j * 64 + row) * NQKV + kcol + c8); const v4u vw = *(const v4u*)(h + (size_t)(j * 64 + row) * NQKV + vcol + c8);
            float* kd = Ks + row * 128 + c8; float* vd = Vs + row * 128 + c8;
            kd[0] = bflo(kw.x); kd[1] = bfhi(kw.x); kd[2] = bflo(kw.y); kd[3] = bfhi(kw.y); kd[4] = bflo(kw.z); kd[5] = bfhi(kw.z); kd[6] = bflo(kw.w); kd[7] = bfhi(kw.w);
            vd[0] = bflo(vw.x); vd[1] = bfhi(vw.x); vd[2] = bflo(vw.y); vd[3] = bfhi(vw.y); vd[4] = bflo(vw.z); vd[5] = bfhi(vw.z); vd[6] = bflo(vw.w); vd[7] = bfhi(vw.w); }
        if (VAR == 0 && tid < 64) Cs[tid] = cg[j * 64 + tid];
        __syncthreads();
        for (int ss = 0; ss < 64; ++ss) {
            const int s = (VAR == 3) ? (63 - ss) : ss; const int ks = j * 64 + s;
            float d1 = 0.f, d2 = 0.f;
            if (VAR != 2) { const float* kr = Ks + s * 128 + part * 32;
#pragma unroll
                for (int d = 0; d < 32; d += 4) { const f32x4 kv = *(const f32x4*)(kr + d); d1 += q[d] * kv.x + q[d + 1] * kv.y + q[d + 2] * kv.z + q[d + 3] * kv.w; } }
            else { const float* kr = Ks + s * 128 + part * 16;
#pragma unroll
                for (int d = 0; d < 16; d += 4) { const f32x4 ka = *(const f32x4*)(kr + d); const f32x4 kb = *(const f32x4*)(kr + 64 + d);
                    d1 += q[d] * ka.x + q[d + 1] * ka.y + q[d + 2] * ka.z + q[d + 3] * ka.w; d2 += q[16 + d] * kb.x + q[17 + d] * kb.y + q[18 + d] * kb.z + q[19 + d] * kb.w; } }
            d1 += __shfl_xor(d1, 1); d1 += __shfl_xor(d1, 2);
            if (VAR == 2) { d2 += __shfl_xor(d2, 1); d2 += __shfl_xor(d2, 2); }
            const float* vr = Vs + s * 128 + part * 32;
            if (VAR == 0 || VAR == 1) {
                bool valid; float sc;
                if (VAR == 0) { valid = ks <= t; sc = d1 * SCALE128 + (ct - Cs[s]); }
                else { const int nb = ks >> 8; valid = (nb == own && ks <= t) || nb == s0 || nb == s1 || nb == s2; const int dist = t - ks; sc = d1 * SCALE128 + lut[dist < 0 ? 0 : (dist > 1023 ? 1023 : dist)]; }
                if (valid) { const float mn = fmaxf(m1, sc), al = __expf(m1 - mn), p = __expf(sc - mn); l1 = l1 * al + p; m1 = mn;
#pragma unroll
                    for (int d = 0; d < 32; ++d) o[d] = o[d] * al + p * vr[d]; }
            } else if (VAR == 2) {
                if (ks <= t) { const float bias = lut[(t - ks) > 1023 ? 1023 : (t - ks)];
                    const float sa = d1 * SCALE64 + bias, sb = d2 * SCALE64 + bias;
                    const float mna = fmaxf(m1, sa), ala = __expf(m1 - mna), pa = __expf(sa - mna); l1 = l1 * ala + pa; m1 = mna;
                    const float mnb = fmaxf(m2, sb), alb = __expf(m2 - mnb), pb = __expf(sb - mnb); l2 = l2 * alb + pb; m2 = mnb;
#pragma unroll
                    for (int d = 0; d < 32; ++d) { const float vv = vr[d]; o[d] = o[d] * ala + pa * vv; o2[d] = o2[d] * alb + pb * vv; } }
            } else {
                if (ks < t) { const float z = d1 * SCALE128; float a = __expf(log_sigmoid(z) + R); R += log_sigmoid(-z);
#if SB_TRIVIAL
                    a = 0.015625f;
#endif

#pragma unroll
                    for (int d = 0; d < 32; ++d) o[d] += a * vr[d]; }
            }
        }
    }
    if (VAR == 0 || VAR == 1) { const float il = 1.f / l1;
#pragma unroll
        for (int d = 0; d < 32; ++d) o[d] *= il; }
    if (VAR == 2) { const float lam = ((const float*)(A.ws + WS_LAM))[0]; const float i1 = 1.f / l1, i2 = lam / l2; float ss = 0.f;
#pragma unroll
        for (int d = 0; d < 32; ++d) { o[d] = o[d] * i1 - o2[d] * i2; ss += o[d] * o[d]; }
        ss += __shfl_xor(ss, 1); ss += __shfl_xor(ss, 2);
        const float r = rsqrtf(ss * (1.f / 128.f) + LN_EPS) * (1.f - LAMBDA_INIT);
#pragma unroll
        for (int d = 0; d < 32; ++d) o[d] = o[d] * r * A.subln_gain[part * 32 + d]; }
    bf16* op = ob + (size_t)t * DM + ocol + part * 32;
#pragma unroll
    for (int d = 0; d < 32; d += 2) *(unsigned*)(op + d) = pk2(o[d], o[d + 1]);
}

constexpr int CW_Q4 = 10560, CW_Q12 = 10752, CW_QM = 10944;
__device__ __forceinline__ int next_item(const Args& A, int cw, LAS int* slot) {
    __syncthreads();
    if (threadIdx.x == 0) *slot = (int)__hip_atomic_fetch_add((unsigned*)(A.ws + WS_CTL) + cw, 1u, RLX_AGENT);
    __syncthreads();
    return *slot;
}


#ifndef SB_R2PROBE
#define SB_R2PROBE 0
#endif
#ifndef FRESH_W
#define FRESH_W 1
#endif
#ifndef FRESH_ALL
#define FRESH_ALL 0
#endif
#ifndef PV_FILL
#define PV_FILL 5
#endif
#ifndef FOX_CH
#define FOX_CH 16
#endif
#ifndef SB_NOCHUNK
#define SB_NOCHUNK 0
#endif
#ifndef SB_TRIVIAL
#define SB_TRIVIAL 0
#endif
namespace att {
typedef float f32x16 __attribute__((ext_vector_type(16)));
typedef short s16x4 __attribute__((ext_vector_type(4)));
constexpr int PITCH = NQKV;
constexpr int SHM_V = 16384, SHM_K = 16384;
constexpr int L_V = 0, L_K = 2 * SHM_V, L_WS = L_K + 2 * SHM_K, L_KB = L_WS + NWAVES * 64 * 4, L_FLAG = L_KB + 512, L_LUT = L_FLAG + 512, LUT_PAD = 320, LUT_N = LUT_PAD + 1024,
              L_STASH = L_LUT + LUT_N * 4 + 256, L_END = L_STASH + 65536;
static_assert(L_STASH % 16 == 0 && L_END <= RING_BYTES, "attention LDS map");
constexpr float THR = 8.f;
#define KSWZ(row, colB) ((row) * 256 + ((colB) ^ (((row) & 7) << 4)))
#define SBAR() __builtin_amdgcn_sched_barrier(0)
__device__ __forceinline__ int v_st(int k, int c) { const int kk = (k & ~0xC) | ((k & 4) << 1) | ((k & 8) >> 1); return ((kk >> 3) * 4 + (c >> 5)) * 512 + ((kk & 7) * 32 + (c & 31)) * 2; }
__device__ __forceinline__ int v_rd_base(int lane) { return ((lane & 3) << 3) | (((lane >> 2) & 3) << 6) | (((lane >> 4) & 1) << 5) | (((lane >> 5) & 1) << 8); }
constexpr int v_rd_off(int d0, int ks, int half) { return d0 * 512 + ks * 4096 + half * 2048; }
__device__ __forceinline__ int crow(int r, int hi) { return (r & 3) + 8 * (r >> 2) + 4 * hi; }
typedef __bf16 bf16x2_t __attribute__((ext_vector_type(2)));
typedef float f32x2_t __attribute__((ext_vector_type(2)));
__device__ __forceinline__ unsigned cvtpk(float lo, float hi) { f32x2_t v = {lo, hi}; bf16x2_t b = __builtin_convertvector(v, bf16x2_t); return __builtin_bit_cast(unsigned, b); }

template <int DQ> __device__ __forceinline__ void partialSM(f32x16& p0, f32x16& p1, float& m_reg, float& mn, float& alpha) {
    constexpr float SC = (DQ == 128) ? SCALE128 : SCALE64; constexpr float C2 = 1.4426950408889634f * SC;
    float pmax = p0[0]; for (int r = 1; r < 16; ++r) pmax = fmaxf(pmax, p0[r]); for (int r = 0; r < 16; ++r) pmax = fmaxf(pmax, p1[r]);
    { auto rr = __builtin_amdgcn_permlane32_swap(__float_as_uint(pmax), __float_as_uint(pmax), false, false);
      pmax = fmaxf(__uint_as_float(rr[0]), __uint_as_float(rr[1])); }
    if (__builtin_expect(__all((pmax - m_reg) * SC <= THR), 1)) { mn = m_reg; alpha = 1.f; }
    else { mn = fmaxf(m_reg, pmax); alpha = __builtin_amdgcn_exp2f((m_reg - mn) * C2); m_reg = mn; }
    const float mnL = -mn * C2;
    for (int r = 0; r < 16; ++r) p0[r] = fmaf(p0[r], C2, mnL); for (int r = 0; r < 16; ++r) p1[r] = fmaf(p1[r], C2, mnL);
    __builtin_amdgcn_sched_barrier(0);
    for (int r = 0; r < 16; ++r) p0[r] = __builtin_amdgcn_exp2f(p0[r]);
}
#define PK4(P, B_, OUT) do { unsigned a0 = cvtpk(P[B_+0], P[B_+1]), a1 = cvtpk(P[B_+2], P[B_+3]);                          \
        unsigned b0 = cvtpk(P[B_+4], P[B_+5]), b1 = cvtpk(P[B_+6], P[B_+7]);                                             \
        auto r0 = __builtin_amdgcn_permlane32_swap(a0, b0, false, false); auto r1 = __builtin_amdgcn_permlane32_swap(a1, b1, false, false); \
        pg8::u32x4 w = {r0[0], r1[0], r0[1], r1[1]}; OUT = *reinterpret_cast<bf16x8*>(&w); } while (0)
__device__ __forceinline__ void finishSM(f32x16& p0, f32x16& p1, float alpha, float& l_reg, bf16x8& pa0, bf16x8& pa1, bf16x8& pa2, bf16x8& pa3) {
    for (int r = 0; r < 16; ++r) p1[r] = __builtin_amdgcn_exp2f(p1[r]);
    __builtin_amdgcn_sched_barrier(0);
    float s0 = 0.f, s1 = 0.f, s2 = 0.f, s3 = 0.f;
    for (int r = 0; r < 16; r += 4) { s0 += p0[r]; s1 += p0[r + 1]; s2 += p0[r + 2]; s3 += p0[r + 3]; }
    for (int r = 0; r < 16; r += 4) { s0 += p1[r]; s1 += p1[r + 1]; s2 += p1[r + 2]; s3 += p1[r + 3]; }
    float ps = (s0 + s1) + (s2 + s3);
    { auto rr = __builtin_amdgcn_permlane32_swap(__float_as_uint(ps), __float_as_uint(ps), false, false);
      ps = __uint_as_float(rr[0]) + __uint_as_float(rr[1]); }
    l_reg = l_reg * alpha + ps;
    PK4(p0, 0, pa0); PK4(p0, 8, pa1); PK4(p1, 0, pa2); PK4(p1, 8, pa3);
}
__device__ __forceinline__ void sb_half(f32x16& p, float& R2, int hi) {
#if SB_TRIVIAL
#pragma unroll
    for (int r = 0; r < 16; ++r) p[r] = (p[r] < -1e37f) ? 0.f : 0.015625f;
    return;
#endif
    constexpr float C2 = 1.4426950408889634f * SCALE128;
    float T = R2;
#pragma unroll
    for (int g = 3; g >= 0; --g) { float z[4], lr[4];
#pragma unroll
        for (int e = 0; e < 4; ++e) { z[e] = p[4 * g + e] * C2; lr[e] = -(fmaxf(z[e], 0.f) + __builtin_amdgcn_logf(1.f + __builtin_amdgcn_exp2f(-fabsf(z[e])))); }
        const float G = (lr[0] + lr[1]) + (lr[2] + lr[3]);
        auto rr = __builtin_amdgcn_permlane32_swap(__float_as_uint(G), __float_as_uint(G), false, false);
        const float Go = hi ? __uint_as_float(rr[0]) : __uint_as_float(rr[1]);
        float a = T + (hi ? 0.f : Go);
        p[4 * g + 3] = __builtin_amdgcn_exp2f(z[3] + lr[3] + a); a += lr[3];
        p[4 * g + 2] = __builtin_amdgcn_exp2f(z[2] + lr[2] + a); a += lr[2];
        p[4 * g + 1] = __builtin_amdgcn_exp2f(z[1] + lr[1] + a); a += lr[1];
        p[4 * g + 0] = __builtin_amdgcn_exp2f(z[0] + lr[0] + a);
        T += G + Go; }
    R2 = T;
}
__device__ __forceinline__ void sb_pack(f32x16& p0, f32x16& p1, bf16x8& pa0, bf16x8& pa1, bf16x8& pa2, bf16x8& pa3) { PK4(p0, 0, pa0); PK4(p0, 8, pa1); PK4(p1, 0, pa2); PK4(p1, 8, pa3); }
template <int DQ> __device__ __forceinline__ void softmaxY(f32x16& p0, f32x16& p1, float& m_reg, float& alpha, float& l_reg, bf16x8& pa0, bf16x8& pa1, bf16x8& pa2, bf16x8& pa3) {
    constexpr float SC = (DQ == 128) ? SCALE128 : SCALE64; constexpr float C2 = 1.4426950408889634f * SC;
    float pmax = p0[0]; for (int r = 1; r < 16; ++r) pmax = fmaxf(pmax, p0[r]); for (int r = 0; r < 16; ++r) pmax = fmaxf(pmax, p1[r]);
    { auto rr = __builtin_amdgcn_permlane32_swap(__float_as_uint(pmax), __float_as_uint(pmax), false, false);
      pmax = fmaxf(__uint_as_float(rr[0]), __uint_as_float(rr[1])); }
    float mn;
    if (__builtin_expect(__all((pmax - m_reg) * SC <= THR), 1)) { mn = m_reg; alpha = 1.f; }
    else { mn = fmaxf(m_reg, pmax); alpha = __builtin_amdgcn_exp2f((m_reg - mn) * C2); m_reg = mn; }
    const float mnL = -mn * C2;
    for (int r = 0; r < 16; ++r) p0[r] = fmaf(p0[r], C2, mnL); for (int r = 0; r < 16; ++r) p1[r] = fmaf(p1[r], C2, mnL);
    __builtin_amdgcn_sched_barrier(0);
    for (int r = 0; r < 16; ++r) p0[r] = __builtin_amdgcn_exp2f(p0[r]); for (int r = 0; r < 16; ++r) p1[r] = __builtin_amdgcn_exp2f(p1[r]);
    __builtin_amdgcn_sched_barrier(0);
    float s0 = 0.f, s1 = 0.f, s2 = 0.f, s3 = 0.f;
    for (int r = 0; r < 16; r += 4) { s0 += p0[r]; s1 += p0[r + 1]; s2 += p0[r + 2]; s3 += p0[r + 3]; }
    for (int r = 0; r < 16; r += 4) { s0 += p1[r]; s1 += p1[r + 1]; s2 += p1[r + 2]; s3 += p1[r + 3]; }
    float ps = (s0 + s1) + (s2 + s3);
    { auto rr = __builtin_amdgcn_permlane32_swap(__float_as_uint(ps), __float_as_uint(ps), false, false);
      ps = __uint_as_float(rr[0]) + __uint_as_float(rr[1]); }
    l_reg = l_reg * alpha + ps;
    PK4(p0, 0, pa0); PK4(p0, 8, pa1); PK4(p1, 0, pa2); PK4(p1, 8, pa3);
}
#undef PK4

template <int KB, int DQ, bool INITC = false>
__device__ __forceinline__ void qkt(f32x16& p0, f32x16& p1, const LAS char* K_lds, int r32, int hi, const bf16x8* qr) {
    if constexpr (!INITC) { p0 = f32x16{}; p1 = f32x16{}; }
    unsigned ka[4];
#pragma unroll
    for (int dd = 0; dd < 4; ++dd) ka[dd] = (unsigned)(uintptr_t)(K_lds + KB * SHM_K + KSWZ(r32, (dd * 16 + hi * 8) * 2));
    bf16x8 fa0, fa1, fb0, fb1, fc0, fc1;
#define KRD(dst, dd, off) asm volatile("ds_read_b128 %0, %1 offset:%2" : "=&v"(dst) : "v"(ka[dd]), "i"(off) : "memory")
#define KRD2(n0, n1, d) do { KRD(n0, (d) & 3, ((d) >> 2) * 128); KRD(n1, (d) & 3, ((d) >> 2) * 128 + 32 * 256); } while (0)
#define KWAITN(N, x0, x1) do { asm volatile("s_waitcnt lgkmcnt(" #N ")" : "+v"(x0), "+v"(x1) :: "memory"); __builtin_amdgcn_sched_barrier(0x406); } while (0)
#define KSTEP3(d0, c0, c1, n0, n1) do { if constexpr ((d0) + 1 < DQ / 16) KWAITN(2, c0, c1); else KWAITN(0, c0, c1); \
        if constexpr ((d0) + 2 < DQ / 16) KRD2(n0, n1, (d0) + 2); \
        p0 = __builtin_amdgcn_mfma_f32_32x32x16_bf16(c0, qr[d0], p0, 0, 0, 0); p1 = __builtin_amdgcn_mfma_f32_32x32x16_bf16(c1, qr[d0], p1, 0, 0, 0); } while (0)
    KRD2(fa0, fa1, 0); KRD2(fb0, fb1, 1);
    KSTEP3(0, fa0, fa1, fc0, fc1); KSTEP3(1, fb0, fb1, fa0, fa1); KSTEP3(2, fc0, fc1, fb0, fb1); KSTEP3(3, fa0, fa1, fc0, fc1);
    if constexpr (DQ == 128) { KSTEP3(4, fb0, fb1, fa0, fa1); KSTEP3(5, fc0, fc1, fb0, fb1); KSTEP3(6, fa0, fa1, fc0, fc1); KSTEP3(7, fb0, fb1, fa0, fa1); }
#undef KSTEP3
#undef KWAITN
#undef KRD2
#undef KRD
}
template <int VB>
__device__ __forceinline__ void pv_tile2(f32x16* o, int vb0, bf16x8 pa0, bf16x8 pa1, bf16x8 pa2, bf16x8 pa3) {
#define TRRD(dst, off) asm volatile("ds_read_b64_tr_b16 %0, %1 offset:%2" : "=&v"(dst) : "v"(vb0), "i"(off) : "memory")
#define PV_RD(d0, P) constexpr int b##P = VB * SHM_V + v_rd_off(d0, 0, 0); s16x4 l0##P, l1##P, l2##P, l3##P, h0##P, h1##P, h2##P, h3##P; \
        TRRD(l0##P, b##P); TRRD(h0##P, b##P + 2048); TRRD(l1##P, b##P + 4096); TRRD(h1##P, b##P + 6144); TRRD(l2##P, b##P + 8192); TRRD(h2##P, b##P + 10240); TRRD(l3##P, b##P + 12288); TRRD(h3##P, b##P + 14336)
#define PV_MM(d0, P) do { \
        o[d0] = __builtin_amdgcn_mfma_f32_32x32x16_bf16(pa0, (bf16x8){l0##P[0], l0##P[1], l0##P[2], l0##P[3], h0##P[0], h0##P[1], h0##P[2], h0##P[3]}, o[d0], 0, 0, 0);   \
        o[d0] = __builtin_amdgcn_mfma_f32_32x32x16_bf16(pa1, (bf16x8){l1##P[0], l1##P[1], l1##P[2], l1##P[3], h1##P[0], h1##P[1], h1##P[2], h1##P[3]}, o[d0], 0, 0, 0);   \
        o[d0] = __builtin_amdgcn_mfma_f32_32x32x16_bf16(pa2, (bf16x8){l2##P[0], l2##P[1], l2##P[2], l2##P[3], h2##P[0], h2##P[1], h2##P[2], h2##P[3]}, o[d0], 0, 0, 0);   \
        o[d0] = __builtin_amdgcn_mfma_f32_32x32x16_bf16(pa3, (bf16x8){l3##P[0], l3##P[1], l3##P[2], l3##P[3], h3##P[0], h3##P[1], h3##P[2], h3##P[3]}, o[d0], 0, 0, 0); } while (0)
#define PV_WAIT() asm volatile("s_waitcnt lgkmcnt(0)" : "+v"(l0A), "+v"(l1A), "+v"(l2A), "+v"(l3A), "+v"(h0A), "+v"(h1A), "+v"(h2A), "+v"(h3A), \
        "+v"(l0B), "+v"(l1B), "+v"(l2B), "+v"(l3B), "+v"(h0B), "+v"(h1B), "+v"(h2B), "+v"(h3B) :: "memory")
    { PV_RD(0, A); PV_RD(1, B); PV_WAIT(); SBAR(); PV_MM(0, A); PV_MM(1, B); SBAR(); }
    { PV_RD(2, A); PV_RD(3, B); PV_WAIT(); SBAR(); PV_MM(2, A); PV_MM(3, B); }
#undef PV_WAIT
#undef PV_RD
#undef PV_MM
#undef TRRD
}
template <int VB>
__device__ __forceinline__ void pv_tile(f32x16* o, int vb0, bf16x8 pa0, bf16x8 pa1, bf16x8 pa2, bf16x8 pa3) {
#define TRRD(dst, off) asm volatile("ds_read_b64_tr_b16 %0, %1 offset:%2" : "=&v"(dst) : "v"(vb0), "i"(off) : "memory")
#define PV_D0(d0) do { s16x4 l0, l1, l2, l3, h0, h1, h2, h3; constexpr int b_ = VB * SHM_V + v_rd_off(d0, 0, 0); \
        TRRD(l0, b_); TRRD(h0, b_ + 2048); TRRD(l1, b_ + 4096); TRRD(h1, b_ + 6144); TRRD(l2, b_ + 8192); TRRD(h2, b_ + 10240); TRRD(l3, b_ + 12288); TRRD(h3, b_ + 14336); \
        asm volatile("s_waitcnt lgkmcnt(0)" : "+v"(l0), "+v"(l1), "+v"(l2), "+v"(l3), "+v"(h0), "+v"(h1), "+v"(h2), "+v"(h3) :: "memory"); __builtin_amdgcn_sched_barrier(0x406);     \
        o[d0] = __builtin_amdgcn_mfma_f32_32x32x16_bf16(pa0, (bf16x8){l0[0], l0[1], l0[2], l0[3], h0[0], h0[1], h0[2], h0[3]}, o[d0], 0, 0, 0);   \
        o[d0] = __builtin_amdgcn_mfma_f32_32x32x16_bf16(pa1, (bf16x8){l1[0], l1[1], l1[2], l1[3], h1[0], h1[1], h1[2], h1[3]}, o[d0], 0, 0, 0);   \
        o[d0] = __builtin_amdgcn_mfma_f32_32x32x16_bf16(pa2, (bf16x8){l2[0], l2[1], l2[2], l2[3], h2[0], h2[1], h2[2], h2[3]}, o[d0], 0, 0, 0);   \
        o[d0] = __builtin_amdgcn_mfma_f32_32x32x16_bf16(pa3, (bf16x8){l3[0], l3[1], l3[2], l3[3], h3[0], h3[1], h3[2], h3[3]}, o[d0], 0, 0, 0); \
        _Pragma("unroll") for (int g_ = 0; g_ < 4; ++g_) { __builtin_amdgcn_sched_group_barrier(0x8, 1, 0); __builtin_amdgcn_sched_group_barrier(0x2, PV_FILL, 0); } } while (0)
    PV_D0(0); PV_D0(1); PV_D0(2); PV_D0(3);
#undef PV_D0
#undef TRRD
}

template <int VB, int KB, int DQ, bool DOQK>
__device__ __forceinline__ void xphase(f32x16* o, int vb0, bf16x8 pa0, bf16x8 pa1, bf16x8 pa2, bf16x8 pa3, f32x16& p0, f32x16& p1, const LAS char* K_lds, int r32, int hi, const bf16x8* qr) {
#define TRRD(dst, off) asm volatile("ds_read_b64_tr_b16 %0, %1 offset:%2" : "=&v"(dst) : "v"(vb0), "i"(off) : "memory")
#define XRD(d0, P) do { constexpr int b_ = VB * SHM_V + v_rd_off(d0, 0, 0); TRRD(l0##P, b_); TRRD(h0##P, b_ + 2048); TRRD(l1##P, b_ + 4096); TRRD(h1##P, b_ + 6144); \
        TRRD(l2##P, b_ + 8192); TRRD(h2##P, b_ + 10240); TRRD(l3##P, b_ + 12288); TRRD(h3##P, b_ + 14336); } while (0)
#define XWAIT(P) do { asm volatile("s_waitcnt lgkmcnt(0)" : "+v"(l0##P), "+v"(l1##P), "+v"(l2##P), "+v"(l3##P), "+v"(h0##P), "+v"(h1##P), "+v"(h2##P), "+v"(h3##P) :: "memory"); SBAR(); } while (0)
#define XMM(d0, P) do { \
        o[d0] = __builtin_amdgcn_mfma_f32_32x32x16_bf16(pa0, (bf16x8){l0##P[0], l0##P[1], l0##P[2], l0##P[3], h0##P[0], h0##P[1], h0##P[2], h0##P[3]}, o[d0], 0, 0, 0); \
        o[d0] = __builtin_amdgcn_mfma_f32_32x32x16_bf16(pa1, (bf16x8){l1##P[0], l1##P[1], l1##P[2], l1##P[3], h1##P[0], h1##P[1], h1##P[2], h1##P[3]}, o[d0], 0, 0, 0); \
        o[d0] = __builtin_amdgcn_mfma_f32_32x32x16_bf16(pa2, (bf16x8){l2##P[0], l2##P[1], l2##P[2], l2##P[3], h2##P[0], h2##P[1], h2##P[2], h2##P[3]}, o[d0], 0, 0, 0); \
        o[d0] = __builtin_amdgcn_mfma_f32_32x32x16_bf16(pa3, (bf16x8){l3##P[0], l3##P[1], l3##P[2], l3##P[3], h3##P[0], h3##P[1], h3##P[2], h3##P[3]}, o[d0], 0, 0, 0); SBAR(); } while (0)
    s16x4 l0A, l1A, l2A, l3A, h0A, h1A, h2A, h3A, l0B, l1B, l2B, l3B, h0B, h1B, h2B, h3B;
    unsigned ka[4];
#pragma unroll
    for (int dd = 0; dd < 4; ++dd) ka[dd] = (unsigned)(uintptr_t)(K_lds + KB * SHM_K + KSWZ(r32, (dd * 16 + hi * 8) * 2));
    bf16x8 fa0, fa1, fb0, fb1;
#define KRD(dst, dd, off) asm volatile("ds_read_b128 %0, %1 offset:%2" : "=&v"(dst) : "v"(ka[dd]), "i"(off) : "memory")
#define KWAIT(x0, x1) do { asm volatile("s_waitcnt lgkmcnt(0)" : "+v"(x0), "+v"(x1) :: "memory"); __builtin_amdgcn_sched_barrier(0x406); } while (0)
#define KSTEP(d0, c0, c1, n0, n1) do { KWAIT(c0, c1); \
        if constexpr ((d0) + 1 < DQ / 16) { KRD(n0, ((d0) + 1) & 3, (((d0) + 1) >> 2) * 128); KRD(n1, ((d0) + 1) & 3, (((d0) + 1) >> 2) * 128 + 32 * 256); } \
        p0 = __builtin_amdgcn_mfma_f32_32x32x16_bf16(c0, qr[d0], p0, 0, 0, 0); p1 = __builtin_amdgcn_mfma_f32_32x32x16_bf16(c1, qr[d0], p1, 0, 0, 0); } while (0)
    XRD(0, A); SBAR();
    XWAIT(A); XRD(1, B); SBAR(); XMM(0, A);
    XWAIT(B); XRD(2, A); SBAR(); XMM(1, B);
    XWAIT(A); XRD(3, B); SBAR(); XMM(2, A);
    if constexpr (DOQK && DQ == 64) {
        bf16x8 fc0, fc1, fd0, fd1;
        XWAIT(B); KRD(fa0, 0, 0); KRD(fa1, 0, 32 * 256); KRD(fb0, 1, 0); KRD(fb1, 1, 32 * 256); SBAR(); XMM(3, B);
        asm volatile("s_waitcnt lgkmcnt(0)" : "+v"(fa0), "+v"(fa1), "+v"(fb0), "+v"(fb1) :: "memory"); SBAR();
        KRD(fc0, 2, 0); KRD(fc1, 2, 32 * 256); SBAR();
        p0 = f32x16{}; p1 = f32x16{};
        p0 = __builtin_amdgcn_mfma_f32_32x32x16_bf16(fa0, qr[0], p0, 0, 0, 0); p1 = __builtin_amdgcn_mfma_f32_32x32x16_bf16(fa1, qr[0], p1, 0, 0, 0); SBAR();
        KRD(fd0, 3, 0); KRD(fd1, 3, 32 * 256); SBAR();
        p0 = __builtin_amdgcn_mfma_f32_32x32x16_bf16(fb0, qr[1], p0, 0, 0, 0); p1 = __builtin_amdgcn_mfma_f32_32x32x16_bf16(fb1, qr[1], p1, 0, 0, 0); SBAR();
        asm volatile("s_waitcnt lgkmcnt(2)" : "+v"(fc0), "+v"(fc1) :: "memory"); SBAR();
        p0 = __builtin_amdgcn_mfma_f32_32x32x16_bf16(fc0, qr[2], p0, 0, 0, 0); p1 = __builtin_amdgcn_mfma_f32_32x32x16_bf16(fc1, qr[2], p1, 0, 0, 0); SBAR();
        asm volatile("s_waitcnt lgkmcnt(0)" : "+v"(fd0), "+v"(fd1) :: "memory"); SBAR();
        p0 = __builtin_amdgcn_mfma_f32_32x32x16_bf16(fd0, qr[3], p0, 0, 0, 0); p1 = __builtin_amdgcn_mfma_f32_32x32x16_bf16(fd1, qr[3], p1, 0, 0, 0);
    } else {
    XWAIT(B); if constexpr (DOQK) { KRD(fa0, 0, 0); KRD(fa1, 0, 32 * 256); SBAR(); } XMM(3, B);
    if constexpr (DOQK) {
        p0 = f32x16{}; p1 = f32x16{};
        KSTEP(0, fa0, fa1, fb0, fb1); KSTEP(1, fb0, fb1, fa0, fa1); KSTEP(2, fa0, fa1, fb0, fb1); KSTEP(3, fb0, fb1, fa0, fa1);
        if constexpr (DQ == 128) { KSTEP(4, fa0, fa1, fb0, fb1); KSTEP(5, fb0, fb1, fa0, fa1); KSTEP(6, fa0, fa1, fb0, fb1); KSTEP(7, fb0, fb1, fa0, fa1); }
    }
    }
#undef KSTEP
#undef KWAIT
#undef KRD
#undef XMM
#undef XWAIT
#undef XRD
#undef TRRD
}

struct ChunkArgs {
    const bf16* hbase; unsigned kcolB, vcolB;
    int ja, jb;
    int qpos;
    int qlo;
    const float* cb; float cref;
    float* tprobe;
};
#ifndef TIME_SEG
#define TIME_SEG 0
#endif
#ifndef PP_DIFF
#define PP_DIFF 1
#endif
#ifndef PP_SB
#define PP_SB 0
#endif
#ifndef MOBA_RES
#define MOBA_RES 1
#endif
#ifndef FOX_RES
#define FOX_RES 1
#endif
#ifndef GATE_MFMA
#define GATE_MFMA 1
#endif
#ifndef DIFF_RES
#define DIFF_RES 0
#endif
#ifndef SB_RES
#define SB_RES 1
#endif
#ifndef RES_PVDB
#define RES_PVDB 0
#endif
#ifndef PP_XPRIO
#define PP_XPRIO 0
#endif
#ifndef PP_YPRIO
#define PP_YPRIO 1
#endif
#ifndef PP_LAUNDER
#define PP_LAUNDER 0
#endif
template <int DQ, int MODE, bool REV>
__device__ __forceinline__ void attn_chunk(const ChunkArgs& a, const bf16x8* qr, float& m_reg, float& l_reg, f32x16* o, LAS char* lds) {
    int tid_ = threadIdx.x; asm volatile("" : "+v"(tid_)); const int tid = tid_, wid = __builtin_amdgcn_readfirstlane(tid >> 6), lane = tid & 63, r32 = lane & 31, hi = lane >> 5;
    const int NT = a.jb - a.ja;
    LAS char* V_lds = lds + L_V; LAS char* K_lds = lds + L_K;
    LAS float* ws = (LAS float*)(lds + L_WS) + wid * 64; LAS float* al_l = ws + 32;
    LAS float* kbl = (LAS float*)(lds + L_KB); const LAS float* lutl = (const LAS float*)(lds + L_LUT);
    const int vb0 = (int)(uintptr_t)V_lds + v_rd_base(lane);
    const __amdgpu_buffer_rsrc_t hrs = __builtin_amdgcn_make_buffer_rsrc((void*)a.hbase, 0, (int)((size_t)SEQ * PITCH * 2), 0x00020000);
#define FRESH_TID_W(t_) int t_ = threadIdx.x; if constexpr ((DQ == 128 && (MODE == 0 && FRESH_W)) || PP_LAUNDER) asm volatile("" : "+v"(t_))
#define FRESH_TID(t_) int t_ = threadIdx.x; if constexpr ((DQ == 128 && (MODE == 0 || FRESH_ALL)) || PP_LAUNDER) asm volatile("" : "+v"(t_))
    const int qlo = a.qlo;
    bf16x8 st_v0, st_v1, st_k0, st_k1; float st_c = 0.f;
#define KBASE(t) ((REV ? (a.jb - 1 - (t)) : (a.ja + (t))) * 64)
#define VMW() asm volatile("s_waitcnt vmcnt(0)" ::: "memory")
#define SLOAD(k0) do { FRESH_TID(t_); const int sr = t_ >> 4, sc = (t_ & 15) * 8; const unsigned so_ = (unsigned)(k0) * (unsigned)(PITCH * 2); \
        const unsigned vo0 = (unsigned)(sr * PITCH + sc) * 2u, vo1 = vo0 + (unsigned)(32 * PITCH * 2); \
        st_v0 = __builtin_bit_cast(bf16x8, __builtin_amdgcn_raw_buffer_load_b128(hrs, vo0, so_ + a.vcolB, 0)); st_v1 = __builtin_bit_cast(bf16x8, __builtin_amdgcn_raw_buffer_load_b128(hrs, vo1, so_ + a.vcolB, 0)); \
        if constexpr (DQ == 128) { st_k0 = __builtin_bit_cast(bf16x8, __builtin_amdgcn_raw_buffer_load_b128(hrs, vo0, so_ + a.kcolB, 0)); st_k1 = __builtin_bit_cast(bf16x8, __builtin_amdgcn_raw_buffer_load_b128(hrs, vo1, so_ + a.kcolB, 0)); } \
        else { const unsigned vk0 = (unsigned)((t_ >> 3) * PITCH + (t_ & 7) * 8) * 2u; st_k0 = __builtin_bit_cast(bf16x8, __builtin_amdgcn_raw_buffer_load_b128(hrs, vk0, so_ + a.kcolB, 0)); } \
        if constexpr (MODE == 0) { if (t_ < 64) st_c = (a.cref - a.cb[(k0) + t_]) * (1.f / SCALE128); } } while (0)
#define SWRITE_K(bf) do { FRESH_TID_W(t_); if constexpr (DQ == 128) { const int sr = t_ >> 4, sc = (t_ & 15) * 8, kws = KSWZ(sr, sc * 2); *(LAS bf16x8*)(K_lds + (bf) * SHM_K + kws) = st_k0; *(LAS bf16x8*)(K_lds + (bf) * SHM_K + kws + 32 * 256) = st_k1; } \
        else { const int sr2 = t_ >> 3, sc2 = (t_ & 7) * 8, kws2 = KSWZ(sr2, sc2 * 2); *(LAS bf16x8*)(K_lds + (bf) * SHM_K + kws2) = st_k0; } \
        if constexpr (MODE == 0) { if (t_ < 64) kbl[(bf) * 64 + t_] = st_c; } } while (0)
#define SWRITE_V(bf) do { FRESH_TID_W(t_); const int sr = t_ >> 4, sc = (t_ & 15) * 8, vst0 = v_st(sr, sc), vst1 = v_st(32 + sr, sc); *(LAS bf16x8*)(V_lds + (bf) * SHM_V + vst0) = st_v0; *(LAS bf16x8*)(V_lds + (bf) * SHM_V + vst1) = st_v1; } while (0)
#define SWRITE(bf) do { SWRITE_V(bf); SWRITE_K(bf); } while (0)
#define SCORES(P0_, P1_, t, BF) do { const int kb_ = KBASE(t); int dq; { FRESH_TID(t_); const int r32_ = t_ & 31, hi_ = (t_ >> 5) & 1; dq = ((MODE == 2) ? a.qpos : (qlo + r32_)) - 4 * hi_ - kb_; } \
        if constexpr (MODE == 1) { if (__builtin_expect(qlo - (kb_ + 63) < 790, 0)) { const LAS float* lp = lutl + (dq + LUT_PAD - 59); \
            _Pragma("unroll") for (int r = 0; r < 16; ++r) { const int c = (r & 3) + 8 * (r >> 2); P0_[r] += lp[59 - c]; P1_[r] += lp[27 - c]; } } } \
        if constexpr (MODE == 2) { if (!__all(dq - 59 >= 1023)) {   \
            _Pragma("unroll") for (int r = 0; r < 16; ++r) { const int c = (r & 3) + 8 * (r >> 2); int d0_ = dq - c, d1_ = dq - c - 32; d0_ = d0_ > 1023 ? 1023 : d0_; d1_ = d1_ > 1023 ? 1023 : d1_; \
                P0_[r] += lutl[d0_ + LUT_PAD]; P1_[r] += lutl[d1_ + LUT_PAD]; } } } \
        if ((MODE == 2 && !__all(dq - 59 >= 0)) || (MODE != 2 && __builtin_expect(kb_ + 63 >= qlo, 0))) { const float NEG = (MODE == 3) ? -3.0e4f : -__builtin_inff(); constexpr int ST = (MODE == 3) ? 1 : 0; \
            _Pragma("unroll") for (int r = 0; r < 16; ++r) { const int c = (r & 3) + 8 * (r >> 2); if (dq - c < ST) P0_[r] = NEG; if (dq - c - 32 < ST) P1_[r] = NEG; } } } while (0)
#define RESC(al) do { if (__builtin_expect(__any((al) < 1.f), 0)) { if (hi == 0) al_l[r32] = (al); asm volatile("s_waitcnt lgkmcnt(0)" ::: "memory"); \
                     for (int d_ = 0; d_ < 4; ++d_) for (int r = 0; r < 16; ++r) o[d_][r] *= al_l[crow(r, hi)]; } } while (0)
#define PARTIAL(P0_, P1_, mnX, alX) do { if constexpr (MODE == 3) { sb_half(P1_, m_reg, hi); } else { partialSM<DQ>(P0_, P1_, m_reg, mnX, alX); } } while (0)
#define FINISH(P0_, P1_, alY) do { if constexpr (MODE == 3) { sb_half(P0_, m_reg, hi); sb_pack(P0_, P1_, pa0, pa1, pa2, pa3); } else { finishSM(P0_, P1_, alY, l_reg, pa0, pa1, pa2, pa3); } } while (0)
#define RESCALE(al) do { if constexpr (MODE != 3) { RESC(al); } } while (0)
    f32x16 pA0, pA1, pB0, pB1; float mnA = 0.f, mnB = 0.f, alA = 1.f, alB = 1.f; bf16x8 pa0, pa1, pa2, pa3;
#if TIME_SEG
    unsigned long long tseg = 0, ttot = 0;
#endif
#define QKT(KB_, P0_, P1_) do { if constexpr (MODE == 0) { \
            _Pragma("unroll") for (int g = 0; g < 4; ++g) { const f32x4 b0 = *(const LAS f32x4*)(kbl + (KB_) * 64 + 8 * g + 4 * hi), b1 = *(const LAS f32x4*)(kbl + (KB_) * 64 + 32 + 8 * g + 4 * hi); \
                _Pragma("unroll") for (int e = 0; e < 4; ++e) { P0_[4 * g + e] = b0[e]; P1_[4 * g + e] = b1[e]; } } \
            qkt<KB_, DQ, true>(P0_, P1_, K_lds, r32, hi, qr); } else { qkt<KB_, DQ>(P0_, P1_, K_lds, r32, hi, qr); } } while (0)
    SLOAD(KBASE(0)); VMW(); SWRITE_K(0);
    __syncthreads();
    SWRITE_V(0); SBAR();
    if (NT > 1) SLOAD(KBASE(1));
    SBAR(); QKT(0, pA0, pA1);
    SCORES(pA0, pA1, 0, 0); PARTIAL(pA0, pA1, mnA, alA);
    if (NT > 1) { VMW(); SWRITE(1); }
    __syncthreads();
#if TIME_SEG
#define TSTAMP(k) do { if constexpr (DQ == 64) { unsigned long long t_; asm volatile("s_memtime %0\n\ts_waitcnt lgkmcnt(0)" : "=s"(t_) :: "memory"); SBAR(); \
        if (TIME_SEG == (k)) tseg -= t_; if (TIME_SEG + 1 == (k)) tseg += t_; if ((k) == 0) ttot -= t_; if ((k) == 7) ttot += t_; } } while (0)
#define TSTAMP2(seg, end) do { if constexpr (DQ == 64 && TIME_SEG == (seg)) { unsigned long long t_; asm volatile("s_memtime %0\n\ts_waitcnt lgkmcnt(0)" : "=s"(t_) :: "memory"); SBAR(); if (end) tseg += t_; else tseg -= t_; } } while (0)
#else
#define TSTAMP(k) do { } while (0)
#define TSTAMP2(seg, end) do { } while (0)
#endif
#define HALF_STEP(PX0, PX1, mnX, alX, PY0, PY1, alY, t, KB, VB, SB) do {                                 \
        TSTAMP(0); TSTAMP2(8, 0); SBAR(); QKT(KB, PX0, PX1); TSTAMP2(8, 1); TSTAMP2(9, 0);            \
        FINISH(PY0, PY1, alY); SBAR(); TSTAMP(1); TSTAMP2(9, 1);                                          \
        if ((t) + 1 < NT) { SLOAD(KBASE((t) + 1)); SBAR(); } TSTAMP(2);                                   \
        pv_tile<VB>(o, vb0, pa0, pa1, pa2, pa3); TSTAMP(3); SCORES(PX0, PX1, (t), KB); PARTIAL(PX0, PX1, mnX, alX); TSTAMP(4);  \
        __syncthreads(); TSTAMP(5);                                                                       \
        if ((t) + 1 < NT) { VMW(); SWRITE(SB); }                                                          \
        RESCALE(alX); TSTAMP(6); __syncthreads(); TSTAMP(7); } while (0)
#if TIME_SEG == 20
    unsigned long long f20a = 0; if constexpr (MODE == 0) asm volatile("s_memtime %0\n\ts_waitcnt lgkmcnt(0)" : "=s"(f20a) :: "memory");
#endif
    for (int t = 1; t + 1 < NT; t += 2) {
        HALF_STEP(pB0, pB1, mnB, alB, pA0, pA1, alA, t, 1, 0, 0);
        HALF_STEP(pA0, pA1, mnA, alA, pB0, pB1, alB, t + 1, 0, 1, 1);
    }
#if TIME_SEG == 20
    if constexpr (MODE == 0) { unsigned long long f20b; asm volatile("s_memtime %0\n\ts_waitcnt lgkmcnt(0)" : "=s"(f20b) :: "memory");
        const int nt2 = (NT - 1) & ~1; if (nt2 >= 8 && (threadIdx.x & 63) == 0) { const unsigned long long d_ = f20b - f20a, b_ = (unsigned long long)nt2 * 2000ull;
            atomicAdd(a.tprobe, (float)(d_ > b_ ? d_ - b_ : 0) * 1e-6f); atomicAdd(a.tprobe + 1, (float)nt2 * 4000.f * 1e-6f); } }
#endif
    const bool even = (NT & 1) == 0;
    if (even) { SBAR(); QKT(1, pB0, pB1); SBAR(); }
    FINISH(pA0, pA1, alA); SBAR();
    pv_tile<0>(o, vb0, pa0, pa1, pa2, pa3);
    if (even) { SCORES(pB0, pB1, NT - 1, 1); PARTIAL(pB0, pB1, mnB, alB); __syncthreads(); RESCALE(alB);
        FINISH(pB0, pB1, alB); SBAR(); pv_tile<1>(o, vb0, pa0, pa1, pa2, pa3); }
    __syncthreads();
#if TIME_SEG
    if constexpr (DQ == 64) { if ((threadIdx.x & 63) == 0) { atomicAdd((float*)(a.cb), (float)tseg * 1e-6f); atomicAdd((float*)(a.cb) + 1, (float)ttot * 1e-6f); } }
#endif
}

template <int DQ, int MODE, bool REV>
__device__ __forceinline__ void attn_chunk_pp(const ChunkArgs& a, const bf16x8* qr, float& m_reg, float& l_reg, f32x16* o, LAS char* lds) {
    int tid_ = threadIdx.x; asm volatile("" : "+v"(tid_)); const int tid = tid_, wid = __builtin_amdgcn_readfirstlane(tid >> 6), lane = tid & 63, r32 = lane & 31, hi = lane >> 5;
    const int NT = a.jb - a.ja;
    LAS char* V_lds = lds + L_V; LAS char* K_lds = lds + L_K;
    LAS float* ws = (LAS float*)(lds + L_WS) + wid * 64; LAS float* al_l = ws + 32;
    LAS float* kbl = (LAS float*)(lds + L_KB); const LAS float* lutl = (const LAS float*)(lds + L_LUT);
    const int vb0 = (int)(uintptr_t)V_lds + v_rd_base(lane);
    const __amdgpu_buffer_rsrc_t hrs = __builtin_amdgcn_make_buffer_rsrc((void*)a.hbase, 0, (int)((size_t)SEQ * PITCH * 2), 0x00020000);
    const int qlo = a.qlo;
    bf16x8 st_v0, st_v1, st_k0, st_k1; float st_c = 0.f;
    static_assert(MODE != 0, "the per-key bias table would need a ring of three here");
#define SLOAD_V(k0) do { FRESH_TID(t_); const int sr = t_ >> 4, sc = (t_ & 15) * 8; const unsigned so_ = (unsigned)(k0) * (unsigned)(PITCH * 2); \
        const unsigned vo0 = (unsigned)(sr * PITCH + sc) * 2u, vo1 = vo0 + (unsigned)(32 * PITCH * 2); \
        st_v0 = __builtin_bit_cast(bf16x8, __builtin_amdgcn_raw_buffer_load_b128(hrs, vo0, so_ + a.vcolB, 0)); st_v1 = __builtin_bit_cast(bf16x8, __builtin_amdgcn_raw_buffer_load_b128(hrs, vo1, so_ + a.vcolB, 0)); } while (0)
#define SLOAD_K(k0) do { FRESH_TID(t_); const unsigned so_ = (unsigned)(k0) * (unsigned)(PITCH * 2); \
        if constexpr (DQ == 128) { const int sr = t_ >> 4, sc = (t_ & 15) * 8; const unsigned vo0 = (unsigned)(sr * PITCH + sc) * 2u, vo1 = vo0 + (unsigned)(32 * PITCH * 2); \
            st_k0 = __builtin_bit_cast(bf16x8, __builtin_amdgcn_raw_buffer_load_b128(hrs, vo0, so_ + a.kcolB, 0)); st_k1 = __builtin_bit_cast(bf16x8, __builtin_amdgcn_raw_buffer_load_b128(hrs, vo1, so_ + a.kcolB, 0)); } \
        else { const unsigned vk0 = (unsigned)((t_ >> 3) * PITCH + (t_ & 7) * 8) * 2u; st_k0 = __builtin_bit_cast(bf16x8, __builtin_amdgcn_raw_buffer_load_b128(hrs, vk0, so_ + a.kcolB, 0)); } } while (0)
#define TCL(x) ((x) < NT ? (x) : NT - 1)
#define WGBAR() do { asm volatile("s_waitcnt lgkmcnt(0)" ::: "memory"); __builtin_amdgcn_s_barrier(); asm volatile("" ::: "memory"); } while (0)
    f32x16 p0, p1; float mn = 0.f, al = 1.f; bf16x8 pa0, pa1, pa2, pa3;
    SLOAD_K(KBASE(0)); SLOAD_V(KBASE(0)); VMW(); SWRITE_K(0); SWRITE_V(0);
    SLOAD_K(KBASE(TCL(1))); SLOAD_V(KBASE(TCL(1))); VMW(); SWRITE_K(1);
    SLOAD_K(KBASE(TCL(2)));
    WGBAR();
    qkt<0, DQ>(p0, p1, K_lds, r32, hi, qr); SBAR();
    if (wid >= 4) WGBAR();
#define YPH(t, PAR) do { __builtin_amdgcn_s_setprio(PP_YPRIO); SCORES(p0, p1, (t), PAR); if constexpr (MODE == 1) { softmaxY<DQ>(p0, p1, m_reg, al, l_reg, pa0, pa1, pa2, pa3); } else { PARTIAL(p0, p1, mn, al); FINISH(p0, p1, al); } SBAR(); RESCALE(al); __builtin_amdgcn_s_setprio(0); SBAR(); } while (0)
#define XLD(t, PAR) do { VMW(); SWRITE_K(PAR); SWRITE_V((PAR) ^ 1); SLOAD_K(KBASE(TCL((t) + 3))); SLOAD_V(KBASE(TCL((t) + 2))); SBAR(); } while (0)
#define XPH(t, PAR) do { XLD(t, PAR); __builtin_amdgcn_s_setprio(PP_XPRIO); xphase<PAR, (PAR) ^ 1, DQ, true>(o, vb0, pa0, pa1, pa2, pa3, p0, p1, K_lds, r32, hi, qr); __builtin_amdgcn_s_setprio(0); SBAR(); } while (0)
#if TIME_SEG
    unsigned long long tseg = 0, tl, tstart;
#define TNOW(t_) asm volatile("s_memtime %0\n\ts_waitcnt lgkmcnt(0)" : "=s"(t_) :: "memory")
#define TST(k) do { unsigned long long t_; TNOW(t_); SBAR(); if ((TIME_SEG % 10) == (k)) tseg += t_ - tl; tl = t_; } while (0)
    TNOW(tl); tstart = tl; unsigned long long rt0 = 0; if ((TIME_SEG % 10) == 6) asm volatile("s_memrealtime %0\n\ts_waitcnt lgkmcnt(0)" : "=s"(rt0) :: "memory");
#else
#define TST(k) do { } while (0)
#endif
    int t = 0;
    for (; t + 2 < NT; t += 2) { YPH(t, 0); TST(1); WGBAR(); TST(2); XPH(t, 0); TST(3); WGBAR(); TST(4); YPH(t + 1, 1); TST(1); WGBAR(); TST(2); XPH(t + 1, 1); TST(3); WGBAR(); TST(4); }
#if TIME_SEG
    { unsigned long long ttot = tl - tstart; if ((TIME_SEG % 10) == 5) { tseg = ttot; ttot = (unsigned long long)(NT & ~1) * 10000ull; } if ((TIME_SEG % 10) == 8) { const unsigned long long base_ = (unsigned long long)(NT & ~1) * 2400ull; tseg = ttot > base_ ? ttot - base_ : 0; ttot = (unsigned long long)(NT & ~1) * 1000ull; }
      if ((TIME_SEG % 10) == 6) { unsigned long long rt1; asm volatile("s_memrealtime %0\n\ts_waitcnt lgkmcnt(0)" : "=s"(rt1) :: "memory"); tseg = ttot; ttot = (rt1 - rt0) * 10ull; }
      if (TIME_SEG != 7 && TIME_SEG != 20 && (TIME_SEG < 10) == (wid < 4) && (threadIdx.x & 63) == 0 && NT > 8) { atomicAdd((float*)(a.cb), (float)tseg * 1e-6f); atomicAdd((float*)(a.cb) + 1, (float)ttot * 1e-6f); } }
#undef TNOW
#endif
#undef TST
    if (t + 1 < NT) { YPH(t, 0); WGBAR(); XPH(t, 0); WGBAR(); YPH(t + 1, 1); WGBAR(); pv_tile<1>(o, vb0, pa0, pa1, pa2, pa3); WGBAR(); }
    else { YPH(t, 0); WGBAR(); pv_tile<0>(o, vb0, pa0, pa1, pa2, pa3); WGBAR(); }
    if (wid < 4) WGBAR();
#undef YPH
#undef XLD
#undef XPH
#undef TCL
#undef WGBAR
#undef SLOAD_K
#undef SLOAD_V

}

constexpr int M_V = 0, M_K = 4 * SHM_V, M_WS = M_K + 4 * SHM_K, M_FLAG = M_WS + NWAVES * 64 * 4, M_LUT = M_FLAG + 512, M_PRE = M_LUT + LUT_N * 4 + 256, M_END = M_PRE + 4352;
static_assert(M_END <= 147456, "MoBA-resident LDS map must stay below the control words");
__device__ __forceinline__ void moba_stage_block(const bf16* hbase, unsigned kcolB, unsigned vcolB, int n, LAS char* lds) {
    int t_ = threadIdx.x; asm volatile("" : "+v"(t_));
    const __amdgpu_buffer_rsrc_t hrs = __builtin_amdgcn_make_buffer_rsrc((void*)hbase, 0, (int)((size_t)SEQ * PITCH * 2), 0x00020000);
    const int sr = t_ >> 4, sc = (t_ & 15) * 8; const unsigned vo0 = (unsigned)(sr * PITCH + sc) * 2u, vo1 = vo0 + (unsigned)(32 * PITCH * 2);
    const int kws = KSWZ(sr, sc * 2), vst0 = v_st(sr, sc), vst1 = v_st(32 + sr, sc);
    bf16x8 k0[4], k1[4], v0[4], v1[4];
#pragma unroll
    for (int b = 0; b < 4; ++b) { const unsigned so_ = (unsigned)((n * 4 + b) * 64) * (unsigned)(PITCH * 2);
        k0[b] = __builtin_bit_cast(bf16x8, __builtin_amdgcn_raw_buffer_load_b128(hrs, vo0, so_ + kcolB, 0)); k1[b] = __builtin_bit_cast(bf16x8, __builtin_amdgcn_raw_buffer_load_b128(hrs, vo1, so_ + kcolB, 0));
        v0[b] = __builtin_bit_cast(bf16x8, __builtin_amdgcn_raw_buffer_load_b128(hrs, vo0, so_ + vcolB, 0)); v1[b] = __builtin_bit_cast(bf16x8, __builtin_amdgcn_raw_buffer_load_b128(hrs, vo1, so_ + vcolB, 0)); }
#pragma unroll
    for (int b = 0; b < 4; ++b) {
        *(LAS bf16x8*)(lds + M_K + b * SHM_K + kws) = k0[b]; *(LAS bf16x8*)(lds + M_K + b * SHM_K + kws + 32 * 256) = k1[b];
        *(LAS bf16x8*)(lds + M_V + b * SHM_V + vst0) = v0[b]; *(LAS bf16x8*)(lds + M_V + b * SHM_V + vst1) = v1[b]; }
}
__device__ __forceinline__ void moba_tiles(const ChunkArgs& a, const bf16x8* qr, float& m_reg, float& l_reg, f32x16* o, LAS char* lds) {
    constexpr int DQ = 128, MODE = 2; constexpr bool REV = false;
    int tid_ = threadIdx.x; asm volatile("" : "+v"(tid_)); const int tid = tid_, wid = __builtin_amdgcn_readfirstlane(tid >> 6), lane = tid & 63, r32 = lane & 31, hi = lane >> 5;
    LAS char* V_lds = lds + M_V; LAS char* K_lds = lds + M_K;
    LAS float* ws = (LAS float*)(lds + M_WS) + wid * 64; LAS float* al_l = ws + 32;
    LAS float* kbl = nullptr; const LAS float* lutl = (const LAS float*)(lds + M_LUT);
    const int vb0 = (int)(uintptr_t)V_lds + v_rd_base(lane);
    const int qlo = a.qlo;
    f32x16 p0, p1; float mn = 0.f, al = 1.f; bf16x8 pa0, pa1, pa2, pa3;
#define MTILE(t) do { if (KBASE(t) <= qlo + 31) { qkt<t, DQ>(p0, p1, K_lds, r32, hi, qr); SBAR(); SCORES(p0, p1, t, 0); PARTIAL(p0, p1, mn, al); RESCALE(al); FINISH(p0, p1, al); SBAR(); pv_tile<t>(o, vb0, pa0, pa1, pa2, pa3); SBAR(); } } while (0)
    MTILE(0); MTILE(1); MTILE(2); MTILE(3);
#undef MTILE
    (void)kbl; (void)ws;
}

constexpr int M_KB = M_PRE;
template <int DQ, int MODE, bool REV>
__device__ __forceinline__ void chunk_res(const ChunkArgs& a, const bf16x8* qr, float& m_reg, float& l_reg, f32x16* o, LAS char* lds) {
    int tid_ = threadIdx.x; asm volatile("" : "+v"(tid_)); const int tid = tid_, wid = __builtin_amdgcn_readfirstlane(tid >> 6), lane = tid & 63, r32 = lane & 31, hi = lane >> 5;
    const int NT = a.jb - a.ja, NP = NT >> 1;
    LAS char* V_lds = lds + M_V; LAS char* K_lds = lds + M_K;
    LAS float* ws = (LAS float*)(lds + M_WS) + wid * 64; LAS float* al_l = ws + 32;
    LAS float* kbl = (LAS float*)(lds + M_KB); const LAS float* lutl = (const LAS float*)(lds + M_LUT);
    const int vb0 = (int)(uintptr_t)V_lds + v_rd_base(lane);
    const __amdgpu_buffer_rsrc_t hrs = __builtin_amdgcn_make_buffer_rsrc((void*)a.hbase, 0, (int)((size_t)SEQ * PITCH * 2), 0x00020000);
    const int qlo = a.qlo;
    bf16x8 sk0[2], sk1[2], sv0[2], sv1[2]; float sc_[2] = {0.f, 0.f};
#define FLOAD(p) do { int t_ = threadIdx.x; asm volatile("" : "+v"(t_)); const int sr = t_ >> 4, sc = (t_ & 15) * 8; const unsigned vo0 = (unsigned)(sr * PITCH + sc) * 2u, vo1 = vo0 + (unsigned)(32 * PITCH * 2); \
        _Pragma("unroll") for (int b = 0; b < 2; ++b) { const int k0_ = KBASE(2 * (p) + b); const unsigned so_ = (unsigned)k0_ * (unsigned)(PITCH * 2); \
            if constexpr (DQ == 128) { sk0[b] = __builtin_bit_cast(bf16x8, __builtin_amdgcn_raw_buffer_load_b128(hrs, vo0, so_ + a.kcolB, 0)); sk1[b] = __builtin_bit_cast(bf16x8, __builtin_amdgcn_raw_buffer_load_b128(hrs, vo1, so_ + a.kcolB, 0)); } \
            else { const unsigned vk0 = (unsigned)((t_ >> 3) * PITCH + (t_ & 7) * 8) * 2u; sk0[b] = __builtin_bit_cast(bf16x8, __builtin_amdgcn_raw_buffer_load_b128(hrs, vk0, so_ + a.kcolB, 0)); } \
            sv0[b] = __builtin_bit_cast(bf16x8, __builtin_amdgcn_raw_buffer_load_b128(hrs, vo0, so_ + a.vcolB, 0)); sv1[b] = __builtin_bit_cast(bf16x8, __builtin_amdgcn_raw_buffer_load_b128(hrs, vo1, so_ + a.vcolB, 0)); \
            if constexpr (MODE == 0) { if (t_ < 64) sc_[b] = (a.cref - a.cb[k0_ + t_]) * (1.f / SCALE128); } } } while (0)
#define FWRITE(g) do { int t_ = threadIdx.x; asm volatile("" : "+v"(t_)); const int sr = t_ >> 4, sc = (t_ & 15) * 8, vst0 = v_st(sr, sc), vst1 = v_st(32 + sr, sc); \
        _Pragma("unroll") for (int b = 0; b < 2; ++b) { constexpr int s_ = 2 * (g); \
            if constexpr (DQ == 128) { const int kws = KSWZ(sr, sc * 2); *(LAS bf16x8*)(K_lds + (s_ + b) * SHM_K + kws) = sk0[b]; *(LAS bf16x8*)(K_lds + (s_ + b) * SHM_K + kws + 32 * 256) = sk1[b]; } \
            else { const int sr2 = t_ >> 3, sc2 = (t_ & 7) * 8, kws2 = KSWZ(sr2, sc2 * 2); *(LAS bf16x8*)(K_lds + (s_ + b) * SHM_K + kws2) = sk0[b]; } \
            *(LAS bf16x8*)(V_lds + (s_ + b) * SHM_V + vst0) = sv0[b]; *(LAS bf16x8*)(V_lds + (s_ + b) * SHM_V + vst1) = sv1[b]; \
            if constexpr (MODE == 0) { if (t_ < 64) kbl[(s_ + b) * 64 + t_] = sc_[b]; } } } while (0)
    f32x16 p0, p1; float mn = 0.f, al = 1.f; bf16x8 pa0, pa1, pa2, pa3;
#define FTILE(t, S) do { if (KBASE(t) <= qlo + 31 - (MODE == 3 ? 1 : 0)) { QKT(S, p0, p1); SBAR(); SCORES(p0, p1, (t), S); \
        if constexpr (MODE == 1) { softmaxY<DQ>(p0, p1, m_reg, al, l_reg, pa0, pa1, pa2, pa3); SBAR(); RESCALE(al); } else { PARTIAL(p0, p1, mn, al); RESCALE(al); FINISH(p0, p1, al); } \
        SBAR(); if constexpr (RES_PVDB) xphase<S, 0, DQ, false>(o, vb0, pa0, pa1, pa2, pa3, p0, p1, K_lds, r32, hi, qr); else pv_tile<S>(o, vb0, pa0, pa1, pa2, pa3); SBAR(); } } while (0)
#define FPAIR(p, g) do { __syncthreads(); \
        if ((p) + 1 < NP) { VMW(); FWRITE((g) ^ 1); if ((p) + 2 < NP) FLOAD((p) + 2); } SBAR(); \
        FTILE(2 * (p), 2 * (g)); FTILE(2 * (p) + 1, 2 * (g) + 1); } while (0)
    FLOAD(0); VMW(); FWRITE(0); if (NP > 1) FLOAD(1);
    int p = 0;
    for (; p + 1 < NP; p += 2) { FPAIR(p, 0); FPAIR(p + 1, 1); }
    if (p < NP) FPAIR(p, 0);
    __syncthreads();
#undef FPAIR
#undef FTILE
#undef FWRITE
#undef FLOAD
    (void)lutl; (void)ws; (void)tid; (void)kbl; (void)mn;
}
__device__ __forceinline__ void fox_chunk_res(const ChunkArgs& a, const bf16x8* qr, float& m_reg, float& l_reg, f32x16* o, LAS char* lds) { chunk_res<128, 0, true>(a, qr, m_reg, l_reg, o, lds); }
#undef QKT
#undef KBASE
#undef VMW
#undef SLOAD
#undef FRESH_TID
#undef FRESH_TID_W
#undef SWRITE_K
#undef SWRITE_V
#undef SWRITE
#undef SCORES
#undef RESC
#undef PARTIAL
#undef FINISH
#undef RESCALE
#undef HALF_STEP
#undef TSTAMP
#undef TSTAMP2

template <int DQ> __device__ __forceinline__ void load_q(bf16x8* qr, const bf16* qrow, int hi) {
#pragma unroll
    for (int d0 = 0; d0 < DQ / 16; ++d0) qr[d0] = *(const bf16x8*)(qrow + d0 * 16 + hi * 8);
}
__device__ __forceinline__ void load_lut(LAS char* lds, const float* lutg, float inv_scale, int off = L_LUT) {
    LAS float* l = (LAS float*)(lds + off); const float far = lutg[1023];
    int i0 = threadIdx.x; asm volatile("" : "+v"(i0));
    for (int i = i0; i < LUT_N; i += NTHREADS) l[i] = (i < LUT_PAD) ? 0.f : (lutg[i - LUT_PAD] - far) * inv_scale;
}
template <int CTRL> __device__ __forceinline__ float quad_bcast(float v) { return __builtin_bit_cast(float, __builtin_amdgcn_mov_dpp(__builtin_bit_cast(int, v), CTRL, 0xf, 0xf, true)); }
constexpr float O8_SCALE = 16.f;
__device__ __forceinline__ void store_o(const f32x16* o, const float* rl  , unsigned char* obase, int ldo, int r32, int hi) {
#pragma unroll
    for (int r = 0; r < 16; ++r) { const int orow = crow(r, hi);
#pragma unroll
        for (int d0 = 0; d0 < 4; ++d0) { const float v = o[d0][r] * rl[r] * O8_SCALE; const float v1 = quad_bcast<0x55>(v), v2 = quad_bcast<0xAA>(v), v3 = quad_bcast<0xFF>(v);
            if ((r32 & 3) == 0) *(unsigned*)(obase + (size_t)orow * ldo + d0 * 32 + r32) = pk4_fp8(v, v1, v2, v3); } }
}
}

__device__ __forceinline__ void fox_epilogue(const att::f32x16* o, float l_reg, LAS char* lds, unsigned char* oblk, int ldo, int ws_off = att::L_WS) {
    int t_ = threadIdx.x; asm volatile("" : "+v"(t_)); const int wid = __builtin_amdgcn_readfirstlane(t_ >> 6), r32 = t_ & 31, hi = (t_ >> 5) & 1;
    LAS float* li_l = (LAS float*)(lds + ws_off) + wid * 64;
    if (hi == 0) li_l[r32] = l_reg; asm volatile("s_waitcnt lgkmcnt(0)" ::: "memory");
    float rli[16];
#pragma unroll
    for (int r = 0; r < 16; ++r) rli[r] = __builtin_amdgcn_rcpf(li_l[att::crow(r, hi)]);
    att::store_o(o, rli, oblk + (size_t)(wid * 32) * ldo, ldo, r32, hi);
    __syncthreads();
}
constexpr int CW_KMAX = 10496;
__device__ __forceinline__ void fox_block(const Args& A, LAS char* lds, int hd, int qb, unsigned char* obuf, int ldo, int ocol) {
    int tid_ = threadIdx.x; asm volatile("" : "+v"(tid_)); const int tid = tid_, wid = __builtin_amdgcn_readfirstlane(tid >> 6), lane = tid & 63, r32 = lane & 31, hi = lane >> 5;
    const bf16* h = (const bf16*)(A.ws + WS_H); const int P0 = qb * 256;
    const float* cg = (const float*)(A.ws + WS_C) + hd * SEQ;
    bf16x8 qr[8]; att::load_q<128>(qr, h + (size_t)(P0 + wid * 32 + r32) * NQKV + hd * 128, hi);
    att::ChunkArgs ca; ca.hbase = h; ca.kcolB = (unsigned)(1024 + hd * 128) * 2u; ca.vcolB = (unsigned)(2048 + hd * 128) * 2u;
    ca.qpos = P0 + wid * 32 + r32; ca.qlo = P0 + wid * 32; ca.cb = cg; ca.cref = cg[P0];
    ca.tprobe = (float*)(A.ws + WS_CTL) + 10240;
    float m_reg = -1e30f, l_reg = 0.f; att::f32x16 o[4] = {};
    LAS int* flg = (LAS int*)(lds + (FOX_RES ? att::M_FLAG : att::L_FLAG));
    int jb = P0 / 64 + 4;
    for (;;) {
        const int ja = jb > FOX_CH ? jb - FOX_CH : 0;
        ca.ja = ja; ca.jb = jb;
#if FOX_RES
        att::fox_chunk_res(ca, qr, m_reg, l_reg, o, lds);
#else
        att::attn_chunk<128, 0, true>(ca, qr, m_reg, l_reg, o, lds);
#endif
        if (ja == 0) break;
        float qn2 = 0.f;
#pragma unroll
        for (int d0 = 0; d0 < 8; ++d0)
#pragma unroll
            for (int j = 0; j < 8; ++j) { const float v = bf2f((unsigned short)qr[d0][j]); qn2 += v * v; }
        { auto rr = __builtin_amdgcn_permlane32_swap(__float_as_uint(qn2), __float_as_uint(qn2), false, false); qn2 = __uint_as_float(rr[0]) + __uint_as_float(rr[1]); }
        const float kmax2 = __uint_as_float(__hip_atomic_load((unsigned*)(A.ws + WS_CTL) + CW_KMAX + hd, RLX_AGENT));
        const float qk_bound = sqrtf(qn2 * kmax2) * 1.001f;
        const float kb_low = (ca.cref - cg[ja * 64]) * (1.f / SCALE128);
        const int done = __all((qk_bound + kb_low - m_reg) * (1.4426950408889634f * SCALE128) < -152.f) ? 1 : 0;
        { int t_ = threadIdx.x; asm volatile("" : "+v"(t_)); if ((t_ & 63) == 0) flg[t_ >> 6] = done; }
        __syncthreads();
        int all = 1;
#pragma unroll
        for (int w = 0; w < NWAVES; ++w) all &= flg[w];
        __syncthreads();
        if (all) break;
        jb = ja;
    }
    fox_epilogue(o, l_reg, lds, obuf + (size_t)P0 * ldo + ocol, ldo, FOX_RES ? att::M_WS : att::L_WS);
}

template <int MP>
__device__ __forceinline__ void diff_map(const Args& A, LAS char* lds, int hd, int qb, unsigned char* obuf) {
    int tid_ = threadIdx.x; asm volatile("" : "+v"(tid_)); const int tid = tid_, wid = __builtin_amdgcn_readfirstlane(tid >> 6), lane = tid & 63, r32 = lane & 31, hi = lane >> 5;
    const bf16* h = (const bf16*)(A.ws + WS_H); const int P0 = qb * 256;
#if DIFF_RES
    unsigned short* stash = (unsigned short*)(A.ws + WS_DSTASH) + ((size_t)blockIdx.x * NWAVES + wid) * 4096 + lane;
    LAS float* li_l = (LAS float*)(lds + att::M_WS) + wid * 64;
#else
    LAS unsigned short* stash = (LAS unsigned short*)(lds + att::L_STASH) + wid * 4096 + lane;
    LAS float* li_l = (LAS float*)(lds + att::L_WS) + wid * 64;
#endif
    bf16x8 qr[4]; att::load_q<64>(qr, h + (size_t)(P0 + wid * 32 + r32) * NQKV + hd * 128 + MP * 64, hi);
    att::ChunkArgs ca; ca.hbase = h; ca.kcolB = (unsigned)(1024 + hd * 128 + MP * 64) * 2u; ca.vcolB = (unsigned)(2048 + hd * 128) * 2u;
    ca.ja = 0; ca.jb = P0 / 64 + 4; ca.qpos = P0 + wid * 32 + r32; ca.qlo = P0 + wid * 32; ca.cb = TIME_SEG ? (const float*)(A.ws + WS_CTL) + 10240 : nullptr; ca.cref = 0.f;
    float m_reg = -1e30f, l_reg = 0.f;
    att::f32x16 o[4] = {};
#if DIFF_RES
    att::chunk_res<64, 1, false>(ca, qr, m_reg, l_reg, o, lds);
#elif PP_DIFF
    att::attn_chunk_pp<64, 1, false>(ca, qr, m_reg, l_reg, o, lds);
#else
    att::attn_chunk<64, 1, false>(ca, qr, m_reg, l_reg, o, lds);
#endif
    if (hi == 0) li_l[r32] = l_reg; asm volatile("s_waitcnt lgkmcnt(0)" ::: "memory");
    if constexpr (MP == 0) {
#pragma unroll
        for (int r = 0; r < 16; ++r) { const float rl = __builtin_amdgcn_rcpf(li_l[att::crow(r, hi)]);
#pragma unroll
            for (int d0 = 0; d0 < 4; ++d0) stash[(r * 4 + d0) * 64] = (unsigned short)f2bf(o[d0][r] * rl); }
    } else {
        const float lam = ((const float*)(A.ws + WS_LAM))[0];
        unsigned char* ob = obuf + (size_t)(P0 + wid * 32) * DM + hd * 128;
#pragma unroll
        for (int r = 0; r < 16; ++r) { const float rl = lam * __builtin_amdgcn_rcpf(li_l[att::crow(r, hi)]); float v[4]; float ss = 0.f;
#pragma unroll
            for (int d0 = 0; d0 < 4; ++d0) { v[d0] = bf2f(stash[(r * 4 + d0) * 64]) - o[d0][r] * rl; ss += v[d0] * v[d0]; }
            ss += __shfl_xor(ss, 1); ss += __shfl_xor(ss, 2); ss += __shfl_xor(ss, 4); ss += __shfl_xor(ss, 8); ss += __shfl_xor(ss, 16);
            const float sc = rsqrtf(ss * (1.f / 128.f) + LN_EPS) * (1.f - LAMBDA_INIT); const int orow = att::crow(r, hi);
#pragma unroll
            for (int d0 = 0; d0 < 4; ++d0) { const float w = v[d0] * sc * A.subln_gain[d0 * 32 + r32] * att::O8_SCALE; const float w1 = att::quad_bcast<0x55>(w), w2 = att::quad_bcast<0xAA>(w), w3 = att::quad_bcast<0xFF>(w);
                if ((r32 & 3) == 0) *(unsigned*)(ob + (size_t)orow * DM + d0 * 32 + r32) = pk4_fp8(w, w1, w2, w3); } }
    }
    __syncthreads();
}
__device__ __forceinline__ void diff_block(const Args& A, LAS char* lds, int hd, int qb, unsigned char* obuf) {
    att::load_lut(lds, (const float*)(A.ws + WS_LUT) + hd * 1024, 1.f / SCALE64, DIFF_RES ? att::M_LUT : att::L_LUT);
    diff_map<0>(A, lds, hd, qb, obuf);
    diff_map<1>(A, lds, hd, qb, obuf);
}

__device__ __forceinline__ void sb_block(const Args& A, LAS char* lds, int hd, int qb, unsigned char* obuf) {
    int tid_ = threadIdx.x; asm volatile("" : "+v"(tid_)); const int tid = tid_, wid = __builtin_amdgcn_readfirstlane(tid >> 6), lane = tid & 63, r32 = lane & 31, hi = lane >> 5;
    const bf16* h = (const bf16*)(A.ws + WS_H); const int P0 = qb * 256;
    bf16x8 qr[8]; att::load_q<128>(qr, h + (size_t)(P0 + wid * 32 + r32) * NQKV + 3072 + hd * 128, hi);
    att::ChunkArgs ca; ca.hbase = h; ca.kcolB = (unsigned)(4096 + hd * 128) * 2u; ca.vcolB = (unsigned)(5120 + hd * 128) * 2u;
    ca.qpos = P0 + wid * 32 + r32; ca.qlo = P0 + wid * 32; ca.cb = nullptr; ca.cref = 0.f;
    float R2 = 0.f, l_dummy = 0.f; att::f32x16 o[4] = {};
    LAS int* flg = (LAS int*)(lds + (SB_RES ? att::M_FLAG : att::L_FLAG));
    int jb = P0 / 64 + 4;
    for (;;) {
#if SB_NOCHUNK
        const int ja = 0;
#else
        const int ja = jb > 8 ? jb - 8 : 0;
#endif
        ca.ja = ja; ca.jb = jb;
#if SB_RES
        att::chunk_res<128, 3, true>(ca, qr, R2, l_dummy, o, lds);
#elif PP_SB
        att::attn_chunk_pp<128, 3, true>(ca, qr, R2, l_dummy, o, lds);
#else
        att::attn_chunk<128, 3, true>(ca, qr, R2, l_dummy, o, lds);
#endif
        const int done = __all(R2 < -150.1f) ? 1 : 0;
        if (lane == 0) flg[wid] = done;
        __syncthreads();
        int all = 1;
#pragma unroll
        for (int w = 0; w < NWAVES; ++w) all &= flg[w];
        __syncthreads();
        if (all || ja == 0) break;
        jb = ja;
    }
#if SB_R2PROBE
    { float rm = fmaxf(R2, 0.f); for (int o_ = 1; o_ < 64; o_ <<= 1) rm = fmaxf(rm, __shfl_xor(rm, o_));
      if (lane == 0) { atomicMax((unsigned*)(A.ws + WS_CTL) + 10240, __float_as_uint(rm)); __hip_atomic_store((float*)(A.ws + WS_CTL) + 10241, 1.f, RLX_AGENT); } }
#endif
    float one[16];
#pragma unroll
    for (int r = 0; r < 16; ++r) one[r] = 1.f;
    att::store_o(o, one, obuf + (size_t)(P0 + wid * 32) * DM + (8 + hd) * 128, DM, r32, hi);
    __syncthreads();
}

__device__ __forceinline__ void sb_unit_test(const Args& A, float sentinel) {
    const int lane = threadIdx.x & 63, r32 = lane & 31, hi = lane >> 5;
    float maxerr = 0.f;
    for (int pat = 0; pat < 4; ++pat) {
        att::f32x16 p0, p1; float R2 = (pat == 3) ? -20.f : 0.f; const float R2in = R2;
        const int lim = (pat == 0) ? 64 : (pat == 1) ? (r32 * 2 + 1) : (pat == 2) ? (r32 < 16 ? 0 : 40) : 33;
#define ZRAW(k) (((k) >= lim) ? sentinel : (25.f * __sinf(0.37f * (float)(k) + 0.11f * (float)r32 + (float)pat)))
#pragma unroll
        for (int r = 0; r < 16; ++r) { p0[r] = ZRAW(att::crow(r, hi)); p1[r] = ZRAW(32 + att::crow(r, hi)); }
        att::sb_half(p1, R2, hi); att::sb_half(p0, R2, hi);
        constexpr float C2 = 1.4426950408889634f * SCALE128;
        float Rr = R2in;
        for (int k = 63; k >= 0; --k) { const float z2 = ZRAW(k) * C2; const float sp = fmaxf(z2, 0.f) + log2f(1.f + exp2f(-fabsf(z2))); const float aref = exp2f(z2 - sp + Rr); Rr -= sp;
#pragma unroll
            for (int r = 0; r < 16; ++r) { if (att::crow(r, hi) == k) maxerr = fmaxf(maxerr, fabsf(p0[r] - aref)); if (32 + att::crow(r, hi) == k) maxerr = fmaxf(maxerr, fabsf(p1[r] - aref)); }
            if (!(aref == aref)) maxerr = 1e9f; }
        maxerr = fmaxf(maxerr, fabsf(R2 - Rr) * 1e-3f);
        if (!(R2 == R2)) maxerr = 1e9f;
#pragma unroll
        for (int r = 0; r < 16; ++r) if (!(p0[r] == p0[r]) || !(p1[r] == p1[r])) maxerr = 1e9f;
#undef ZRAW
    }
    for (int o_ = 1; o_ < 64; o_ <<= 1) maxerr = fmaxf(maxerr, __shfl_xor(maxerr, o_));
    if (lane == 0) { atomicMax((unsigned*)(A.ws + WS_CTL) + 10240, __float_as_uint(maxerr)); __hip_atomic_store((float*)(A.ws + WS_CTL) + 10241, 1.f, RLX_AGENT); }
}

__device__ __forceinline__ void p3_gate_mfma(const Args& A, LAS char* lds, int G, int* sel) {
    int tid_ = threadIdx.x; asm volatile("" : "+v"(tid_)); const int tid = tid_, wid = __builtin_amdgcn_readfirstlane(tid >> 6), lane = tid & 63, r32 = lane & 31, hi = lane >> 5;
    const bf16* h = (const bf16*)(A.ws + WS_H);
    char* ldsg = (char*)lds; float* scal = (float*)(ldsg + 65536); int* lcnt = (int*)(ldsg + 66560); int* gbs = lcnt + 64;
    for (int u = blockIdx.x; u < 1024; u += G) {
        if (u < 512) {
            const int hd = u >> 6, qb = (u & 256) ? 63 - (u & 63) : (u & 63);
            const float* kmg = (const float*)(A.ws + WS_KMEAN) + (size_t)hd * 64 * 128;
            {   const int sr = tid >> 4, sc = (tid & 15) * 8, kws = KSWZ(sr, sc * 2);
#pragma unroll
                for (int half = 0; half < 2; ++half) { const float* src = kmg + (size_t)(sr + 32 * half) * 128 + sc;
                    const f32x4 a = *(const f32x4*)src, b = *(const f32x4*)(src + 4);
                    const float v[8] = {a[0], a[1], a[2], a[3], b[0], b[1], b[2], b[3]};
                    unsigned wh[4], wl[4], wm[4];
#pragma unroll
                    for (int e = 0; e < 4; ++e) {
                        const unsigned short h0 = f2bf(v[2 * e]), h1 = f2bf(v[2 * e + 1]); const float r0 = v[2 * e] - bf2f(h0), r1 = v[2 * e + 1] - bf2f(h1);
                        const unsigned short l0 = f2bf(r0), l1 = f2bf(r1); const float q0 = r0 - bf2f(l0), q1 = r1 - bf2f(l1);
                        wh[e] = (unsigned)h0 | ((unsigned)h1 << 16); wl[e] = (unsigned)l0 | ((unsigned)l1 << 16); wm[e] = (unsigned)f2bf(q0) | ((unsigned)f2bf(q1) << 16); }
                    *(LAS v4u*)(lds + att::L_K + 0 * att::SHM_K + kws + half * 32 * 256) = (v4u){wh[0], wh[1], wh[2], wh[3]};
                    *(LAS v4u*)(lds + att::L_K + 1 * att::SHM_K + kws + half * 32 * 256) = (v4u){wl[0], wl[1], wl[2], wl[3]};
                    *(LAS v4u*)(lds + att::L_V + 0 * att::SHM_K + kws + half * 32 * 256) = (v4u){wm[0], wm[1], wm[2], wm[3]}; } }
            if (tid < 64) lcnt[tid] = 0;
            const int t = qb * 256 + wid * 32 + r32;
            bf16x8 qr[8]; att::load_q<128>(qr, h + (size_t)t * NQKV + 3072 + hd * 128, hi);
            __syncthreads();
            att::f32x16 p0, p1;
            att::qkt<0, 128>(p0, p1, lds + att::L_K, r32, hi, qr); SBAR();
            att::qkt<1, 128, true>(p0, p1, lds + att::L_K, r32, hi, qr); SBAR();
            att::qkt<0, 128, true>(p0, p1, lds + att::L_V, r32, hi, qr); SBAR();
            float v0 = -3e38f, v1 = -3e38f, v2 = -3e38f; int i0 = 0, i1 = 1, i2 = 2;
#define G_INS(s_, n_) do { const float gs_ = (s_); const int gn_ = (n_); \
                if (gs_ > v0) { v2 = v1; i2 = i1; v1 = v0; i1 = i0; v0 = gs_; i0 = gn_; } else if (gs_ > v1) { v2 = v1; i2 = i1; v1 = gs_; i1 = gn_; } else if (gs_ > v2) { v2 = gs_; i2 = gn_; } } while (0)
#pragma unroll
            for (int r = 0; r < 16; ++r) { const int n = (r & 3) + 8 * (r >> 2) + 4 * hi; G_INS(n < qb ? p0[r] : -3e38f, n); }
#pragma unroll
            for (int r = 0; r < 16; ++r) { const int n = 32 + (r & 3) + 8 * (r >> 2) + 4 * hi; G_INS(n < qb ? p1[r] : -3e38f, n); }
#undef G_INS
            float ov[3]; int oi[3];
            { const float mv[3] = {v0, v1, v2}; const int mi[3] = {i0, i1, i2};
#pragma unroll
              for (int k = 0; k < 3; ++k) { auto rv = __builtin_amdgcn_permlane32_swap(__float_as_uint(mv[k]), __float_as_uint(mv[k]), false, false); auto ri = __builtin_amdgcn_permlane32_swap((unsigned)mi[k], (unsigned)mi[k], false, false);
                  ov[k] = __uint_as_float(hi ? rv[0] : rv[1]); oi[k] = (int)(hi ? ri[0] : ri[1]); } }
#define G_BEF(sa, na, sb, nb) ((sa) > (sb) || ((sa) == (sb) && (na) < (nb)))
#pragma unroll
            for (int k = 0; k < 3; ++k) { const float s = ov[k]; const int n = oi[k];
                if (s > -1e38f) {
                    if (G_BEF(s, n, v0, i0)) { v2 = v1; i2 = i1; v1 = v0; i1 = i0; v0 = s; i0 = n; } else if (G_BEF(s, n, v1, i1)) { v2 = v1; i2 = i1; v1 = s; i1 = n; } else if (G_BEF(s, n, v2, i2)) { v2 = s; i2 = n; } } }
#undef G_BEF
            const int nsel = qb < 3 ? qb : 3;
            if (hi == 0) *(int4*)(sel + ((size_t)hd * SEQ + t) * 4) = make_int4(i0, i1, i2, nsel);
            int lp0 = 0, lp1 = 0, lp2 = 0;
            if (hi == 0) { if (nsel > 0) lp0 = atomicAdd(&lcnt[i0], 1); if (nsel > 1) lp1 = atomicAdd(&lcnt[i1], 1); if (nsel > 2) lp2 = atomicAdd(&lcnt[i2], 1); }
            __syncthreads();
            if (tid < 64) { const int c = lcnt[tid]; gbs[tid] = c > 0 ? (int)__hip_atomic_fetch_add((unsigned*)(A.ws + WS_CTL) + CW_MOBACNT + hd * 64 + tid, (unsigned)c, RLX_AGENT) : 0; }
            __syncthreads();
            if (hi == 0) { int* ml = (int*)((unsigned char*)A.out + (4u << 20)) + (size_t)hd * 64 * SEQ;
                if (nsel > 0) ml[(size_t)i0 * SEQ + gbs[i0] + lp0] = t * 4 + 0;
                if (nsel > 1) ml[(size_t)i1 * SEQ + gbs[i1] + lp1] = t * 4 + 1;
                if (nsel > 2) ml[(size_t)i2 * SEQ + gbs[i2] + lp2] = t * 4 + 2; }
            __syncthreads();
        } else {
            const int v = u - 512, hd = v >> 6, ch = v & 63;
            if (wid == 0) { float x = (lane < ch) ? ((const float*)(A.ws + WS_CTOT))[hd * 64 + lane] : 0.f; x = wave_sum(x); if (lane == 0) scal[0] = x; }
            __syncthreads();
            if (tid < 256) ((float*)(A.ws + WS_C))[hd * SEQ + ch * 256 + tid] = ((const float*)(A.ws + WS_CLOC))[hd * SEQ + ch * 256 + tid] + scal[0];
            __syncthreads();
        }
    }
}

constexpr size_t DO_LSE = 2 * MiB, DO_MLIST = 4 * MiB;
__device__ __forceinline__ void moba_block(const Args& A, LAS char* lds, int hd, int n, int chunk  , int cnt) {
    int tid_ = threadIdx.x; asm volatile("" : "+v"(tid_)); const int tid = tid_, wid = __builtin_amdgcn_readfirstlane(tid >> 6), lane = tid & 63, r32 = lane & 31, hi = lane >> 5;
    const bf16* h = (const bf16*)(A.ws + WS_H);
    int t, slot, valid;
    if (chunk < 0) { t = n * 256 + wid * 32 + r32; slot = 3; valid = 1; }
    else { const int idx = chunk * 256 + wid * 32 + r32; valid = idx < cnt; const int ent = valid ? ((const int*)((const unsigned char*)A.out + DO_MLIST))[(size_t)(hd * 64 + n) * SEQ + idx] : (SEQ - 1) * 4; t = ent >> 2; slot = ent & 3; }
    bf16x8 qr[8]; att::load_q<128>(qr, h + (size_t)t * NQKV + 3072 + hd * 128, hi);
    att::ChunkArgs ca; ca.hbase = h; ca.kcolB = (unsigned)(4096 + hd * 128) * 2u; ca.vcolB = (unsigned)(5120 + hd * 128) * 2u;
    ca.ja = n * 4; ca.jb = n * 4 + 4; ca.qpos = t; ca.qlo = 0; ca.cb = nullptr; ca.cref = 0.f;
    float m_reg = -1e30f, l_reg = 0.f; att::f32x16 o[4] = {};
    att::attn_chunk<128, 2, false>(ca, qr, m_reg, l_reg, o, lds);
    LAS float* li_l = (LAS float*)(lds + att::L_WS) + wid * 64; LAS int* dst_l = (LAS int*)(li_l + 32);
    const int dst = valid ? ((hd * SEQ + t) * 4 + slot) : -1;
    if (hi == 0) { li_l[r32] = l_reg; dst_l[r32] = dst;
        if (valid) ((float*)((unsigned char*)A.out + DO_LSE))[dst] = m_reg * (1.4426950408889634f * SCALE128) + __builtin_amdgcn_logf(l_reg); }
    asm volatile("s_waitcnt lgkmcnt(0)" ::: "memory");
    bf16* part = (bf16*)(A.ws + WS_Y);
#pragma unroll
    for (int r = 0; r < 16; ++r) { const int row = att::crow(r, hi); const int d = dst_l[row]; const float rl = __builtin_amdgcn_rcpf(li_l[row]);
#pragma unroll
        for (int d0 = 0; d0 < 4; ++d0) { const float v = o[d0][r] * rl; const float vn = __shfl_xor(v, 1);
            if ((r32 & 1) == 0 && d >= 0) *(unsigned*)(part + (size_t)d * 128 + d0 * 32 + r32) = att::cvtpk(v, vn); } }
    __syncthreads();
}
__device__ __forceinline__ void moba_unit_res(const Args& A, LAS char* lds, int hd, int n, int chunk  , int cnt) {
    int tid_ = threadIdx.x; asm volatile("" : "+v"(tid_)); const int tid = tid_, wid = __builtin_amdgcn_readfirstlane(tid >> 6), lane = tid & 63, r32 = lane & 31, hi = lane >> 5;
    const bf16* h = (const bf16*)(A.ws + WS_H);
    int t, slot, valid;
    if (chunk < 0) { t = n * 256 + wid * 32 + r32; slot = 3; valid = 1; }
    else { const int idx = chunk * 256 + wid * 32 + r32; valid = idx < cnt; const int ent = valid ? ((const int*)((const unsigned char*)A.out + DO_MLIST))[(size_t)(hd * 64 + n) * SEQ + idx] : (SEQ - 1) * 4; t = ent >> 2; slot = ent & 3; }
    if (chunk >= 0 && chunk * 256 + wid * 32 >= cnt) return;
    bf16x8 qr[8]; att::load_q<128>(qr, h + (size_t)t * NQKV + 3072 + hd * 128, hi);
    att::ChunkArgs ca; ca.hbase = h; ca.kcolB = 0; ca.vcolB = 0; ca.ja = n * 4; ca.jb = n * 4 + 4; ca.qpos = t; ca.qlo = (chunk < 0) ? n * 256 + wid * 32 : (1 << 29); ca.cb = nullptr; ca.cref = 0.f; ca.tprobe = nullptr;
    float m_reg = -1e30f, l_reg = 0.f; att::f32x16 o[4] = {};
    att::moba_tiles(ca, qr, m_reg, l_reg, o, lds);
    LAS float* li_l = (LAS float*)(lds + att::M_WS) + wid * 64; LAS int* dst_l = (LAS int*)(li_l + 32);
    const int dst = valid ? ((hd * SEQ + t) * 4 + slot) : -1;
    if (hi == 0) { li_l[r32] = l_reg; dst_l[r32] = dst;
        if (valid) ((float*)((unsigned char*)A.out + DO_LSE))[dst] = m_reg * (1.4426950408889634f * SCALE128) + __builtin_amdgcn_logf(l_reg); }
    asm volatile("s_waitcnt lgkmcnt(0)" ::: "memory");
    bf16* part = (bf16*)(A.ws + WS_Y);
#pragma unroll
    for (int r = 0; r < 16; ++r) { const int row = att::crow(r, hi); const int d = dst_l[row]; const float rl = __builtin_amdgcn_rcpf(li_l[row]);
#pragma unroll
        for (int d0 = 0; d0 < 4; ++d0) { const float v = o[d0][r] * rl; const float vn = __shfl_xor(v, 1);
            if ((r32 & 1) == 0 && d >= 0) *(unsigned*)(part + (size_t)d * 128 + d0 * 32 + r32) = att::cvtpk(v, vn); } }
    asm volatile("s_waitcnt lgkmcnt(0)" ::: "memory");
}
__device__ __forceinline__ void moba_phase_res(const Args& A, LAS char* lds, int G) {
    int curhd = -1;
    for (;;) {
        const int g = next_item(A, CW_QM, (LAS int*)(lds + att::M_FLAG + 64)); if (g >= 512) break;
        const int n = g >> 3, hd = g & 7;
        const int cnt = (int)__hip_atomic_load((unsigned*)(A.ws + WS_CTL) + CW_MOBACNT + hd * 64 + n, RLX_AGENT);
        if (hd != curhd) { att::load_lut(lds, (const float*)(A.ws + WS_LUT) + hd * 1024, 1.f / SCALE128, att::M_LUT); curhd = hd; }
        att::moba_stage_block((const bf16*)(A.ws + WS_H), (unsigned)(4096 + hd * 128) * 2u, (unsigned)(5120 + hd * 128) * 2u, n, lds);
        __syncthreads();
        const int nch = (cnt + 255) >> 8;
        for (int c = -1; c < nch; ++c) moba_unit_res(A, lds, hd, n, c, cnt);
    }
}
__device__ __forceinline__ void moba_phase(const Args& A, LAS char* lds, int G) {
    const int tid = fresh_tid();
    LAS int* pre = (LAS int*)(lds + att::L_STASH);
    LAS int* cnts = pre + 520;
    if (tid < 512) { const int c = (int)__hip_atomic_load((unsigned*)(A.ws + WS_CTL) + CW_MOBACNT + tid, RLX_AGENT); cnts[tid] = c; pre[tid] = (c + 255) >> 8; }
    __syncthreads();
    if (tid == 0) { int acc = 0; for (int i = 0; i < 512; ++i) { const int v = pre[i]; pre[i] = acc; acc += v; } pre[512] = acc; }
    __syncthreads();
    const int total = 512 + pre[512];
    int curhd = -1;
    for (;;) {
        const int u = next_item(A, CW_QM, (LAS int*)(lds + att::L_FLAG + 64)); if (u >= total) break;
        int hn, chunk;
        if (u < 512) { hn = u; chunk = -1; }
        else { const int g = u - 512; int lo = 0, hi_ = 511;
            while (lo < hi_) { const int mid = (lo + hi_ + 1) >> 1; if (pre[mid] <= g) lo = mid; else hi_ = mid - 1; }
            hn = lo; chunk = g - pre[hn]; }
        const int hd = hn >> 6, n = hn & 63;
        if (hd != curhd) { att::load_lut(lds, (const float*)(A.ws + WS_LUT) + hd * 1024, 1.f / SCALE128); curhd = hd; }
        moba_block(A, lds, hd, n, chunk, cnts[hn]);
    }
}
__device__ __forceinline__ void moba_combine(const Args& A, int G, unsigned char* obuf) {
    const int tid = fresh_tid();
    const float* lse = (const float*)((const unsigned char*)A.out + DO_LSE); const bf16* part = (const bf16*)(A.ws + WS_Y);
    for (int i = blockIdx.x * NTHREADS + tid; i < 8 * SEQ * 16; i += G * NTHREADS) { const int it = i >> 4, c8 = (i & 15) * 8; const int hd = it >> 14, t = it & (SEQ - 1);
        const int own = t >> 8, nsel = own < 3 ? own : 3; const size_t base = ((size_t)hd * SEQ + t) * 4;
        const f32x4 lv = *(const f32x4*)(lse + base);
        v4u pw[4];
#pragma unroll
        for (int j = 0; j < 4; ++j) pw[j] = *(const v4u*)(part + (base + j) * 128 + c8);
        float l[4] = {lv.x, lv.y, lv.z, lv.w}; float mx = l[3];
#pragma unroll
        for (int j = 0; j < 3; ++j) { l[j] = (j < nsel) ? l[j] : -3e38f; mx = fmaxf(mx, l[j]); }
        float w[4], ws_ = 0.f;
#pragma unroll
        for (int j = 0; j < 4; ++j) { w[j] = (j == 3 || j < nsel) ? __builtin_amdgcn_exp2f(l[j] - mx) : 0.f; ws_ += w[j]; }
        const float inv = 1.f / ws_; float a[8] = {0, 0, 0, 0, 0, 0, 0, 0};
#pragma unroll
        for (int j = 0; j < 4; ++j) { const float wj = w[j] * inv; const bool on = (j == 3 || j < nsel);
            a[0] += on ? wj * bflo(pw[j].x) : 0.f; a[1] += on ? wj * bfhi(pw[j].x) : 0.f; a[2] += on ? wj * bflo(pw[j].y) : 0.f; a[3] += on ? wj * bfhi(pw[j].y) : 0.f;
            a[4] += on ? wj * bflo(pw[j].z) : 0.f; a[5] += on ? wj * bfhi(pw[j].z) : 0.f; a[6] += on ? wj * bflo(pw[j].w) : 0.f; a[7] += on ? wj * bfhi(pw[j].w) : 0.f; }
        v2u o; o.x = pk4_fp8(a[0] * att::O8_SCALE, a[1] * att::O8_SCALE, a[2] * att::O8_SCALE, a[3] * att::O8_SCALE); o.y = pk4_fp8(a[4] * att::O8_SCALE, a[5] * att::O8_SCALE, a[6] * att::O8_SCALE, a[7] * att::O8_SCALE);
        *(v2u*)(obuf + (size_t)t * DM + (8 + hd) * 128 + c8) = o; }
}


template <bool RES_F32>
__device__ __forceinline__ void p_ln1_router(const Args& A, char* lds, int G, int layer, const void* xres, const bf16* y, bf16* x1) {
    const int tid = fresh_tid(), lane = tid & 63, wave = tid >> 6;
    constexpr int WP = DM + 4;
    float* wT = (float*)lds; int* rinfo = (int*)(lds + 131584); int* lcnt = (int*)(lds + 139776); int* gbase = lcnt + 16;
    for (int idx = tid; idx < 16 * DM; idx += NTHREADS) { const int d = idx >> 4, e = idx & 15; const int pos = 256 * (2 * (d >> 9) + ((d >> 2) & 1)) + 4 * ((d >> 3) & 63) + (d & 3); wT[e * WP + pos] = A.w_router[idx]; }
    if (tid < 16) lcnt[tid] = 0;
    __syncthreads();
    const int rows_per = (SEQ + G - 1) / G; const int row0 = blockIdx.x * rows_per; int nrows = SEQ - row0; nrows = nrows < 0 ? 0 : (nrows > rows_per ? rows_per : nrows);
    const float* gain = A.ln_gain + (size_t)(layer * 2 + 0) * DM; const float* bias = A.ln_bias + (size_t)(layer * 2 + 0) * DM;
    auto ln_row = [&](int m, f32x4 (&v)[8]) __attribute__((always_inline)) {
        float s = 0.f; int lane = tid & 63; asm volatile("" : "+v"(lane));
#pragma unroll
        for (int j = 0; j < 4; ++j) {
            f32x4 x0, x1v;
            if constexpr (RES_F32) { const f32x4* xp = (const f32x4*)((const float*)xres + (size_t)m * DM) + 2 * lane + 128 * j; x0 = xp[0]; x1v = xp[1]; }
            else { const v4u w = *((const v4u*)((const bf16*)xres + (size_t)m * DM) + lane + 64 * j); x0 = (f32x4){bflo(w.x), bfhi(w.x), bflo(w.y), bfhi(w.y)}; x1v = (f32x4){bflo(w.z), bfhi(w.z), bflo(w.w), bfhi(w.w)}; }
            const v4u yw = *((const v4u*)(y + (size_t)m * DM) + lane + 64 * j);
            v[2 * j] = x0 * ALPHA + (f32x4){bflo(yw.x), bfhi(yw.x), bflo(yw.y), bfhi(yw.y)}; v[2 * j + 1] = x1v * ALPHA + (f32x4){bflo(yw.z), bfhi(yw.z), bflo(yw.w), bfhi(yw.w)};
            s += ((v[2 * j].x + v[2 * j].y) + (v[2 * j].z + v[2 * j].w)) + ((v[2 * j + 1].x + v[2 * j + 1].y) + (v[2 * j + 1].z + v[2 * j + 1].w)); }
        const float mean = wave_sum(s) * (1.f / DM); float s2 = 0.f;
#pragma unroll
        for (int j = 0; j < 8; ++j) { v[j] = v[j] - mean; s2 += (v[j].x * v[j].x + v[j].y * v[j].y) + (v[j].z * v[j].z + v[j].w * v[j].w); }
        const float rstd = rsqrtf(wave_sum(s2) * (1.f / DM) + LN_EPS);
#pragma unroll
        for (int j = 0; j < 4; ++j) {
            const f32x4 g0 = *((const f32x4*)gain + 2 * lane + 128 * j), g1 = *((const f32x4*)gain + 2 * lane + 128 * j + 1), b0 = *((const f32x4*)bias + 2 * lane + 128 * j), b1 = *((const f32x4*)bias + 2 * lane + 128 * j + 1);
            v[2 * j] = v[2 * j] * rstd * g0 + b0; v[2 * j + 1] = v[2 * j + 1] * rstd * g1 + b1;
            const f32x4 o0 = v[2 * j], o1 = v[2 * j + 1];
            v4u w; w.x = pk2(o0.x, o0.y); w.y = pk2(o0.z, o0.w); w.z = pk2(o1.x, o1.y); w.w = pk2(o1.z, o1.w); *((v4u*)(x1 + (size_t)m * DM) + lane + 64 * j) = w;
            v2u f; f.x = pk4_fp8(o0.x, o0.y, o0.z, o0.w); f.y = pk4_fp8(o1.x, o1.y, o1.z, o1.w); *((v2u*)(A.ws + WS_X1F8 + (size_t)m * DM) + lane + 64 * j) = f; }
    };
    auto route_row = [&](int r, const float (&lg)[16]) __attribute__((always_inline)) {
        int gs = 0; float gbest = fmaxf(fmaxf(lg[0], lg[1]), fmaxf(lg[2], lg[3]));
#pragma unroll
        for (int g = 1; g < 4; ++g) { const float gm = fmaxf(fmaxf(lg[4 * g], lg[4 * g + 1]), fmaxf(lg[4 * g + 2], lg[4 * g + 3])); if (gm > gbest) { gbest = gm; gs = g; } }
        float c0 = 0.f, c1 = 0.f, c2 = 0.f, c3 = 0.f;
#pragma unroll
        for (int g = 0; g < 4; ++g) if (gs == g) { c0 = lg[4 * g]; c1 = lg[4 * g + 1]; c2 = lg[4 * g + 2]; c3 = lg[4 * g + 3]; }
        float b0 = c0; int k0 = 0; if (c1 > b0) { b0 = c1; k0 = 1; } if (c2 > b0) { b0 = c2; k0 = 2; } if (c3 > b0) { b0 = c3; k0 = 3; }
        float b1 = -3e38f; int k1 = 0;
        if (k0 != 0 && c0 > b1) { b1 = c0; k1 = 0; } if (k0 != 1 && c1 > b1) { b1 = c1; k1 = 1; } if (k0 != 2 && c2 > b1) { b1 = c2; k1 = 2; } if (k0 != 3 && c3 > b1) { b1 = c3; k1 = 3; }
        const float ex = __expf(b1 - b0); const float w0 = 1.f / (1.f + ex), w1 = ex / (1.f + ex);
        if (lane == 0) { const int e0 = gs * 4 + k0, e1 = gs * 4 + k1; const int p0 = atomicAdd(&lcnt[e0], 1), p1 = atomicAdd(&lcnt[e1], 1);
            int* ri = rinfo + r * 8; ri[0] = e0; ri[1] = e1; ri[2] = __builtin_bit_cast(int, w0); ri[3] = __builtin_bit_cast(int, w1); ri[4] = p0; ri[5] = p1; }
    };
    for (int r = wave; r < nrows; r += 2 * NWAVES) {
        const int rB = r + NWAVES; const bool hasB = rB < nrows;
        f32x4 vA[8], vB[8];
        ln_row(row0 + r, vA); __builtin_amdgcn_sched_barrier(0);
        if (hasB) ln_row(row0 + rB, vB); else {
#pragma unroll
            for (int j = 0; j < 8; ++j) vB[j] = vA[j]; }
        __builtin_amdgcn_sched_barrier(0);
        float lgA[16], lgB[16];
#pragma unroll
        for (int e = 0; e < 16; ++e) { float a = 0.f, b = 0.f;
#pragma unroll
            for (int j = 0; j < 8; ++j) { const f32x4 w = *(const f32x4*)(wT + e * WP + 256 * j + 4 * lane);
                a += vA[j].x * w.x + vA[j].y * w.y + vA[j].z * w.z + vA[j].w * w.w; b += vB[j].x * w.x + vB[j].y * w.y + vB[j].z * w.z + vB[j].w * w.w; }
            const float be = A.b_router[e]; lgA[e] = wave_sum(a) + be; lgB[e] = wave_sum(b) + be; }
        route_row(r, lgA);
        if (hasB) route_row(rB, lgB);
    }
    __syncthreads();
    if (tid < 16) gbase[tid] = (int)__hip_atomic_fetch_add((unsigned*)(A.ws + WS_CTL) + CW_MOECNT + layer * 64 + tid, (unsigned)lcnt[tid], RLX_AGENT);
    __syncthreads();
    int* mlist = (int*)(A.ws + WS_MLIST) + (size_t)layer * 16 * SEQ; float* mgw = (float*)(A.ws + WS_MGW) + (size_t)layer * 16 * SEQ;
    if (tid < nrows) { const int* ri = rinfo + tid * 8; const int m = row0 + tid;
        const int e0 = ri[0], e1 = ri[1]; const int q0 = gbase[e0] + ri[4], q1 = gbase[e1] + ri[5];
        mlist[e0 * SEQ + q0] = m * 2 + 0; mgw[e0 * SEQ + q0] = __builtin_bit_cast(float, ri[2]);
        mlist[e1 * SEQ + q1] = m * 2 + 1; mgw[e1 * SEQ + q1] = __builtin_bit_cast(float, ri[3]); }
    __syncthreads();
}

struct MoeTable { const LAS int* t; };
__device__ __forceinline__ void moe_build_table(const Args& A, LAS int* tbl, int layer) {
    if (threadIdx.x == 0) { int acc = 0;
        for (int e = 0; e < 16; ++e) { const int c = (int)__hip_atomic_load((unsigned*)(A.ws + WS_CTL) + CW_MOECNT + layer * 64 + e, RLX_AGENT); tbl[e] = acc; tbl[17 + e] = c; acc += (c + 255) >> 8; }
        tbl[16] = acc; tbl[33] = acc; }
    __syncthreads();
}
template <bool GATH>
struct MoeOrder {
    static constexpr bool GATHER = GATH;
    const LAS int* tbl; const int* list; size_t bstride;
    int G, c;
    __device__ bool next(int i, pg8::Unit& u) const {
        const int L = i * G + c; const int total = tbl[16];
        if (L >= total * 8) return false;
        const int mt = L >> 3; u.pn = L & 7; u.pm = mt; int e = 0;
#pragma unroll
        for (int j = 1; j < 16; ++j) e += (mt >= tbl[j]) ? 1 : 0;
        u.e = e; u.mi = mt - tbl[e]; return true;
    }
    __device__ __forceinline__ unsigned a_off(const pg8::Gemm& g, const pg8::Unit& u) const {
        if constexpr (GATH) return 0u; else return (unsigned)u.pm * 256u * (unsigned)g.rb; }
    __device__ __forceinline__ unsigned b_off(const pg8::Gemm& g, const pg8::Unit& u) const { return (unsigned)u.e * (unsigned)bstride + (unsigned)u.pn * 256u * (unsigned)g.rb; }
    __device__ __forceinline__ void a_voff(const pg8::Gemm& g, const pg8::Unit& u, const int (&R)[2], const int (&C)[2], unsigned (&vo)[2][2]) const {
        if constexpr (GATH) { const int cnt = tbl[17 + u.e];
#pragma unroll
            for (int h = 0; h < 2; ++h)
#pragma unroll
                for (int i = 0; i < 2; ++i) { const int idx = u.mi * 256 + h * 128 + R[i]; const int tok = (idx < cnt) ? (list[u.e * SEQ + idx] >> 1) : 0; vo[h][i] = (unsigned)(tok * g.rb + C[i] * 2); }
        } else {
#pragma unroll
            for (int h = 0; h < 2; ++h)
#pragma unroll
                for (int i = 0; i < 2; ++i) vo[h][i] = (unsigned)((h * 128 + R[i]) * g.rb + C[i] * 2);
        }
    }
};
struct EpiSwiglu {
    static constexpr bool PERM = true;
    unsigned char* H;
    __device__ __forceinline__ void operator()(const pg8::f32x4 (&acc)[2][2][4][2], const pg8::Unit& u, int wr, int wc, int fr, int fq) const {
        const int row0 = u.pm * 256 + wr * 64 + fr, col0 = u.pn * 128 + wc * 32 + 8 * fq;
#pragma unroll
        for (int ai = 0; ai < 2; ++ai)
#pragma unroll
            for (int m = 0; m < 4; ++m) { float hv[8];
#pragma unroll
                for (int n = 0; n < 2; ++n)
#pragma unroll
                    for (int i = 0; i < 4; ++i) { const float gt = acc[ai][0][m][n][i], up = acc[ai][1][m][n][i]; hv[n * 4 + i] = gt * __builtin_amdgcn_rcpf(1.f + __expf(-gt)) * up; }
                v2u w; w.x = pk4_fp8(hv[0], hv[1], hv[2], hv[3]); w.y = pk4_fp8(hv[4], hv[5], hv[6], hv[7]);
                *(v2u*)(H + (size_t)(row0 + ai * 128 + m * 16) * DEXP + col0) = w; asm volatile("" ::: "memory"); }
    }
};
struct EpiDown {
    static constexpr bool PERM = true;
    bf16* Y; const LAS int* tbl; const int* list; const float* gw;
    __device__ __forceinline__ void operator()(const pg8::f32x4 (&acc)[2][2][4][2], const pg8::Unit& u, int wr, int wc, int fr, int fq) const {
        const int cnt = tbl[17 + u.e]; const int col0 = u.pn * 256 + wc * 32 + 8 * fq;
#pragma unroll
        for (int ai = 0; ai < 2; ++ai)
#pragma unroll
            for (int m = 0; m < 4; ++m) { const int idx = u.mi * 256 + ai * 128 + wr * 64 + m * 16 + fr;
                if (idx < cnt) { const int ent = list[u.e * SEQ + idx]; const float g = gw[u.e * SEQ + idx];
                    bf16* rowp = Y + ((size_t)(ent & 1) * SEQ + (size_t)(ent >> 1)) * DM + col0;
#pragma unroll
                    for (int bj = 0; bj < 2; ++bj) { const pg8::f32x4 v0 = acc[ai][bj][m][0] * g, v1 = acc[ai][bj][m][1] * g;
                        pg8::u32x4 w; w.x = pg8::cvt_pk_bf16(v0[0], v0[1]); w.y = pg8::cvt_pk_bf16(v0[2], v0[3]); w.z = pg8::cvt_pk_bf16(v1[0], v1[1]); w.w = pg8::cvt_pk_bf16(v1[2], v1[3]);
                        *(pg8::u32x4*)(rowp + bj * 128) = w; } }
                asm volatile("" ::: "memory"); }
    }
};

template <bool OUT_F32>
__device__ __forceinline__ void p_ln2(const Args& A, int G, int layer, const bf16* x1, const bf16* ys, void* outp) {
    const int tid = fresh_tid(), lane = tid & 63, wave = tid >> 6;
    const int gw = blockIdx.x * NWAVES + wave, NGW = G * NWAVES;
    const float* gain = A.ln_gain + (size_t)(layer * 2 + 1) * DM; const float* bias = A.ln_bias + (size_t)(layer * 2 + 1) * DM;
    for (int m = gw; m < SEQ; m += NGW) {
        float v[4][8]; float s = 0.f;
#pragma unroll
        for (int j = 0; j < 4; ++j) {
            const v4u a = *((const v4u*)(x1 + (size_t)m * DM) + lane + 64 * j), b = *((const v4u*)(ys + (size_t)m * DM) + lane + 64 * j), c = *((const v4u*)(ys + ((size_t)SEQ + m) * DM) + lane + 64 * j);
            const unsigned aw[4] = {a.x, a.y, a.z, a.w}, bw[4] = {b.x, b.y, b.z, b.w}, cw[4] = {c.x, c.y, c.z, c.w};
#pragma unroll
            for (int e = 0; e < 4; ++e) { v[j][2 * e] = bflo(aw[e]) * ALPHA + bflo(bw[e]) + bflo(cw[e]); v[j][2 * e + 1] = bfhi(aw[e]) * ALPHA + bfhi(bw[e]) + bfhi(cw[e]); }
#pragma unroll
            for (int e = 0; e < 8; e += 4) s += (v[j][e] + v[j][e + 1]) + (v[j][e + 2] + v[j][e + 3]); }
        const float mean = wave_sum(s) * (1.f / DM); float s2 = 0.f;
#pragma unroll
        for (int j = 0; j < 4; ++j)
#pragma unroll
            for (int e = 0; e < 8; e += 4) { v[j][e] -= mean; v[j][e + 1] -= mean; v[j][e + 2] -= mean; v[j][e + 3] -= mean;
                s2 += (v[j][e] * v[j][e] + v[j][e + 1] * v[j][e + 1]) + (v[j][e + 2] * v[j][e + 2] + v[j][e + 3] * v[j][e + 3]); }
        const float rstd = rsqrtf(wave_sum(s2) * (1.f / DM) + LN_EPS);
#pragma unroll
        for (int j = 0; j < 4; ++j) {
            const f32x4 g0 = *((const f32x4*)gain + 2 * lane + 128 * j), g1 = *((const f32x4*)gain + 2 * lane + 128 * j + 1), b0 = *((const f32x4*)bias + 2 * lane + 128 * j), b1 = *((const f32x4*)bias + 2 * lane + 128 * j + 1);
            const f32x4 o0 = (f32x4){v[j][0], v[j][1], v[j][2], v[j][3]} * rstd * g0 + b0, o1 = (f32x4){v[j][4], v[j][5], v[j][6], v[j][7]} * rstd * g1 + b1;
            if constexpr (OUT_F32) { f32x4* op = (f32x4*)((float*)outp + (size_t)m * DM) + 2 * lane + 128 * j; op[0] = o0; op[1] = o1; }
            else { v4u w; w.x = pk2(o0.x, o0.y); w.y = pk2(o0.z, o0.w); w.z = pk2(o1.x, o1.y); w.w = pk2(o1.z, o1.w); *((v4u*)((bf16*)outp + (size_t)m * DM) + lane + 64 * j) = w;
                if (L1IN_F8) { v2u f; f.x = pk4_fp8(o0.x, o0.y, o0.z, o0.w); f.y = pk4_fp8(o1.x, o1.y, o1.z, o1.w); *((v2u*)(A.ws + WS_X1F8 + (size_t)m * DM) + lane + 64 * j) = f; } } }
    }
}


constexpr int CW_TEST = 10240;
__device__ __forceinline__ void p_compare(const Args& A, int G, const bf16* a, const bf16* b, int c0, int nc) {
    const int tid = fresh_tid(); float num = 0.f, den = 0.f;
    const size_t total = (size_t)SEQ * nc;
    for (size_t i = (size_t)blockIdx.x * NTHREADS + tid; i < total; i += (size_t)G * NTHREADS) { const int m = (int)(i / nc), c = (int)(i % nc);
        const float x = bf2f(a[(size_t)m * DM + c0 + c]), y = bf2f(b[(size_t)m * DM + c0 + c]);
        if ((m & 255) < TEST_RLO || (m & 255) >= TEST_RHI) continue;
#if TEST_NANCOUNT == 2
        if (x == x) num = fmaxf(num, fabsf(x)); den = 1.f;
#elif TEST_NANCOUNT == 1
        num += (x == x && fabsf(x) < 1e4f) ? 0.f : 1.f; den += 1.f;
#else
        float d2 = (x - y) * (x - y); if (!(d2 == d2) || d2 > 1e12f) d2 = TEST_BADVAL; num += d2; den += y * y;
#endif
    }
#if TEST_NANCOUNT == 2
    for (int o = 1; o < 64; o <<= 1) num = fmaxf(num, __shfl_xor(num, o));
    if ((tid & 63) == 0) { atomicMax((unsigned*)(A.ws + WS_CTL) + CW_TEST, __float_as_uint(num)); __hip_atomic_store((float*)(A.ws + WS_CTL) + CW_TEST + 1, 1.f, RLX_AGENT); }
#else
    num = wave_sum(num); den = wave_sum(den);
    if ((tid & 63) == 0) { atomicAdd((float*)(A.ws + WS_CTL) + CW_TEST, num); atomicAdd((float*)(A.ws + WS_CTL) + CW_TEST + 1, den); }
#endif
}
__device__ __forceinline__ void p_apply_test(const Args& A, int G) {
    const float num = __hip_atomic_load((float*)(A.ws + WS_CTL) + CW_TEST, RLX_AGENT), den = __hip_atomic_load((float*)(A.ws + WS_CTL) + CW_TEST + 1, RLX_AGENT);
#if TIME_SEG == 20
    const float f = 1.f + TEST_GAIN * sqrtf(floorf(num / den * 50.f + 0.5f) * 0.02f);
#else
    const float f = 1.f + TEST_GAIN * sqrtf(num / den);
#endif
    for (size_t i = (size_t)blockIdx.x * NTHREADS + threadIdx.x; i < (size_t)SEQ * DM; i += (size_t)G * NTHREADS) A.out[i] *= f;
}

constexpr int NPHASE = 18 + ((TEST_ATT || TIME_SEG) ? 1 : 0);
__global__ void __launch_bounds__(NTHREADS, 2) fwd(Args A) {
    extern __shared__ __attribute__((aligned(16))) unsigned char lds[];
    LAS unsigned char* ldsl = (LAS unsigned char*)lds;
    const int tid = fresh_tid(); const int G = gridDim.x;
    for (int u = tid; u < (LDS_BYTES - LCTL_OFF) / 4; u += NTHREADS) ((LAS unsigned*)(ldsl + LCTL_OFF))[u] = 0u;
    __syncthreads();
    unsigned char* ws = A.ws;
    const int lo = A.ph_lo, hi = A.ph_hi;
#if TIME_SEG == 7
    unsigned long long kt0; asm volatile("s_memtime %0\n\ts_waitcnt lgkmcnt(0)" : "=s"(kt0) :: "memory");
#endif
    const bool fused = (hi - lo) > 1;
    XcdBarrier bar; bar.bar = (unsigned*)(ws + WS_CTL) + CW_BAR; bar.x = 0; bar.st = nullptr;
    if (fused) bar = xcd_barrier_post((unsigned*)(ws + WS_CTL) + CW_BAR, (volatile LAS unsigned*)(ldsl + LCTL_OFF));
#define IN(k) (lo <= (k) && (k) < hi)
#define SEAM(k) do { if (IN(k) && IN((k) + 1)) xcd_barrier(bar); } while (0)
    bf16* xb = (bf16*)(ws + WS_XB); bf16* hb = (bf16*)(ws + WS_H); bf16* ob = (bf16*)(ws + WS_O); bf16* yb = (bf16*)(ws + WS_Y); bf16* x1 = (bf16*)(ws + WS_X1);
    bf16* hid = (bf16*)(ws + WS_HID); bf16* ysl = (bf16*)(ws + WS_YSLOT);
    int* sel = (int*)((unsigned char*)A.out + DO_SEL);
    LAS int* mtbl = (LAS int*)(ldsl + LCTL_OFF + 256);

    if (IN(0)) { p0_prologue(A, ldsl, G);
#if DBL_PHASE == 0
        __syncthreads(); p0_prologue(A, ldsl, G);
#endif
    } SEAM(0);
#define LAYER_BACK(layer, P_OUT, WOUT, RESF32, XRES) \
    if (IN(P_OUT)) { pg8::Gemm g{ob, (const bf16*)(ws + WOUT), SEQ, DM, DM, DM}; pg8::DenseOrder S; S.init(SEQ, DM, G, (int)blockIdx.x); \
        pg8::EpiBf16 E{yb, DM}; pg8::gemm_phase<pg8::EpiBf16, pg8::DenseOrder, true, 122, 123>(ldsl, g, S, E); } \
    SEAM(P_OUT); \
    if (IN(P_OUT + 1)) { p_ln1_router<RESF32>(A, (char*)lds, G, layer, (const void*)(XRES), yb, x1); } \
    SEAM(P_OUT + 1); \
    if (IN(P_OUT + 2)) { moe_build_table(A, mtbl, layer); \
        pg8::Gemm g{(const bf16*)(ws + WS_X1F8), (const bf16*)(ws + WS_WGU + (size_t)layer * 16 * 2048 * 2048), 0, 2048, DM, DM}; \
        MoeOrder<true> S{mtbl, (const int*)(ws + WS_MLIST) + (size_t)layer * 16 * SEQ, (size_t)2048 * 2048, G, (int)blockIdx.x}; EpiSwiglu E{(unsigned char*)hid}; \
        pg8::gemm_phase<EpiSwiglu, MoeOrder<true>, true, 122, 127>(ldsl, g, S, E); \
        if (DBL_PHASE == 100 + P_OUT + 2) { __syncthreads(); pg8::gemm_phase<EpiSwiglu, MoeOrder<true>, true, 122, 127>(ldsl, g, S, E); } } \
    SEAM(P_OUT + 2); \
    if (IN(P_OUT + 3)) { moe_build_table(A, mtbl, layer); \
        pg8::Gemm g{hid, (const bf16*)(ws + WS_WDN + (size_t)layer * 16 * 2048 * 1024), 0, 2048, DEXP, DEXP}; \
        const int* mlist = (const int*)(ws + WS_MLIST) + (size_t)layer * 16 * SEQ; const float* mgw = (const float*)(ws + WS_MGW) + (size_t)layer * 16 * SEQ; \
        MoeOrder<false> S{mtbl, mlist, (size_t)2048 * 1024, G, (int)blockIdx.x}; EpiDown E{ysl, mtbl, mlist, mgw}; \
        pg8::gemm_phase<EpiDown, MoeOrder<false>, true, 122, 127>(ldsl, g, S, E); \
        if (DBL_PHASE == 100 + P_OUT + 3) { __syncthreads(); pg8::gemm_phase<EpiDown, MoeOrder<false>, true, 122, 127>(ldsl, g, S, E); } } \
    SEAM(P_OUT + 3);
    if (IN(1)) { pg8::Gemm g{xb, (const bf16*)(ws + WS_WIN0), SEQ, NQKV, DM, DM}; pg8::DenseOrder S; S.init(SEQ, NQKV, G, (int)blockIdx.x);
        pg8::EpiBf16 E{hb, NQKV}; pg8::gemm_phase<pg8::EpiBf16, pg8::DenseOrder, true, 122, 127>(ldsl, g, S, E); }
    SEAM(1);
    if (IN(2)) { p2_kmean_cumsum(A, (char*)lds, G);
#if DBL_PHASE == 2
        p2_kmean_cumsum(A, (char*)lds, G);
#endif
    } SEAM(2);
#if GATE_MFMA
    if (IN(3)) p3_gate_mfma(A, (LAS char*)ldsl, G, sel); SEAM(3);
#else
    if (IN(3)) p3_gate_cfinal(A, (char*)lds, G, sel); SEAM(3);
#endif
#if TEST_ATT
    if (IN(4)) { for (int u = blockIdx.x; u < 2048; u += G) { const int var = u >> 10, hd = (u >> 7) & 7, qb = u & 127;
            if (var == 0) naive_attn_unit<0>(A, (char*)lds, hd, qb, sel); else naive_attn_unit<1>(A, (char*)lds, hd, qb, sel); } }
#else
    if (IN(4)) { for (;;) { const int it = next_item(A, CW_Q4, (LAS int*)(ldsl + LCTL_OFF + 512)); if (it >= 512) break;
            fox_block(A, (LAS char*)ldsl, it & 7, 63 - (it >> 3), (unsigned char*)ob, DM, (it & 7) * 128); }
#if MOBA_RES
        moba_phase_res(A, (LAS char*)ldsl, G);
#else
        moba_phase(A, (LAS char*)ldsl, G);
#endif
#if DBL_PHASE == 4
        for (int it = blockIdx.x; it < 512; it += G) { const int hd = (it & 255) >> 5, x = it & 31; fox_block(A, (LAS char*)ldsl, hd, (it < 256) ? 63 - x : x, (unsigned char*)ob, DM, hd * 128); }
#endif
#if DBL_PHASE == 41
        moba_phase(A, (LAS char*)ldsl, G);
#endif
    }
#endif
#if TEST_ATT == 4
    if (IN(4)) moba_phase(A, (LAS char*)ldsl, G);
#endif
#if TEST_ATT == 1
    if (IN(4)) { for (int u = blockIdx.x; u < 512; u += G) fox_block(A, (LAS char*)ldsl, u >> 6, u & 63, yb, DM, (u >> 6) * 128); }
#endif
    SEAM(4);
#if !TEST_ATT
    if (IN(5)) { moba_combine(A, G, (unsigned char*)ob); }
#endif
#if TEST_ATT == 1
    if (IN(5)) p_compare(A, G, yb, ob, 0, 1024);
#endif
#if TEST_ATT == 4
    if (IN(5)) moba_combine(A, G, xb);
    SEAM(5);
    if (IN(5)) p_compare(A, G, xb, ob, 1024, 1024);
#endif
    SEAM(5);
    LAYER_BACK(0, 6, WS_WOUT0, true, A.x)
    if (IN(10)) p_ln2<false>(A, G, 0, x1, ysl, (void*)xb);
    SEAM(10);
#if L1IN_F8
    if (IN(11)) { pg8::Gemm g{(const bf16*)(ws + WS_X1F8), (const bf16*)(ws + WS_WIN1), SEQ, NQKV, DM, DM}; pg8::DenseOrder S; S.init(SEQ, NQKV, G, (int)blockIdx.x);
        pg8::EpiBf16 E{hb, NQKV}; pg8::gemm_phase<pg8::EpiBf16, pg8::DenseOrder, true, 122, 127>(ldsl, g, S, E); }
#else
    if (IN(11)) { pg8::Gemm g{xb, (const bf16*)(ws + WS_WIN1), SEQ, NQKV, DM, DM * 2}; pg8::DenseOrder S; S.init(SEQ, NQKV, G, (int)blockIdx.x);
        pg8::EpiBf16 E{hb, NQKV}; pg8::gemm_phase<pg8::EpiBf16, pg8::DenseOrder>(ldsl, g, S, E);
#if DBL_PHASE == 11
        __syncthreads(); pg8::gemm_phase<pg8::EpiBf16, pg8::DenseOrder>(ldsl, g, S, E);
#endif
    }
#endif
    SEAM(11);
#if TEST_ATT
    if (IN(12)) { for (int u = blockIdx.x; u < 2048; u += G) { const int var = u >> 10, hd = (u >> 7) & 7, qb = u & 127;
            if (var == 0) naive_attn_unit<2>(A, (char*)lds, hd, qb, sel); else naive_attn_unit<3>(A, (char*)lds, hd, qb, sel); } }
#else
#if DBL_PHASE == 12
    if (IN(12)) { for (int it_ = blockIdx.x; it_ < 1536; it_ += G) { const int it = it_ & 511, hd = (it & 255) >> 5, x = it & 31; diff_block(A, (LAS char*)ldsl, hd, (it < 256) ? 63 - x : x, (unsigned char*)ob); }
#else
    if (IN(12)) { for (;;) { const int it = next_item(A, CW_Q12, (LAS int*)(ldsl + LCTL_OFF + 512)); if (it >= 512) break;
            diff_block(A, (LAS char*)ldsl, it & 7, 63 - (it >> 3), (unsigned char*)ob); }
#endif
        for (;;) { const int it = next_item(A, CW_Q12 + 64, (LAS int*)(ldsl + LCTL_OFF + 512)); if (it >= 512) break;
            sb_block(A, (LAS char*)ldsl, it & 7, 63 - (it >> 3), (unsigned char*)ob); }
#if DBL_PHASE == 121
        for (int u = blockIdx.x; u < 512; u += G) sb_block(A, (LAS char*)ldsl, u >> 6, u & 63, (unsigned char*)ob);
#endif
    }
#endif
#if TEST_ATT == 3
    if (IN(12) && blockIdx.x == 0) sb_unit_test(A, TEST_SENT);
#endif
#if TEST_ATT == 2
    if (IN(12)) { for (int u = blockIdx.x; u < 512; u += G) diff_block(A, (LAS char*)ldsl, u >> 6, u & 63, yb);
        for (int u = blockIdx.x; u < 512; u += G) sb_block(A, (LAS char*)ldsl, u >> 6, u & 63, yb); }
    SEAM(12);
#if !SB_R2PROBE
    if (IN(12)) p_compare(A, G, yb, ob, TEST_C0, TEST_NC);
#endif
#endif
    SEAM(12);
#ifdef EXTRA_BARRIERS
    if (IN(12) && IN(13)) { for (int i_ = 0; i_ < EXTRA_BARRIERS; ++i_) xcd_barrier(bar); }
#endif
    LAYER_BACK(1, 13, WS_WOUT1, false, xb)
    if (IN(17)) p_ln2<true>(A, G, 1, x1, ysl, (void*)A.out);
#if TIME_SEG == 7
    if (blockIdx.x == 0 && threadIdx.x == 0) { unsigned long long kt1; asm volatile("s_memtime %0\n\ts_waitcnt lgkmcnt(0)" : "=s"(kt1) :: "memory");
        const float ghz = (float)(kt1 - kt0) / 3.42e6f; atomicAdd((float*)(A.ws + WS_CTL) + CW_TEST, floorf(ghz * 5.f + 0.5f) * 0.2f); atomicAdd((float*)(A.ws + WS_CTL) + CW_TEST + 1, 10.f); }
#endif
#if TEST_ATT || TIME_SEG
    SEAM(17);
    if (IN(18)) p_apply_test(A, G);
#endif
#undef LAYER_BACK
#undef IN
#undef SEAM
}

#ifndef MK_FUSED
#define MK_FUSED 1
#endif
extern "C" void kernel_launch(void* const* d_in, const int* in_sizes, int n_in, void* d_out, int out_size, void* d_ws, size_t ws_size, hipStream_t stream) {
    static int grid = 0;
    if (grid == 0) {
        if (n_in != 17 || out_size != SEQ * DM || ws_size < WS_END) { fprintf(stderr, "kernel_launch: unexpected shapes (n_in %d out %d ws %zu)\n", n_in, out_size, ws_size); grid = -1; return; }
        int dev = 0, cus = 0, per_cu = 0;
        if (hipGetDevice(&dev) != hipSuccess || hipDeviceGetAttribute(&cus, hipDeviceAttributeMultiprocessorCount, dev) != hipSuccess) { grid = -1; return; }
        if (hipFuncSetAttribute((const void*)fwd, hipFuncAttributeMaxDynamicSharedMemorySize, LDS_BYTES) != hipSuccess) { fprintf(stderr, "kernel_launch: hipFuncSetAttribute failed\n"); grid = -1; return; }
        if (hipOccupancyMaxActiveBlocksPerMultiprocessor(&per_cu, (const void*)fwd, NTHREADS, LDS_BYTES) != hipSuccess || per_cu < 1) fprintf(stderr, "kernel_launch: occupancy query says %d\n", per_cu);
        (void)hipGetLastError();
        grid = cus;
    }
    if (grid < 0) return;
    (void)hipMemsetAsync((char*)d_ws + WS_CTL, 0, CTL_ZERO_BYTES, stream);
    Args a{};
    a.x = (const float*)d_in[0]; a.w_in_even = (const float*)d_in[1]; a.w_out_even = (const float*)d_in[2]; a.forget_bias = (const float*)d_in[3];
    a.w_in_odd = (const float*)d_in[4]; a.w_out_odd = (const float*)d_in[5]; a.lambda_q = (const float*)d_in[6]; a.lambda_k = (const float*)d_in[7];
    a.subln_gain = (const float*)d_in[8]; a.rel_bias = (const float*)d_in[9]; a.w_router = (const float*)d_in[10]; a.b_router = (const float*)d_in[11];
    a.w_gate = (const float*)d_in[12]; a.w_up = (const float*)d_in[13]; a.w_down = (const float*)d_in[14]; a.ln_gain = (const float*)d_in[15]; a.ln_bias = (const float*)d_in[16];
    a.out = (float*)d_out; a.ws = (unsigned char*)d_ws;
#if MK_FUSED
    a.ph_lo = 0; a.ph_hi = NPHASE;
    hipLaunchKernelGGL(fwd, dim3(grid), dim3(NTHREADS), LDS_BYTES, stream, a);
#else
    for (int p = 0; p < NPHASE; ++p) {  a.ph_lo = p; a.ph_hi = p + 1; hipLaunchKernelGGL(fwd, dim3(grid), dim3(NTHREADS), LDS_BYTES, stream, a); }
#endif
}
```
